# Optimizing an MI355X kernel written in HIP

```python
import jax
import jax.numpy as jnp
from jax import lax
import numpy as np

D_MODEL = 1024
BATCH = 4
SEQ = 8192
DEPTH = 2

N_GROUPS = 4
D_GROUP = D_MODEL // N_GROUPS
HEAD_DIM = 64
N_HEADS = D_GROUP // HEAD_DIM
CHUNK = 64
CONF_KERNEL = 31
SHORT_CONV = 4
ROPE_BASE = 10000.0
D_FF = -(-8 * D_MODEL // (3 * 256)) * 256
IN_SIZES = (D_GROUP, D_GROUP, D_GROUP, D_GROUP,
            D_GROUP, D_GROUP,
            D_GROUP, D_GROUP, D_GROUP, D_GROUP,
            N_HEADS, N_HEADS,
            D_GROUP, D_GROUP, D_GROUP, D_GROUP)
D_IN = 14 * D_GROUP + 2 * N_HEADS

kernel_name = 'hybrid_parallel_head_groups_trunk'


def rms_norm(x, w, eps=1e-6):
    xf = x.astype(jnp.float32)
    y = xf * lax.rsqrt(jnp.mean(xf * xf, axis=-1, keepdims=True) + eps)
    return (y * w.astype(jnp.float32)).astype(x.dtype)


def layer_norm(x, w, b, eps=1e-5):
    mu = jnp.mean(x, axis=-1, keepdims=True)
    var = jnp.mean(jnp.square(x - mu), axis=-1, keepdims=True)
    return (x - mu) * lax.rsqrt(var + eps) * w.astype(jnp.float32) + b.astype(jnp.float32)


def head_rms_norm(o, w, eps=1e-6):
    y = o * lax.rsqrt(jnp.mean(o * o, axis=-1, keepdims=True) + eps) * w.astype(jnp.float32)
    return y.reshape(o.shape[0], o.shape[1], -1)


def head_group_norm(o, w, eps=1e-5):
    mu = jnp.mean(o, axis=-1, keepdims=True)
    var = jnp.mean(jnp.square(o - mu), axis=-1, keepdims=True)
    y = (o - mu) * lax.rsqrt(var + eps) * w.astype(jnp.float32).reshape(N_HEADS, HEAD_DIM)
    return y.reshape(o.shape[0], o.shape[1], -1)


def l2_normalize(x, eps=1e-6):
    return x * lax.rsqrt(jnp.sum(x * x, axis=-1, keepdims=True) + eps)


def split_heads(t):
    b, s, _ = t.shape
    return t.reshape(b, s, -1, HEAD_DIM).transpose(0, 2, 1, 3)


def to_chunks(t):
    b, h, s = t.shape[:3]
    t = t.reshape(b, h, s // CHUNK, CHUNK, *t.shape[3:])
    return jnp.moveaxis(t, 2, 0)


def from_chunks(t):
    n, b, h, c, dv = t.shape
    return jnp.moveaxis(t, 0, 2).reshape(b, h, n * c, dv).transpose(0, 2, 1, 3)


def causal_depthwise_conv(x, w):
    k, c = w.shape
    return lax.conv_general_dilated(
        x, w.astype(x.dtype)[:, None, :], window_strides=(1,), padding=[(k - 1, 0)],
        dimension_numbers=('NWC', 'WIO', 'NWC'), feature_group_count=c)


def apply_rotary(x, pos):
    half = HEAD_DIM // 2
    inv = ROPE_BASE ** (-jnp.arange(half, dtype=jnp.float32) / half)
    ang = pos[:, None] * inv[None, :]
    cos, sin = jnp.cos(ang), jnp.sin(ang)
    x1, x2 = x[..., :half], x[..., half:]
    return jnp.concatenate([x1 * cos - x2 * sin, x1 * sin + x2 * cos], axis=-1)


def retention_mixer(q, k, v):
    q, k, v = split_heads(q), split_heads(k), split_heads(v)
    pos = jnp.arange(q.shape[2], dtype=jnp.float32)
    q = apply_rotary(q, pos)
    k = apply_rotary(k, pos) * HEAD_DIM ** -0.5
    log_gamma = jnp.log1p(-(2.0 ** (-5.0 - jnp.arange(N_HEADS, dtype=jnp.float32))))
    idx = jnp.arange(CHUNK, dtype=jnp.float32)
    diff = idx[:, None] - idx[None, :]
    decay_mask = jnp.where(diff >= 0, jnp.exp(jnp.maximum(diff, 0.0) * log_gamma[:, None, None]), 0.0)
    q_decay = jnp.exp((idx + 1.0) * log_gamma[:, None])[..., None]
    k_decay = jnp.exp((CHUNK - 1.0 - idx) * log_gamma[:, None])[..., None]
    chunk_decay = jnp.exp(CHUNK * log_gamma)[:, None, None]

    def step(state, inp):
        qc, kc, vc = inp
        scores = jnp.einsum('bhid,bhjd->bhij', qc, kc) * decay_mask
        out = (jnp.einsum('bhij,bhjv->bhiv', scores, vc)
               + jnp.einsum('bhid,bhdv->bhiv', qc * q_decay, state))
        state = state * chunk_decay + jnp.einsum('bhjd,bhjv->bhdv', kc * k_decay, vc)
        return state, out

    s0 = jnp.zeros((q.shape[0], N_HEADS, HEAD_DIM, HEAD_DIM), jnp.float32)
    _, out = lax.scan(step, s0, (to_chunks(q), to_chunks(k), to_chunks(v)))
    return from_chunks(out)


def conformer_conv_mixer(a, gate, conv_w, conv_b, ln_w, ln_b):
    glu = a * jax.nn.sigmoid(gate)
    y = causal_depthwise_conv(glu, conv_w) + conv_b.astype(jnp.float32)
    return jax.nn.silu(layer_norm(y, ln_w, ln_b))


def gated_deltanet_mixer(q, k, v, beta_logit, a_logit, A_log, dt_bias):
    q = l2_normalize(split_heads(q)) * HEAD_DIM ** -0.5
    k = l2_normalize(split_heads(k))
    v = split_heads(v)
    beta = jax.nn.sigmoid(beta_logit).transpose(0, 2, 1)
    g = (-jnp.exp(A_log.astype(jnp.float32))
         * jax.nn.softplus(a_logit + dt_bias.astype(jnp.float32))).transpose(0, 2, 1)
    idx = jnp.arange(CHUNK)
    incl = idx[:, None] >= idx[None, :]
    strict = idx[:, None] > idx[None, :]

    def step(state, inp):
        qc, kc, vc, bc, gc = inp
        G = jnp.cumsum(gc, axis=-1)
        L = jnp.exp(jnp.where(incl, G[..., :, None] - G[..., None, :], -jnp.inf))
        kb = kc * bc[..., None]
        A = jnp.where(strict, jnp.einsum('bhid,bhjd->bhij', kb, kc) * L, 0.0)
        rhs = jnp.concatenate([vc * bc[..., None], kb * jnp.exp(G)[..., None]], axis=-1)
        sol = lax.linalg.triangular_solve(A, rhs, left_side=True, lower=True, unit_diagonal=True)
        u, w = sol[..., :HEAD_DIM], sol[..., HEAD_DIM:]
        v_new = u - jnp.einsum('bhik,bhkv->bhiv', w, state)
        attn = jnp.einsum('bhid,bhjd->bhij', qc, kc) * L
        out = (jnp.einsum('bhid,bhdv->bhiv', qc * jnp.exp(G)[..., None], state)
               + jnp.einsum('bhij,bhjv->bhiv', attn, v_new))
        g_last = G[..., -1:]
        state = (state * jnp.exp(g_last)[..., None]
                 + jnp.einsum('bhjd,bhjv->bhdv', kc * jnp.exp(g_last - G)[..., None], v_new))
        return state, out

    s0 = jnp.zeros((q.shape[0], N_HEADS, HEAD_DIM, HEAD_DIM), jnp.float32)
    _, out = lax.scan(step, s0, (to_chunks(q), to_chunks(k), to_chunks(v), to_chunks(beta), to_chunks(g)))
    return from_chunks(out)


def hgrn2_mixer(q, f_logit, i, lb):
    lb = lb.astype(jnp.float32)
    log_f = jnp.logaddexp(jnp.log(lb), jnp.log1p(-lb) + jax.nn.log_sigmoid(f_logit))
    k = -jnp.expm1(log_f)
    q, k, v, gf = split_heads(q), split_heads(k), split_heads(i), split_heads(log_f)
    idx = jnp.arange(CHUNK)
    incl = (idx[:, None] >= idx[None, :])[:, :, None]

    def step(state, inp):
        qc, kc, vc, gc = inp
        G = jnp.cumsum(gc, axis=2)
        dec = jnp.exp(jnp.where(incl, G[:, :, :, None, :] - G[:, :, None, :, :], -jnp.inf))
        scores = jnp.einsum('bhid,bhijd,bhjd->bhij', qc, dec, kc)
        out = (jnp.einsum('bhij,bhjv->bhiv', scores, vc)
               + jnp.einsum('bhid,bhdv->bhiv', qc * jnp.exp(G), state))
        g_last = G[:, :, -1:, :]
        state = (state * jnp.exp(g_last[:, :, 0, :])[..., None]
                 + jnp.einsum('bhjd,bhjv->bhdv', kc * jnp.exp(g_last - G), vc))
        return state, out

    s0 = jnp.zeros((q.shape[0], N_HEADS, HEAD_DIM, HEAD_DIM), jnp.float32)
    _, out = lax.scan(step, s0, (to_chunks(q), to_chunks(k), to_chunks(v), to_chunks(gf)))
    return from_chunks(out)


def setup_inputs(seed: int = 0) -> dict:
    key = jax.random.key(seed)
    ks = jax.random.split(key, 20)
    f32 = jnp.float32
    nrm = lambda k, shape, scale: jax.random.normal(k, shape, f32) * scale
    gain = lambda k, shape: 1.0 + 0.02 * jax.random.normal(k, shape, f32)
    dt = jnp.exp(jax.random.uniform(ks[10], (DEPTH, N_HEADS), f32, minval=np.log(1e-3), maxval=np.log(1e-1)))
    return {
        'x': jax.random.normal(ks[0], (BATCH, SEQ, D_MODEL), f32),
        'norm_mix_w': gain(ks[1], (DEPTH, D_MODEL)),
        'w_in': nrm(ks[2], (DEPTH, D_MODEL, D_IN), D_MODEL ** -0.5),
        'ret_norm_w': gain(ks[3], (DEPTH, D_GROUP)),
        'conf_conv_w': nrm(ks[4], (DEPTH, CONF_KERNEL, D_GROUP), CONF_KERNEL ** -0.5),
        'conf_conv_b': nrm(ks[5], (DEPTH, D_GROUP), 0.02),
        'conf_ln_w': gain(ks[6], (DEPTH, D_GROUP)),
        'conf_ln_b': nrm(ks[7], (DEPTH, D_GROUP), 0.02),
        'gdn_conv_w': nrm(ks[8], (DEPTH, SHORT_CONV, 3 * D_GROUP), SHORT_CONV ** -0.5),
        'gdn_A_log': jnp.log(jax.random.uniform(ks[9], (DEPTH, N_HEADS), f32, minval=1.0, maxval=16.0)),
        'gdn_dt_bias': dt + jnp.log(-jnp.expm1(-dt)),
        'gdn_norm_w': gain(ks[11], (DEPTH, HEAD_DIM)),
        'hgrn_lb_logits': nrm(ks[12], (DEPTH, D_GROUP), 0.1),
        'hgrn_norm_w': gain(ks[13], (DEPTH, HEAD_DIM)),
        'w_out': nrm(ks[14], (DEPTH, D_MODEL, D_MODEL), D_MODEL ** -0.5),
        'norm_ffn_w': gain(ks[15], (DEPTH, D_MODEL)),
        'ffn_w_gate': nrm(ks[16], (DEPTH, D_MODEL, D_FF), D_MODEL ** -0.5),
        'ffn_w_up': nrm(ks[17], (DEPTH, D_MODEL, D_FF), D_MODEL ** -0.5),
        'ffn_w_down': nrm(ks[18], (DEPTH, D_FF, D_MODEL), D_FF ** -0.5),
        'final_norm_w': gain(ks[19], (D_MODEL,)),
    }


def reference(x, norm_mix_w, w_in, ret_norm_w, conf_conv_w, conf_conv_b, conf_ln_w, conf_ln_b,
              gdn_conv_w, gdn_A_log, gdn_dt_bias, gdn_norm_w, hgrn_lb_logits, hgrn_norm_w,
              w_out, norm_ffn_w, ffn_w_gate, ffn_w_up, ffn_w_down, final_norm_w):
    b, t = x.shape[0], x.shape[1]
    offsets = [int(o) for o in np.cumsum(IN_SIZES)[:-1]]
    lb_all = jnp.cumsum(jax.nn.softmax(hgrn_lb_logits.astype(jnp.float32), axis=0), axis=0)
    lb_all = lb_all - lb_all[0:1]
    for l in range(DEPTH):
        h = rms_norm(x, norm_mix_w[l])
        proj = (h @ w_in[l]).astype(jnp.float32)
        (rq, rk, rv, rg, ca, cg, gq, gk, gv, gg, gb, ga, hq, hf, hi, hgate) = jnp.split(proj, offsets, axis=-1)
        ret = head_group_norm(retention_mixer(rq, rk, rv), ret_norm_w[l]) * jax.nn.silu(rg)
        conf = conformer_conv_mixer(ca, cg, conf_conv_w[l], conf_conv_b[l], conf_ln_w[l], conf_ln_b[l])
        qkv = jax.nn.silu(causal_depthwise_conv(jnp.concatenate([gq, gk, gv], axis=-1), gdn_conv_w[l]))
        gq, gk, gv = jnp.split(qkv, [D_GROUP, 2 * D_GROUP], axis=-1)
        gdn = head_rms_norm(gated_deltanet_mixer(gq, gk, gv, gb, ga, gdn_A_log[l], gdn_dt_bias[l]),
                            gdn_norm_w[l]) * jax.nn.silu(gg)
        hg = head_rms_norm(hgrn2_mixer(hq, hf, hi, lb_all[l]), hgrn_norm_w[l]) * jax.nn.silu(hgate)
        mix = jnp.concatenate([ret, conf, gdn, hg], axis=-1).astype(x.dtype)
        x = x + mix @ w_out[l]
        h = rms_norm(x, norm_ffn_w[l])
        x = x + (jax.nn.silu(h @ ffn_w_gate[l]) * (h @ ffn_w_up[l])) @ ffn_w_down[l]
    return rms_norm(x, final_norm_w)
```

```cpp
#include <hip/hip_runtime.h>
#include <hip/hip_cooperative_groups.h>
#include <cstdio>
#include <cstdint>
namespace cg = cooperative_groups;

#ifndef MIX_MASK
#define MIX_MASK 15
#endif
namespace pg8 {
#define PG8_LAS __attribute__((address_space(3)))
typedef unsigned short bf16_t;
typedef short bf16x8 __attribute__((ext_vector_type(8)));
typedef float f32x4 __attribute__((ext_vector_type(4)));
typedef unsigned u32x4 __attribute__((ext_vector_type(4)));
constexpr int BM = 256, BK = 64, HALF = 128, HTB = HALF * BK * 2  , STAGE_BYTES = 8 * HTB, NXCD = 8, WGM = 8;

__host__ __device__ __forceinline__ int lds_byte(int r, int c) { const int st = (r >> 4) * 2 + (c >> 5), rr = r & 15, cc = c & 31, ob = rr * 64 + cc * 2; return st * 1024 + (ob ^ (((ob >> 9) & 1) << 5)); }
__host__ __device__ __forceinline__ void stage_rc(int b, int& R, int& C) { const int st = b / 1024, sb = b % 1024, swz = sb ^ (((sb >> 9) & 1) << 5); R = (st >> 1) * 16 + swz / 64; C = (st & 1) * 32 + (swz % 64) / 2; }
__host__ __device__ __forceinline__ int perm32(int rho) { const int n = rho >> 4, i = rho & 15; return 8 * (i >> 2) + 4 * n + (i & 3); }

struct Unit { int pm, pn; };
struct Gemm { const bf16_t* A; const bf16_t* Bt; int M, N, K; };

struct StaticOrder {
    int nM, nN, nwg, G, c;
    __host__ __device__ void init(int M, int N, int G_, int c_) { nM = M / BM; nN = N / BM; nwg = nM * nN; G = G_; c = c_; }
    __host__ __device__ bool next(int i, Unit& u) const {
        const long L = (long)i * G + c; if (L >= nwg) return false;
        int wgid = (int)L; { const int q = nwg / NXCD, r = nwg % NXCD, xcd = wgid % NXCD, off = wgid / NXCD; wgid = (xcd < r ? xcd * (q + 1) : r * (q + 1) + (xcd - r) * q) + off; }
        const int nig = WGM * nN, gid = wgid / nig, fm = gid * WGM, gsz = (nM - fm) < WGM ? (nM - fm) : WGM;
        u.pm = fm + ((wgid % nig) % gsz); u.pn = (wgid % nig) / gsz; return true;
    }
    __device__ __forceinline__ void a_ready(const Unit&) const {}
    __device__ __forceinline__ void done(const Unit&) const {}
};

__device__ __forceinline__ unsigned cvt_pk_bf16(float lo, float hi) { unsigned r; asm volatile("v_cvt_pk_bf16_f32 %0, %1, %2" : "=v"(r) : "v"(lo), "v"(hi)); return r; }
__device__ __forceinline__ float silu_f(float g) { return g * __builtin_amdgcn_rcpf(1.0f + __expf(-g)); }

struct EpiProj {
    static constexpr bool PERM = true, AFTER_DRAIN = false;
    bf16_t* O; int ldc; int ncols; const float* rowsq;
    __device__ __forceinline__ void operator()(const f32x4 (&acc)[2][2][4][2], const Unit& u, int wr, int wc, int fr, int fq) const {
        const int row0 = u.pm * BM + wr * 64 + fr; const int col0 = u.pn * BM + wc * 32 + 8 * fq;
#pragma unroll
        for (int ai = 0; ai < 2; ++ai)
#pragma unroll
            for (int m = 0; m < 4; ++m) { bf16_t* rowp = O + (size_t)(row0 + ai * HALF + m * 16) * ldc;
                const float rs = __builtin_amdgcn_rsqf(rowsq[row0 + ai * HALF + m * 16] * (1.0f / 1024.0f) + 1e-6f);
#pragma unroll
                for (int bj = 0; bj < 2; ++bj) { const int col = col0 + bj * HALF;
                    if (col < ncols) { const f32x4 v0 = acc[ai][bj][m][0] * rs, v1 = acc[ai][bj][m][1] * rs; u32x4 w;
                        w.x = cvt_pk_bf16(v0[0], v0[1]); w.y = cvt_pk_bf16(v0[2], v0[3]); w.z = cvt_pk_bf16(v1[0], v1[1]); w.w = cvt_pk_bf16(v1[2], v1[3]);
                        *(u32x4*)(rowp + col) = w; } } }
    }
};
struct EpiResid {
    static constexpr bool PERM = false, AFTER_DRAIN = false;
    const float* base_f; const bf16_t* base_b; float* out_f; bf16_t* out_b; int ldc; float* rowsq;
    __device__ __forceinline__ void operator()(const f32x4 (&acc)[2][2][4][2], const Unit& u, int wr, int wc, int fr, int fq) const {
        const int row0 = u.pm * BM + wr * 64 + fr; const int col0 = u.pn * BM + wc * 32 + 4 * fq;
        typedef unsigned u32x2e __attribute__((ext_vector_type(2)));
#pragma unroll
        for (int ai = 0; ai < 2; ++ai)
#pragma unroll
            for (int m = 0; m < 4; ++m) { const size_t off = (size_t)(row0 + ai * HALF + m * 16) * ldc + col0; float sq = 0.f;
#pragma unroll
                for (int bj = 0; bj < 2; ++bj)
#pragma unroll
                    for (int n = 0; n < 2; ++n) { const size_t o_ = off + bj * HALF + n * 16; f32x4 bs;
                        if (base_b) { const u32x2e w = *(const u32x2e*)(base_b + o_); bs = (f32x4){__uint_as_float(w.x << 16), __uint_as_float(w.x & 0xffff0000u), __uint_as_float(w.y << 16), __uint_as_float(w.y & 0xffff0000u)}; }
                        else bs = *(const f32x4*)(base_f + o_);
                        const f32x4 o = bs + acc[ai][bj][m][n];
                        if (out_f) *(f32x4*)(out_f + o_) = o;
                        if (out_b) { u32x2e w; w.x = cvt_pk_bf16(o[0], o[1]); w.y = cvt_pk_bf16(o[2], o[3]); *(u32x2e*)(out_b + o_) = w; }
                        sq += (o[0] * o[0] + o[1] * o[1]) + (o[2] * o[2] + o[3] * o[3]); }
                if (rowsq) { sq += __shfl_xor(sq, 16); sq += __shfl_xor(sq, 32); if (fq == 0) atomicAdd(rowsq + row0 + ai * HALF + m * 16, sq); } }
    }
};
struct EpiSwiglu {
    static constexpr bool PERM = true, AFTER_DRAIN = false;
    bf16_t* O; int ldc; const float* rowsq;
    __device__ __forceinline__ void operator()(const f32x4 (&acc)[2][2][4][2], const Unit& u, int wr, int wc, int fr, int fq) const {
        const int row0 = u.pm * BM + wr * 64 + fr; const int col0 = u.pn * HALF + wc * 32 + 8 * fq;
#pragma unroll
        for (int ai = 0; ai < 2; ++ai)
#pragma unroll
            for (int m = 0; m < 4; ++m) { bf16_t* rowp = O + (size_t)(row0 + ai * HALF + m * 16) * ldc + col0;
                const float rs = __builtin_amdgcn_rsqf(rowsq[row0 + ai * HALF + m * 16] * (1.0f / 1024.0f) + 1e-6f);
                const f32x4 g0 = acc[ai][0][m][0] * rs, g1 = acc[ai][0][m][1] * rs, u0 = acc[ai][1][m][0] * rs, u1 = acc[ai][1][m][1] * rs; u32x4 w;
                w.x = cvt_pk_bf16(silu_f(g0[0]) * u0[0], silu_f(g0[1]) * u0[1]); w.y = cvt_pk_bf16(silu_f(g0[2]) * u0[2], silu_f(g0[3]) * u0[3]);
                w.z = cvt_pk_bf16(silu_f(g1[0]) * u1[0], silu_f(g1[1]) * u1[1]); w.w = cvt_pk_bf16(silu_f(g1[2]) * u1[2], silu_f(g1[3]) * u1[3]);
                *(u32x4*)rowp = w; }
    }
};

template <class Epi, class Sched, bool ALIGN_EPI = false, bool SP2 = false>
__device__ __forceinline__ void gemm_phase(PG8_LAS unsigned char* lds, const Gemm g, const Sched& S, const Epi& E) {
    int tid_ = threadIdx.x; asm volatile("" : "+v"(tid_));
    const int tid = tid_, wid = __builtin_amdgcn_readfirstlane(tid >> 6), lane = tid & 63, wr = wid >> 2, wc = wid & 3, fr = lane & 15, fq = lane >> 4;
    const int K = g.K, nt = K / BK;
    unsigned voffA[2], voffB[2];
#pragma unroll
    for (int i = 0; i < 2; ++i) { int R, C; stage_rc(tid * 16 + i * 8192, R, C); const int Rb = Epi::PERM ? ((R & ~31) + perm32(R & 31)) : R;
        voffA[i] = (unsigned)(R * K + C) * 2u; voffB[i] = (unsigned)(Rb * K + C) * 2u; }
    const size_t kstep = (size_t)(BK * 2);
    const size_t hstep = (size_t)HALF * K * 2;
    const size_t tstep = 2 * hstep;
    const unsigned ldsw = (unsigned)wid * 1024u;
    const int aoff = lds_byte(wr * 64 + fr, fq * 8), boff = lds_byte(wc * 32 + fr, fq * 8);
#define PG8_SA(b, h) (((b) * 2 + (h)) * HTB)
#define PG8_SB(b, h) ((4 + (b) * 2 + (h)) * HTB)
#define PG8_STAGE(bufoff, gbase, voff) do { _Pragma("unroll") for (int _i = 0; _i < 2; ++_i) \
        __builtin_amdgcn_global_load_lds((const unsigned*)((const char*)(gbase) + (voff)[_i]), (PG8_LAS unsigned*)(lds + (bufoff) + ldsw + _i * 8192), 16, 0, 0); } while (0)
#define PG8_LDA(dst, b, h) do { _Pragma("unroll") for (int m = 0; m < 4; ++m) _Pragma("unroll") for (int k = 0; k < 2; ++k) dst[m][k] = *(const PG8_LAS bf16x8*)(lds + PG8_SA(b, h) + aoff + m * 2048 + k * 1024); } while (0)
#define PG8_LDB(dst, b, h) do { _Pragma("unroll") for (int n = 0; n < 2; ++n) _Pragma("unroll") for (int k = 0; k < 2; ++k) dst[n][k] = *(const PG8_LAS bf16x8*)(lds + PG8_SB(b, h) + boff + n * 2048 + k * 1024); } while (0)
#define PG8_MMA(ai, bj, At, Bt) do { __builtin_amdgcn_s_setprio(1); _Pragma("unroll") for (int m = 0; m < 4; ++m) _Pragma("unroll") for (int n = 0; n < 2; ++n) _Pragma("unroll") for (int k = 0; k < 2; ++k) \
        acc[ai][bj][m][n] = __builtin_amdgcn_mfma_f32_16x16x32_bf16(Bt[n][k], At[m][k], acc[ai][bj][m][n], 0, 0, 0); __builtin_amdgcn_s_setprio(0); } while (0)
#define PG8_WAIT_V(n) asm volatile("s_waitcnt vmcnt(" #n ")" ::: "memory")
#define PG8_WAIT_L(n) asm volatile("s_waitcnt lgkmcnt(" #n ")" ::: "memory")
#define PG8_BAR __builtin_amdgcn_s_barrier()
#define PG8_SCHED __builtin_amdgcn_sched_barrier(0)
    Unit cur, nxt; int ui = 0;
    if (!S.next(0, cur)) return;
    f32x4 acc[2][2][4][2];
#pragma unroll
    for (int a = 0; a < 2; ++a)
#pragma unroll
        for (int b = 0; b < 2; ++b)
#pragma unroll
            for (int m = 0; m < 4; ++m)
#pragma unroll
                for (int n = 0; n < 2; ++n) acc[a][b][m][n] = (f32x4){0.f, 0.f, 0.f, 0.f};
    bf16x8 At[4][2], B0[2][2], B1[2][2];
    const char* cA = (const char*)g.A + (size_t)cur.pm * tstep; const char* cB = (const char*)g.Bt + (size_t)cur.pn * tstep;
    S.a_ready(cur);
    if constexpr (SP2) {
        PG8_STAGE(PG8_SB(0, 0), cB, voffB); PG8_STAGE(PG8_SB(0, 1), cB + hstep, voffB); PG8_STAGE(PG8_SA(0, 0), cA, voffA); PG8_STAGE(PG8_SA(0, 1), cA + hstep, voffA);
        if (wr == 1) PG8_BAR;
        PG8_WAIT_V(2); PG8_BAR;
        PG8_STAGE(PG8_SB(1, 0), cB + kstep, voffB); PG8_STAGE(PG8_SA(1, 0), cA + kstep, voffA); PG8_STAGE(PG8_SB(1, 1), cB + hstep + kstep, voffB);
        PG8_WAIT_V(6); PG8_BAR;
    } else {
        PG8_STAGE(PG8_SB(0, 0), cB, voffB); PG8_STAGE(PG8_SA(0, 0), cA, voffA); PG8_STAGE(PG8_SB(0, 1), cB + hstep, voffB); PG8_STAGE(PG8_SA(0, 1), cA + hstep, voffA);
        if (wr == 1) PG8_BAR;
        PG8_WAIT_V(4); PG8_BAR;
        PG8_STAGE(PG8_SB(1, 0), cB + kstep, voffB); PG8_STAGE(PG8_SA(1, 0), cA + kstep, voffA); PG8_STAGE(PG8_SB(1, 1), cB + hstep + kstep, voffB);
        PG8_WAIT_V(6); PG8_BAR;
    }
    for (;;) {
        const bool has_next = S.next(ui + 1, nxt);
        const char* nA = has_next ? (const char*)g.A + (size_t)nxt.pm * tstep : cA; const char* nB = has_next ? (const char*)g.Bt + (size_t)nxt.pn * tstep : cB;
        for (int t = 0; t < nt; t += 2) {
            const bool last = (t == nt - 2);
            const char* a1 = cA + (size_t)(t + 1) * kstep;
            const char* a2 = last ? nA : cA + (size_t)(t + 2) * kstep; const char* b2 = last ? nB : cB + (size_t)(t + 2) * kstep;
            const char* a3 = a2 + kstep; const char* b3 = b2 + kstep;
            if (last && has_next) S.a_ready(nxt);
            if constexpr (SP2) {
            PG8_LDB(B0, 0, 0); PG8_LDB(B1, 0, 1); PG8_SCHED; PG8_LDA(At, 0, 0); PG8_STAGE(PG8_SA(1, 1), a1 + hstep, voffA);
            PG8_WAIT_V(8); PG8_WAIT_L(0); PG8_BAR; PG8_MMA(0, 0, At, B0); PG8_MMA(0, 1, At, B1); PG8_BAR; PG8_SCHED;
            PG8_LDA(At, 0, 1); PG8_STAGE(PG8_SB(0, 0), b2, voffB); PG8_STAGE(PG8_SB(0, 1), b2 + hstep, voffB); PG8_STAGE(PG8_SA(0, 0), a2, voffA);
            PG8_WAIT_V(8); PG8_WAIT_L(0); PG8_BAR; PG8_MMA(1, 0, At, B0); PG8_MMA(1, 1, At, B1); PG8_BAR; PG8_SCHED;
            PG8_LDB(B0, 1, 0); PG8_LDB(B1, 1, 1); PG8_SCHED; PG8_LDA(At, 1, 0); PG8_STAGE(PG8_SA(0, 1), a2 + hstep, voffA);
            PG8_WAIT_V(8); PG8_WAIT_L(0); PG8_BAR; PG8_MMA(0, 0, At, B0); PG8_MMA(0, 1, At, B1); PG8_BAR; PG8_SCHED;
            PG8_LDA(At, 1, 1); PG8_STAGE(PG8_SB(1, 0), b3, voffB); PG8_STAGE(PG8_SB(1, 1), b3 + hstep, voffB); PG8_STAGE(PG8_SA(1, 0), a3, voffA);
            PG8_WAIT_V(8); PG8_WAIT_L(0); PG8_BAR; PG8_MMA(1, 0, At, B0); PG8_MMA(1, 1, At, B1); PG8_BAR; PG8_SCHED;
            } else {
            PG8_LDB(B0, 0, 0); PG8_SCHED; PG8_LDA(At, 0, 0); PG8_STAGE(PG8_SA(1, 1), a1 + hstep, voffA);
            PG8_WAIT_L(8); PG8_BAR; PG8_WAIT_L(0); PG8_MMA(0, 0, At, B0); PG8_BAR; PG8_SCHED;
            PG8_LDB(B1, 0, 1); PG8_STAGE(PG8_SB(0, 0), b2, voffB);
            PG8_BAR; PG8_WAIT_L(0); PG8_MMA(0, 1, At, B1); PG8_BAR;
            PG8_LDA(At, 0, 1); PG8_STAGE(PG8_SA(0, 0), a2, voffA);
            PG8_BAR; PG8_WAIT_L(0); PG8_MMA(1, 0, At, B0); PG8_BAR; PG8_SCHED;
            PG8_STAGE(PG8_SB(0, 1), b2 + hstep, voffB);
            PG8_WAIT_V(6); PG8_BAR; PG8_MMA(1, 1, At, B1); PG8_BAR;
            PG8_LDB(B0, 1, 0); PG8_SCHED; PG8_LDA(At, 1, 0); PG8_STAGE(PG8_SA(0, 1), a2 + hstep, voffA);
            PG8_WAIT_L(8); PG8_BAR; PG8_WAIT_L(0); PG8_MMA(0, 0, At, B0); PG8_BAR; PG8_SCHED;
            PG8_LDB(B1, 1, 1); PG8_STAGE(PG8_SB(1, 0), b3, voffB);
            PG8_BAR; PG8_WAIT_L(0); PG8_MMA(0, 1, At, B1); PG8_BAR;
            PG8_LDA(At, 1, 1); PG8_STAGE(PG8_SA(1, 0), a3, voffA);
            PG8_BAR; PG8_WAIT_L(0); PG8_MMA(1, 0, At, B0); PG8_BAR; PG8_SCHED;
            PG8_STAGE(PG8_SB(1, 1), b3 + hstep, voffB);
            PG8_WAIT_V(6); PG8_BAR; PG8_MMA(1, 1, At, B1); PG8_BAR;
            }
        }
        if constexpr (ALIGN_EPI) { if (wr == 0) PG8_BAR; }
        if constexpr (!Epi::AFTER_DRAIN) { E(acc, cur, wr, wc, fr, fq); S.done(cur); }
        if (!has_next) break;
#pragma unroll
        for (int a = 0; a < 2; ++a)
#pragma unroll
            for (int b = 0; b < 2; ++b)
#pragma unroll
                for (int m = 0; m < 4; ++m)
#pragma unroll
                    for (int n = 0; n < 2; ++n) acc[a][b][m][n] = (f32x4){0.f, 0.f, 0.f, 0.f};
        cur = nxt; cA = nA; cB = nB; ++ui;
        if constexpr (ALIGN_EPI) { if (wr == 1) PG8_BAR; }
    }
    PG8_WAIT_V(0);
    if constexpr (!ALIGN_EPI) { if (wr == 0) PG8_BAR; }
    PG8_BAR;
    if constexpr (Epi::AFTER_DRAIN) { E.fused(acc, cur, wr, wc, fr, fq, lds, wid, lane); S.done(cur); }
#undef PG8_SA
#undef PG8_SB
#undef PG8_STAGE
#undef PG8_LDA
#undef PG8_LDB
#undef PG8_MMA
#undef PG8_WAIT_V
#undef PG8_WAIT_L
#undef PG8_BAR
#undef PG8_SCHED
}
}

constexpr int NB = 4, T = 8192, D = 1024, DIN = 3592, NINP = 3584, DFF = 2816, NGU = 2 * DFF, DEPTH = 2;
constexpr int M = NB * T;
constexpr int NCH = T / 64;
constexpr int LDP = NINP;
constexpr int C_RQ = 0, C_RK = 256, C_RV = 512, C_RG = 768, C_CA = 1024, C_CG = 1280, C_GQ = 1536, C_GK = 1792, C_GV = 2048, C_GG = 2304,
              C_HQ = 2560, C_HF = 2816, C_HI = 3072, C_HG = 3328;
constexpr size_t MiB = 1u << 20;
constexpr size_t WS_CTL = 0;
constexpr size_t WS_WIN = 1 * MiB;
constexpr size_t WS_WOUT = 16 * MiB;
constexpr size_t WS_WGU = 20 * MiB;
constexpr size_t WS_WDN = 42 * MiB;
constexpr size_t WS_XN = 53 * MiB;
constexpr size_t WS_BCS = WS_XN;
constexpr size_t WS_MM = WS_XN + 48 * MiB;
constexpr size_t WS_MIX = 117 * MiB;
constexpr size_t WS_PROJ = 181 * MiB;
constexpr size_t WS_QEFF = 406 * MiB;
constexpr size_t WS_OLOC = 454 * MiB;
constexpr size_t WS_MVEC = 502 * MiB;
constexpr size_t WS_RSA = 503 * MiB;
constexpr size_t WS_RSB = 503 * MiB + 131072;
constexpr size_t WS_GBA = 503 * MiB + 262144;
constexpr size_t WS_WBA = 504 * MiB + 524288;
constexpr size_t WS_END = 505 * MiB;
constexpr int LDS_BYTES = 147456 + 256;
constexpr int LDS_BAR_OFF = 147456;
constexpr int HEAD_LDS = 73728;

#define LAS __attribute__((address_space(3)))
typedef unsigned short bf16_t;
typedef short bf16x8 __attribute__((ext_vector_type(8)));
typedef float f32x4 __attribute__((ext_vector_type(4)));
typedef unsigned u32x4 __attribute__((ext_vector_type(4)));
typedef unsigned u32x2 __attribute__((ext_vector_type(2)));
constexpr int LT = 72;
template <class Tp> __device__ __forceinline__ LAS Tp* opq(LAS Tp* p) { asm volatile("" : "+v"(p)); return p; }

__device__ __forceinline__ float bf_lo(unsigned u) { return __uint_as_float(u << 16); }
__device__ __forceinline__ float bf_hi(unsigned u) { return __uint_as_float(u & 0xffff0000u); }
__device__ __forceinline__ float bf2f(bf16_t b) { return __uint_as_float((unsigned)b << 16); }
__device__ __forceinline__ unsigned pk2(float lo, float hi) { return pg8::cvt_pk_bf16(lo, hi); }
__device__ __forceinline__ bf16_t f2bf(float f) { return (bf16_t)(pk2(f, 0.f) & 0xffffu); }
__device__ __forceinline__ float fexp(float x) { return __expf(x); }
__device__ __forceinline__ float frcp(float x) { return __builtin_amdgcn_rcpf(x); }
__device__ __forceinline__ float sigmoid_f(float x) { return frcp(1.0f + fexp(-x)); }
__device__ __forceinline__ float silu_acc(float x) { return x * frcp(1.0f + fexp(-x)); }
__device__ __forceinline__ float softplus_f(float x) { return fmaxf(x, 0.f) + log1pf(expf(-fabsf(x))); }
__device__ __forceinline__ float wave_sum(float v) {
#pragma unroll
    for (int o = 1; o < 64; o <<= 1) v += __shfl_xor(v, o);
    return v;
}
__device__ __forceinline__ void unpack8(const u32x4 w, float (&f)[8]) {
    f[0] = bf_lo(w.x); f[1] = bf_hi(w.x); f[2] = bf_lo(w.y); f[3] = bf_hi(w.y); f[4] = bf_lo(w.z); f[5] = bf_hi(w.z); f[6] = bf_lo(w.w); f[7] = bf_hi(w.w);
}
__device__ __forceinline__ u32x4 pack8(const float (&f)[8]) { u32x4 w; w.x = pk2(f[0], f[1]); w.y = pk2(f[2], f[3]); w.z = pk2(f[4], f[5]); w.w = pk2(f[6], f[7]); return w; }

struct Ctx {
    const float* in[20]; float* out; unsigned char* ws;
};
#define WSP(T_, off) ((T_*)(X.ws + (off)))

__device__ __forceinline__ f32x4 mma16(const LAS bf16_t* A, int a0, const LAS bf16_t* B, int b0, f32x4 acc, int r, int q) {
#pragma unroll
    for (int ks = 0; ks < 2; ++ks) {
        const bf16x8 a = *(const LAS bf16x8*)(A + (a0 + r) * LT + ks * 32 + q * 8);
        const bf16x8 b = *(const LAS bf16x8*)(B + (b0 + r) * LT + ks * 32 + q * 8);
        acc = __builtin_amdgcn_mfma_f32_16x16x32_bf16(a, b, acc, 0, 0, 0);
    }
    return acc;
}
__device__ __forceinline__ void store_oloc(bf16_t* oloc, int uid, int w4, int lane, const f32x4 (&acc)[4]) {
    u32x4* p = (u32x4*)(oloc + ((size_t)uid * 4 + w4) * 1024 + lane * 16);
    u32x4 a, b;
    a.x = pk2(acc[0][0], acc[0][1]); a.y = pk2(acc[0][2], acc[0][3]); a.z = pk2(acc[1][0], acc[1][1]); a.w = pk2(acc[1][2], acc[1][3]);
    b.x = pk2(acc[2][0], acc[2][1]); b.y = pk2(acc[2][2], acc[2][3]); b.z = pk2(acc[3][0], acc[3][1]); b.w = pk2(acc[3][2], acc[3][3]);
    p[0] = a; p[1] = b;
}
__device__ __forceinline__ void store_bc(bf16_t* bcs, int uid, int w4, int r, int q, const f32x4 (&acc)[4]) {
#pragma unroll
    for (int ct = 0; ct < 4; ++ct) { u32x2 w; w.x = pk2(acc[ct][0], acc[ct][1]); w.y = pk2(acc[ct][2], acc[ct][3]);
        *(u32x2*)(bcs + (size_t)uid * 4096 + ((ct * 4 + w4) * 64 + q * 16 + r) * 4) = w; }
}


typedef __attribute__((address_space(1))) unsigned gu32;
#define XB_TMO      128
#define XB_XCNT(j)  (256  + 64 * (j))
#define XB_XSUB(j)  (1280 + 64 * (j))
#define XB_XGEN(j)  (2304 + 64 * (j))
#define XB_TOP      3328
#define XB_TOPGEN   3392
#define XCD_BAR_WORDS 3456
#define XB_SPIN_CAP (1u << 18)

__device__ __forceinline__ unsigned xb_ld(unsigned* p)              { return __hip_atomic_load(p, __ATOMIC_RELAXED, __HIP_MEMORY_SCOPE_AGENT); }
__device__ __forceinline__ unsigned xb_add(unsigned* p, unsigned v) { return __hip_atomic_fetch_add(p, v, __ATOMIC_RELAXED, __HIP_MEMORY_SCOPE_AGENT); }
__device__ __forceinline__ unsigned xb_xcc_id() { return (unsigned)__builtin_amdgcn_s_getreg((3 << 11) | 20) & 0xFu; }
#define XB_SPIN(cond, bar) do { unsigned _sp = 0; while (cond) { __builtin_amdgcn_s_sleep(1); \
    if ((++_sp & 255u) == 0u) { if (xb_ld(&(bar)[XB_TMO])) break; if (_sp > XB_SPIN_CAP) { atomicAdd(&(bar)[XB_TMO], 1u); break; } } } } while (0)

struct XcdBarrier {
    unsigned* bar; unsigned x;
    volatile LAS unsigned* st;
};

__device__ __forceinline__ XcdBarrier xcd_barrier_post(unsigned* bar, volatile LAS unsigned* st) {
    XcdBarrier b; b.bar = bar; b.x = xb_xcc_id(); b.st = st;
    if (threadIdx.x == 0) (void)xb_add(&bar[XB_XCNT(b.x)], 1u);
    return b;
}
__device__ __forceinline__ void xcd_barrier_complete(unsigned* bar, unsigned x, unsigned& nloc, unsigned& nx) {
    const unsigned G = gridDim.x * gridDim.y * gridDim.z;
    unsigned sum, cnt, mine, sp = 0u;
    for (;;) {
        sum = 0u; cnt = 0u; mine = 0u;
#pragma unroll
        for (unsigned j = 0; j < 16; ++j) { const unsigned c = xb_ld(&bar[XB_XCNT(j)]); sum += c; cnt += (c > 0u) ? 1u : 0u; mine = (j == x) ? c : mine; }
        if (sum == G) break;
        __builtin_amdgcn_s_sleep(1);
        if ((++sp & 255u) == 0u) { if (xb_ld(&bar[XB_TMO])) break; if (sp > XB_SPIN_CAP) { atomicAdd(&bar[XB_TMO], 1u); break; } }
    }
    nloc = mine > 0u ? mine : 1u; nx = cnt > 0u ? cnt : 1u;
}

__device__ __forceinline__ void xcd_barrier(const XcdBarrier& b) {
    asm volatile("s_waitcnt vmcnt(0)" ::: "memory");
    __syncthreads();
    if (threadIdx.x == 0) {
        unsigned* bar = b.bar;
        __builtin_amdgcn_s_waitcnt(0);
        unsigned nloc = b.st[0], nx = b.st[1];
        if (nloc == 0u) { xcd_barrier_complete(bar, b.x, nloc, nx); b.st[0] = nloc; b.st[1] = nx; }
        const unsigned old = xb_add(&bar[XB_XSUB(b.x)], 1u);
        const unsigned gen = old / nloc;
        if (old + 1u == (gen + 1u) * nloc) {
            __builtin_amdgcn_fence(__ATOMIC_RELEASE, "agent");
            asm volatile("s_waitcnt vmcnt(0)" ::: "memory");
            const unsigned og = xb_add(&bar[XB_TOP], 1u);
            const unsigned tg = og / nx;
            if (og + 1u == (tg + 1u) * nx) xb_add(&bar[XB_TOPGEN], 1u);
            else XB_SPIN(xb_ld(&bar[XB_TOPGEN]) == tg, bar);
            __builtin_amdgcn_fence(__ATOMIC_ACQUIRE, "agent");
            xb_add(&bar[XB_XGEN(b.x)], 1u);
            asm volatile("s_waitcnt vmcnt(0)" ::: "memory");
        } else {
            XB_SPIN(xb_ld(&bar[XB_XGEN(b.x)]) == gen, bar);
            __builtin_amdgcn_fence(__ATOMIC_ACQUIRE, "agent");
            asm volatile("s_waitcnt vmcnt(0)" ::: "memory");
        }
    }
    __syncthreads();
}

__device__ __forceinline__ void transpose_item(const float* W, int K, int N, bf16_t* WT, int mode, LAS float* scr, int kb, int nb, int lane, const float* kscale, int coff) {
    const int k0 = 64 * kb, n0 = 32 * nb;
    const int nn = n0 + (lane & 31) + coff;
#pragma unroll 8
    for (int i = 0; i < 32; ++i) { const int kk = 2 * i + (lane >> 5); const float ksc = kscale ? kscale[k0 + kk] : 1.0f; scr[kk * 33 + (lane & 31)] = nn < N ? W[(size_t)(k0 + kk) * N + nn] * ksc : 0.f; }
    asm volatile("s_waitcnt lgkmcnt(0)" ::: "memory");
    const int c = lane & 7;
#pragma unroll
    for (int j = 0; j < 4; ++j) { const int n = (lane >> 3) + 8 * j; const LAS float* s = scr + (8 * c) * 33 + n;
        u32x4 o; o.x = pk2(s[0 * 33], s[1 * 33]); o.y = pk2(s[2 * 33], s[3 * 33]); o.z = pk2(s[4 * 33], s[5 * 33]); o.w = pk2(s[6 * 33], s[7 * 33]);
        const int ng = n0 + n; const int row = mode == 0 ? ng : ((ng >> 7) * 256 + (ng & 127) + (mode == 2 ? 128 : 0));
        *(u32x4*)(WT + (size_t)row * K + k0 + 8 * c) = o; }
    asm volatile("s_waitcnt lgkmcnt(0)" ::: "memory");
}
__device__ __forceinline__ void prep_weights(const Ctx& X, LAS unsigned char* lds, int gw, int ngw, int wave, int lane, int it_lo, int it_hi) {
    LAS float* scr = (LAS float*)(lds + wave * 16384);
    constexpr int I_IN = (D / 64) * (NINP / 32), I_OUT = (D / 64) * (D / 32), I_G = (D / 64) * (DFF / 32), I_DN = (DFF / 64) * (D / 32);
    constexpr int PER_L = I_IN + I_OUT + 2 * I_G + I_DN;
    asm volatile("" : "+v"(lane));
    for (int it = it_lo + gw; it < it_hi; it += ngw) {
        const int l = it / PER_L; int r = it % PER_L;
        if (r < I_IN) { transpose_item(X.in[2] + (size_t)l * D * DIN, D, DIN, WSP(bf16_t, WS_WIN) + (size_t)l * NINP * D, 0, scr, r / (NINP / 32), r % (NINP / 32), lane, X.in[1] + l * D, (r % (NINP / 32)) * 32 >= 2560 ? 8 : 0); continue; } r -= I_IN;
        if (r < I_OUT) { transpose_item(X.in[14] + (size_t)l * D * D, D, D, WSP(bf16_t, WS_WOUT) + (size_t)l * D * D, 0, scr, r / (D / 32), r % (D / 32), lane, nullptr, 0); continue; } r -= I_OUT;
        if (r < I_G) { transpose_item(X.in[16] + (size_t)l * D * DFF, D, DFF, WSP(bf16_t, WS_WGU) + (size_t)l * NGU * D, 1, scr, r / (DFF / 32), r % (DFF / 32), lane, X.in[15] + l * D, 0); continue; } r -= I_G;
        if (r < I_G) { transpose_item(X.in[17] + (size_t)l * D * DFF, D, DFF, WSP(bf16_t, WS_WGU) + (size_t)l * NGU * D, 2, scr, r / (DFF / 32), r % (DFF / 32), lane, X.in[15] + l * D, 0); continue; } r -= I_G;
        transpose_item(X.in[18] + (size_t)l * DFF * D, DFF, D, WSP(bf16_t, WS_WDN) + (size_t)l * D * DFF, 0, scr, r / (D / 32), r % (D / 32), lane, nullptr, 0);
    }
}
__device__ __forceinline__ void rms_row(const float* xrow, const float* w, bf16_t* orow, float* of, int lane) {
    const f32x4* xr = (const f32x4*)xrow + lane; const f32x4* wr = (const f32x4*)w + lane;
    f32x4 v[4]; float s = 0.f;
#pragma unroll
    for (int j = 0; j < 4; ++j) { v[j] = xr[64 * j]; s += (v[j].x * v[j].x + v[j].y * v[j].y) + (v[j].z * v[j].z + v[j].w * v[j].w); }
    const float rstd = 1.0f / sqrtf(wave_sum(s) * (1.f / D) + 1e-6f);
#pragma unroll
    for (int j = 0; j < 4; ++j) { const f32x4 ww = wr[64 * j]; const f32x4 o = v[j] * rstd * ww;
        if (of) ((f32x4*)of + lane)[64 * j] = o;
        else { u32x2 p; p.x = pk2(o.x, o.y); p.y = pk2(o.z, o.w); ((u32x2*)orow + lane)[64 * j] = p; } }
}
__device__ __forceinline__ void cast_phase(const float* x, bf16_t* xb, float* rowsq, int gw, int ngw, int lane) {
    asm volatile("" : "+v"(lane));
    for (int m = gw; m < M; m += ngw) {
        const f32x4* xr = (const f32x4*)(x + (size_t)m * D) + lane; float s = 0.f;
#pragma unroll
        for (int j = 0; j < 4; ++j) { const f32x4 v = xr[64 * j]; s += (v.x * v.x + v.y * v.y) + (v.z * v.z + v.w * v.w); u32x2 p; p.x = pk2(v.x, v.y); p.y = pk2(v.z, v.w); ((u32x2*)(xb + (size_t)m * D) + lane)[64 * j] = p; }
        s = wave_sum(s); if (lane == 0) rowsq[m] = s;
    }
}
__device__ __forceinline__ void norm_phase(const float* x, const float* w, bf16_t* xn, float* of, int gw, int ngw, int lane) {
    asm volatile("" : "+v"(lane));
    for (int m = gw; m < M; m += ngw) rms_row(x + (size_t)m * D, w, xn ? xn + (size_t)m * D : nullptr, of ? of + (size_t)m * D : nullptr, lane);
}

__device__ __forceinline__ int unit_id(int mixer, int b, int h, int c) { return ((mixer * 4 + b) * 4 + h) * NCH + c; }

__device__ __forceinline__ void ret_unit(const Ctx& X, LAS unsigned char* hl, int b, int c, int h, int tid_h, int w4, int lane) {
    LAS bf16_t* QR = opq((LAS bf16_t*)hl); LAS bf16_t* KR = opq(QR + 64 * LT); LAS bf16_t* KDT = opq(KR + 64 * LT); LAS bf16_t* VT = opq(KDT + 64 * LT); LAS bf16_t* P = opq(VT + 64 * LT);
    const bf16_t* proj = WSP(const bf16_t, WS_PROJ);
    const int uid = unit_id(0, b, h, c);
    const int r = lane & 15, q = lane >> 4;
    const float lg = log1pf(-exp2f(-5.0f - (float)h));
    {
        const int i = tid_h >> 2, sg = tid_h & 3, d0 = sg * 8;
        const bf16_t* pr = proj + ((size_t)b * T + c * 64 + i) * LDP;
        const u32x4 q1 = *(const u32x4*)(pr + C_RQ + h * 64 + d0), q2 = *(const u32x4*)(pr + C_RQ + h * 64 + d0 + 32);
        const u32x4 k1 = *(const u32x4*)(pr + C_RK + h * 64 + d0), k2 = *(const u32x4*)(pr + C_RK + h * 64 + d0 + 32);
        const u32x4 v1 = *(const u32x4*)(pr + C_RV + h * 64 + sg * 16), v2 = *(const u32x4*)(pr + C_RV + h * 64 + sg * 16 + 8);
        float qa[8], qb[8], ka[8], kb[8], va[8], vb[8];
        unpack8(q1, qa); unpack8(q2, qb); unpack8(k1, ka); unpack8(k2, kb); unpack8(v1, va); unpack8(v2, vb);
        const float pos = (float)(c * 64 + i);
        const float qd = fexp(lg * (float)(i + 1)), kd = fexp(lg * (float)(63 - i));
        float qr1[8], qr2[8], kr1[8], kr2[8], qe1[8], qe2[8];
#pragma unroll
        for (int e = 0; e < 8; ++e) {
            const float inv = exp2f(-(float)(d0 + e) * (13.287712379549449f / 32.0f));
            const float rev = __builtin_amdgcn_fractf(pos * inv * 0.15915494309189535f); const float sn = __builtin_amdgcn_sinf(rev), cs = __builtin_amdgcn_cosf(rev);
            qr1[e] = qa[e] * cs - qb[e] * sn; qr2[e] = qa[e] * sn + qb[e] * cs;
            kr1[e] = (ka[e] * cs - kb[e] * sn) * 0.125f; kr2[e] = (ka[e] * sn + kb[e] * cs) * 0.125f;
            qe1[e] = qr1[e] * qd; qe2[e] = qr2[e] * qd;
            KDT[(d0 + e) * LT + i] = f2bf(kr1[e] * kd); KDT[(d0 + 32 + e) * LT + i] = f2bf(kr2[e] * kd);
            VT[(sg * 16 + e) * LT + i] = f2bf(va[e]); VT[(sg * 16 + 8 + e) * LT + i] = f2bf(vb[e]);
        }
        *(LAS u32x4*)(QR + i * LT + d0) = pack8(qr1); *(LAS u32x4*)(QR + i * LT + d0 + 32) = pack8(qr2);
        *(LAS u32x4*)(KR + i * LT + d0) = pack8(kr1); *(LAS u32x4*)(KR + i * LT + d0 + 32) = pack8(kr2);
        bf16_t* qe = WSP(bf16_t, WS_QEFF) + (size_t)uid * 4096 + i * 64;
        *(u32x4*)(qe + d0) = pack8(qe1); *(u32x4*)(qe + d0 + 32) = pack8(qe2);
    }
    __syncthreads();
    f32x4 acc[4];
#pragma unroll
    for (int ct = 0; ct < 4; ++ct) acc[ct] = mma16(QR, 16 * w4, KR, 16 * ct, (f32x4){0.f, 0.f, 0.f, 0.f}, r, q);
#pragma unroll
    for (int ct = 0; ct < 4; ++ct)
#pragma unroll
        for (int j = 0; j < 4; ++j) { const int ii = 16 * w4 + 4 * q + j, col = 16 * ct + r;
            P[ii * LT + col] = f2bf(ii >= col ? acc[ct][j] * fexp(lg * (float)(ii - col)) : 0.f); }
    __syncthreads();
#pragma unroll
    for (int ct = 0; ct < 4; ++ct) acc[ct] = mma16(P, 16 * w4, VT, 16 * ct, (f32x4){0.f, 0.f, 0.f, 0.f}, r, q);
    store_oloc(WSP(bf16_t, WS_OLOC), uid, w4, lane, acc);
#pragma unroll
    for (int ct = 0; ct < 4; ++ct) acc[ct] = mma16(KDT, 16 * w4, VT, 16 * ct, (f32x4){0.f, 0.f, 0.f, 0.f}, r, q);
    store_bc(WSP(bf16_t, WS_BCS), uid, w4, r, q, acc);
    __syncthreads();
}

__device__ __forceinline__ void hgrn_unit(const Ctx& X, LAS unsigned char* hl, int b, int c, int h, int tid_h, int w4, int lane, int layer) {
    LAS bf16_t* QT = opq((LAS bf16_t*)hl);
    LAS float* Gt = opq((LAS float*)(hl + 9216));
    LAS bf16_t* Kt = opq((LAS bf16_t*)(hl + 25600));
    LAS bf16_t* KTI = opq((LAS bf16_t*)(hl + 34816));
    LAS bf16_t* VT = KTI; LAS bf16_t* KDT = opq(KTI + 64 * LT);
    LAS float* tot = opq((LAS float*)(hl + 57856));
    const bf16_t* proj = WSP(const bf16_t, WS_PROJ);
    const int uid = unit_id(2, b, h, c);
    const int r = lane & 15, q = lane >> 4;
    const int i = tid_h >> 2, ds = (tid_h & 3) * 16;
    const bf16_t* pr = proj + ((size_t)b * T + c * 64 + i) * LDP;
    float kk[16], qv[16], vv[16];
    {
        float ff[16];
        { float t0[8], t1[8]; unpack8(*(const u32x4*)(pr + C_HF + h * 64 + ds), t0); unpack8(*(const u32x4*)(pr + C_HF + h * 64 + ds + 8), t1);
#pragma unroll
          for (int e = 0; e < 8; ++e) { ff[e] = t0[e]; ff[8 + e] = t1[e]; } }
        { float t0[8], t1[8]; unpack8(*(const u32x4*)(pr + C_HQ + h * 64 + ds), t0); unpack8(*(const u32x4*)(pr + C_HQ + h * 64 + ds + 8), t1);
#pragma unroll
          for (int e = 0; e < 8; ++e) { qv[e] = t0[e]; qv[8 + e] = t1[e]; } }
        { float t0[8], t1[8]; unpack8(*(const u32x4*)(pr + C_HI + h * 64 + ds), t0); unpack8(*(const u32x4*)(pr + C_HI + h * 64 + ds + 8), t1);
#pragma unroll
          for (int e = 0; e < 8; ++e) { vv[e] = t0[e]; vv[8 + e] = t1[e]; } }
#pragma unroll
        for (int e = 0; e < 16; ++e) {
            const int ch = h * 64 + ds + e;
            const float lb = layer == 0 ? 0.f : sigmoid_f(X.in[12][256 + ch] - X.in[12][ch]);
            const float f = ff[e];
            const float ls = fminf(f, 0.f) - __logf(1.0f + fexp(-fabsf(f)));
            const float lf = layer == 0 ? ls : __logf(lb + (1.f - lb) * fexp(ls));
            kk[e] = (1.f - lb) * frcp(1.f + fexp(f));
            Gt[i * 64 + ds + e] = lf;
        }
    }
    __syncthreads();
    {
        const int d = tid_h & 63, seg = tid_h >> 6; float cs[16]; float run = 0.f;
#pragma unroll
        for (int jj = 0; jj < 16; ++jj) { run += Gt[(16 * seg + jj) * 64 + d]; cs[jj] = run; }
        tot[seg * 64 + d] = run;
        __syncthreads();
        float off = 0.f;
#pragma unroll
        for (int s = 0; s < 3; ++s) off += (s < seg) ? tot[s * 64 + d] : 0.f;
#pragma unroll
        for (int jj = 0; jj < 16; ++jj) Gt[(16 * seg + jj) * 64 + d] = cs[jj] + off;
    }
    __syncthreads();
    float Gi[16], G63[16];
    {
        const int I = i >> 4;
        float qt[16], qe[16];
#pragma unroll
        for (int e = 0; e < 16; ++e) { Gi[e] = Gt[i * 64 + ds + e]; G63[e] = Gt[63 * 64 + ds + e]; const float gr = Gt[(16 * I) * 64 + ds + e];
            qt[e] = qv[e] * fexp(Gi[e] - gr); qe[e] = qv[e] * fexp(Gi[e]); }
        u32x4 w0, w1;
        w0.x = pk2(qt[0], qt[1]); w0.y = pk2(qt[2], qt[3]); w0.z = pk2(qt[4], qt[5]); w0.w = pk2(qt[6], qt[7]);
        w1.x = pk2(qt[8], qt[9]); w1.y = pk2(qt[10], qt[11]); w1.z = pk2(qt[12], qt[13]); w1.w = pk2(qt[14], qt[15]);
        *(LAS u32x4*)(QT + i * LT + ds) = w0; *(LAS u32x4*)(QT + i * LT + ds + 8) = w1;
        w0.x = pk2(qe[0], qe[1]); w0.y = pk2(qe[2], qe[3]); w0.z = pk2(qe[4], qe[5]); w0.w = pk2(qe[6], qe[7]);
        w1.x = pk2(qe[8], qe[9]); w1.y = pk2(qe[10], qe[11]); w1.z = pk2(qe[12], qe[13]); w1.w = pk2(qe[14], qe[15]);
        bf16_t* qg = WSP(bf16_t, WS_QEFF) + (size_t)uid * 4096 + i * 64 + ds;
        *(u32x4*)qg = w0; *(u32x4*)(qg + 8) = w1;
        w0.x = pk2(kk[0], kk[1]); w0.y = pk2(kk[2], kk[3]); w0.z = pk2(kk[4], kk[5]); w0.w = pk2(kk[6], kk[7]);
        w1.x = pk2(kk[8], kk[9]); w1.y = pk2(kk[10], kk[11]); w1.z = pk2(kk[12], kk[13]); w1.w = pk2(kk[14], kk[15]);
        *(LAS u32x4*)(Kt + i * LT + ds) = w0; *(LAS u32x4*)(Kt + i * LT + ds + 8) = w1;
        if (i == 63) { float* mv = WSP(float, WS_MVEC) + (size_t)(uid - 2 * 2048) * 64 + ds;
#pragma unroll
            for (int e = 0; e < 16; ++e) mv[e] = fexp(G63[e]); }
    }
    __syncthreads();
    const int I = w4;
    LAS bf16_t* KI = opq(KTI + (8 * I * (I + 1)) * LT);
    {
        const int nit = 16 * (I + 1) * 8;
        for (int idx = lane; idx < nit; idx += 64) { const int j = idx >> 3, d8 = (idx & 7) * 8;
            float kf[8]; unpack8(*(const LAS u32x4*)(Kt + j * LT + d8), kf);
            float o[8];
#pragma unroll
            for (int e = 0; e < 8; ++e) o[e] = kf[e] * fexp(fminf(Gt[(16 * I) * 64 + d8 + e] - Gt[j * 64 + d8 + e], 80.f));
            *(LAS u32x4*)(KI + j * LT + d8) = pack8(o); }
    }
    __syncthreads();
    f32x4 acc[4];
    {
        bf16x8 a[2];
#pragma unroll
        for (int ks = 0; ks < 2; ++ks) a[ks] = *(const LAS bf16x8*)(QT + (16 * I + r) * LT + ks * 32 + q * 8);
#pragma unroll
        for (int ct = 0; ct < 4; ++ct) { acc[ct] = (f32x4){0.f, 0.f, 0.f, 0.f};
            if (ct <= I) {
#pragma unroll
                for (int ks = 0; ks < 2; ++ks) { const bf16x8 bb = *(const LAS bf16x8*)(KI + (16 * ct + r) * LT + ks * 32 + q * 8);
                    acc[ct] = __builtin_amdgcn_mfma_f32_16x16x32_bf16(a[ks], bb, acc[ct], 0, 0, 0); } } }
        asm volatile("s_waitcnt lgkmcnt(0)" ::: "memory");
#pragma unroll
        for (int ct = 0; ct < 4; ++ct)
#pragma unroll
            for (int j = 0; j < 4; ++j) { const int ii = 16 * I + 4 * q + j, col = 16 * ct + r;
                QT[ii * LT + col] = f2bf((ct <= I && ii >= col) ? acc[ct][j] : 0.f); }
    }
    __syncthreads();
    {
#pragma unroll
        for (int e = 0; e < 16; ++e) { VT[(ds + e) * LT + i] = f2bf(vv[e]); KDT[(ds + e) * LT + i] = f2bf(kk[e] * fexp(G63[e] - Gi[e])); }
    }
    __syncthreads();
#pragma unroll
    for (int ct = 0; ct < 4; ++ct) acc[ct] = mma16(QT, 16 * w4, VT, 16 * ct, (f32x4){0.f, 0.f, 0.f, 0.f}, r, q);
    store_oloc(WSP(bf16_t, WS_OLOC), uid, w4, lane, acc);
#pragma unroll
    for (int ct = 0; ct < 4; ++ct) acc[ct] = mma16(KDT, 16 * w4, VT, 16 * ct, (f32x4){0.f, 0.f, 0.f, 0.f}, r, q);
    store_bc(WSP(bf16_t, WS_BCS), uid, w4, r, q, acc);
    __syncthreads();
}

__device__ __forceinline__ void gdn_unit(const Ctx& X, LAS unsigned char* hl, int b, int c, int h, int tid_h, int w4, int lane, int layer) {
    LAS bf16_t* Q = opq((LAS bf16_t*)hl); LAS bf16_t* K = opq(Q + 64 * LT); LAS bf16_t* KB = opq(K + 64 * LT); LAS bf16_t* V = opq(KB + 64 * LT); LAS bf16_t* KDT = opq(V + 64 * LT); LAS bf16_t* P = opq(KDT + 64 * LT);
    LAS bf16_t* WT = KB; LAS bf16_t* UT = V;
    LAS bf16_t* AB = opq((LAS bf16_t*)(hl + 55296));
    LAS float* ACCS = opq((LAS float*)(hl + 64512));
    LAS float* Gs = opq((LAS float*)(hl + 72704));
    LAS float* Bs = opq(Gs + 64);
    const bf16_t* proj = WSP(const bf16_t, WS_PROJ);
    const int uid = unit_id(1, b, h, c);
    const int r = lane & 15, q = lane >> 4;
    {
    LAS bf16_t* RAW = opq((LAS bf16_t*)(hl + 46080));
    const int cseg = tid_h & 7, i0 = tid_h >> 3;
    f32x4 wq[3][4][2];
    {
        const float* cw = X.in[8] + (size_t)layer * 4 * 768 + h * 64 + cseg * 8;
#pragma unroll
        for (int tn = 0; tn < 3; ++tn)
#pragma unroll
            for (int k = 0; k < 4; ++k) { const f32x4* wp = (const f32x4*)(cw + k * 768 + tn * 256); wq[tn][k][0] = wp[0]; wq[tn][k][1] = wp[1]; }
        u32x4 rawv[7];
#pragma unroll
        for (int n = 0; n < 7; ++n) { const int item = tid_h + 256 * n; const int seg = item & 7; int rowid = item >> 3; rowid = rowid < 201 ? rowid : 200;
            const int tn = rowid / 67, rr = rowid - tn * 67; const int tt = c * 64 - 3 + rr; const int ttc = tt < 0 ? 0 : tt;
            const u32x4 v = *(const u32x4*)(proj + ((size_t)b * T + ttc) * LDP + C_GQ + tn * 256 + h * 64 + seg * 8);
            rawv[n] = tt < 0 ? (u32x4){0u, 0u, 0u, 0u} : v; }
        float g = 0.f, bt = 0.f;
        if (tid_h < 64) {
            const bf16_t* pr = proj + ((size_t)b * T + c * 64 + tid_h) * LDP;
            const float* gba = WSP(const float, WS_GBA) + ((size_t)b * T + c * 64 + tid_h) * 8; const float gb = gba[h], ga = gba[4 + h];
            g = -fexp(X.in[9][layer * 4 + h]) * softplus_f(ga + X.in[10][layer * 4 + h]);
#pragma unroll
            for (int o = 1; o < 64; o <<= 1) { const float t = __shfl_up(g, o); if (lane >= o) g += t; }
            bt = sigmoid_f(gb);
            Gs[tid_h] = g; Bs[tid_h] = bt;
        }
#pragma unroll
        for (int n = 0; n < 7; ++n) { const int item = tid_h + 256 * n; if (item < 1608) *(LAS u32x4*)(RAW + (item >> 3) * 64 + (item & 7) * 8) = rawv[n]; }
    }
    __syncthreads();
    {
        const float G63 = Gs[63];
#pragma unroll
        for (int rs = 0; rs < 2; ++rs) {
            const int i = i0 + 32 * rs;
            const float bi = Bs[i], Gi = Gs[i];
            float y[3][8];
#pragma unroll
            for (int tn = 0; tn < 3; ++tn) {
#pragma unroll
                for (int e = 0; e < 8; ++e) y[tn][e] = 0.f;
#pragma unroll
                for (int k = 0; k < 4; ++k) { float x8[8]; unpack8(*(const LAS u32x4*)(RAW + (tn * 67 + i + k) * 64 + cseg * 8), x8);
                    y[tn][0] += wq[tn][k][0].x * x8[0]; y[tn][1] += wq[tn][k][0].y * x8[1]; y[tn][2] += wq[tn][k][0].z * x8[2]; y[tn][3] += wq[tn][k][0].w * x8[3];
                    y[tn][4] += wq[tn][k][1].x * x8[4]; y[tn][5] += wq[tn][k][1].y * x8[5]; y[tn][6] += wq[tn][k][1].z * x8[6]; y[tn][7] += wq[tn][k][1].w * x8[7]; }
#pragma unroll
                for (int e = 0; e < 8; ++e) y[tn][e] = silu_acc(y[tn][e]);
            }
            float sq = 0.f, sk = 0.f;
#pragma unroll
            for (int e = 0; e < 8; ++e) { sq += y[0][e] * y[0][e]; sk += y[1][e] * y[1][e]; }
            sq += __shfl_xor(sq, 1); sq += __shfl_xor(sq, 2); sq += __shfl_xor(sq, 4);
            sk += __shfl_xor(sk, 1); sk += __shfl_xor(sk, 2); sk += __shfl_xor(sk, 4);
            const float rq = 0.125f * rsqrtf(sq + 1e-6f), rk = rsqrtf(sk + 1e-6f), kd = rk * fexp(G63 - Gi);
            float t8[8];
#pragma unroll
            for (int e = 0; e < 8; ++e) t8[e] = y[0][e] * rq;
            *(LAS u32x4*)(Q + i * LT + cseg * 8) = pack8(t8);
#pragma unroll
            for (int e = 0; e < 8; ++e) t8[e] = y[1][e] * rk;
            *(LAS u32x4*)(K + i * LT + cseg * 8) = pack8(t8);
#pragma unroll
            for (int e = 0; e < 8; ++e) t8[e] = y[1][e] * rk * bi;
            *(LAS u32x4*)(KB + i * LT + cseg * 8) = pack8(t8);
            *(LAS u32x4*)(V + i * LT + cseg * 8) = pack8(y[2]);
#pragma unroll
            for (int e = 0; e < 8; ++e) KDT[(cseg * 8 + e) * LT + i] = f2bf(y[1][e] * kd);
        }
    }
    __syncthreads();
    }
    {
        f32x4 aA[4], aP[4];
#pragma unroll
        for (int ct = 0; ct < 4; ++ct) { aA[ct] = mma16(KB, 16 * w4, K, 16 * ct, (f32x4){0.f, 0.f, 0.f, 0.f}, r, q); aP[ct] = mma16(Q, 16 * w4, K, 16 * ct, (f32x4){0.f, 0.f, 0.f, 0.f}, r, q); }
#pragma unroll
        for (int ct = 0; ct < 4; ++ct)
#pragma unroll
            for (int j = 0; j < 4; ++j) { const int ii = 16 * w4 + 4 * q + j, col = 16 * ct + r;
                const float L = fexp(fminf(Gs[ii] - Gs[col], 0.f));
                AB[ii * LT + col] = f2bf(ii > col ? aA[ct][j] * L : 0.f);
                P[ii * LT + col] = f2bf(ii >= col ? aP[ct][j] * L : 0.f); }
    }
    __syncthreads();
    float rc[64];
    if (w4 < 2) {
        const int col = tid_h & 63; const LAS bf16_t* src = w4 == 0 ? V : KB;
#pragma unroll
        for (int i = 0; i < 64; ++i) { const float sc = w4 == 0 ? Bs[i] : fexp(Gs[i]); rc[i] = bf2f(src[i * LT + col]) * sc; }
    }
    __syncthreads();
    {
    for (int idx = tid_h; idx < 1152; idx += 256) { const int tl = idx >= 576; const int rem = idx - tl * 576; *(LAS u32x4*)((tl ? KB : V) + rem * 8) = (u32x4){0u, 0u, 0u, 0u}; }
    __syncthreads();
#pragma unroll
    for (int I = 0; I < 4; ++I) {
        if (I > 0) {
#pragma unroll
            for (int t2 = 0; t2 < 2; ++t2) { const int ct8 = 2 * w4 + t2; const LAS bf16_t* Bt = ct8 < 4 ? UT : WT;
                const f32x4 a = mma16(AB, 16 * I, Bt, 16 * (ct8 & 3), (f32x4){0.f, 0.f, 0.f, 0.f}, r, q);
#pragma unroll
                for (int j = 0; j < 4; ++j) ACCS[(4 * q + j) * 128 + 16 * ct8 + r] = a[j]; }
            __syncthreads();
        }
        if (w4 < 2) {
            const int col = tid_h & 63, c128 = w4 * 64 + col;
            float t[16];
#pragma unroll
            for (int ii = 0; ii < 16; ++ii) t[ii] = rc[16 * I + ii] - (I > 0 ? ACCS[ii * 128 + c128] : 0.f);
#pragma unroll
            for (int ii = 1; ii < 16; ++ii) {
                float a16[16];
                { float lo[8]; unpack8(*(const LAS u32x4*)(AB + (16 * I + ii) * LT + 16 * I), lo);
#pragma unroll
                  for (int e = 0; e < 8; ++e) a16[e] = lo[e]; }
                if (ii > 8) { float hi[8]; unpack8(*(const LAS u32x4*)(AB + (16 * I + ii) * LT + 16 * I + 8), hi);
#pragma unroll
                  for (int e = 0; e < 8; ++e) a16[8 + e] = hi[e]; }
                float s0 = t[ii], s1 = 0.f;
#pragma unroll
                for (int kk = 0; kk < ii; ++kk) { if (kk & 1) s1 -= a16[kk] * t[kk]; else s0 -= a16[kk] * t[kk]; }
                t[ii] = s0 + s1;
            }
            LAS bf16_t* dst = (w4 == 0 ? UT : WT) + col * LT + 16 * I;
            u32x4 w0, w1;
            w0.x = pk2(t[0], t[1]); w0.y = pk2(t[2], t[3]); w0.z = pk2(t[4], t[5]); w0.w = pk2(t[6], t[7]);
            w1.x = pk2(t[8], t[9]); w1.y = pk2(t[10], t[11]); w1.z = pk2(t[12], t[13]); w1.w = pk2(t[14], t[15]);
            *(LAS u32x4*)dst = w0; *(LAS u32x4*)(dst + 8) = w1;
        }
        __syncthreads();
    }
    }
    {
        f32x4 acc[4];
        const float eG63 = fexp(Gs[63]);
#pragma unroll
        for (int ct = 0; ct < 4; ++ct) acc[ct] = mma16(P, 16 * w4, WT, 16 * ct, (f32x4){0.f, 0.f, 0.f, 0.f}, r, q);
        bf16_t* qe = WSP(bf16_t, WS_QEFF) + (size_t)uid * 4096;
#pragma unroll
        for (int ct = 0; ct < 4; ++ct)
#pragma unroll
            for (int j = 0; j < 4; ++j) { const int ii = 16 * w4 + 4 * q + j, col = 16 * ct + r;
                qe[ii * 64 + col] = f2bf(bf2f(Q[ii * LT + col]) * fexp(Gs[ii]) - acc[ct][j]); }
#pragma unroll
        for (int ct = 0; ct < 4; ++ct) acc[ct] = mma16(P, 16 * w4, UT, 16 * ct, (f32x4){0.f, 0.f, 0.f, 0.f}, r, q);
        store_oloc(WSP(bf16_t, WS_OLOC), uid, w4, lane, acc);
#pragma unroll
        for (int ct = 0; ct < 4; ++ct) acc[ct] = mma16(KDT, 16 * w4, WT, 16 * ct, (f32x4){0.f, 0.f, 0.f, 0.f}, r, q);
        bf16_t* mm = WSP(bf16_t, WS_MM) + (size_t)(uid - 2048) * 4096;
#pragma unroll
        for (int ct = 0; ct < 4; ++ct)
#pragma unroll
            for (int j = 0; j < 4; ++j) { const int ii = 16 * w4 + 4 * q + j, col = 16 * ct + r;
                mm[((w4 * 2 + (ct >> 1)) * 64 + (r >> 2) * 16 + 4 * q + j) * 8 + (ct & 1) * 4 + (r & 3)] = f2bf((ii == col ? eG63 : 0.f) - acc[ct][j]); }
#pragma unroll
        for (int ct = 0; ct < 4; ++ct) acc[ct] = mma16(KDT, 16 * w4, UT, 16 * ct, (f32x4){0.f, 0.f, 0.f, 0.f}, r, q);
        store_bc(WSP(bf16_t, WS_BCS), uid, w4, r, q, acc);
    }
    __syncthreads();
}

__device__ __forceinline__ void conf_unit(const Ctx& X, LAS unsigned char* lds, int b, int c, int tid, int wave, int lane, int layer) {
    LAS bf16_t* GL = opq((LAS bf16_t*)lds);
    LAS float* Y = opq((LAS float*)(lds + 49152));
    const bf16_t* proj = WSP(const bf16_t, WS_PROJ);
    bf16_t* mix = WSP(bf16_t, WS_MIX);
    const int t0 = c * 64;
    for (int item = tid; item < 94 * 32; item += 512) { const int rr = item >> 5, seg = (item & 31) * 8, tt = t0 - 30 + rr;
        u32x4 w = (u32x4){0u, 0u, 0u, 0u};
        if (tt >= 0) { const bf16_t* pr = proj + ((size_t)b * T + tt) * LDP; float a[8], g[8], o[8]; unpack8(*(const u32x4*)(pr + C_CA + seg), a); unpack8(*(const u32x4*)(pr + C_CG + seg), g);
#pragma unroll
            for (int e = 0; e < 8; ++e) o[e] = a[e] * sigmoid_f(g[e]);
            w = pack8(o); }
        *(LAS u32x4*)(GL + rr * 256 + seg) = w; }
    __syncthreads();
    {
        const int ch = tid & 255, half = tid >> 8;
        const float* cw = X.in[4] + (size_t)layer * 31 * 256 + ch;
        float w[31];
#pragma unroll
        for (int k = 0; k < 31; ++k) w[k] = cw[k * 256];
        const float bias = X.in[5][layer * 256 + ch];
        float acc[32];
#pragma unroll
        for (int tk = 0; tk < 32; ++tk) acc[tk] = bias;
#pragma unroll
        for (int rr = 0; rr < 62; ++rr) { const float g = bf2f(GL[(half * 32 + rr) * 256 + ch]);
#pragma unroll
            for (int tk = 0; tk < 32; ++tk) { const int k = rr - tk; if (k >= 0 && k < 31) acc[tk] += w[k] * g; } }
#pragma unroll
        for (int tk = 0; tk < 32; ++tk) Y[(half * 32 + tk) * 256 + ch] = acc[tk];
    }
    __syncthreads();
    {
        const f32x4 lw = *((const f32x4*)(X.in[6] + layer * 256) + lane), lb = *((const f32x4*)(X.in[7] + layer * 256) + lane);
#pragma unroll 2
        for (int tk = wave * 8; tk < wave * 8 + 8; ++tk) {
            const f32x4 v = *((const LAS f32x4*)(Y + tk * 256) + lane);
            const float mu = wave_sum((v.x + v.y) + (v.z + v.w)) * (1.f / 256.f);
            const f32x4 dv = v - mu;
            const float var = wave_sum((dv.x * dv.x + dv.y * dv.y) + (dv.z * dv.z + dv.w * dv.w)) * (1.f / 256.f);
            const float rs = rsqrtf(var + 1e-5f);
            f32x4 o = dv * rs * lw + lb;
            const bool on = (MIX_MASK & 2) != 0;
            u32x2 p; p.x = on ? pk2(silu_acc(o.x), silu_acc(o.y)) : 0u; p.y = on ? pk2(silu_acc(o.z), silu_acc(o.w)) : 0u;
            *(u32x2*)(mix + ((size_t)b * T + t0 + tk) * D + 256 + lane * 4) = p;
        }
    }
    __syncthreads();
}

__device__ __forceinline__ void mixer_local_phase(const Ctx& X, LAS unsigned char* lds, int layer, int tid, int wave, int lane) {
    const int hs = wave >> 2, w4 = wave & 3; int tid_h = tid & 255;
    LAS unsigned char* hl = lds + hs * HEAD_LDS;
    for (int u = blockIdx.x; u < 3584; u += gridDim.x) {
        asm volatile("" : "+v"(tid_h), "+v"(lane), "+v"(tid));
        if (u < 3072) { const int mixer = u >> 10, idx = u & 1023, hp = idx & 1, cb = idx >> 1, b = cb >> 7, c = cb & 127, h = hp * 2 + hs;
            if (mixer == 0) { ret_unit(X, hl, b, c, h, tid_h, w4, lane);
            } else if (mixer == 1) { gdn_unit(X, hl, b, c, h, tid_h, w4, lane, layer);
            } else { hgrn_unit(X, hl, b, c, h, tid_h, w4, lane, layer);
            }
        } else { const int cb = u - 3072; conf_unit(X, lds, cb >> 7, cb & 127, tid, wave, lane, layer);
        }
    }
}

__device__ __forceinline__ void scan_phase(const Ctx& X, int wave, int lane) {
    const int job = blockIdx.x;
    if (job >= 192 || wave != 0) return;
    asm volatile("" : "+v"(lane));
    const int mixer = job >> 6, rem = job & 63, bh = rem >> 2, vg = rem & 3;
    const int uid0 = (mixer * 16 + bh) * NCH;
    const int r = lane & 15, q = lane >> 4;
    bf16_t* bc0 = WSP(bf16_t, WS_BCS) + (size_t)uid0 * 4096 + (vg * 4 * 64 + lane) * 4;
    float S[4][4];
#pragma unroll
    for (int t = 0; t < 4; ++t)
#pragma unroll
        for (int j = 0; j < 4; ++j) S[t][j] = 0.f;
    if (mixer == 1) {
        const bf16_t* mm0 = WSP(const bf16_t, WS_MM) + (size_t)(uid0 - 2048) * 4096;
        u32x2 cb[4][4], ca[4][4][2][2];
#define SCAN_LOAD_G(slot, cc) { const int c_ = (cc) < NCH ? (cc) : NCH - 1; const bf16_t* bcn = bc0 + (size_t)c_ * 4096; const bf16_t* mmn = mm0 + (size_t)c_ * 4096; \
            _Pragma("unroll") for (int t = 0; t < 4; ++t) { cb[slot][t] = *(const u32x2*)(bcn + 256 * t); \
                _Pragma("unroll") for (int s2 = 0; s2 < 2; ++s2) { const u32x4 w_ = *(const u32x4*)(mmn + ((t * 2 + s2) * 64 + lane) * 8); ca[slot][t][s2][0] = (u32x2){w_.x, w_.y}; ca[slot][t][s2][1] = (u32x2){w_.z, w_.w}; } } }
        SCAN_LOAD_G(0, 0) SCAN_LOAD_G(1, 1) SCAN_LOAD_G(2, 2)
#pragma unroll 1
        for (int c0 = 0; c0 < NCH; c0 += 4) {
#pragma unroll
            for (int k = 0; k < 4; ++k) {
                const int c = c0 + k;
                SCAN_LOAD_G((k + 3) & 3, c + 3)
                bf16_t* bcc = bc0 + (size_t)c * 4096;
                u32x2 sp[4];
#pragma unroll
                for (int t = 0; t < 4; ++t) { sp[t].x = pk2(S[t][0], S[t][1]); sp[t].y = pk2(S[t][2], S[t][3]);
                    asm volatile("" : "+v"(sp[t].x) : "v"(cb[k][t].x));
                    *(u32x2*)(bcc + 256 * t) = sp[t]; }
                bf16x8 bfr[2];
#pragma unroll
                for (int s2 = 0; s2 < 2; ++s2) { u32x4 w; w.x = sp[2 * s2].x; w.y = sp[2 * s2].y; w.z = sp[2 * s2 + 1].x; w.w = sp[2 * s2 + 1].y; bfr[s2] = __builtin_bit_cast(bf16x8, w); }
#pragma unroll
                for (int t = 0; t < 4; ++t) {
                    f32x4 acc = (f32x4){bf_lo(cb[k][t].x), bf_hi(cb[k][t].x), bf_lo(cb[k][t].y), bf_hi(cb[k][t].y)};
#pragma unroll
                    for (int s2 = 0; s2 < 2; ++s2) { u32x4 w; w.x = ca[k][t][s2][0].x; w.y = ca[k][t][s2][0].y; w.z = ca[k][t][s2][1].x; w.w = ca[k][t][s2][1].y;
                        acc = __builtin_amdgcn_mfma_f32_16x16x32_bf16(__builtin_bit_cast(bf16x8, w), bfr[s2], acc, 0, 0, 0); }
                    S[t][0] = acc[0]; S[t][1] = acc[1]; S[t][2] = acc[2]; S[t][3] = acc[3];
                }
            }
        }
#undef SCAN_LOAD_G
    } else {
        const int h = bh & 3;
        const float g64 = __expf(64.0f * log1pf(-exp2f(-5.0f - (float)h)));
        const float* mv0 = WSP(const float, WS_MVEC) + (size_t)(mixer == 2 ? uid0 - 2 * 2048 : 0) * 64 + 4 * q;
        u32x2 cb[4][4]; f32x4 cm[4][4];
#define SCAN_LOAD_D(slot, cc) { const int c_ = (cc) < NCH ? (cc) : NCH - 1; const bf16_t* bcn = bc0 + (size_t)c_ * 4096; \
            _Pragma("unroll") for (int t = 0; t < 4; ++t) { cb[slot][t] = *(const u32x2*)(bcn + 256 * t); cm[slot][t] = mixer == 2 ? *(const f32x4*)(mv0 + (size_t)c_ * 64 + 16 * t) : (f32x4){g64, g64, g64, g64}; } }
        SCAN_LOAD_D(0, 0) SCAN_LOAD_D(1, 1) SCAN_LOAD_D(2, 2)
#pragma unroll 1
        for (int c0 = 0; c0 < NCH; c0 += 4) {
#pragma unroll
            for (int k = 0; k < 4; ++k) {
                const int c = c0 + k;
                SCAN_LOAD_D((k + 3) & 3, c + 3)
                bf16_t* bcc = bc0 + (size_t)c * 4096;
#pragma unroll
                for (int t = 0; t < 4; ++t) { u32x2 sp; sp.x = pk2(S[t][0], S[t][1]); sp.y = pk2(S[t][2], S[t][3]);
                    asm volatile("" : "+v"(sp.x) : "v"(cb[k][t].x));
                    *(u32x2*)(bcc + 256 * t) = sp;
                    S[t][0] = cm[k][t].x * S[t][0] + bf_lo(cb[k][t].x); S[t][1] = cm[k][t].y * S[t][1] + bf_hi(cb[k][t].x);
                    S[t][2] = cm[k][t].z * S[t][2] + bf_lo(cb[k][t].y); S[t][3] = cm[k][t].w * S[t][3] + bf_hi(cb[k][t].y); }
            }
        }
#undef SCAN_LOAD_D
    }
}

__device__ __forceinline__ void mixer_out_phase(const Ctx& X, LAS unsigned char* lds, int layer, int tid, int wave, int lane) {
    constexpr int GP = 264;
    const bf16_t* proj = WSP(const bf16_t, WS_PROJ);
    bf16_t* mix = WSP(bf16_t, WS_MIX);
    for (int u = blockIdx.x; u < 1536; u += gridDim.x) {
        asm volatile("" : "+v"(lane), "+v"(tid));
        LAS bf16_t* GT = opq((LAS bf16_t*)lds);
        const int r = lane & 15, q = lane >> 4, h = wave >> 1, half = wave & 1;
        const int mixer = u >> 9, rem = u & 511, b = rem >> 7, c = rem & 127;
        const int uid = unit_id(mixer, b, h, c);
        const int goff = mixer == 0 ? C_RG : (mixer == 1 ? C_GG : C_HG), moff = mixer == 0 ? 0 : (mixer == 1 ? 512 : 768);
        const size_t row0 = (size_t)b * T + c * 64;
        u32x4 gv[4];
#pragma unroll
        for (int n = 0; n < 4; ++n) { const int idx = tid + 512 * n; gv[n] = *(const u32x4*)(proj + (row0 + (idx >> 5)) * LDP + goff + (idx & 31) * 8); }
        const bf16_t* qe = WSP(const bf16_t, WS_QEFF) + (size_t)uid * 4096;
        const bf16_t* st = WSP(const bf16_t, WS_BCS) + (size_t)uid * 4096;
        bf16x8 a[2][2], bb[4][2]; u32x4 ov[2][2];
#pragma unroll
        for (int rt = 0; rt < 2; ++rt) { const int rt4 = 2 * half + rt;
#pragma unroll
            for (int ks = 0; ks < 2; ++ks) a[rt][ks] = *(const bf16x8*)(qe + (16 * rt4 + r) * 64 + ks * 32 + q * 8);
            const u32x4* ol = (const u32x4*)(WSP(const bf16_t, WS_OLOC) + ((size_t)uid * 4 + rt4) * 1024 + lane * 16); ov[rt][0] = ol[0]; ov[rt][1] = ol[1]; }
#pragma unroll
        for (int ct = 0; ct < 4; ++ct)
#pragma unroll
            for (int ks = 0; ks < 2; ++ks) { const bf16_t* tb = st + (size_t)((ct * 4 + 2 * ks + (q >> 1)) * 64) * 4;
                const u32x2 lo = *(const u32x2*)(tb + ((2 * (q & 1)) * 16 + r) * 4), hi = *(const u32x2*)(tb + ((2 * (q & 1) + 1) * 16 + r) * 4);
                bb[ct][ks] = __builtin_bit_cast(bf16x8, (u32x4){lo.x, lo.y, hi.x, hi.y}); }
        const float* nw = mixer == 0 ? X.in[3] + layer * 256 + h * 64 : (mixer == 1 ? X.in[11] + layer * 64 : X.in[13] + layer * 64);
        float wv[4];
#pragma unroll
        for (int ct = 0; ct < 4; ++ct) wv[ct] = nw[16 * ct + r];
#pragma unroll
        for (int n = 0; n < 4; ++n) { const int idx = tid + 512 * n; *(LAS u32x4*)(GT + (idx >> 5) * GP + (idx & 31) * 8) = gv[n]; }
        __syncthreads();
        const bool on = ((MIX_MASK >> (mixer == 0 ? 0 : (mixer == 1 ? 2 : 3))) & 1) != 0;
#pragma unroll
        for (int rt = 0; rt < 2; ++rt) {
            f32x4 acc[4];
            acc[0] = (f32x4){bf_lo(ov[rt][0].x), bf_hi(ov[rt][0].x), bf_lo(ov[rt][0].y), bf_hi(ov[rt][0].y)}; acc[1] = (f32x4){bf_lo(ov[rt][0].z), bf_hi(ov[rt][0].z), bf_lo(ov[rt][0].w), bf_hi(ov[rt][0].w)};
            acc[2] = (f32x4){bf_lo(ov[rt][1].x), bf_hi(ov[rt][1].x), bf_lo(ov[rt][1].y), bf_hi(ov[rt][1].y)}; acc[3] = (f32x4){bf_lo(ov[rt][1].z), bf_hi(ov[rt][1].z), bf_lo(ov[rt][1].w), bf_hi(ov[rt][1].w)};
#pragma unroll
            for (int ct = 0; ct < 4; ++ct)
#pragma unroll
                for (int ks = 0; ks < 2; ++ks) acc[ct] = __builtin_amdgcn_mfma_f32_16x16x32_bf16(a[rt][ks], bb[ct][ks], acc[ct], 0, 0, 0);
#pragma unroll
            for (int j = 0; j < 4; ++j) {
                float sm = (acc[0][j] + acc[1][j]) + (acc[2][j] + acc[3][j]);
                sm += __shfl_xor(sm, 1); sm += __shfl_xor(sm, 2); sm += __shfl_xor(sm, 4); sm += __shfl_xor(sm, 8);
                const float mu = mixer == 0 ? sm * (1.f / 64.f) : 0.f;
                float d[4], s2 = 0.f;
#pragma unroll
                for (int ct = 0; ct < 4; ++ct) { d[ct] = acc[ct][j] - mu; s2 += d[ct] * d[ct]; }
                s2 += __shfl_xor(s2, 1); s2 += __shfl_xor(s2, 2); s2 += __shfl_xor(s2, 4); s2 += __shfl_xor(s2, 8);
                const float rs = rsqrtf(s2 * (1.f / 64.f) + (mixer == 0 ? 1e-5f : 1e-6f));
                const int ii = 16 * (2 * half + rt) + 4 * q + j;
#pragma unroll
                for (int ct = 0; ct < 4; ++ct) { LAS bf16_t* gp = GT + ii * GP + h * 64 + 16 * ct + r;
                    const float y = d[ct] * rs * wv[ct] * silu_acc(bf2f(*gp));
                    *gp = on ? f2bf(y) : (bf16_t)0; }
            }
        }
        __syncthreads();
#pragma unroll
        for (int n = 0; n < 4; ++n) { const int idx = tid + 512 * n; *(u32x4*)(mix + (row0 + (idx >> 5)) * D + moff + (idx & 31) * 8) = *(const LAS u32x4*)(GT + (idx >> 5) * GP + (idx & 31) * 8); }
        __syncthreads();
    }
}

constexpr int PREP_FIRST = (D / 64) * (NINP / 32), PREP_ALL = DEPTH * ((D / 64) * (NINP / 32) + (D / 64) * (D / 32) + 2 * (D / 64) * (DFF / 32) + (DFF / 64) * (D / 32));
__global__ void __launch_bounds__(512, 2) fwd_kernel(Ctx X) {
    extern __shared__ __attribute__((aligned(16))) unsigned char lds_raw[];
    LAS unsigned char* lds = (LAS unsigned char*)lds_raw;
    cg::grid_group grid = cg::this_grid();
    const int tid = threadIdx.x, lane = tid & 63, wave = __builtin_amdgcn_readfirstlane(tid >> 6);
    const int G = gridDim.x, gw = blockIdx.x * 8 + wave, ngw = G * 8;
    bf16_t* XS = (bf16_t*)X.out;
    bf16_t* XN = WSP(bf16_t, WS_XN); bf16_t* PROJ = WSP(bf16_t, WS_PROJ); bf16_t* ACT = WSP(bf16_t, WS_PROJ); bf16_t* MIX = WSP(bf16_t, WS_MIX);

    if (X.ws == nullptr) grid.sync();
    if (tid < 4) ((LAS unsigned*)(lds + LDS_BAR_OFF))[tid] = 0u;
    __syncthreads();
    const XcdBarrier bar = xcd_barrier_post(WSP(unsigned, WS_CTL), (volatile LAS unsigned*)(lds + LDS_BAR_OFF));
#define GSYNC() xcd_barrier(bar)
    prep_weights(X, lds, gw, ngw, wave, lane, 0, PREP_FIRST);
    for (int idx = blockIdx.x * 512 + tid; idx < DEPTH * 16 * D; idx += G * 512) { const int ll = idx >> 14, n = (idx >> 10) & 15, k = idx & 1023;
        WSP(bf16_t, WS_WBA)[idx] = n < 8 ? f2bf(X.in[2][((size_t)ll * D + k) * DIN + 2560 + n] * X.in[1][ll * D + k]) : (bf16_t)0; }
    cast_phase(X.in[0], XS, WSP(float, WS_RSA), gw, ngw, lane);
    GSYNC();
#pragma unroll 1
    for (int l = 0; l < DEPTH; ++l) {
        {
            pg8::Gemm g{XS, WSP(const bf16_t, WS_WIN) + (size_t)l * NINP * D, M, NINP, D}; pg8::StaticOrder S; S.init(M, NINP, G, (int)blockIdx.x);
            pg8::EpiProj E{PROJ, LDP, DIN, WSP(const float, WS_RSA)};
            pg8::gemm_phase<pg8::EpiProj, pg8::StaticOrder, true, true>(lds, g, S, E);
            int ln = lane; asm volatile("" : "+v"(ln));
            const int r = ln & 15, q = ln >> 4;
            for (int rb = blockIdx.x; rb < M / 128; rb += G) {
                const bf16_t* Ap = XS + (size_t)(rb * 128 + wave * 16 + r) * D + q * 8;
                const bf16_t* Bp = WSP(const bf16_t, WS_WBA) + (size_t)l * 16 * D + r * D + q * 8;
                f32x4 acc = (f32x4){0.f, 0.f, 0.f, 0.f};
#pragma unroll 8
                for (int ks = 0; ks < 32; ++ks) acc = __builtin_amdgcn_mfma_f32_16x16x32_bf16(*(const bf16x8*)(Ap + ks * 32), *(const bf16x8*)(Bp + ks * 32), acc, 0, 0, 0);
                if (r < 8) {
#pragma unroll
                    for (int j = 0; j < 4; ++j) { const int row = rb * 128 + wave * 16 + 4 * q + j;
                        WSP(float, WS_GBA)[(size_t)row * 8 + r] = acc[j] * rsqrtf(WSP(const float, WS_RSA)[row] * (1.0f / 1024.0f) + 1e-6f); } }
            }
        }
        GSYNC();
        int tz = tid; asm volatile("" : "+v"(tz));
        for (int i = blockIdx.x * 512 + tz; i < M; i += G * 512) { WSP(float, WS_RSA)[i] = 0.f; WSP(float, WS_RSB)[i] = 0.f; }
        mixer_local_phase(X, lds, l, tid, wave, lane);
        GSYNC();
        scan_phase(X, wave, lane);
        if (l == 0 && wave != 0) prep_weights(X, lds, blockIdx.x * 7 + wave - 1, G * 7, wave, lane, PREP_FIRST, PREP_ALL);
        GSYNC();
        mixer_out_phase(X, lds, l, tid, wave, lane);
        GSYNC();
        {
            pg8::Gemm g{MIX, WSP(const bf16_t, WS_WOUT) + (size_t)l * D * D, M, D, D}; pg8::StaticOrder S; S.init(M, D, G, (int)blockIdx.x);
            pg8::EpiResid E{l == 0 ? X.in[0] : nullptr, l == 0 ? nullptr : XS, nullptr, XN, D, WSP(float, WS_RSB)};
            pg8::gemm_phase<pg8::EpiResid, pg8::StaticOrder, true, true>(lds, g, S, E);
        }
        GSYNC();
        {
            pg8::Gemm g{XN, WSP(const bf16_t, WS_WGU) + (size_t)l * NGU * D, M, NGU, D}; pg8::StaticOrder S; S.init(M, NGU, G, (int)blockIdx.x);
            pg8::EpiSwiglu E{ACT, DFF, WSP(const float, WS_RSB)};
            pg8::gemm_phase<pg8::EpiSwiglu, pg8::StaticOrder, true, true>(lds, g, S, E);
        }
        GSYNC();
        {
            pg8::Gemm g{ACT, WSP(const bf16_t, WS_WDN) + (size_t)l * D * DFF, M, D, DFF}; pg8::StaticOrder S; S.init(M, D, G, (int)blockIdx.x);
            pg8::EpiResid E{nullptr, XN, l + 1 < DEPTH ? nullptr : X.out, l + 1 < DEPTH ? XS : nullptr, D, l + 1 < DEPTH ? WSP(float, WS_RSA) : nullptr};
            pg8::gemm_phase<pg8::EpiResid, pg8::StaticOrder, true, true>(lds, g, S, E);
        }
        GSYNC();
        if (l + 1 == DEPTH) norm_phase(X.out, X.in[19], nullptr, X.out, gw, ngw, lane);
    }
}

extern "C" void kernel_launch(void* const* d_in, const int* in_sizes, int n_in, void* d_out, int out_size, void* d_ws, size_t ws_size, hipStream_t stream) {
    static int grid = 0;
    if (grid == 0) {
        if (n_in != 20 || out_size != M * D || ws_size < WS_END) { fprintf(stderr, "kernel_launch: unexpected shapes (n_in %d, out %d, ws %zu)\n", n_in, out_size, ws_size); grid = -1; return; }
        int dev = 0, cus = 0, per_cu = 0;
        hipGetDevice(&dev); hipDeviceGetAttribute(&cus, hipDeviceAttributeMultiprocessorCount, dev);
        if (hipFuncSetAttribute((const void*)fwd_kernel, hipFuncAttributeMaxDynamicSharedMemorySize, LDS_BYTES) != hipSuccess) { fprintf(stderr, "kernel_launch: hipFuncSetAttribute failed\n"); grid = -1; return; }
        if (hipOccupancyMaxActiveBlocksPerMultiprocessor(&per_cu, (const void*)fwd_kernel, 512, LDS_BYTES) != hipSuccess || per_cu < 1) { fprintf(stderr, "kernel_launch: occupancy query says %d\n", per_cu); per_cu = 1; }
        (void)hipGetLastError();
        grid = cus * (per_cu > 1 ? 1 : per_cu);
    }
    if (grid < 0) return;
    Ctx X{};
    for (int i = 0; i < 20; ++i) X.in[i] = (const float*)d_in[i];
    X.out = (float*)d_out; X.ws = (unsigned char*)d_ws;
    void* args[] = {&X};
    if (hipMemsetAsync((char*)d_ws + WS_CTL, 0, 16384, stream) != hipSuccess) { fprintf(stderr, "kernel_launch: hipMemsetAsync of the barrier words failed\n"); return; }
    hipError_t e = hipLaunchCooperativeKernel((const void*)fwd_kernel, dim3(grid), dim3(512), args, LDS_BYTES, stream);
    if (e != hipSuccess) fprintf(stderr, "cooperative launch failed: %s (grid %d)\n", hipGetErrorString(e), grid);
}
```

```cpp
#include <hip/hip_runtime.h>
#include <hip/hip_cooperative_groups.h>
#include <cstdio>
#include <cstdint>
namespace cg = cooperative_groups;

#ifndef MIX_MASK
#define MIX_MASK 15
#endif
namespace pg8 {
#define PG8_LAS __attribute__((address_space(3)))
typedef unsigned short bf16_t;
typedef short bf16x8 __attribute__((ext_vector_type(8)));
typedef float f32x4 __attribute__((ext_vector_type(4)));
typedef unsigned u32x4 __attribute__((ext_vector_type(4)));
constexpr int BM = 256, BK = 64, HALF = 128, HTB = HALF * BK * 2  , STAGE_BYTES = 8 * HTB, NXCD = 8, WGM = 8;

__host__ __device__ __forceinline__ int lds_byte(int r, int c) { const int st = (r >> 4) * 2 + (c >> 5), rr = r & 15, cc = c & 31, ob = rr * 64 + cc * 2; return st * 1024 + (ob ^ (((ob >> 9) & 1) << 5)); }
__host__ __device__ __forceinline__ void stage_rc(int b, int& R, int& C) { const int st = b / 1024, sb = b % 1024, swz = sb ^ (((sb >> 9) & 1) << 5); R = (st >> 1) * 16 + swz / 64; C = (st & 1) * 32 + (swz % 64) / 2; }
__host__ __device__ __forceinline__ int perm32(int rho) { const int n = rho >> 4, i = rho & 15; return 8 * (i >> 2) + 4 * n + (i & 3); }

struct Unit { int pm, pn; };
struct Gemm { const bf16_t* A; const bf16_t* Bt; int M, N, K; };

struct StaticOrder {
    int nM, nN, nwg, G, c;
    __host__ __device__ void init(int M, int N, int G_, int c_) { nM = M / BM; nN = N / BM; nwg = nM * nN; G = G_; c = c_; }
    __host__ __device__ bool next(int i, Unit& u) const {
        const long L = (long)i * G + c; if (L >= nwg) return false;
        int wgid = (int)L; { const int q = nwg / NXCD, r = nwg % NXCD, xcd = wgid % NXCD, off = wgid / NXCD; wgid = (xcd < r ? xcd * (q + 1) : r * (q + 1) + (xcd - r) * q) + off; }
        const int nig = WGM * nN, gid = wgid / nig, fm = gid * WGM, gsz = (nM - fm) < WGM ? (nM - fm) : WGM;
        u.pm = fm + ((wgid % nig) % gsz); u.pn = (wgid % nig) / gsz; return true;
    }
    __device__ __forceinline__ void a_ready(const Unit&) const {}
    __device__ __forceinline__ void done(const Unit&) const {}
};

__device__ __forceinline__ unsigned cvt_pk_bf16(float lo, float hi) { unsigned r; asm volatile("v_cvt_pk_bf16_f32 %0, %1, %2" : "=v"(r) : "v"(lo), "v"(hi)); return r; }
__device__ __forceinline__ float silu_f(float g) { return g * __builtin_amdgcn_rcpf(1.0f + __expf(-g)); }

struct EpiProj {
    static constexpr bool PERM = true, AFTER_DRAIN = false;
    bf16_t* O; int ldc; int ncols; const float* rowsq;
    __device__ __forceinline__ void operator()(const f32x4 (&acc)[2][2][4][2], const Unit& u, int wr, int wc, int fr, int fq) const {
        const int row0 = u.pm * BM + wr * 64 + fr; const int col0 = u.pn * BM + wc * 32 + 8 * fq;
#pragma unroll
        for (int ai = 0; ai < 2; ++ai)
#pragma unroll
            for (int m = 0; m < 4; ++m) { bf16_t* rowp = O + (size_t)(row0 + ai * HALF + m * 16) * ldc;
                const float rs = __builtin_amdgcn_rsqf(rowsq[row0 + ai * HALF + m * 16] * (1.0f / 1024.0f) + 1e-6f);
#pragma unroll
                for (int bj = 0; bj < 2; ++bj) { const int col = col0 + bj * HALF;
                    if (col < ncols) { const f32x4 v0 = acc[ai][bj][m][0] * rs, v1 = acc[ai][bj][m][1] * rs; u32x4 w;
                        w.x = cvt_pk_bf16(v0[0], v0[1]); w.y = cvt_pk_bf16(v0[2], v0[3]); w.z = cvt_pk_bf16(v1[0], v1[1]); w.w = cvt_pk_bf16(v1[2], v1[3]);
                        *(u32x4*)(rowp + col) = w; } } }
    }
};
struct EpiResid {
    static constexpr bool PERM = true, AFTER_DRAIN = false;
    const float* base_f; const bf16_t* base_b; float* out_f; bf16_t* out_b; int ldc; float* rowsq;
    __device__ __forceinline__ void operator()(const f32x4 (&acc)[2][2][4][2], const Unit& u, int wr, int wc, int fr, int fq) const {
        const int row0 = u.pm * BM + wr * 64 + fr; const int col0 = u.pn * BM + wc * 32 + 8 * fq;
#pragma unroll
        for (int ai = 0; ai < 2; ++ai)
#pragma unroll
            for (int m = 0; m < 4; ++m) { const size_t off = (size_t)(row0 + ai * HALF + m * 16) * ldc + col0; float sq = 0.f;
#pragma unroll
                for (int bj = 0; bj < 2; ++bj) { const size_t o_ = off + bj * HALF; f32x4 b0, b1;
                    if (base_b) { const u32x4 w = *(const u32x4*)(base_b + o_);
                        b0 = (f32x4){__uint_as_float(w.x << 16), __uint_as_float(w.x & 0xffff0000u), __uint_as_float(w.y << 16), __uint_as_float(w.y & 0xffff0000u)};
                        b1 = (f32x4){__uint_as_float(w.z << 16), __uint_as_float(w.z & 0xffff0000u), __uint_as_float(w.w << 16), __uint_as_float(w.w & 0xffff0000u)}; }
                    else { b0 = *(const f32x4*)(base_f + o_); b1 = *(const f32x4*)(base_f + o_ + 4); }
                    const f32x4 o0 = b0 + acc[ai][bj][m][0], o1 = b1 + acc[ai][bj][m][1];
                    if (out_f) { *(f32x4*)(out_f + o_) = o0; *(f32x4*)(out_f + o_ + 4) = o1; }
                    if (out_b) { u32x4 w; w.x = cvt_pk_bf16(o0[0], o0[1]); w.y = cvt_pk_bf16(o0[2], o0[3]); w.z = cvt_pk_bf16(o1[0], o1[1]); w.w = cvt_pk_bf16(o1[2], o1[3]); *(u32x4*)(out_b + o_) = w; }
                    sq += ((o0[0] * o0[0] + o0[1] * o0[1]) + (o0[2] * o0[2] + o0[3] * o0[3])) + ((o1[0] * o1[0] + o1[1] * o1[1]) + (o1[2] * o1[2] + o1[3] * o1[3])); }
                if (rowsq) { sq += __shfl_xor(sq, 16); sq += __shfl_xor(sq, 32); if (fq == 0) atomicAdd(rowsq + row0 + ai * HALF + m * 16, sq); } }
    }
};
struct EpiSwiglu {
    static constexpr bool PERM = true, AFTER_DRAIN = false;
    bf16_t* O; int ldc; const float* rowsq;
    __device__ __forceinline__ void operator()(const f32x4 (&acc)[2][2][4][2], const Unit& u, int wr, int wc, int fr, int fq) const {
        const int row0 = u.pm * BM + wr * 64 + fr; const int col0 = u.pn * HALF + wc * 32 + 8 * fq;
#pragma unroll
        for (int ai = 0; ai < 2; ++ai)
#pragma unroll
            for (int m = 0; m < 4; ++m) { bf16_t* rowp = O + (size_t)(row0 + ai * HALF + m * 16) * ldc + col0;
                const float rs = __builtin_amdgcn_rsqf(rowsq[row0 + ai * HALF + m * 16] * (1.0f / 1024.0f) + 1e-6f);
                const f32x4 g0 = acc[ai][0][m][0] * rs, g1 = acc[ai][0][m][1] * rs, u0 = acc[ai][1][m][0] * rs, u1 = acc[ai][1][m][1] * rs; u32x4 w;
                w.x = cvt_pk_bf16(silu_f(g0[0]) * u0[0], silu_f(g0[1]) * u0[1]); w.y = cvt_pk_bf16(silu_f(g0[2]) * u0[2], silu_f(g0[3]) * u0[3]);
                w.z = cvt_pk_bf16(silu_f(g1[0]) * u1[0], silu_f(g1[1]) * u1[1]); w.w = cvt_pk_bf16(silu_f(g1[2]) * u1[2], silu_f(g1[3]) * u1[3]);
                *(u32x4*)rowp = w; }
    }
};

template <class Epi, class Sched, bool ALIGN_EPI = false, bool SP2 = false>
__device__ __forceinline__ void gemm_phase(PG8_LAS unsigned char* lds, const Gemm g, const Sched& S, const Epi& E) {
    int tid_ = threadIdx.x; asm volatile("" : "+v"(tid_));
    const int tid = tid_, wid = __builtin_amdgcn_readfirstlane(tid >> 6), lane = tid & 63, wr = wid >> 2, wc = wid & 3, fr = lane & 15, fq = lane >> 4;
    const int K = g.K, nt = K / BK;
    unsigned voffA[2], voffB[2];
#pragma unroll
    for (int i = 0; i < 2; ++i) { int R, C; stage_rc(tid * 16 + i * 8192, R, C); const int Rb = Epi::PERM ? ((R & ~31) + perm32(R & 31)) : R;
        voffA[i] = (unsigned)(R * K + C) * 2u; voffB[i] = (unsigned)(Rb * K + C) * 2u; }
    const size_t kstep = (size_t)(BK * 2);
    const size_t hstep = (size_t)HALF * K * 2;
    const size_t tstep = 2 * hstep;
    const unsigned ldsw = (unsigned)wid * 1024u;
    const int aoff = lds_byte(wr * 64 + fr, fq * 8), boff = lds_byte(wc * 32 + fr, fq * 8);
#define PG8_SA(b, h) (((b) * 2 + (h)) * HTB)
#define PG8_SB(b, h) ((4 + (b) * 2 + (h)) * HTB)
#define PG8_STAGE(bufoff, gbase, voff) do { _Pragma("unroll") for (int _i = 0; _i < 2; ++_i) \
        __builtin_amdgcn_global_load_lds((const unsigned*)((const char*)(gbase) + (voff)[_i]), (PG8_LAS unsigned*)(lds + (bufoff) + ldsw + _i * 8192), 16, 0, 0); } while (0)
#define PG8_LDA(dst, b, h) do { _Pragma("unroll") for (int m = 0; m < 4; ++m) _Pragma("unroll") for (int k = 0; k < 2; ++k) dst[m][k] = *(const PG8_LAS bf16x8*)(lds + PG8_SA(b, h) + aoff + m * 2048 + k * 1024); } while (0)
#define PG8_LDB(dst, b, h) do { _Pragma("unroll") for (int n = 0; n < 2; ++n) _Pragma("unroll") for (int k = 0; k < 2; ++k) dst[n][k] = *(const PG8_LAS bf16x8*)(lds + PG8_SB(b, h) + boff + n * 2048 + k * 1024); } while (0)
#define PG8_MMA(ai, bj, At, Bt) do { __builtin_amdgcn_s_setprio(1); _Pragma("unroll") for (int m = 0; m < 4; ++m) _Pragma("unroll") for (int n = 0; n < 2; ++n) _Pragma("unroll") for (int k = 0; k < 2; ++k) \
        acc[ai][bj][m][n] = __builtin_amdgcn_mfma_f32_16x16x32_bf16(Bt[n][k], At[m][k], acc[ai][bj][m][n], 0, 0, 0); __builtin_amdgcn_s_setprio(0); } while (0)
#define PG8_WAIT_V(n) asm volatile("s_waitcnt vmcnt(" #n ")" ::: "memory")
#define PG8_WAIT_L(n) asm volatile("s_waitcnt lgkmcnt(" #n ")" ::: "memory")
#define PG8_BAR __builtin_amdgcn_s_barrier()
#define PG8_SCHED __builtin_amdgcn_sched_barrier(0)
    Unit cur, nxt; int ui = 0;
    if (!S.next(0, cur)) return;
    f32x4 acc[2][2][4][2];
#pragma unroll
    for (int a = 0; a < 2; ++a)
#pragma unroll
        for (int b = 0; b < 2; ++b)
#pragma unroll
            for (int m = 0; m < 4; ++m)
#pragma unroll
                for (int n = 0; n < 2; ++n) acc[a][b][m][n] = (f32x4){0.f, 0.f, 0.f, 0.f};
    bf16x8 At[4][2], B0[2][2], B1[2][2];
    const char* cA = (const char*)g.A + (size_t)cur.pm * tstep; const char* cB = (const char*)g.Bt + (size_t)cur.pn * tstep;
    S.a_ready(cur);
    if constexpr (SP2) {
        PG8_STAGE(PG8_SB(0, 0), cB, voffB); PG8_STAGE(PG8_SB(0, 1), cB + hstep, voffB); PG8_STAGE(PG8_SA(0, 0), cA, voffA); PG8_STAGE(PG8_SA(0, 1), cA + hstep, voffA);
        if (wr == 1) PG8_BAR;
        PG8_WAIT_V(2); PG8_BAR;
        PG8_STAGE(PG8_SB(1, 0), cB + kstep, voffB); PG8_STAGE(PG8_SA(1, 0), cA + kstep, voffA); PG8_STAGE(PG8_SB(1, 1), cB + hstep + kstep, voffB);
        PG8_WAIT_V(6); PG8_BAR;
    } else {
        PG8_STAGE(PG8_SB(0, 0), cB, voffB); PG8_STAGE(PG8_SA(0, 0), cA, voffA); PG8_STAGE(PG8_SB(0, 1), cB + hstep, voffB); PG8_STAGE(PG8_SA(0, 1), cA + hstep, voffA);
        if (wr == 1) PG8_BAR;
        PG8_WAIT_V(4); PG8_BAR;
        PG8_STAGE(PG8_SB(1, 0), cB + kstep, voffB); PG8_STAGE(PG8_SA(1, 0), cA + kstep, voffA); PG8_STAGE(PG8_SB(1, 1), cB + hstep + kstep, voffB);
        PG8_WAIT_V(6); PG8_BAR;
    }
    for (;;) {
        const bool has_next = S.next(ui + 1, nxt);
        const char* nA = has_next ? (const char*)g.A + (size_t)nxt.pm * tstep : cA; const char* nB = has_next ? (const char*)g.Bt + (size_t)nxt.pn * tstep : cB;
        for (int t = 0; t < nt; t += 2) {
            const bool last = (t == nt - 2);
            const char* a1 = cA + (size_t)(t + 1) * kstep;
            const char* a2 = last ? nA : cA + (size_t)(t + 2) * kstep; const char* b2 = last ? nB : cB + (size_t)(t + 2) * kstep;
            const char* a3 = a2 + kstep; const char* b3 = b2 + kstep;
            if (last && has_next) S.a_ready(nxt);
            if constexpr (SP2) {
            PG8_LDB(B0, 0, 0); PG8_LDB(B1, 0, 1); PG8_SCHED; PG8_LDA(At, 0, 0); PG8_STAGE(PG8_SA(1, 1), a1 + hstep, voffA);
            PG8_WAIT_V(8); PG8_WAIT_L(0); PG8_BAR; PG8_MMA(0, 0, At, B0); PG8_MMA(0, 1, At, B1); PG8_BAR; PG8_SCHED;
            PG8_LDA(At, 0, 1); PG8_STAGE(PG8_SB(0, 0), b2, voffB); PG8_STAGE(PG8_SB(0, 1), b2 + hstep, voffB); PG8_STAGE(PG8_SA(0, 0), a2, voffA);
            PG8_WAIT_V(8); PG8_WAIT_L(0); PG8_BAR; PG8_MMA(1, 0, At, B0); PG8_MMA(1, 1, At, B1); PG8_BAR; PG8_SCHED;
            PG8_LDB(B0, 1, 0); PG8_LDB(B1, 1, 1); PG8_SCHED; PG8_LDA(At, 1, 0); PG8_STAGE(PG8_SA(0, 1), a2 + hstep, voffA);
            PG8_WAIT_V(8); PG8_WAIT_L(0); PG8_BAR; PG8_MMA(0, 0, At, B0); PG8_MMA(0, 1, At, B1); PG8_BAR; PG8_SCHED;
            PG8_LDA(At, 1, 1); PG8_STAGE(PG8_SB(1, 0), b3, voffB); PG8_STAGE(PG8_SB(1, 1), b3 + hstep, voffB); PG8_STAGE(PG8_SA(1, 0), a3, voffA);
            PG8_WAIT_V(8); PG8_WAIT_L(0); PG8_BAR; PG8_MMA(1, 0, At, B0); PG8_MMA(1, 1, At, B1); PG8_BAR; PG8_SCHED;
            } else {
            PG8_LDB(B0, 0, 0); PG8_SCHED; PG8_LDA(At, 0, 0); PG8_STAGE(PG8_SA(1, 1), a1 + hstep, voffA);
            PG8_WAIT_L(8); PG8_BAR; PG8_WAIT_L(0); PG8_MMA(0, 0, At, B0); PG8_BAR; PG8_SCHED;
            PG8_LDB(B1, 0, 1); PG8_STAGE(PG8_SB(0, 0), b2, voffB);
            PG8_BAR; PG8_WAIT_L(0); PG8_MMA(0, 1, At, B1); PG8_BAR;
            PG8_LDA(At, 0, 1); PG8_STAGE(PG8_SA(0, 0), a2, voffA);
            PG8_BAR; PG8_WAIT_L(0); PG8_MMA(1, 0, At, B0); PG8_BAR; PG8_SCHED;
            PG8_STAGE(PG8_SB(0, 1), b2 + hstep, voffB);
            PG8_WAIT_V(6); PG8_BAR; PG8_MMA(1, 1, At, B1); PG8_BAR;
            PG8_LDB(B0, 1, 0); PG8_SCHED; PG8_LDA(At, 1, 0); PG8_STAGE(PG8_SA(0, 1), a2 + hstep, voffA);
            PG8_WAIT_L(8); PG8_BAR; PG8_WAIT_L(0); PG8_MMA(0, 0, At, B0); PG8_BAR; PG8_SCHED;
            PG8_LDB(B1, 1, 1); PG8_STAGE(PG8_SB(1, 0), b3, voffB);
            PG8_BAR; PG8_WAIT_L(0); PG8_MMA(0, 1, At, B1); PG8_BAR;
            PG8_LDA(At, 1, 1); PG8_STAGE(PG8_SA(1, 0), a3, voffA);
            PG8_BAR; PG8_WAIT_L(0); PG8_MMA(1, 0, At, B0); PG8_BAR; PG8_SCHED;
            PG8_STAGE(PG8_SB(1, 1), b3 + hstep, voffB);
            PG8_WAIT_V(6); PG8_BAR; PG8_MMA(1, 1, At, B1); PG8_BAR;
            }
        }
        if constexpr (ALIGN_EPI) { if (wr == 0) PG8_BAR; }
        if constexpr (!Epi::AFTER_DRAIN) { E(acc, cur, wr, wc, fr, fq); S.done(cur); }
        if (!has_next) break;
#pragma unroll
        for (int a = 0; a < 2; ++a)
#pragma unroll
            for (int b = 0; b < 2; ++b)
#pragma unroll
                for (int m = 0; m < 4; ++m)
#pragma unroll
                    for (int n = 0; n < 2; ++n) acc[a][b][m][n] = (f32x4){0.f, 0.f, 0.f, 0.f};
        cur = nxt; cA = nA; cB = nB; ++ui;
        if constexpr (ALIGN_EPI) { if (wr == 1) PG8_BAR; }
    }
    PG8_WAIT_V(0);
    if constexpr (!ALIGN_EPI) { if (wr == 0) PG8_BAR; }
    PG8_BAR;
    if constexpr (Epi::AFTER_DRAIN) { E.fused(acc, cur, wr, wc, fr, fq, lds, wid, lane); S.done(cur); }
#undef PG8_SA
#undef PG8_SB
#undef PG8_STAGE
#undef PG8_LDA
#undef PG8_LDB
#undef PG8_MMA
#undef PG8_WAIT_V
#undef PG8_WAIT_L
#undef PG8_BAR
#undef PG8_SCHED
}
}

constexpr int NB = 4, T = 8192, D = 1024, DIN = 3592, NINP = 3584, DFF = 2816, NGU = 2 * DFF, DEPTH = 2;
constexpr int M = NB * T;
constexpr int NCH = T / 64;
constexpr int LDP = NINP;
constexpr int C_RQ = 0, C_RK = 256, C_RV = 512, C_RG = 768, C_CA = 1024, C_CG = 1280, C_GQ = 1536, C_GK = 1792, C_GV = 2048, C_GG = 2304,
              C_HQ = 2560, C_HF = 2816, C_HI = 3072, C_HG = 3328;
constexpr size_t MiB = 1u << 20;
constexpr size_t WS_CTL = 0;
constexpr size_t WS_WIN = 1 * MiB;
constexpr size_t WS_WOUT = 16 * MiB;
constexpr size_t WS_WGU = 20 * MiB;
constexpr size_t WS_WDN = 42 * MiB;
constexpr size_t WS_XN = 53 * MiB;
constexpr size_t WS_BCS = WS_XN;
constexpr size_t WS_MM = WS_XN + 48 * MiB;
constexpr size_t WS_MIX = 117 * MiB;
constexpr size_t WS_PROJ = 181 * MiB;
constexpr size_t WS_QEFF = 406 * MiB;
constexpr size_t WS_OLOC = 454 * MiB;
constexpr size_t WS_MVEC = 502 * MiB;
constexpr size_t WS_RSA = 503 * MiB;
constexpr size_t WS_RSB = 503 * MiB + 131072;
constexpr size_t WS_GBA = 503 * MiB + 262144;
constexpr size_t WS_WBA = 504 * MiB + 524288;
constexpr size_t WS_END = 505 * MiB;
constexpr int LDS_BYTES = 147456 + 256;
constexpr int LDS_BAR_OFF = 147456;
constexpr int HEAD_LDS = 73728;

#define LAS __attribute__((address_space(3)))
typedef unsigned short bf16_t;
typedef short bf16x8 __attribute__((ext_vector_type(8)));
typedef float f32x4 __attribute__((ext_vector_type(4)));
typedef unsigned u32x4 __attribute__((ext_vector_type(4)));
typedef unsigned u32x2 __attribute__((ext_vector_type(2)));
constexpr int LT = 72;
template <class Tp> __device__ __forceinline__ LAS Tp* opq(LAS Tp* p) { asm volatile("" : "+v"(p)); return p; }

__device__ __forceinline__ float bf_lo(unsigned u) { return __uint_as_float(u << 16); }
__device__ __forceinline__ float bf_hi(unsigned u) { return __uint_as_float(u & 0xffff0000u); }
__device__ __forceinline__ float bf2f(bf16_t b) { return __uint_as_float((unsigned)b << 16); }
__device__ __forceinline__ unsigned pk2(float lo, float hi) { return pg8::cvt_pk_bf16(lo, hi); }
__device__ __forceinline__ bf16_t f2bf(float f) { return (bf16_t)(pk2(f, 0.f) & 0xffffu); }
__device__ __forceinline__ float fexp(float x) { return __expf(x); }
__device__ __forceinline__ float frcp(float x) { return __builtin_amdgcn_rcpf(x); }
__device__ __forceinline__ float sigmoid_f(float x) { return frcp(1.0f + fexp(-x)); }
__device__ __forceinline__ float silu_acc(float x) { return x * frcp(1.0f + fexp(-x)); }
__device__ __forceinline__ float softplus_f(float x) { return fmaxf(x, 0.f) + log1pf(expf(-fabsf(x))); }
__device__ __forceinline__ float wave_sum(float v) {
#pragma unroll
    for (int o = 1; o < 64; o <<= 1) v += __shfl_xor(v, o);
    return v;
}
__device__ __forceinline__ void unpack8(const u32x4 w, float (&f)[8]) {
    f[0] = bf_lo(w.x); f[1] = bf_hi(w.x); f[2] = bf_lo(w.y); f[3] = bf_hi(w.y); f[4] = bf_lo(w.z); f[5] = bf_hi(w.z); f[6] = bf_lo(w.w); f[7] = bf_hi(w.w);
}
__device__ __forceinline__ u32x4 pack8(const float (&f)[8]) { u32x4 w; w.x = pk2(f[0], f[1]); w.y = pk2(f[2], f[3]); w.z = pk2(f[4], f[5]); w.w = pk2(f[6], f[7]); return w; }

struct Ctx {
    const float* in[20]; float* out; unsigned char* ws;
};
#define WSP(T_, off) ((T_*)(X.ws + (off)))

__device__ __forceinline__ f32x4 mma16(const LAS bf16_t* A, int a0, const LAS bf16_t* B, int b0, f32x4 acc, int r, int q) {
#pragma unroll
    for (int ks = 0; ks < 2; ++ks) {
        const bf16x8 a = *(const LAS bf16x8*)(A + (a0 + r) * LT + ks * 32 + q * 8);
        const bf16x8 b = *(const LAS bf16x8*)(B + (b0 + r) * LT + ks * 32 + q * 8);
        acc = __builtin_amdgcn_mfma_f32_16x16x32_bf16(a, b, acc, 0, 0, 0);
    }
    return acc;
}
__device__ __forceinline__ void store_oloc(bf16_t* oloc, int uid, int w4, int lane, const f32x4 (&acc)[4]) {
    u32x4* p = (u32x4*)(oloc + ((size_t)uid * 4 + w4) * 1024 + lane * 16);
    u32x4 a, b;
    a.x = pk2(acc[0][0], acc[0][1]); a.y = pk2(acc[0][2], acc[0][3]); a.z = pk2(acc[1][0], acc[1][1]); a.w = pk2(acc[1][2], acc[1][3]);
    b.x = pk2(acc[2][0], acc[2][1]); b.y = pk2(acc[2][2], acc[2][3]); b.z = pk2(acc[3][0], acc[3][1]); b.w = pk2(acc[3][2], acc[3][3]);
    p[0] = a; p[1] = b;
}
__device__ __forceinline__ void store_bc(bf16_t* bcs, int uid, int w4, int r, int q, const f32x4 (&acc)[4]) {
#pragma unroll
    for (int ct = 0; ct < 4; ++ct) { u32x2 w; w.x = pk2(acc[ct][0], acc[ct][1]); w.y = pk2(acc[ct][2], acc[ct][3]);
        *(u32x2*)(bcs + (size_t)uid * 4096 + ((ct * 4 + w4) * 64 + q * 16 + r) * 4) = w; }
}


typedef __attribute__((address_space(1))) unsigned gu32;
#define XB_TMO      128
#define XB_XCNT(j)  (256  + 64 * (j))
#define XB_XSUB(j)  (1280 + 64 * (j))
#define XB_XGEN(j)  (2304 + 64 * (j))
#define XB_TOP      3328
#define XB_TOPGEN   3392
#define XCD_BAR_WORDS 3456
#define XB_SPIN_CAP (1u << 18)

__device__ __forceinline__ unsigned xb_ld(unsigned* p)              { return __hip_atomic_load(p, __ATOMIC_RELAXED, __HIP_MEMORY_SCOPE_AGENT); }
__device__ __forceinline__ unsigned xb_add(unsigned* p, unsigned v) { return __hip_atomic_fetch_add(p, v, __ATOMIC_RELAXED, __HIP_MEMORY_SCOPE_AGENT); }
__device__ __forceinline__ unsigned xb_xcc_id() { return (unsigned)__builtin_amdgcn_s_getreg((3 << 11) | 20) & 0xFu; }
#define XB_SPIN(cond, bar) do { unsigned _sp = 0; while (cond) { __builtin_amdgcn_s_sleep(1); \
    if ((++_sp & 255u) == 0u) { if (xb_ld(&(bar)[XB_TMO])) break; if (_sp > XB_SPIN_CAP) { atomicAdd(&(bar)[XB_TMO], 1u); break; } } } } while (0)

struct XcdBarrier {
    unsigned* bar; unsigned x;
    volatile LAS unsigned* st;
};

__device__ __forceinline__ XcdBarrier xcd_barrier_post(unsigned* bar, volatile LAS unsigned* st) {
    XcdBarrier b; b.bar = bar; b.x = xb_xcc_id(); b.st = st;
    if (threadIdx.x == 0) (void)xb_add(&bar[XB_XCNT(b.x)], 1u);
    return b;
}
__device__ __forceinline__ void xcd_barrier_complete(unsigned* bar, unsigned x, unsigned& nloc, unsigned& nx) {
    const unsigned G = gridDim.x * gridDim.y * gridDim.z;
    unsigned sum, cnt, mine, sp = 0u;
    for (;;) {
        sum = 0u; cnt = 0u; mine = 0u;
#pragma unroll
        for (unsigned j = 0; j < 16; ++j) { const unsigned c = xb_ld(&bar[XB_XCNT(j)]); sum += c; cnt += (c > 0u) ? 1u : 0u; mine = (j == x) ? c : mine; }
        if (sum == G) break;
        __builtin_amdgcn_s_sleep(1);
        if ((++sp & 255u) == 0u) { if (xb_ld(&bar[XB_TMO])) break; if (sp > XB_SPIN_CAP) { atomicAdd(&bar[XB_TMO], 1u); break; } }
    }
    nloc = mine > 0u ? mine : 1u; nx = cnt > 0u ? cnt : 1u;
}

__device__ __forceinline__ void xcd_barrier(const XcdBarrier& b) {
    asm volatile("s_waitcnt vmcnt(0)" ::: "memory");
    __syncthreads();
    if (threadIdx.x == 0) {
        unsigned* bar = b.bar;
        __builtin_amdgcn_s_waitcnt(0);
        unsigned nloc = b.st[0], nx = b.st[1];
        if (nloc == 0u) { xcd_barrier_complete(bar, b.x, nloc, nx); b.st[0] = nloc; b.st[1] = nx; }
        const unsigned old = xb_add(&bar[XB_XSUB(b.x)], 1u);
        const unsigned gen = old / nloc;
        if (old + 1u == (gen + 1u) * nloc) {
            __builtin_amdgcn_fence(__ATOMIC_RELEASE, "agent");
            asm volatile("s_waitcnt vmcnt(0)" ::: "memory");
            const unsigned og = xb_add(&bar[XB_TOP], 1u);
            const unsigned tg = og / nx;
            if (og + 1u == (tg + 1u) * nx) xb_add(&bar[XB_TOPGEN], 1u);
            else XB_SPIN(xb_ld(&bar[XB_TOPGEN]) == tg, bar);
            __builtin_amdgcn_fence(__ATOMIC_ACQUIRE, "agent");
            xb_add(&bar[XB_XGEN(b.x)], 1u);
            asm volatile("s_waitcnt vmcnt(0)" ::: "memory");
        } else {
            XB_SPIN(xb_ld(&bar[XB_XGEN(b.x)]) == gen, bar);
            __builtin_amdgcn_fence(__ATOMIC_ACQUIRE, "agent");
            asm volatile("s_waitcnt vmcnt(0)" ::: "memory");
        }
    }
    __syncthreads();
}

__device__ __forceinline__ void transpose_item(const float* W, int K, int N, bf16_t* WT, int mode, LAS float* scr, int kb, int nb, int lane, const float* kscale, int coff) {
    const int k0 = 64 * kb, n0 = 32 * nb;
    const int nn = n0 + (lane & 31) + coff;
#pragma unroll 8
    for (int i = 0; i < 32; ++i) { const int kk = 2 * i + (lane >> 5); const float ksc = kscale ? kscale[k0 + kk] : 1.0f; scr[kk * 33 + (lane & 31)] = nn < N ? W[(size_t)(k0 + kk) * N + nn] * ksc : 0.f; }
    asm volatile("s_waitcnt lgkmcnt(0)" ::: "memory");
    const int c = lane & 7;
#pragma unroll
    for (int j = 0; j < 4; ++j) { const int n = (lane >> 3) + 8 * j; const LAS float* s = scr + (8 * c) * 33 + n;
        u32x4 o; o.x = pk2(s[0 * 33], s[1 * 33]); o.y = pk2(s[2 * 33], s[3 * 33]); o.z = pk2(s[4 * 33], s[5 * 33]); o.w = pk2(s[6 * 33], s[7 * 33]);
        const int ng = n0 + n; const int row = mode == 0 ? ng : ((ng >> 7) * 256 + (ng & 127) + (mode == 2 ? 128 : 0));
        *(u32x4*)(WT + (size_t)row * K + k0 + 8 * c) = o; }
    asm volatile("s_waitcnt lgkmcnt(0)" ::: "memory");
}
__device__ __forceinline__ void prep_weights(const Ctx& X, LAS unsigned char* lds, int gw, int ngw, int wave, int lane, int it_lo, int it_hi) {
    LAS float* scr = (LAS float*)(lds + wave * 16384);
    constexpr int I_IN = (D / 64) * (NINP / 32), I_OUT = (D / 64) * (D / 32), I_G = (D / 64) * (DFF / 32), I_DN = (DFF / 64) * (D / 32);
    constexpr int PER_L = I_IN + I_OUT + 2 * I_G + I_DN;
    asm volatile("" : "+v"(lane));
    for (int it = it_lo + gw; it < it_hi; it += ngw) {
        const int l = it / PER_L; int r = it % PER_L;
        if (r < I_IN) { transpose_item(X.in[2] + (size_t)l * D * DIN, D, DIN, WSP(bf16_t, WS_WIN) + (size_t)l * NINP * D, 0, scr, r / (NINP / 32), r % (NINP / 32), lane, X.in[1] + l * D, (r % (NINP / 32)) * 32 >= 2560 ? 8 : 0); continue; } r -= I_IN;
        if (r < I_OUT) { transpose_item(X.in[14] + (size_t)l * D * D, D, D, WSP(bf16_t, WS_WOUT) + (size_t)l * D * D, 0, scr, r / (D / 32), r % (D / 32), lane, nullptr, 0); continue; } r -= I_OUT;
        if (r < I_G) { transpose_item(X.in[16] + (size_t)l * D * DFF, D, DFF, WSP(bf16_t, WS_WGU) + (size_t)l * NGU * D, 1, scr, r / (DFF / 32), r % (DFF / 32), lane, X.in[15] + l * D, 0); continue; } r -= I_G;
        if (r < I_G) { transpose_item(X.in[17] + (size_t)l * D * DFF, D, DFF, WSP(bf16_t, WS_WGU) + (size_t)l * NGU * D, 2, scr, r / (DFF / 32), r % (DFF / 32), lane, X.in[15] + l * D, 0); continue; } r -= I_G;
        transpose_item(X.in[18] + (size_t)l * DFF * D, DFF, D, WSP(bf16_t, WS_WDN) + (size_t)l * D * DFF, 0, scr, r / (D / 32), r % (D / 32), lane, nullptr, 0);
    }
}
__device__ __forceinline__ void rms_row(const float* xrow, const float* w, bf16_t* orow, float* of, int lane) {
    const f32x4* xr = (const f32x4*)xrow + lane; const f32x4* wr = (const f32x4*)w + lane;
    f32x4 v[4]; float s = 0.f;
#pragma unroll
    for (int j = 0; j < 4; ++j) { v[j] = xr[64 * j]; s += (v[j].x * v[j].x + v[j].y * v[j].y) + (v[j].z * v[j].z + v[j].w * v[j].w); }
    const float rstd = 1.0f / sqrtf(wave_sum(s) * (1.f / D) + 1e-6f);
#pragma unroll
    for (int j = 0; j < 4; ++j) { const f32x4 ww = wr[64 * j]; const f32x4 o = v[j] * rstd * ww;
        if (of) ((f32x4*)of + lane)[64 * j] = o;
        else { u32x2 p; p.x = pk2(o.x, o.y); p.y = pk2(o.z, o.w); ((u32x2*)orow + lane)[64 * j] = p; } }
}
__device__ __forceinline__ void cast_phase(const float* x, bf16_t* xb, float* rowsq, int gw, int ngw, int lane) {
    asm volatile("" : "+v"(lane));
    for (int m = gw; m < M; m += ngw) {
        const f32x4* xr = (const f32x4*)(x + (size_t)m * D) + lane; float s = 0.f;
#pragma unroll
        for (int j = 0; j < 4; ++j) { const f32x4 v = xr[64 * j]; s += (v.x * v.x + v.y * v.y) + (v.z * v.z + v.w * v.w); u32x2 p; p.x = pk2(v.x, v.y); p.y = pk2(v.z, v.w); ((u32x2*)(xb + (size_t)m * D) + lane)[64 * j] = p; }
        s = wave_sum(s); if (lane == 0) rowsq[m] = s;
    }
}
__device__ __forceinline__ void norm_phase(const float* x, const float* w, bf16_t* xn, float* of, int gw, int ngw, int lane) {
    asm volatile("" : "+v"(lane));
    for (int m = gw; m < M; m += ngw) rms_row(x + (size_t)m * D, w, xn ? xn + (size_t)m * D : nullptr, of ? of + (size_t)m * D : nullptr, lane);
}

__device__ __forceinline__ int unit_id(int mixer, int b, int h, int c) { return ((mixer * 4 + b) * 4 + h) * NCH + c; }

__device__ __forceinline__ void ret_unit(const Ctx& X, LAS unsigned char* hl, int b, int c, int h, int tid_h, int w4, int lane) {
    LAS bf16_t* QR = opq((LAS bf16_t*)hl); LAS bf16_t* KR = opq(QR + 64 * LT); LAS bf16_t* KDT = opq(KR + 64 * LT); LAS bf16_t* VT = opq(KDT + 64 * LT); LAS bf16_t* P = opq(VT + 64 * LT);
    const bf16_t* proj = WSP(const bf16_t, WS_PROJ);
    const int uid = unit_id(0, b, h, c);
    const int r = lane & 15, q = lane >> 4;
    const float lg = log1pf(-exp2f(-5.0f - (float)h));
    {
        const int i = tid_h >> 2, sg = tid_h & 3, d0 = sg * 8;
        const bf16_t* pr = proj + ((size_t)b * T + c * 64 + i) * LDP;
        const u32x4 q1 = *(const u32x4*)(pr + C_RQ + h * 64 + d0), q2 = *(const u32x4*)(pr + C_RQ + h * 64 + d0 + 32);
        const u32x4 k1 = *(const u32x4*)(pr + C_RK + h * 64 + d0), k2 = *(const u32x4*)(pr + C_RK + h * 64 + d0 + 32);
        const u32x4 v1 = *(const u32x4*)(pr + C_RV + h * 64 + sg * 16), v2 = *(const u32x4*)(pr + C_RV + h * 64 + sg * 16 + 8);
        float qa[8], qb[8], ka[8], kb[8], va[8], vb[8];
        unpack8(q1, qa); unpack8(q2, qb); unpack8(k1, ka); unpack8(k2, kb); unpack8(v1, va); unpack8(v2, vb);
        const float pos = (float)(c * 64 + i);
        const float qd = fexp(lg * (float)(i + 1)), kd = fexp(lg * (float)(63 - i));
        float qr1[8], qr2[8], kr1[8], kr2[8], qe1[8], qe2[8];
#pragma unroll
        for (int e = 0; e < 8; ++e) {
            const float inv = exp2f(-(float)(d0 + e) * (13.287712379549449f / 32.0f));
            const float rev = __builtin_amdgcn_fractf(pos * inv * 0.15915494309189535f); const float sn = __builtin_amdgcn_sinf(rev), cs = __builtin_amdgcn_cosf(rev);
            qr1[e] = qa[e] * cs - qb[e] * sn; qr2[e] = qa[e] * sn + qb[e] * cs;
            kr1[e] = (ka[e] * cs - kb[e] * sn) * 0.125f; kr2[e] = (ka[e] * sn + kb[e] * cs) * 0.125f;
            qe1[e] = qr1[e] * qd; qe2[e] = qr2[e] * qd;
            KDT[(d0 + e) * LT + i] = f2bf(kr1[e] * kd); KDT[(d0 + 32 + e) * LT + i] = f2bf(kr2[e] * kd);
            VT[(sg * 16 + e) * LT + i] = f2bf(va[e]); VT[(sg * 16 + 8 + e) * LT + i] = f2bf(vb[e]);
        }
        *(LAS u32x4*)(QR + i * LT + d0) = pack8(qr1); *(LAS u32x4*)(QR + i * LT + d0 + 32) = pack8(qr2);
        *(LAS u32x4*)(KR + i * LT + d0) = pack8(kr1); *(LAS u32x4*)(KR + i * LT + d0 + 32) = pack8(kr2);
        bf16_t* qe = WSP(bf16_t, WS_QEFF) + (size_t)uid * 4096 + i * 64;
        *(u32x4*)(qe + d0) = pack8(qe1); *(u32x4*)(qe + d0 + 32) = pack8(qe2);
    }
    __syncthreads();
    f32x4 acc[4];
#pragma unroll
    for (int ct = 0; ct < 4; ++ct) acc[ct] = mma16(QR, 16 * w4, KR, 16 * ct, (f32x4){0.f, 0.f, 0.f, 0.f}, r, q);
#pragma unroll
    for (int ct = 0; ct < 4; ++ct)
#pragma unroll
        for (int j = 0; j < 4; ++j) { const int ii = 16 * w4 + 4 * q + j, col = 16 * ct + r;
            P[ii * LT + col] = f2bf(ii >= col ? acc[ct][j] * fexp(lg * (float)(ii - col)) : 0.f); }
    __syncthreads();
#pragma unroll
    for (int ct = 0; ct < 4; ++ct) acc[ct] = mma16(P, 16 * w4, VT, 16 * ct, (f32x4){0.f, 0.f, 0.f, 0.f}, r, q);
    store_oloc(WSP(bf16_t, WS_OLOC), uid, w4, lane, acc);
#pragma unroll
    for (int ct = 0; ct < 4; ++ct) acc[ct] = mma16(KDT, 16 * w4, VT, 16 * ct, (f32x4){0.f, 0.f, 0.f, 0.f}, r, q);
    store_bc(WSP(bf16_t, WS_BCS), uid, w4, r, q, acc);
    __syncthreads();
}

__device__ __forceinline__ void hgrn_unit(const Ctx& X, LAS unsigned char* hl, int b, int c, int h, int tid_h, int w4, int lane, int layer) {
    LAS bf16_t* QT = opq((LAS bf16_t*)hl);
    LAS float* Gt = opq((LAS float*)(hl + 9216));
    LAS bf16_t* Kt = opq((LAS bf16_t*)(hl + 25600));
    LAS bf16_t* KTI = opq((LAS bf16_t*)(hl + 34816));
    LAS bf16_t* VT = KTI; LAS bf16_t* KDT = opq(KTI + 64 * LT);
    LAS float* tot = opq((LAS float*)(hl + 57856));
    const bf16_t* proj = WSP(const bf16_t, WS_PROJ);
    const int uid = unit_id(2, b, h, c);
    const int r = lane & 15, q = lane >> 4;
    const int i = tid_h >> 2, ds = (tid_h & 3) * 16;
    const bf16_t* pr = proj + ((size_t)b * T + c * 64 + i) * LDP;
    float kk[16], qv[16], vv[16];
    {
        float ff[16];
        { float t0[8], t1[8]; unpack8(*(const u32x4*)(pr + C_HF + h * 64 + ds), t0); unpack8(*(const u32x4*)(pr + C_HF + h * 64 + ds + 8), t1);
#pragma unroll
          for (int e = 0; e < 8; ++e) { ff[e] = t0[e]; ff[8 + e] = t1[e]; } }
        { float t0[8], t1[8]; unpack8(*(const u32x4*)(pr + C_HQ + h * 64 + ds), t0); unpack8(*(const u32x4*)(pr + C_HQ + h * 64 + ds + 8), t1);
#pragma unroll
          for (int e = 0; e < 8; ++e) { qv[e] = t0[e]; qv[8 + e] = t1[e]; } }
        { float t0[8], t1[8]; unpack8(*(const u32x4*)(pr + C_HI + h * 64 + ds), t0); unpack8(*(const u32x4*)(pr + C_HI + h * 64 + ds + 8), t1);
#pragma unroll
          for (int e = 0; e < 8; ++e) { vv[e] = t0[e]; vv[8 + e] = t1[e]; } }
#pragma unroll
        for (int e = 0; e < 16; ++e) {
            const int ch = h * 64 + ds + e;
            const float lb = layer == 0 ? 0.f : sigmoid_f(X.in[12][256 + ch] - X.in[12][ch]);
            const float f = ff[e];
            const float ls = fminf(f, 0.f) - __logf(1.0f + fexp(-fabsf(f)));
            const float lf = layer == 0 ? ls : __logf(lb + (1.f - lb) * fexp(ls));
            kk[e] = (1.f - lb) * frcp(1.f + fexp(f));
            Gt[i * 64 + ds + e] = lf;
        }
    }
    __syncthreads();
    {
        const int d = tid_h & 63, seg = tid_h >> 6; float cs[16]; float run = 0.f;
#pragma unroll
        for (int jj = 0; jj < 16; ++jj) { run += Gt[(16 * seg + jj) * 64 + d]; cs[jj] = run; }
        tot[seg * 64 + d] = run;
        __syncthreads();
        float off = 0.f;
#pragma unroll
        for (int s = 0; s < 3; ++s) off += (s < seg) ? tot[s * 64 + d] : 0.f;
#pragma unroll
        for (int jj = 0; jj < 16; ++jj) Gt[(16 * seg + jj) * 64 + d] = cs[jj] + off;
    }
    __syncthreads();
    float Gi[16], G63[16];
    {
        const int I = i >> 4;
        float qt[16], qe[16];
#pragma unroll
        for (int e = 0; e < 16; ++e) { Gi[e] = Gt[i * 64 + ds + e]; G63[e] = Gt[63 * 64 + ds + e]; const float gr = Gt[(16 * I) * 64 + ds + e];
            qt[e] = qv[e] * fexp(Gi[e] - gr); qe[e] = qv[e] * fexp(Gi[e]); }
        u32x4 w0, w1;
        w0.x = pk2(qt[0], qt[1]); w0.y = pk2(qt[2], qt[3]); w0.z = pk2(qt[4], qt[5]); w0.w = pk2(qt[6], qt[7]);
        w1.x = pk2(qt[8], qt[9]); w1.y = pk2(qt[10], qt[11]); w1.z = pk2(qt[12], qt[13]); w1.w = pk2(qt[14], qt[15]);
        *(LAS u32x4*)(QT + i * LT + ds) = w0; *(LAS u32x4*)(QT + i * LT + ds + 8) = w1;
        w0.x = pk2(qe[0], qe[1]); w0.y = pk2(qe[2], qe[3]); w0.z = pk2(qe[4], qe[5]); w0.w = pk2(qe[6], qe[7]);
        w1.x = pk2(qe[8], qe[9]); w1.y = pk2(qe[10], qe[11]); w1.z = pk2(qe[12], qe[13]); w1.w = pk2(qe[14], qe[15]);
        bf16_t* qg = WSP(bf16_t, WS_QEFF) + (size_t)uid * 4096 + i * 64 + ds;
        *(u32x4*)qg = w0; *(u32x4*)(qg + 8) = w1;
        w0.x = pk2(kk[0], kk[1]); w0.y = pk2(kk[2], kk[3]); w0.z = pk2(kk[4], kk[5]); w0.w = pk2(kk[6], kk[7]);
        w1.x = pk2(kk[8], kk[9]); w1.y = pk2(kk[10], kk[11]); w1.z = pk2(kk[12], kk[13]); w1.w = pk2(kk[14], kk[15]);
        *(LAS u32x4*)(Kt + i * LT + ds) = w0; *(LAS u32x4*)(Kt + i * LT + ds + 8) = w1;
        if (i == 63) { float* mv = WSP(float, WS_MVEC) + (size_t)(uid - 2 * 2048) * 64 + ds;
#pragma unroll
            for (int e = 0; e < 16; ++e) mv[e] = fexp(G63[e]); }
    }
    __syncthreads();
    const int I = w4;
    LAS bf16_t* KI = opq(KTI + (8 * I * (I + 1)) * LT);
    {
        const int nit = 16 * (I + 1) * 8;
        for (int idx = lane; idx < nit; idx += 64) { const int j = idx >> 3, d8 = (idx & 7) * 8;
            float kf[8]; unpack8(*(const LAS u32x4*)(Kt + j * LT + d8), kf);
            float o[8];
#pragma unroll
            for (int e = 0; e < 8; ++e) o[e] = kf[e] * fexp(fminf(Gt[(16 * I) * 64 + d8 + e] - Gt[j * 64 + d8 + e], 80.f));
            *(LAS u32x4*)(KI + j * LT + d8) = pack8(o); }
    }
    __syncthreads();
    f32x4 acc[4];
    {
        bf16x8 a[2];
#pragma unroll
        for (int ks = 0; ks < 2; ++ks) a[ks] = *(const LAS bf16x8*)(QT + (16 * I + r) * LT + ks * 32 + q * 8);
#pragma unroll
        for (int ct = 0; ct < 4; ++ct) { acc[ct] = (f32x4){0.f, 0.f, 0.f, 0.f};
            if (ct <= I) {
#pragma unroll
                for (int ks = 0; ks < 2; ++ks) { const bf16x8 bb = *(const LAS bf16x8*)(KI + (16 * ct + r) * LT + ks * 32 + q * 8);
                    acc[ct] = __builtin_amdgcn_mfma_f32_16x16x32_bf16(a[ks], bb, acc[ct], 0, 0, 0); } } }
        asm volatile("s_waitcnt lgkmcnt(0)" ::: "memory");
#pragma unroll
        for (int ct = 0; ct < 4; ++ct)
#pragma unroll
            for (int j = 0; j < 4; ++j) { const int ii = 16 * I + 4 * q + j, col = 16 * ct + r;
                QT[ii * LT + col] = f2bf((ct <= I && ii >= col) ? acc[ct][j] : 0.f); }
    }
    __syncthreads();
    {
#pragma unroll
        for (int e = 0; e < 16; ++e) { VT[(ds + e) * LT + i] = f2bf(vv[e]); KDT[(ds + e) * LT + i] = f2bf(kk[e] * fexp(G63[e] - Gi[e])); }
    }
    __syncthreads();
#pragma unroll
    for (int ct = 0; ct < 4; ++ct) acc[ct] = mma16(QT, 16 * w4, VT, 16 * ct, (f32x4){0.f, 0.f, 0.f, 0.f}, r, q);
    store_oloc(WSP(bf16_t, WS_OLOC), uid, w4, lane, acc);
#pragma unroll
    for (int ct = 0; ct < 4; ++ct) acc[ct] = mma16(KDT, 16 * w4, VT, 16 * ct, (f32x4){0.f, 0.f, 0.f, 0.f}, r, q);
    store_bc(WSP(bf16_t, WS_BCS), uid, w4, r, q, acc);
    __syncthreads();
}

__device__ __forceinline__ void gdn_unit(const Ctx& X, LAS unsigned char* hl, int b, int c, int h, int tid_h, int w4, int lane, int layer) {
    LAS bf16_t* Q = opq((LAS bf16_t*)hl); LAS bf16_t* K = opq(Q + 64 * LT); LAS bf16_t* KB = opq(K + 64 * LT); LAS bf16_t* V = opq(KB + 64 * LT); LAS bf16_t* KDT = opq(V + 64 * LT); LAS bf16_t* P = opq(KDT + 64 * LT);
    LAS bf16_t* WT = KB; LAS bf16_t* UT = V;
    LAS bf16_t* AB = opq((LAS bf16_t*)(hl + 55296));
    LAS float* ACCS = opq((LAS float*)(hl + 64512));
    LAS float* Gs = opq((LAS float*)(hl + 72704));
    LAS float* Bs = opq(Gs + 64);
    const bf16_t* proj = WSP(const bf16_t, WS_PROJ);
    const int uid = unit_id(1, b, h, c);
    const int r = lane & 15, q = lane >> 4;
    {
    LAS bf16_t* RAW = opq((LAS bf16_t*)(hl + 46080));
    const int cseg = tid_h & 7, i0 = tid_h >> 3;
    f32x4 wq[3][4][2];
    {
        const float* cw = X.in[8] + (size_t)layer * 4 * 768 + h * 64 + cseg * 8;
#pragma unroll
        for (int tn = 0; tn < 3; ++tn)
#pragma unroll
            for (int k = 0; k < 4; ++k) { const f32x4* wp = (const f32x4*)(cw + k * 768 + tn * 256); wq[tn][k][0] = wp[0]; wq[tn][k][1] = wp[1]; }
        u32x4 rawv[7];
#pragma unroll
        for (int n = 0; n < 7; ++n) { const int item = tid_h + 256 * n; const int seg = item & 7; int rowid = item >> 3; rowid = rowid < 201 ? rowid : 200;
            const int tn = rowid / 67, rr = rowid - tn * 67; const int tt = c * 64 - 3 + rr; const int ttc = tt < 0 ? 0 : tt;
            const u32x4 v = *(const u32x4*)(proj + ((size_t)b * T + ttc) * LDP + C_GQ + tn * 256 + h * 64 + seg * 8);
            rawv[n] = tt < 0 ? (u32x4){0u, 0u, 0u, 0u} : v; }
        float g = 0.f, bt = 0.f;
        if (tid_h < 64) {
            const bf16_t* pr = proj + ((size_t)b * T + c * 64 + tid_h) * LDP;
            const float* gba = WSP(const float, WS_GBA) + ((size_t)b * T + c * 64 + tid_h) * 8; const float gb = gba[h], ga = gba[4 + h];
            g = -fexp(X.in[9][layer * 4 + h]) * softplus_f(ga + X.in[10][layer * 4 + h]);
#pragma unroll
            for (int o = 1; o < 64; o <<= 1) { const float t = __shfl_up(g, o); if (lane >= o) g += t; }
            bt = sigmoid_f(gb);
            Gs[tid_h] = g; Bs[tid_h] = bt;
        }
#pragma unroll
        for (int n = 0; n < 7; ++n) { const int item = tid_h + 256 * n; if (item < 1608) *(LAS u32x4*)(RAW + (item >> 3) * 64 + (item & 7) * 8) = rawv[n]; }
    }
    __syncthreads();
    {
        const float G63 = Gs[63];
#pragma unroll
        for (int rs = 0; rs < 2; ++rs) {
            const int i = i0 + 32 * rs;
            const float bi = Bs[i], Gi = Gs[i];
            float y[3][8];
#pragma unroll
            for (int tn = 0; tn < 3; ++tn) {
#pragma unroll
                for (int e = 0; e < 8; ++e) y[tn][e] = 0.f;
#pragma unroll
                for (int k = 0; k < 4; ++k) { float x8[8]; unpack8(*(const LAS u32x4*)(RAW + (tn * 67 + i + k) * 64 + cseg * 8), x8);
                    y[tn][0] += wq[tn][k][0].x * x8[0]; y[tn][1] += wq[tn][k][0].y * x8[1]; y[tn][2] += wq[tn][k][0].z * x8[2]; y[tn][3] += wq[tn][k][0].w * x8[3];
                    y[tn][4] += wq[tn][k][1].x * x8[4]; y[tn][5] += wq[tn][k][1].y * x8[5]; y[tn][6] += wq[tn][k][1].z * x8[6]; y[tn][7] += wq[tn][k][1].w * x8[7]; }
#pragma unroll
                for (int e = 0; e < 8; ++e) y[tn][e] = silu_acc(y[tn][e]);
            }
            float sq = 0.f, sk = 0.f;
#pragma unroll
            for (int e = 0; e < 8; ++e) { sq += y[0][e] * y[0][e]; sk += y[1][e] * y[1][e]; }
            sq += __shfl_xor(sq, 1); sq += __shfl_xor(sq, 2); sq += __shfl_xor(sq, 4);
            sk += __shfl_xor(sk, 1); sk += __shfl_xor(sk, 2); sk += __shfl_xor(sk, 4);
            const float rq = 0.125f * rsqrtf(sq + 1e-6f), rk = rsqrtf(sk + 1e-6f), kd = rk * fexp(G63 - Gi);
            float t8[8];
#pragma unroll
            for (int e = 0; e < 8; ++e) t8[e] = y[0][e] * rq;
            *(LAS u32x4*)(Q + i * LT + cseg * 8) = pack8(t8);
#pragma unroll
            for (int e = 0; e < 8; ++e) t8[e] = y[1][e] * rk;
            *(LAS u32x4*)(K + i * LT + cseg * 8) = pack8(t8);
#pragma unroll
            for (int e = 0; e < 8; ++e) t8[e] = y[1][e] * rk * bi;
            *(LAS u32x4*)(KB + i * LT + cseg * 8) = pack8(t8);
            *(LAS u32x4*)(V + i * LT + cseg * 8) = pack8(y[2]);
#pragma unroll
            for (int e = 0; e < 8; ++e) KDT[(cseg * 8 + e) * LT + i] = f2bf(y[1][e] * kd);
        }
    }
    __syncthreads();
    }
    {
        f32x4 aA[4], aP[4];
#pragma unroll
        for (int ct = 0; ct < 4; ++ct) { aA[ct] = mma16(KB, 16 * w4, K, 16 * ct, (f32x4){0.f, 0.f, 0.f, 0.f}, r, q); aP[ct] = mma16(Q, 16 * w4, K, 16 * ct, (f32x4){0.f, 0.f, 0.f, 0.f}, r, q); }
#pragma unroll
        for (int ct = 0; ct < 4; ++ct)
#pragma unroll
            for (int j = 0; j < 4; ++j) { const int ii = 16 * w4 + 4 * q + j, col = 16 * ct + r;
                const float L = fexp(fminf(Gs[ii] - Gs[col], 0.f));
                AB[ii * LT + col] = f2bf(ii > col ? aA[ct][j] * L : 0.f);
                P[ii * LT + col] = f2bf(ii >= col ? aP[ct][j] * L : 0.f); }
    }
    __syncthreads();
    float rc[64];
    if (w4 < 2) {
        const int col = tid_h & 63; const LAS bf16_t* src = w4 == 0 ? V : KB;
#pragma unroll
        for (int i = 0; i < 64; ++i) { const float sc = w4 == 0 ? Bs[i] : fexp(Gs[i]); rc[i] = bf2f(src[i * LT + col]) * sc; }
    }
    __syncthreads();
    {
    for (int idx = tid_h; idx < 1152; idx += 256) { const int tl = idx >= 576; const int rem = idx - tl * 576; *(LAS u32x4*)((tl ? KB : V) + rem * 8) = (u32x4){0u, 0u, 0u, 0u}; }
    __syncthreads();
#pragma unroll
    for (int I = 0; I < 4; ++I) {
        if (I > 0) {
#pragma unroll
            for (int t2 = 0; t2 < 2; ++t2) { const int ct8 = 2 * w4 + t2; const LAS bf16_t* Bt = ct8 < 4 ? UT : WT;
                const f32x4 a = mma16(AB, 16 * I, Bt, 16 * (ct8 & 3), (f32x4){0.f, 0.f, 0.f, 0.f}, r, q);
#pragma unroll
                for (int j = 0; j < 4; ++j) ACCS[(4 * q + j) * 128 + 16 * ct8 + r] = a[j]; }
            __syncthreads();
        }
        if (w4 < 2) {
            const int col = tid_h & 63, c128 = w4 * 64 + col;
            float t[16];
#pragma unroll
            for (int ii = 0; ii < 16; ++ii) t[ii] = rc[16 * I + ii] - (I > 0 ? ACCS[ii * 128 + c128] : 0.f);
#pragma unroll
            for (int ii = 1; ii < 16; ++ii) {
                float a16[16];
                { float lo[8]; unpack8(*(const LAS u32x4*)(AB + (16 * I + ii) * LT + 16 * I), lo);
#pragma unroll
                  for (int e = 0; e < 8; ++e) a16[e] = lo[e]; }
                if (ii > 8) { float hi[8]; unpack8(*(const LAS u32x4*)(AB + (16 * I + ii) * LT + 16 * I + 8), hi);
#pragma unroll
                  for (int e = 0; e < 8; ++e) a16[8 + e] = hi[e]; }
                float s0 = t[ii], s1 = 0.f;
#pragma unroll
                for (int kk = 0; kk < ii; ++kk) { if (kk & 1) s1 -= a16[kk] * t[kk]; else s0 -= a16[kk] * t[kk]; }
                t[ii] = s0 + s1;
            }
            LAS bf16_t* dst = (w4 == 0 ? UT : WT) + col * LT + 16 * I;
            u32x4 w0, w1;
            w0.x = pk2(t[0], t[1]); w0.y = pk2(t[2], t[3]); w0.z = pk2(t[4], t[5]); w0.w = pk2(t[6], t[7]);
            w1.x = pk2(t[8], t[9]); w1.y = pk2(t[10], t[11]); w1.z = pk2(t[12], t[13]); w1.w = pk2(t[14], t[15]);
            *(LAS u32x4*)dst = w0; *(LAS u32x4*)(dst + 8) = w1;
        }
        __syncthreads();
    }
    }
    {
        f32x4 acc[4];
        const float eG63 = fexp(Gs[63]);
#pragma unroll
        for (int ct = 0; ct < 4; ++ct) acc[ct] = mma16(P, 16 * w4, WT, 16 * ct, (f32x4){0.f, 0.f, 0.f, 0.f}, r, q);
        bf16_t* qe = WSP(bf16_t, WS_QEFF) + (size_t)uid * 4096;
#pragma unroll
        for (int ct = 0; ct < 4; ++ct)
#pragma unroll
            for (int j = 0; j < 4; ++j) { const int ii = 16 * w4 + 4 * q + j, col = 16 * ct + r;
                qe[ii * 64 + col] = f2bf(bf2f(Q[ii * LT + col]) * fexp(Gs[ii]) - acc[ct][j]); }
#pragma unroll
        for (int ct = 0; ct < 4; ++ct) acc[ct] = mma16(P, 16 * w4, UT, 16 * ct, (f32x4){0.f, 0.f, 0.f, 0.f}, r, q);
        store_oloc(WSP(bf16_t, WS_OLOC), uid, w4, lane, acc);
#pragma unroll
        for (int ct = 0; ct < 4; ++ct) acc[ct] = mma16(KDT, 16 * w4, WT, 16 * ct, (f32x4){0.f, 0.f, 0.f, 0.f}, r, q);
        bf16_t* mm = WSP(bf16_t, WS_MM) + (size_t)(uid - 2048) * 4096;
#pragma unroll
        for (int ct = 0; ct < 4; ++ct)
#pragma unroll
            for (int j = 0; j < 4; ++j) { const int ii = 16 * w4 + 4 * q + j, col = 16 * ct + r;
                mm[((w4 * 2 + (ct >> 1)) * 64 + (r >> 2) * 16 + 4 * q + j) * 8 + (ct & 1) * 4 + (r & 3)] = f2bf((ii == col ? eG63 : 0.f) - acc[ct][j]); }
#pragma unroll
        for (int ct = 0; ct < 4; ++ct) acc[ct] = mma16(KDT, 16 * w4, UT, 16 * ct, (f32x4){0.f, 0.f, 0.f, 0.f}, r, q);
        store_bc(WSP(bf16_t, WS_BCS), uid, w4, r, q, acc);
    }
    __syncthreads();
}

__device__ __forceinline__ void conf_unit(const Ctx& X, LAS unsigned char* lds, int b, int c, int tid, int wave, int lane, int layer) {
    LAS bf16_t* GL = opq((LAS bf16_t*)lds);
    LAS float* Y = opq((LAS float*)(lds + 49152));
    const bf16_t* proj = WSP(const bf16_t, WS_PROJ);
    bf16_t* mix = WSP(bf16_t, WS_MIX);
    const int t0 = c * 64;
    for (int item = tid; item < 94 * 32; item += 512) { const int rr = item >> 5, seg = (item & 31) * 8, tt = t0 - 30 + rr;
        u32x4 w = (u32x4){0u, 0u, 0u, 0u};
        if (tt >= 0) { const bf16_t* pr = proj + ((size_t)b * T + tt) * LDP; float a[8], g[8], o[8]; unpack8(*(const u32x4*)(pr + C_CA + seg), a); unpack8(*(const u32x4*)(pr + C_CG + seg), g);
#pragma unroll
            for (int e = 0; e < 8; ++e) o[e] = a[e] * sigmoid_f(g[e]);
            w = pack8(o); }
        *(LAS u32x4*)(GL + rr * 256 + seg) = w; }
    __syncthreads();
    {
        const int ch = tid & 255, half = tid >> 8;
        const float* cw = X.in[4] + (size_t)layer * 31 * 256 + ch;
        float w[31];
#pragma unroll
        for (int k = 0; k < 31; ++k) w[k] = cw[k * 256];
        const float bias = X.in[5][layer * 256 + ch];
        float acc[32];
#pragma unroll
        for (int tk = 0; tk < 32; ++tk) acc[tk] = bias;
#pragma unroll
        for (int rr = 0; rr < 62; ++rr) { const float g = bf2f(GL[(half * 32 + rr) * 256 + ch]);
#pragma unroll
            for (int tk = 0; tk < 32; ++tk) { const int k = rr - tk; if (k >= 0 && k < 31) acc[tk] += w[k] * g; } }
#pragma unroll
        for (int tk = 0; tk < 32; ++tk) Y[(half * 32 + tk) * 256 + ch] = acc[tk];
    }
    __syncthreads();
    {
        const f32x4 lw = *((const f32x4*)(X.in[6] + layer * 256) + lane), lb = *((const f32x4*)(X.in[7] + layer * 256) + lane);
#pragma unroll 2
        for (int tk = wave * 8; tk < wave * 8 + 8; ++tk) {
            const f32x4 v = *((const LAS f32x4*)(Y + tk * 256) + lane);
            const float mu = wave_sum((v.x + v.y) + (v.z + v.w)) * (1.f / 256.f);
            const f32x4 dv = v - mu;
            const float var = wave_sum((dv.x * dv.x + dv.y * dv.y) + (dv.z * dv.z + dv.w * dv.w)) * (1.f / 256.f);
            const float rs = rsqrtf(var + 1e-5f);
            f32x4 o = dv * rs * lw + lb;
            const bool on = (MIX_MASK & 2) != 0;
            u32x2 p; p.x = on ? pk2(silu_acc(o.x), silu_acc(o.y)) : 0u; p.y = on ? pk2(silu_acc(o.z), silu_acc(o.w)) : 0u;
            *(u32x2*)(mix + ((size_t)b * T + t0 + tk) * D + 256 + lane * 4) = p;
        }
    }
    __syncthreads();
}

__device__ __forceinline__ void mixer_local_phase(const Ctx& X, LAS unsigned char* lds, int layer, int tid, int wave, int lane) {
    const int hs = wave >> 2, w4 = wave & 3; int tid_h = tid & 255;
    LAS unsigned char* hl = lds + hs * HEAD_LDS;
    for (int u = blockIdx.x; u < 3584; u += gridDim.x) {
        asm volatile("" : "+v"(tid_h), "+v"(lane), "+v"(tid));
        if (u < 3072) { const int mixer = u >> 10, idx = u & 1023, hp = idx & 1, cb = idx >> 1, b = cb >> 7, c = cb & 127, h = hp * 2 + hs;
            if (mixer == 0) { ret_unit(X, hl, b, c, h, tid_h, w4, lane);
            } else if (mixer == 1) { gdn_unit(X, hl, b, c, h, tid_h, w4, lane, layer);
            } else { hgrn_unit(X, hl, b, c, h, tid_h, w4, lane, layer);
            }
        } else { const int cb = u - 3072; conf_unit(X, lds, cb >> 7, cb & 127, tid, wave, lane, layer);
        }
    }
}

__device__ __forceinline__ void scan_phase(const Ctx& X, int wave, int lane) {
    const int job = blockIdx.x;
    if (job >= 192 || wave != 0) return;
    asm volatile("" : "+v"(lane));
    const int mixer = job >> 6, rem = job & 63, bh = rem >> 2, vg = rem & 3;
    const int uid0 = (mixer * 16 + bh) * NCH;
    const int r = lane & 15, q = lane >> 4;
    bf16_t* bc0 = WSP(bf16_t, WS_BCS) + (size_t)uid0 * 4096 + (vg * 4 * 64 + lane) * 4;
    float S[4][4];
#pragma unroll
    for (int t = 0; t < 4; ++t)
#pragma unroll
        for (int j = 0; j < 4; ++j) S[t][j] = 0.f;
    if (mixer == 1) {
        const bf16_t* mm0 = WSP(const bf16_t, WS_MM) + (size_t)(uid0 - 2048) * 4096;
        u32x2 cb[4][4], ca[4][4][2][2];
#define SCAN_LOAD_G(slot, cc) { const int c_ = (cc) < NCH ? (cc) : NCH - 1; const bf16_t* bcn = bc0 + (size_t)c_ * 4096; const bf16_t* mmn = mm0 + (size_t)c_ * 4096; \
            _Pragma("unroll") for (int t = 0; t < 4; ++t) { cb[slot][t] = *(const u32x2*)(bcn + 256 * t); \
                _Pragma("unroll") for (int s2 = 0; s2 < 2; ++s2) { const u32x4 w_ = *(const u32x4*)(mmn + ((t * 2 + s2) * 64 + lane) * 8); ca[slot][t][s2][0] = (u32x2){w_.x, w_.y}; ca[slot][t][s2][1] = (u32x2){w_.z, w_.w}; } } }
        SCAN_LOAD_G(0, 0) SCAN_LOAD_G(1, 1) SCAN_LOAD_G(2, 2)
#pragma unroll 1
        for (int c0 = 0; c0 < NCH; c0 += 4) {
#pragma unroll
            for (int k = 0; k < 4; ++k) {
                const int c = c0 + k;
                SCAN_LOAD_G((k + 3) & 3, c + 3)
                bf16_t* bcc = bc0 + (size_t)c * 4096;
                u32x2 sp[4];
#pragma unroll
                for (int t = 0; t < 4; ++t) { sp[t].x = pk2(S[t][0], S[t][1]); sp[t].y = pk2(S[t][2], S[t][3]);
                    asm volatile("" : "+v"(sp[t].x) : "v"(cb[k][t].x));
                    *(u32x2*)(bcc + 256 * t) = sp[t]; }
                bf16x8 bfr[2];
#pragma unroll
                for (int s2 = 0; s2 < 2; ++s2) { u32x4 w; w.x = sp[2 * s2].x; w.y = sp[2 * s2].y; w.z = sp[2 * s2 + 1].x; w.w = sp[2 * s2 + 1].y; bfr[s2] = __builtin_bit_cast(bf16x8, w); }
#pragma unroll
                for (int t = 0; t < 4; ++t) {
                    f32x4 acc = (f32x4){bf_lo(cb[k][t].x), bf_hi(cb[k][t].x), bf_lo(cb[k][t].y), bf_hi(cb[k][t].y)};
#pragma unroll
                    for (int s2 = 0; s2 < 2; ++s2) { u32x4 w; w.x = ca[k][t][s2][0].x; w.y = ca[k][t][s2][0].y; w.z = ca[k][t][s2][1].x; w.w = ca[k][t][s2][1].y;
                        acc = __builtin_amdgcn_mfma_f32_16x16x32_bf16(__builtin_bit_cast(bf16x8, w), bfr[s2], acc, 0, 0, 0); }
                    S[t][0] = acc[0]; S[t][1] = acc[1]; S[t][2] = acc[2]; S[t][3] = acc[3];
                }
            }
        }
#undef SCAN_LOAD_G
    } else {
        const int h = bh & 3;
        const float g64 = __expf(64.0f * log1pf(-exp2f(-5.0f - (float)h)));
        const float* mv0 = WSP(const float, WS_MVEC) + (size_t)(mixer == 2 ? uid0 - 2 * 2048 : 0) * 64 + 4 * q;
        u32x2 cb[4][4]; f32x4 cm[4][4];
#define SCAN_LOAD_D(slot, cc) { const int c_ = (cc) < NCH ? (cc) : NCH - 1; const bf16_t* bcn = bc0 + (size_t)c_ * 4096; \
            _Pragma("unroll") for (int t = 0; t < 4; ++t) { cb[slot][t] = *(const u32x2*)(bcn + 256 * t); cm[slot][t] = mixer == 2 ? *(const f32x4*)(mv0 + (size_t)c_ * 64 + 16 * t) : (f32x4){g64, g64, g64, g64}; } }
        SCAN_LOAD_D(0, 0) SCAN_LOAD_D(1, 1) SCAN_LOAD_D(2, 2)
#pragma unroll 1
        for (int c0 = 0; c0 < NCH; c0 += 4) {
#pragma unroll
            for (int k = 0; k < 4; ++k) {
                const int c = c0 + k;
                SCAN_LOAD_D((k + 3) & 3, c + 3)
                bf16_t* bcc = bc0 + (size_t)c * 4096;
#pragma unroll
                for (int t = 0; t < 4; ++t) { u32x2 sp; sp.x = pk2(S[t][0], S[t][1]); sp.y = pk2(S[t][2], S[t][3]);
                    asm volatile("" : "+v"(sp.x) : "v"(cb[k][t].x));
                    *(u32x2*)(bcc + 256 * t) = sp;
                    S[t][0] = cm[k][t].x * S[t][0] + bf_lo(cb[k][t].x); S[t][1] = cm[k][t].y * S[t][1] + bf_hi(cb[k][t].x);
                    S[t][2] = cm[k][t].z * S[t][2] + bf_lo(cb[k][t].y); S[t][3] = cm[k][t].w * S[t][3] + bf_hi(cb[k][t].y); }
            }
        }
#undef SCAN_LOAD_D
    }
}

__device__ __forceinline__ void mixer_out_phase(const Ctx& X, LAS unsigned char* lds, int layer, int tid, int wave, int lane) {
    constexpr int GP = 264;
    const bf16_t* proj = WSP(const bf16_t, WS_PROJ);
    bf16_t* mix = WSP(bf16_t, WS_MIX);
    for (int u = blockIdx.x; u < 1536; u += gridDim.x) {
        asm volatile("" : "+v"(lane), "+v"(tid));
        LAS bf16_t* GT = opq((LAS bf16_t*)lds);
        const int r = lane & 15, q = lane >> 4, h = wave >> 1, half = wave & 1;
        const int mixer = u >> 9, rem = u & 511, b = rem >> 7, c = rem & 127;
        const int uid = unit_id(mixer, b, h, c);
        const int goff = mixer == 0 ? C_RG : (mixer == 1 ? C_GG : C_HG), moff = mixer == 0 ? 0 : (mixer == 1 ? 512 : 768);
        const size_t row0 = (size_t)b * T + c * 64;
        u32x4 gv[4];
#pragma unroll
        for (int n = 0; n < 4; ++n) { const int idx = tid + 512 * n; gv[n] = *(const u32x4*)(proj + (row0 + (idx >> 5)) * LDP + goff + (idx & 31) * 8); }
        const bf16_t* qe = WSP(const bf16_t, WS_QEFF) + (size_t)uid * 4096;
        const bf16_t* st = WSP(const bf16_t, WS_BCS) + (size_t)uid * 4096;
        bf16x8 a[2][2], bb[4][2]; u32x4 ov[2][2];
#pragma unroll
        for (int rt = 0; rt < 2; ++rt) { const int rt4 = 2 * half + rt;
#pragma unroll
            for (int ks = 0; ks < 2; ++ks) a[rt][ks] = *(const bf16x8*)(qe + (16 * rt4 + r) * 64 + ks * 32 + q * 8);
            const u32x4* ol = (const u32x4*)(WSP(const bf16_t, WS_OLOC) + ((size_t)uid * 4 + rt4) * 1024 + lane * 16); ov[rt][0] = ol[0]; ov[rt][1] = ol[1]; }
#pragma unroll
        for (int ct = 0; ct < 4; ++ct)
#pragma unroll
            for (int ks = 0; ks < 2; ++ks) { const bf16_t* tb = st + (size_t)((ct * 4 + 2 * ks + (q >> 1)) * 64) * 4;
                const u32x2 lo = *(const u32x2*)(tb + ((2 * (q & 1)) * 16 + r) * 4), hi = *(const u32x2*)(tb + ((2 * (q & 1) + 1) * 16 + r) * 4);
                bb[ct][ks] = __builtin_bit_cast(bf16x8, (u32x4){lo.x, lo.y, hi.x, hi.y}); }
        const float* nw = mixer == 0 ? X.in[3] + layer * 256 + h * 64 : (mixer == 1 ? X.in[11] + layer * 64 : X.in[13] + layer * 64);
        float wv[4];
#pragma unroll
        for (int ct = 0; ct < 4; ++ct) wv[ct] = nw[16 * ct + r];
#pragma unroll
        for (int n = 0; n < 4; ++n) { const int idx = tid + 512 * n; *(LAS u32x4*)(GT + (idx >> 5) * GP + (idx & 31) * 8) = gv[n]; }
        __syncthreads();
        const bool on = ((MIX_MASK >> (mixer == 0 ? 0 : (mixer == 1 ? 2 : 3))) & 1) != 0;
#pragma unroll
        for (int rt = 0; rt < 2; ++rt) {
            f32x4 acc[4];
            acc[0] = (f32x4){bf_lo(ov[rt][0].x), bf_hi(ov[rt][0].x), bf_lo(ov[rt][0].y), bf_hi(ov[rt][0].y)}; acc[1] = (f32x4){bf_lo(ov[rt][0].z), bf_hi(ov[rt][0].z), bf_lo(ov[rt][0].w), bf_hi(ov[rt][0].w)};
            acc[2] = (f32x4){bf_lo(ov[rt][1].x), bf_hi(ov[rt][1].x), bf_lo(ov[rt][1].y), bf_hi(ov[rt][1].y)}; acc[3] = (f32x4){bf_lo(ov[rt][1].z), bf_hi(ov[rt][1].z), bf_lo(ov[rt][1].w), bf_hi(ov[rt][1].w)};
#pragma unroll
            for (int ct = 0; ct < 4; ++ct)
#pragma unroll
                for (int ks = 0; ks < 2; ++ks) acc[ct] = __builtin_amdgcn_mfma_f32_16x16x32_bf16(a[rt][ks], bb[ct][ks], acc[ct], 0, 0, 0);
#pragma unroll
            for (int j = 0; j < 4; ++j) {
                float sm = (acc[0][j] + acc[1][j]) + (acc[2][j] + acc[3][j]);
                sm += __shfl_xor(sm, 1); sm += __shfl_xor(sm, 2); sm += __shfl_xor(sm, 4); sm += __shfl_xor(sm, 8);
                const float mu = mixer == 0 ? sm * (1.f / 64.f) : 0.f;
                float d[4], s2 = 0.f;
#pragma unroll
                for (int ct = 0; ct < 4; ++ct) { d[ct] = acc[ct][j] - mu; s2 += d[ct] * d[ct]; }
                s2 += __shfl_xor(s2, 1); s2 += __shfl_xor(s2, 2); s2 += __shfl_xor(s2, 4); s2 += __shfl_xor(s2, 8);
                const float rs = rsqrtf(s2 * (1.f / 64.f) + (mixer == 0 ? 1e-5f : 1e-6f));
                const int ii = 16 * (2 * half + rt) + 4 * q + j;
#pragma unroll
                for (int ct = 0; ct < 4; ++ct) { LAS bf16_t* gp = GT + ii * GP + h * 64 + 16 * ct + r;
                    const float y = d[ct] * rs * wv[ct] * silu_acc(bf2f(*gp));
                    *gp = on ? f2bf(y) : (bf16_t)0; }
            }
        }
        __syncthreads();
#pragma unroll
        for (int n = 0; n < 4; ++n) { const int idx = tid + 512 * n; *(u32x4*)(mix + (row0 + (idx >> 5)) * D + moff + (idx & 31) * 8) = *(const LAS u32x4*)(GT + (idx >> 5) * GP + (idx & 31) * 8); }
        __syncthreads();
    }
}

constexpr int PREP_FIRST = (D / 64) * (NINP / 32), PREP_ALL = DEPTH * ((D / 64) * (NINP / 32) + (D / 64) * (D / 32) + 2 * (D / 64) * (DFF / 32) + (DFF / 64) * (D / 32));
__global__ void __launch_bounds__(512, 2) fwd_kernel(Ctx X) {
    extern __shared__ __attribute__((aligned(16))) unsigned char lds_raw[];
    LAS unsigned char* lds = (LAS unsigned char*)lds_raw;
    cg::grid_group grid = cg::this_grid();
    const int tid = threadIdx.x, lane = tid & 63, wave = __builtin_amdgcn_readfirstlane(tid >> 6);
    const int G = gridDim.x, gw = blockIdx.x * 8 + wave, ngw = G * 8;
    bf16_t* XS = (bf16_t*)X.out;
    bf16_t* XN = WSP(bf16_t, WS_XN); bf16_t* PROJ = WSP(bf16_t, WS_PROJ); bf16_t* ACT = WSP(bf16_t, WS_PROJ); bf16_t* MIX = WSP(bf16_t, WS_MIX);

    if (X.ws == nullptr) grid.sync();
    if (tid < 4) ((LAS unsigned*)(lds + LDS_BAR_OFF))[tid] = 0u;
    __syncthreads();
    const XcdBarrier bar = xcd_barrier_post(WSP(unsigned, WS_CTL), (volatile LAS unsigned*)(lds + LDS_BAR_OFF));
#define GSYNC() xcd_barrier(bar)
    prep_weights(X, lds, gw, ngw, wave, lane, 0, PREP_FIRST);
    for (int idx = blockIdx.x * 512 + tid; idx < DEPTH * 16 * D; idx += G * 512) { const int ll = idx >> 14, n = (idx >> 10) & 15, k = idx & 1023;
        WSP(bf16_t, WS_WBA)[idx] = n < 8 ? f2bf(X.in[2][((size_t)ll * D + k) * DIN + 2560 + n] * X.in[1][ll * D + k]) : (bf16_t)0; }
    cast_phase(X.in[0], XS, WSP(float, WS_RSA), gw, ngw, lane);
    GSYNC();
#pragma unroll 1
    for (int l = 0; l < DEPTH; ++l) {
        {
            pg8::Gemm g{XS, WSP(const bf16_t, WS_WIN) + (size_t)l * NINP * D, M, NINP, D}; pg8::StaticOrder S; S.init(M, NINP, G, (int)blockIdx.x);
            pg8::EpiProj E{PROJ, LDP, DIN, WSP(const float, WS_RSA)};
            pg8::gemm_phase<pg8::EpiProj, pg8::StaticOrder, true, true>(lds, g, S, E);
            int ln = lane; asm volatile("" : "+v"(ln));
            const int r = ln & 15, q = ln >> 4;
            for (int rb = blockIdx.x; rb < M / 128; rb += G) {
                const bf16_t* Ap = XS + (size_t)(rb * 128 + wave * 16 + r) * D + q * 8;
                const bf16_t* Bp = WSP(const bf16_t, WS_WBA) + (size_t)l * 16 * D + r * D + q * 8;
                f32x4 acc = (f32x4){0.f, 0.f, 0.f, 0.f};
#pragma unroll 8
                for (int ks = 0; ks < 32; ++ks) acc = __builtin_amdgcn_mfma_f32_16x16x32_bf16(*(const bf16x8*)(Ap + ks * 32), *(const bf16x8*)(Bp + ks * 32), acc, 0, 0, 0);
                if (r < 8) {
#pragma unroll
                    for (int j = 0; j < 4; ++j) { const int row = rb * 128 + wave * 16 + 4 * q + j;
                        WSP(float, WS_GBA)[(size_t)row * 8 + r] = acc[j] * rsqrtf(WSP(const float, WS_RSA)[row] * (1.0f / 1024.0f) + 1e-6f); } }
            }
        }
        GSYNC();
        int tz = tid; asm volatile("" : "+v"(tz));
        for (int i = blockIdx.x * 512 + tz; i < M; i += G * 512) { WSP(float, WS_RSA)[i] = 0.f; WSP(float, WS_RSB)[i] = 0.f; }
        mixer_local_phase(X, lds, l, tid, wave, lane);
        GSYNC();
        scan_phase(X, wave, lane);
        if (l == 0 && wave != 0) prep_weights(X, lds, blockIdx.x * 7 + wave - 1, G * 7, wave, lane, PREP_FIRST, PREP_ALL);
        GSYNC();
        mixer_out_phase(X, lds, l, tid, wave, lane);
        GSYNC();
        {
            pg8::Gemm g{MIX, WSP(const bf16_t, WS_WOUT) + (size_t)l * D * D, M, D, D}; pg8::StaticOrder S; S.init(M, D, G, (int)blockIdx.x);
            pg8::EpiResid E{l == 0 ? X.in[0] : nullptr, l == 0 ? nullptr : XS, nullptr, XN, D, WSP(float, WS_RSB)};
            pg8::gemm_phase<pg8::EpiResid, pg8::StaticOrder, true, true>(lds, g, S, E);
        }
        GSYNC();
        {
            pg8::Gemm g{XN, WSP(const bf16_t, WS_WGU) + (size_t)l * NGU * D, M, NGU, D}; pg8::StaticOrder S; S.init(M, NGU, G, (int)blockIdx.x);
            pg8::EpiSwiglu E{ACT, DFF, WSP(const float, WS_RSB)};
            pg8::gemm_phase<pg8::EpiSwiglu, pg8::StaticOrder, true, true>(lds, g, S, E);
        }
        GSYNC();
        {
            pg8::Gemm g{ACT, WSP(const bf16_t, WS_WDN) + (size_t)l * D * DFF, M, D, DFF}; pg8::StaticOrder S; S.init(M, D, G, (int)blockIdx.x);
            pg8::EpiResid E{nullptr, XN, l + 1 < DEPTH ? nullptr : X.out, l + 1 < DEPTH ? XS : nullptr, D, l + 1 < DEPTH ? WSP(float, WS_RSA) : nullptr};
            pg8::gemm_phase<pg8::EpiResid, pg8::StaticOrder, true, true>(lds, g, S, E);
        }
        GSYNC();
        if (l + 1 == DEPTH) norm_phase(X.out, X.in[19], nullptr, X.out, gw, ngw, lane);
    }
}

extern "C" void kernel_launch(void* const* d_in, const int* in_sizes, int n_in, void* d_out, int out_size, void* d_ws, size_t ws_size, hipStream_t stream) {
    static int grid = 0;
    if (grid == 0) {
        if (n_in != 20 || out_size != M * D || ws_size < WS_END) { fprintf(stderr, "kernel_launch: unexpected shapes (n_in %d, out %d, ws %zu)\n", n_in, out_size, ws_size); grid = -1; return; }
        int dev = 0, cus = 0, per_cu = 0;
        hipGetDevice(&dev); hipDeviceGetAttribute(&cus, hipDeviceAttributeMultiprocessorCount, dev);
        if (hipFuncSetAttribute((const void*)fwd_kernel, hipFuncAttributeMaxDynamicSharedMemorySize, LDS_BYTES) != hipSuccess) { fprintf(stderr, "kernel_launch: hipFuncSetAttribute failed\n"); grid = -1; return; }
        if (hipOccupancyMaxActiveBlocksPerMultiprocessor(&per_cu, (const void*)fwd_kernel, 512, LDS_BYTES) != hipSuccess || per_cu < 1) { fprintf(stderr, "kernel_launch: occupancy query says %d\n", per_cu); per_cu = 1; }
        (void)hipGetLastError();
        grid = cus * (per_cu > 1 ? 1 : per_cu);
    }
    if (grid < 0) return;
    Ctx X{};
    for (int i = 0; i < 20; ++i) X.in[i] = (const float*)d_in[i];
    X.out = (float*)d_out; X.ws = (unsigned char*)d_ws;
    void* args[] = {&X};
    if (hipMemsetAsync((char*)d_ws + WS_CTL, 0, 16384, stream) != hipSuccess) { fprintf(stderr, "kernel_launch: hipMemsetAsync of the barrier words failed\n"); return; }
    hipError_t e = hipLaunchCooperativeKernel((const void*)fwd_kernel, dim3(grid), dim3(512), args, LDS_BYTES, stream);
    if (e != hipSuccess) fprintf(stderr, "cooperative launch failed: %s (grid %d)\n", hipGetErrorString(e), grid);
}
```

```cpp
#include <hip/hip_runtime.h>
#include <hip/hip_cooperative_groups.h>
#include <cstdio>
#include <cstdint>
namespace cg = cooperative_groups;

#ifndef MIX_MASK
#define MIX_MASK 15
#endif
namespace pg8 {
#define PG8_LAS __attribute__((address_space(3)))
typedef unsigned short bf16_t;
typedef short bf16x8 __attribute__((ext_vector_type(8)));
typedef float f32x4 __attribute__((ext_vector_type(4)));
typedef unsigned u32x4 __attribute__((ext_vector_type(4)));
constexpr int BM = 256, BK = 64, HALF = 128, HTB = HALF * BK * 2  , STAGE_BYTES = 8 * HTB, NXCD = 8, WGM = 8;

__host__ __device__ __forceinline__ int lds_byte(int r, int c) { const int st = (r >> 4) * 2 + (c >> 5), rr = r & 15, cc = c & 31, ob = rr * 64 + cc * 2; return st * 1024 + (ob ^ (((ob >> 9) & 1) << 5)); }
__host__ __device__ __forceinline__ void stage_rc(int b, int& R, int& C) { const int st = b / 1024, sb = b % 1024, swz = sb ^ (((sb >> 9) & 1) << 5); R = (st >> 1) * 16 + swz / 64; C = (st & 1) * 32 + (swz % 64) / 2; }
__host__ __device__ __forceinline__ int perm32(int rho) { const int n = rho >> 4, i = rho & 15; return 8 * (i >> 2) + 4 * n + (i & 3); }

struct Unit { int pm, pn; };
struct Gemm { const bf16_t* A; const bf16_t* Bt; int M, N, K; };

struct StaticOrder {
    int nM, nN, nwg, G, c;
    __host__ __device__ void init(int M, int N, int G_, int c_) { nM = M / BM; nN = N / BM; nwg = nM * nN; G = G_; c = c_; }
    __host__ __device__ bool next(int i, Unit& u) const {
        const long L = (long)i * G + c; if (L >= nwg) return false;
        int wgid = (int)L; { const int q = nwg / NXCD, r = nwg % NXCD, xcd = wgid % NXCD, off = wgid / NXCD; wgid = (xcd < r ? xcd * (q + 1) : r * (q + 1) + (xcd - r) * q) + off; }
        const int nig = WGM * nN, gid = wgid / nig, fm = gid * WGM, gsz = (nM - fm) < WGM ? (nM - fm) : WGM;
        u.pm = fm + ((wgid % nig) % gsz); u.pn = (wgid % nig) / gsz; return true;
    }
    __device__ __forceinline__ void a_ready(const Unit&) const {}
    __device__ __forceinline__ void done(const Unit&) const {}
};

__device__ __forceinline__ unsigned cvt_pk_bf16(float lo, float hi) { unsigned r; asm volatile("v_cvt_pk_bf16_f32 %0, %1, %2" : "=v"(r) : "v"(lo), "v"(hi)); return r; }
__device__ __forceinline__ float silu_f(float g) { return g * __builtin_amdgcn_rcpf(1.0f + __expf(-g)); }

struct EpiProj {
    static constexpr bool PERM = true, AFTER_DRAIN = false;
    bf16_t* O; int ldc; int ncols; const float* rowsq;
    __device__ __forceinline__ void operator()(const f32x4 (&acc)[2][2][4][2], const Unit& u, int wr, int wc, int fr, int fq) const {
        const int row0 = u.pm * BM + wr * 64 + fr; const int col0 = u.pn * BM + wc * 32 + 8 * fq;
#pragma unroll
        for (int ai = 0; ai < 2; ++ai)
#pragma unroll
            for (int m = 0; m < 4; ++m) { bf16_t* rowp = O + (size_t)(row0 + ai * HALF + m * 16) * ldc;
                const float rs = __builtin_amdgcn_rsqf(rowsq[row0 + ai * HALF + m * 16] * (1.0f / 1024.0f) + 1e-6f);
#pragma unroll
                for (int bj = 0; bj < 2; ++bj) { const int col = col0 + bj * HALF;
                    if (col < ncols) { const f32x4 v0 = acc[ai][bj][m][0] * rs, v1 = acc[ai][bj][m][1] * rs; u32x4 w;
                        w.x = cvt_pk_bf16(v0[0], v0[1]); w.y = cvt_pk_bf16(v0[2], v0[3]); w.z = cvt_pk_bf16(v1[0], v1[1]); w.w = cvt_pk_bf16(v1[2], v1[3]);
                        *(u32x4*)(rowp + col) = w; } } }
    }
};
struct EpiResid {
    static constexpr bool PERM = true, AFTER_DRAIN = false;
    const float* base_f; const bf16_t* base_b; float* out_f; bf16_t* out_b; int ldc; float* rowsq;
    __device__ __forceinline__ void operator()(const f32x4 (&acc)[2][2][4][2], const Unit& u, int wr, int wc, int fr, int fq) const {
        const int row0 = u.pm * BM + wr * 64 + fr; const int col0 = u.pn * BM + wc * 32 + 8 * fq;
#pragma unroll
        for (int ai = 0; ai < 2; ++ai)
#pragma unroll
            for (int m = 0; m < 4; ++m) { const size_t off = (size_t)(row0 + ai * HALF + m * 16) * ldc + col0; float sq = 0.f;
#pragma unroll
                for (int bj = 0; bj < 2; ++bj) { const size_t o_ = off + bj * HALF; f32x4 b0, b1;
                    if (base_b) { const u32x4 w = *(const u32x4*)(base_b + o_);
                        b0 = (f32x4){__uint_as_float(w.x << 16), __uint_as_float(w.x & 0xffff0000u), __uint_as_float(w.y << 16), __uint_as_float(w.y & 0xffff0000u)};
                        b1 = (f32x4){__uint_as_float(w.z << 16), __uint_as_float(w.z & 0xffff0000u), __uint_as_float(w.w << 16), __uint_as_float(w.w & 0xffff0000u)}; }
                    else { b0 = *(const f32x4*)(base_f + o_); b1 = *(const f32x4*)(base_f + o_ + 4); }
                    const f32x4 o0 = b0 + acc[ai][bj][m][0], o1 = b1 + acc[ai][bj][m][1];
                    if (out_f) { *(f32x4*)(out_f + o_) = o0; *(f32x4*)(out_f + o_ + 4) = o1; }
                    if (out_b) { u32x4 w; w.x = cvt_pk_bf16(o0[0], o0[1]); w.y = cvt_pk_bf16(o0[2], o0[3]); w.z = cvt_pk_bf16(o1[0], o1[1]); w.w = cvt_pk_bf16(o1[2], o1[3]); *(u32x4*)(out_b + o_) = w; }
                    sq += ((o0[0] * o0[0] + o0[1] * o0[1]) + (o0[2] * o0[2] + o0[3] * o0[3])) + ((o1[0] * o1[0] + o1[1] * o1[1]) + (o1[2] * o1[2] + o1[3] * o1[3])); }
                if (rowsq) { sq += __shfl_xor(sq, 16); sq += __shfl_xor(sq, 32); if (fq == 0) atomicAdd(rowsq + row0 + ai * HALF + m * 16, sq); } }
    }
};
struct EpiSwiglu {
    static constexpr bool PERM = true, AFTER_DRAIN = false;
    bf16_t* O; int ldc; const float* rowsq;
    __device__ __forceinline__ void operator()(const f32x4 (&acc)[2][2][4][2], const Unit& u, int wr, int wc, int fr, int fq) const {
        const int row0 = u.pm * BM + wr * 64 + fr; const int col0 = u.pn * HALF + wc * 32 + 8 * fq;
#pragma unroll
        for (int ai = 0; ai < 2; ++ai)
#pragma unroll
            for (int m = 0; m < 4; ++m) { bf16_t* rowp = O + (size_t)(row0 + ai * HALF + m * 16) * ldc + col0;
                const float rs = __builtin_amdgcn_rsqf(rowsq[row0 + ai * HALF + m * 16] * (1.0f / 1024.0f) + 1e-6f);
                const f32x4 g0 = acc[ai][0][m][0] * rs, g1 = acc[ai][0][m][1] * rs, u0 = acc[ai][1][m][0] * rs, u1 = acc[ai][1][m][1] * rs; u32x4 w;
                w.x = cvt_pk_bf16(silu_f(g0[0]) * u0[0], silu_f(g0[1]) * u0[1]); w.y = cvt_pk_bf16(silu_f(g0[2]) * u0[2], silu_f(g0[3]) * u0[3]);
                w.z = cvt_pk_bf16(silu_f(g1[0]) * u1[0], silu_f(g1[1]) * u1[1]); w.w = cvt_pk_bf16(silu_f(g1[2]) * u1[2], silu_f(g1[3]) * u1[3]);
                *(u32x4*)rowp = w; }
    }
};

template <class Epi, class Sched, bool ALIGN_EPI = false, bool SP2 = false>
__device__ __forceinline__ void gemm_phase(PG8_LAS unsigned char* lds, const Gemm g, const Sched& S, const Epi& E) {
    int tid_ = threadIdx.x; asm volatile("" : "+v"(tid_));
    const int tid = tid_, wid = __builtin_amdgcn_readfirstlane(tid >> 6), lane = tid & 63, wr = wid >> 2, wc = wid & 3, fr = lane & 15, fq = lane >> 4;
    const int K = g.K, nt = K / BK;
    unsigned voffA[2], voffB[2];
#pragma unroll
    for (int i = 0; i < 2; ++i) { int R, C; stage_rc(tid * 16 + i * 8192, R, C); const int Rb = Epi::PERM ? ((R & ~31) + perm32(R & 31)) : R;
        voffA[i] = (unsigned)(R * K + C) * 2u; voffB[i] = (unsigned)(Rb * K + C) * 2u; }
    const size_t kstep = (size_t)(BK * 2);
    const size_t hstep = (size_t)HALF * K * 2;
    const size_t tstep = 2 * hstep;
    const unsigned ldsw = (unsigned)wid * 1024u;
    const int aoff = lds_byte(wr * 64 + fr, fq * 8), boff = lds_byte(wc * 32 + fr, fq * 8);
#define PG8_SA(b, h) (((b) * 2 + (h)) * HTB)
#define PG8_SB(b, h) ((4 + (b) * 2 + (h)) * HTB)
#define PG8_STAGE(bufoff, gbase, voff) do { _Pragma("unroll") for (int _i = 0; _i < 2; ++_i) \
        __builtin_amdgcn_global_load_lds((const unsigned*)((const char*)(gbase) + (voff)[_i]), (PG8_LAS unsigned*)(lds + (bufoff) + ldsw + _i * 8192), 16, 0, 0); } while (0)
#define PG8_LDA(dst, b, h) do { _Pragma("unroll") for (int m = 0; m < 4; ++m) _Pragma("unroll") for (int k = 0; k < 2; ++k) dst[m][k] = *(const PG8_LAS bf16x8*)(lds + PG8_SA(b, h) + aoff + m * 2048 + k * 1024); } while (0)
#define PG8_LDB(dst, b, h) do { _Pragma("unroll") for (int n = 0; n < 2; ++n) _Pragma("unroll") for (int k = 0; k < 2; ++k) dst[n][k] = *(const PG8_LAS bf16x8*)(lds + PG8_SB(b, h) + boff + n * 2048 + k * 1024); } while (0)
#define PG8_MMA(ai, bj, At, Bt) do { __builtin_amdgcn_s_setprio(1); _Pragma("unroll") for (int m = 0; m < 4; ++m) _Pragma("unroll") for (int n = 0; n < 2; ++n) _Pragma("unroll") for (int k = 0; k < 2; ++k) \
        acc[ai][bj][m][n] = __builtin_amdgcn_mfma_f32_16x16x32_bf16(Bt[n][k], At[m][k], acc[ai][bj][m][n], 0, 0, 0); __builtin_amdgcn_s_setprio(0); } while (0)
#define PG8_WAIT_V(n) asm volatile("s_waitcnt vmcnt(" #n ")" ::: "memory")
#define PG8_WAIT_L(n) asm volatile("s_waitcnt lgkmcnt(" #n ")" ::: "memory")
#define PG8_BAR __builtin_amdgcn_s_barrier()
#define PG8_SCHED __builtin_amdgcn_sched_barrier(0)
    Unit cur, nxt; int ui = 0;
    if (!S.next(0, cur)) return;
    f32x4 acc[2][2][4][2];
#pragma unroll
    for (int a = 0; a < 2; ++a)
#pragma unroll
        for (int b = 0; b < 2; ++b)
#pragma unroll
            for (int m = 0; m < 4; ++m)
#pragma unroll
                for (int n = 0; n < 2; ++n) acc[a][b][m][n] = (f32x4){0.f, 0.f, 0.f, 0.f};
    bf16x8 At[4][2], B0[2][2], B1[2][2];
    const char* cA = (const char*)g.A + (size_t)cur.pm * tstep; const char* cB = (const char*)g.Bt + (size_t)cur.pn * tstep;
    S.a_ready(cur);
    if constexpr (SP2) {
        PG8_STAGE(PG8_SB(0, 0), cB, voffB); PG8_STAGE(PG8_SB(0, 1), cB + hstep, voffB); PG8_STAGE(PG8_SA(0, 0), cA, voffA); PG8_STAGE(PG8_SA(0, 1), cA + hstep, voffA);
        if (wr == 1) PG8_BAR;
        PG8_WAIT_V(2); PG8_BAR;
        PG8_STAGE(PG8_SB(1, 0), cB + kstep, voffB); PG8_STAGE(PG8_SA(1, 0), cA + kstep, voffA); PG8_STAGE(PG8_SB(1, 1), cB + hstep + kstep, voffB);
        PG8_WAIT_V(6); PG8_BAR;
    } else {
        PG8_STAGE(PG8_SB(0, 0), cB, voffB); PG8_STAGE(PG8_SA(0, 0), cA, voffA); PG8_STAGE(PG8_SB(0, 1), cB + hstep, voffB); PG8_STAGE(PG8_SA(0, 1), cA + hstep, voffA);
        if (wr == 1) PG8_BAR;
        PG8_WAIT_V(4); PG8_BAR;
        PG8_STAGE(PG8_SB(1, 0), cB + kstep, voffB); PG8_STAGE(PG8_SA(1, 0), cA + kstep, voffA); PG8_STAGE(PG8_SB(1, 1), cB + hstep + kstep, voffB);
        PG8_WAIT_V(6); PG8_BAR;
    }
    for (;;) {
        const bool has_next = S.next(ui + 1, nxt);
        const char* nA = has_next ? (const char*)g.A + (size_t)nxt.pm * tstep : cA; const char* nB = has_next ? (const char*)g.Bt + (size_t)nxt.pn * tstep : cB;
        for (int t = 0; t < nt; t += 2) {
            const bool last = (t == nt - 2);
            const char* a1 = cA + (size_t)(t + 1) * kstep;
            const char* a2 = last ? nA : cA + (size_t)(t + 2) * kstep; const char* b2 = last ? nB : cB + (size_t)(t + 2) * kstep;
            const char* a3 = a2 + kstep; const char* b3 = b2 + kstep;
            if (last && has_next) S.a_ready(nxt);
            if constexpr (SP2) {
            PG8_LDB(B0, 0, 0); PG8_LDB(B1, 0, 1); PG8_SCHED; PG8_LDA(At, 0, 0); PG8_STAGE(PG8_SA(1, 1), a1 + hstep, voffA);
            PG8_WAIT_V(8); PG8_WAIT_L(0); PG8_BAR; PG8_MMA(0, 0, At, B0); PG8_MMA(0, 1, At, B1); PG8_BAR; PG8_SCHED;
            PG8_LDA(At, 0, 1); PG8_STAGE(PG8_SB(0, 0), b2, voffB); PG8_STAGE(PG8_SB(0, 1), b2 + hstep, voffB); PG8_STAGE(PG8_SA(0, 0), a2, voffA);
            PG8_WAIT_V(8); PG8_WAIT_L(0); PG8_BAR; PG8_MMA(1, 0, At, B0); PG8_MMA(1, 1, At, B1); PG8_BAR; PG8_SCHED;
            PG8_LDB(B0, 1, 0); PG8_LDB(B1, 1, 1); PG8_SCHED; PG8_LDA(At, 1, 0); PG8_STAGE(PG8_SA(0, 1), a2 + hstep, voffA);
            PG8_WAIT_V(8); PG8_WAIT_L(0); PG8_BAR; PG8_MMA(0, 0, At, B0); PG8_MMA(0, 1, At, B1); PG8_BAR; PG8_SCHED;
            PG8_LDA(At, 1, 1); PG8_STAGE(PG8_SB(1, 0), b3, voffB); PG8_STAGE(PG8_SB(1, 1), b3 + hstep, voffB); PG8_STAGE(PG8_SA(1, 0), a3, voffA);
            PG8_WAIT_V(8); PG8_WAIT_L(0); PG8_BAR; PG8_MMA(1, 0, At, B0); PG8_MMA(1, 1, At, B1); PG8_BAR; PG8_SCHED;
            } else {
            PG8_LDB(B0, 0, 0); PG8_SCHED; PG8_LDA(At, 0, 0); PG8_STAGE(PG8_SA(1, 1), a1 + hstep, voffA);
            PG8_WAIT_L(8); PG8_BAR; PG8_WAIT_L(0); PG8_MMA(0, 0, At, B0); PG8_BAR; PG8_SCHED;
            PG8_LDB(B1, 0, 1); PG8_STAGE(PG8_SB(0, 0), b2, voffB);
            PG8_BAR; PG8_WAIT_L(0); PG8_MMA(0, 1, At, B1); PG8_BAR;
            PG8_LDA(At, 0, 1); PG8_STAGE(PG8_SA(0, 0), a2, voffA);
            PG8_BAR; PG8_WAIT_L(0); PG8_MMA(1, 0, At, B0); PG8_BAR; PG8_SCHED;
            PG8_STAGE(PG8_SB(0, 1), b2 + hstep, voffB);
            PG8_WAIT_V(6); PG8_BAR; PG8_MMA(1, 1, At, B1); PG8_BAR;
            PG8_LDB(B0, 1, 0); PG8_SCHED; PG8_LDA(At, 1, 0); PG8_STAGE(PG8_SA(0, 1), a2 + hstep, voffA);
            PG8_WAIT_L(8); PG8_BAR; PG8_WAIT_L(0); PG8_MMA(0, 0, At, B0); PG8_BAR; PG8_SCHED;
            PG8_LDB(B1, 1, 1); PG8_STAGE(PG8_SB(1, 0), b3, voffB);
            PG8_BAR; PG8_WAIT_L(0); PG8_MMA(0, 1, At, B1); PG8_BAR;
            PG8_LDA(At, 1, 1); PG8_STAGE(PG8_SA(1, 0), a3, voffA);
            PG8_BAR; PG8_WAIT_L(0); PG8_MMA(1, 0, At, B0); PG8_BAR; PG8_SCHED;
            PG8_STAGE(PG8_SB(1, 1), b3 + hstep, voffB);
            PG8_WAIT_V(6); PG8_BAR; PG8_MMA(1, 1, At, B1); PG8_BAR;
            }
        }
        if constexpr (ALIGN_EPI) { if (wr == 0) PG8_BAR; }
        if constexpr (!Epi::AFTER_DRAIN) { E(acc, cur, wr, wc, fr, fq); S.done(cur); }
        if (!has_next) break;
#pragma unroll
        for (int a = 0; a < 2; ++a)
#pragma unroll
            for (int b = 0; b < 2; ++b)
#pragma unroll
                for (int m = 0; m < 4; ++m)
#pragma unroll
                    for (int n = 0; n < 2; ++n) acc[a][b][m][n] = (f32x4){0.f, 0.f, 0.f, 0.f};
        cur = nxt; cA = nA; cB = nB; ++ui;
        if constexpr (ALIGN_EPI) { if (wr == 1) PG8_BAR; }
    }
    PG8_WAIT_V(0);
    if constexpr (!ALIGN_EPI) { if (wr == 0) PG8_BAR; }
    PG8_BAR;
    if constexpr (Epi::AFTER_DRAIN) { E.fused(acc, cur, wr, wc, fr, fq, lds, wid, lane); S.done(cur); }
#undef PG8_SA
#undef PG8_SB
#undef PG8_STAGE
#undef PG8_LDA
#undef PG8_LDB
#undef PG8_MMA
#undef PG8_WAIT_V
#undef PG8_WAIT_L
#undef PG8_BAR
#undef PG8_SCHED
}
}

constexpr int NB = 4, T = 8192, D = 1024, DIN = 3592, NINP = 3584, DFF = 2816, NGU = 2 * DFF, DEPTH = 2;
constexpr int M = NB * T;
constexpr int NCH = T / 64;
constexpr int LDP = NINP;
constexpr int C_RQ = 0, C_RK = 256, C_RV = 512, C_RG = 768, C_CA = 1024, C_CG = 1280, C_GQ = 1536, C_GK = 1792, C_GV = 2048, C_GG = 2304,
              C_HQ = 2560, C_HF = 2816, C_HI = 3072, C_HG = 3328;
constexpr size_t MiB = 1u << 20;
constexpr size_t WS_CTL = 0;
constexpr size_t WS_WIN = 1 * MiB;
constexpr size_t WS_WOUT = 16 * MiB;
constexpr size_t WS_WGU = 20 * MiB;
constexpr size_t WS_WDN = 42 * MiB;
constexpr size_t WS_XN = 53 * MiB;
constexpr size_t WS_BCS = WS_XN;
constexpr size_t WS_MM = WS_XN + 48 * MiB;
constexpr size_t WS_MIX = 117 * MiB;
constexpr size_t WS_PROJ = 181 * MiB;
constexpr size_t WS_QEFF = 406 * MiB;
constexpr size_t WS_OLOC = 454 * MiB;
constexpr size_t WS_MVEC = 502 * MiB;
constexpr size_t WS_RSA = 503 * MiB;
constexpr size_t WS_RSB = 503 * MiB + 131072;
constexpr size_t WS_GBA = 503 * MiB + 262144;
constexpr size_t WS_WBA = 504 * MiB + 524288;
constexpr size_t WS_END = 505 * MiB;
constexpr int LDS_BYTES = 147456 + 256;
constexpr int LDS_BAR_OFF = 147456;
constexpr int HEAD_LDS = 73728;

#define LAS __attribute__((address_space(3)))
typedef unsigned short bf16_t;
typedef short bf16x8 __attribute__((ext_vector_type(8)));
typedef float f32x4 __attribute__((ext_vector_type(4)));
typedef unsigned u32x4 __attribute__((ext_vector_type(4)));
typedef unsigned u32x2 __attribute__((ext_vector_type(2)));
constexpr int LT = 72;
template <class Tp> __device__ __forceinline__ LAS Tp* opq(LAS Tp* p) { asm volatile("" : "+v"(p)); return p; }

__device__ __forceinline__ float bf_lo(unsigned u) { return __uint_as_float(u << 16); }
__device__ __forceinline__ float bf_hi(unsigned u) { return __uint_as_float(u & 0xffff0000u); }
__device__ __forceinline__ float bf2f(bf16_t b) { return __uint_as_float((unsigned)b << 16); }
__device__ __forceinline__ unsigned pk2(float lo, float hi) { return pg8::cvt_pk_bf16(lo, hi); }
__device__ __forceinline__ bf16_t f2bf(float f) { return (bf16_t)(pk2(f, 0.f) & 0xffffu); }
__device__ __forceinline__ float fexp(float x) { return __expf(x); }
__device__ __forceinline__ float frcp(float x) { return __builtin_amdgcn_rcpf(x); }
__device__ __forceinline__ float sigmoid_f(float x) { return frcp(1.0f + fexp(-x)); }
__device__ __forceinline__ float silu_acc(float x) { return x * frcp(1.0f + fexp(-x)); }
__device__ __forceinline__ float softplus_f(float x) { return fmaxf(x, 0.f) + log1pf(expf(-fabsf(x))); }
__device__ __forceinline__ float wave_sum(float v) {
#pragma unroll
    for (int o = 1; o < 64; o <<= 1) v += __shfl_xor(v, o);
    return v;
}
__device__ __forceinline__ void unpack8(const u32x4 w, float (&f)[8]) {
    f[0] = bf_lo(w.x); f[1] = bf_hi(w.x); f[2] = bf_lo(w.y); f[3] = bf_hi(w.y); f[4] = bf_lo(w.z); f[5] = bf_hi(w.z); f[6] = bf_lo(w.w); f[7] = bf_hi(w.w);
}
__device__ __forceinline__ u32x4 pack8(const float (&f)[8]) { u32x4 w; w.x = pk2(f[0], f[1]); w.y = pk2(f[2], f[3]); w.z = pk2(f[4], f[5]); w.w = pk2(f[6], f[7]); return w; }

struct Ctx {
    const float* in[20]; float* out; unsigned char* ws;
};
#define WSP(T_, off) ((T_*)(X.ws + (off)))

__device__ __forceinline__ f32x4 mma16(const LAS bf16_t* A, int a0, const LAS bf16_t* B, int b0, f32x4 acc, int r, int q) {
#pragma unroll
    for (int ks = 0; ks < 2; ++ks) {
        const bf16x8 a = *(const LAS bf16x8*)(A + (a0 + r) * LT + ks * 32 + q * 8);
        const bf16x8 b = *(const LAS bf16x8*)(B + (b0 + r) * LT + ks * 32 + q * 8);
        acc = __builtin_amdgcn_mfma_f32_16x16x32_bf16(a, b, acc, 0, 0, 0);
    }
    return acc;
}
__device__ __forceinline__ void store_oloc(bf16_t* oloc, int uid, int w4, int lane, const f32x4 (&acc)[4]) {
    u32x4* p = (u32x4*)(oloc + ((size_t)uid * 4 + w4) * 1024 + lane * 16);
    u32x4 a, b;
    a.x = pk2(acc[0][0], acc[0][1]); a.y = pk2(acc[0][2], acc[0][3]); a.z = pk2(acc[1][0], acc[1][1]); a.w = pk2(acc[1][2], acc[1][3]);
    b.x = pk2(acc[2][0], acc[2][1]); b.y = pk2(acc[2][2], acc[2][3]); b.z = pk2(acc[3][0], acc[3][1]); b.w = pk2(acc[3][2], acc[3][3]);
    p[0] = a; p[1] = b;
}
__device__ __forceinline__ void store_bc(bf16_t* bcs, int uid, int w4, int r, int q, const f32x4 (&acc)[4]) {
#pragma unroll
    for (int ct = 0; ct < 4; ++ct) { u32x2 w; w.x = pk2(acc[ct][0], acc[ct][1]); w.y = pk2(acc[ct][2], acc[ct][3]);
        *(u32x2*)(bcs + (size_t)uid * 4096 + ((ct * 4 + w4) * 64 + q * 16 + r) * 4) = w; }
}


typedef __attribute__((address_space(1))) unsigned gu32;
#define XB_TMO      128
#define XB_XCNT(j)  (256  + 64 * (j))
#define XB_XSUB(j)  (1280 + 64 * (j))
#define XB_XGEN(j)  (2304 + 64 * (j))
#define XB_TOP      3328
#define XB_TOPGEN   3392
#define XCD_BAR_WORDS 3456
#define XB_SPIN_CAP (1u << 18)

__device__ __forceinline__ unsigned xb_ld(unsigned* p)              { return __hip_atomic_load(p, __ATOMIC_RELAXED, __HIP_MEMORY_SCOPE_AGENT); }
__device__ __forceinline__ unsigned xb_add(unsigned* p, unsigned v) { return __hip_atomic_fetch_add(p, v, __ATOMIC_RELAXED, __HIP_MEMORY_SCOPE_AGENT); }
__device__ __forceinline__ unsigned xb_xcc_id() { return (unsigned)__builtin_amdgcn_s_getreg((3 << 11) | 20) & 0xFu; }
#define XB_SPIN(cond, bar) do { unsigned _sp = 0; while (cond) { __builtin_amdgcn_s_sleep(1); \
    if ((++_sp & 255u) == 0u) { if (xb_ld(&(bar)[XB_TMO])) break; if (_sp > XB_SPIN_CAP) { atomicAdd(&(bar)[XB_TMO], 1u); break; } } } } while (0)

struct XcdBarrier {
    unsigned* bar; unsigned x;
    volatile LAS unsigned* st;
};

__device__ __forceinline__ XcdBarrier xcd_barrier_post(unsigned* bar, volatile LAS unsigned* st) {
    XcdBarrier b; b.bar = bar; b.x = xb_xcc_id(); b.st = st;
    if (threadIdx.x == 0) (void)xb_add(&bar[XB_XCNT(b.x)], 1u);
    return b;
}
__device__ __forceinline__ void xcd_barrier_complete(unsigned* bar, unsigned x, unsigned& nloc, unsigned& nx) {
    const unsigned G = gridDim.x * gridDim.y * gridDim.z;
    unsigned sum, cnt, mine, sp = 0u;
    for (;;) {
        sum = 0u; cnt = 0u; mine = 0u;
#pragma unroll
        for (unsigned j = 0; j < 16; ++j) { const unsigned c = xb_ld(&bar[XB_XCNT(j)]); sum += c; cnt += (c > 0u) ? 1u : 0u; mine = (j == x) ? c : mine; }
        if (sum == G) break;
        __builtin_amdgcn_s_sleep(1);
        if ((++sp & 255u) == 0u) { if (xb_ld(&bar[XB_TMO])) break; if (sp > XB_SPIN_CAP) { atomicAdd(&bar[XB_TMO], 1u); break; } }
    }
    nloc = mine > 0u ? mine : 1u; nx = cnt > 0u ? cnt : 1u;
}

__device__ __forceinline__ void xcd_barrier(const XcdBarrier& b) {
    asm volatile("s_waitcnt vmcnt(0)" ::: "memory");
    __syncthreads();
    if (threadIdx.x == 0) {
        unsigned* bar = b.bar;
        __builtin_amdgcn_s_waitcnt(0);
        unsigned nloc = b.st[0], nx = b.st[1];
        if (nloc == 0u) { xcd_barrier_complete(bar, b.x, nloc, nx); b.st[0] = nloc; b.st[1] = nx; }
        const unsigned old = xb_add(&bar[XB_XSUB(b.x)], 1u);
        const unsigned gen = old / nloc;
        if (old + 1u == (gen + 1u) * nloc) {
            __builtin_amdgcn_fence(__ATOMIC_RELEASE, "agent");
            asm volatile("s_waitcnt vmcnt(0)" ::: "memory");
            const unsigned og = xb_add(&bar[XB_TOP], 1u);
            const unsigned tg = og / nx;
            if (og + 1u == (tg + 1u) * nx) xb_add(&bar[XB_TOPGEN], 1u);
            else XB_SPIN(xb_ld(&bar[XB_TOPGEN]) == tg, bar);
            __builtin_amdgcn_fence(__ATOMIC_ACQUIRE, "agent");
            xb_add(&bar[XB_XGEN(b.x)], 1u);
            asm volatile("s_waitcnt vmcnt(0)" ::: "memory");
        } else {
            XB_SPIN(xb_ld(&bar[XB_XGEN(b.x)]) == gen, bar);
            __builtin_amdgcn_fence(__ATOMIC_ACQUIRE, "agent");
            asm volatile("s_waitcnt vmcnt(0)" ::: "memory");
        }
    }
    __syncthreads();
}

__device__ __forceinline__ void transpose_item(const float* W, int K, int N, bf16_t* WT, int mode, LAS float* scr, int kb, int nb, int lane, const float* kscale, int coff) {
    const int k0 = 64 * kb, n0 = 32 * nb;
    const int nn = n0 + (lane & 31) + coff;
#pragma unroll 8
    for (int i = 0; i < 32; ++i) { const int kk = 2 * i + (lane >> 5); const float ksc = kscale ? kscale[k0 + kk] : 1.0f; scr[kk * 33 + (lane & 31)] = nn < N ? W[(size_t)(k0 + kk) * N + nn] * ksc : 0.f; }
    asm volatile("s_waitcnt lgkmcnt(0)" ::: "memory");
    const int c = lane & 7;
#pragma unroll
    for (int j = 0; j < 4; ++j) { const int n = (lane >> 3) + 8 * j; const LAS float* s = scr + (8 * c) * 33 + n;
        u32x4 o; o.x = pk2(s[0 * 33], s[1 * 33]); o.y = pk2(s[2 * 33], s[3 * 33]); o.z = pk2(s[4 * 33], s[5 * 33]); o.w = pk2(s[6 * 33], s[7 * 33]);
        const int ng = n0 + n; const int row = mode == 0 ? ng : ((ng >> 7) * 256 + (ng & 127) + (mode == 2 ? 128 : 0));
        *(u32x4*)(WT + (size_t)row * K + k0 + 8 * c) = o; }
    asm volatile("s_waitcnt lgkmcnt(0)" ::: "memory");
}
__device__ __forceinline__ void prep_weights(const Ctx& X, LAS unsigned char* lds, int gw, int ngw, int wave, int lane, int it_lo, int it_hi) {
    LAS float* scr = (LAS float*)(lds + wave * 16384);
    constexpr int I_IN = (D / 64) * (NINP / 32), I_OUT = (D / 64) * (D / 32), I_G = (D / 64) * (DFF / 32), I_DN = (DFF / 64) * (D / 32);
    constexpr int PER_L = I_IN + I_OUT + 2 * I_G + I_DN;
    asm volatile("" : "+v"(lane));
    for (int it = it_lo + gw; it < it_hi; it += ngw) {
        const int l = it / PER_L; int r = it % PER_L;
        if (r < I_IN) { transpose_item(X.in[2] + (size_t)l * D * DIN, D, DIN, WSP(bf16_t, WS_WIN) + (size_t)l * NINP * D, 0, scr, r / (NINP / 32), r % (NINP / 32), lane, X.in[1] + l * D, (r % (NINP / 32)) * 32 >= 2560 ? 8 : 0); continue; } r -= I_IN;
        if (r < I_OUT) { transpose_item(X.in[14] + (size_t)l * D * D, D, D, WSP(bf16_t, WS_WOUT) + (size_t)l * D * D, 0, scr, r / (D / 32), r % (D / 32), lane, nullptr, 0); continue; } r -= I_OUT;
        if (r < I_G) { transpose_item(X.in[16] + (size_t)l * D * DFF, D, DFF, WSP(bf16_t, WS_WGU) + (size_t)l * NGU * D, 1, scr, r / (DFF / 32), r % (DFF / 32), lane, X.in[15] + l * D, 0); continue; } r -= I_G;
        if (r < I_G) { transpose_item(X.in[17] + (size_t)l * D * DFF, D, DFF, WSP(bf16_t, WS_WGU) + (size_t)l * NGU * D, 2, scr, r / (DFF / 32), r % (DFF / 32), lane, X.in[15] + l * D, 0); continue; } r -= I_G;
        transpose_item(X.in[18] + (size_t)l * DFF * D, DFF, D, WSP(bf16_t, WS_WDN) + (size_t)l * D * DFF, 0, scr, r / (D / 32), r % (D / 32), lane, nullptr, 0);
    }
}
__device__ __forceinline__ void rms_row(const float* xrow, const float* w, bf16_t* orow, float* of, int lane) {
    const f32x4* xr = (const f32x4*)xrow + lane; const f32x4* wr = (const f32x4*)w + lane;
    f32x4 v[4]; float s = 0.f;
#pragma unroll
    for (int j = 0; j < 4; ++j) { v[j] = xr[64 * j]; s += (v[j].x * v[j].x + v[j].y * v[j].y) + (v[j].z * v[j].z + v[j].w * v[j].w); }
    const float rstd = 1.0f / sqrtf(wave_sum(s) * (1.f / D) + 1e-6f);
#pragma unroll
    for (int j = 0; j < 4; ++j) { const f32x4 ww = wr[64 * j]; const f32x4 o = v[j] * rstd * ww;
        if (of) ((f32x4*)of + lane)[64 * j] = o;
        else { u32x2 p; p.x = pk2(o.x, o.y); p.y = pk2(o.z, o.w); ((u32x2*)orow + lane)[64 * j] = p; } }
}
__device__ __forceinline__ void cast_phase(const float* x, bf16_t* xb, float* rowsq, int gw, int ngw, int lane) {
    asm volatile("" : "+v"(lane));
    for (int m = gw; m < M; m += ngw) {
        const f32x4* xr = (const f32x4*)(x + (size_t)m * D) + lane; float s = 0.f;
#pragma unroll
        for (int j = 0; j < 4; ++j) { const f32x4 v = xr[64 * j]; s += (v.x * v.x + v.y * v.y) + (v.z * v.z + v.w * v.w); u32x2 p; p.x = pk2(v.x, v.y); p.y = pk2(v.z, v.w); ((u32x2*)(xb + (size_t)m * D) + lane)[64 * j] = p; }
        s = wave_sum(s); if (lane == 0) rowsq[m] = s;
    }
}
__device__ __forceinline__ void norm_phase(const float* x, const float* w, bf16_t* xn, float* of, int gw, int ngw, int lane) {
    asm volatile("" : "+v"(lane));
    for (int m = gw; m < M; m += ngw) rms_row(x + (size_t)m * D, w, xn ? xn + (size_t)m * D : nullptr, of ? of + (size_t)m * D : nullptr, lane);
}

__device__ __forceinline__ int unit_id(int mixer, int b, int h, int c) { return ((mixer * 4 + b) * 4 + h) * NCH + c; }

__device__ __forceinline__ void ret_unit(const Ctx& X, LAS unsigned char* hl, int b, int c, int h, int tid_h, int w4, int lane) {
    LAS bf16_t* QR = opq((LAS bf16_t*)hl); LAS bf16_t* KR = opq(QR + 64 * LT); LAS bf16_t* KDT = opq(KR + 64 * LT); LAS bf16_t* VT = opq(KDT + 64 * LT); LAS bf16_t* P = opq(VT + 64 * LT);
    const bf16_t* proj = WSP(const bf16_t, WS_PROJ);
    const int uid = unit_id(0, b, h, c);
    const int r = lane & 15, q = lane >> 4;
    const float lg = log1pf(-exp2f(-5.0f - (float)h));
    {
        const int i = tid_h >> 2, sg = tid_h & 3, d0 = sg * 8;
        const bf16_t* pr = proj + ((size_t)b * T + c * 64 + i) * LDP;
        const u32x4 q1 = *(const u32x4*)(pr + C_RQ + h * 64 + d0), q2 = *(const u32x4*)(pr + C_RQ + h * 64 + d0 + 32);
        const u32x4 k1 = *(const u32x4*)(pr + C_RK + h * 64 + d0), k2 = *(const u32x4*)(pr + C_RK + h * 64 + d0 + 32);
        const u32x4 v1 = *(const u32x4*)(pr + C_RV + h * 64 + sg * 16), v2 = *(const u32x4*)(pr + C_RV + h * 64 + sg * 16 + 8);
        float qa[8], qb[8], ka[8], kb[8], va[8], vb[8];
        unpack8(q1, qa); unpack8(q2, qb); unpack8(k1, ka); unpack8(k2, kb); unpack8(v1, va); unpack8(v2, vb);
        const float pos = (float)(c * 64 + i);
        const float qd = fexp(lg * (float)(i + 1)), kd = fexp(lg * (float)(63 - i));
        float qr1[8], qr2[8], kr1[8], kr2[8], qe1[8], qe2[8];
#pragma unroll
        for (int e = 0; e < 8; ++e) {
            const float inv = exp2f(-(float)(d0 + e) * (13.287712379549449f / 32.0f));
            const float rev = __builtin_amdgcn_fractf(pos * inv * 0.15915494309189535f); const float sn = __builtin_amdgcn_sinf(rev), cs = __builtin_amdgcn_cosf(rev);
            qr1[e] = qa[e] * cs - qb[e] * sn; qr2[e] = qa[e] * sn + qb[e] * cs;
            kr1[e] = (ka[e] * cs - kb[e] * sn) * 0.125f; kr2[e] = (ka[e] * sn + kb[e] * cs) * 0.125f;
            qe1[e] = qr1[e] * qd; qe2[e] = qr2[e] * qd;
            KDT[(d0 + e) * LT + i] = f2bf(kr1[e] * kd); KDT[(d0 + 32 + e) * LT + i] = f2bf(kr2[e] * kd);
            VT[(sg * 16 + e) * LT + i] = f2bf(va[e]); VT[(sg * 16 + 8 + e) * LT + i] = f2bf(vb[e]);
        }
        *(LAS u32x4*)(QR + i * LT + d0) = pack8(qr1); *(LAS u32x4*)(QR + i * LT + d0 + 32) = pack8(qr2);
        *(LAS u32x4*)(KR + i * LT + d0) = pack8(kr1); *(LAS u32x4*)(KR + i * LT + d0 + 32) = pack8(kr2);
        bf16_t* qe = WSP(bf16_t, WS_QEFF) + (size_t)uid * 4096 + i * 64;
        *(u32x4*)(qe + d0) = pack8(qe1); *(u32x4*)(qe + d0 + 32) = pack8(qe2);
    }
    __syncthreads();
    f32x4 acc[4];
#pragma unroll
    for (int ct = 0; ct < 4; ++ct) acc[ct] = mma16(QR, 16 * w4, KR, 16 * ct, (f32x4){0.f, 0.f, 0.f, 0.f}, r, q);
#pragma unroll
    for (int ct = 0; ct < 4; ++ct)
#pragma unroll
        for (int j = 0; j < 4; ++j) { const int ii = 16 * w4 + 4 * q + j, col = 16 * ct + r;
            P[ii * LT + col] = f2bf(ii >= col ? acc[ct][j] * fexp(lg * (float)(ii - col)) : 0.f); }
    __syncthreads();
#pragma unroll
    for (int ct = 0; ct < 4; ++ct) acc[ct] = mma16(P, 16 * w4, VT, 16 * ct, (f32x4){0.f, 0.f, 0.f, 0.f}, r, q);
    store_oloc(WSP(bf16_t, WS_OLOC), uid, w4, lane, acc);
#pragma unroll
    for (int ct = 0; ct < 4; ++ct) acc[ct] = mma16(KDT, 16 * w4, VT, 16 * ct, (f32x4){0.f, 0.f, 0.f, 0.f}, r, q);
    store_bc(WSP(bf16_t, WS_BCS), uid, w4, r, q, acc);
    __syncthreads();
}

__device__ __forceinline__ void hgrn_unit(const Ctx& X, LAS unsigned char* hl, int b, int c, int h, int tid_h, int w4, int lane, int layer) {
    LAS bf16_t* QT = opq((LAS bf16_t*)hl);
    LAS float* Gt = opq((LAS float*)(hl + 9216));
    LAS bf16_t* Kt = opq((LAS bf16_t*)(hl + 25600));
    LAS bf16_t* KTI = opq((LAS bf16_t*)(hl + 34816));
    LAS bf16_t* VT = KTI; LAS bf16_t* KDT = opq(KTI + 64 * LT);
    LAS float* tot = opq((LAS float*)(hl + 57856));
    const bf16_t* proj = WSP(const bf16_t, WS_PROJ);
    const int uid = unit_id(2, b, h, c);
    const int r = lane & 15, q = lane >> 4;
    const int i = tid_h >> 2, ds = (tid_h & 3) * 16;
    const bf16_t* pr = proj + ((size_t)b * T + c * 64 + i) * LDP;
    float kk[16], qv[16], vv[16];
    {
        float ff[16];
        { float t0[8], t1[8]; unpack8(*(const u32x4*)(pr + C_HF + h * 64 + ds), t0); unpack8(*(const u32x4*)(pr + C_HF + h * 64 + ds + 8), t1);
#pragma unroll
          for (int e = 0; e < 8; ++e) { ff[e] = t0[e]; ff[8 + e] = t1[e]; } }
        { float t0[8], t1[8]; unpack8(*(const u32x4*)(pr + C_HQ + h * 64 + ds), t0); unpack8(*(const u32x4*)(pr + C_HQ + h * 64 + ds + 8), t1);
#pragma unroll
          for (int e = 0; e < 8; ++e) { qv[e] = t0[e]; qv[8 + e] = t1[e]; } }
        { float t0[8], t1[8]; unpack8(*(const u32x4*)(pr + C_HI + h * 64 + ds), t0); unpack8(*(const u32x4*)(pr + C_HI + h * 64 + ds + 8), t1);
#pragma unroll
          for (int e = 0; e < 8; ++e) { vv[e] = t0[e]; vv[8 + e] = t1[e]; } }
#pragma unroll
        for (int e = 0; e < 16; ++e) {
            const int ch = h * 64 + ds + e;
            const float lb = layer == 0 ? 0.f : sigmoid_f(X.in[12][256 + ch] - X.in[12][ch]);
            const float f = ff[e];
            const float ls = fminf(f, 0.f) - __logf(1.0f + fexp(-fabsf(f)));
            const float lf = layer == 0 ? ls : __logf(lb + (1.f - lb) * fexp(ls));
            kk[e] = (1.f - lb) * frcp(1.f + fexp(f));
            Gt[i * 64 + ds + e] = lf;
        }
    }
    __syncthreads();
    {
        const int d = tid_h & 63, seg = tid_h >> 6; float cs[16]; float run = 0.f;
#pragma unroll
        for (int jj = 0; jj < 16; ++jj) { run += Gt[(16 * seg + jj) * 64 + d]; cs[jj] = run; }
        tot[seg * 64 + d] = run;
        __syncthreads();
        float off = 0.f;
#pragma unroll
        for (int s = 0; s < 3; ++s) off += (s < seg) ? tot[s * 64 + d] : 0.f;
#pragma unroll
        for (int jj = 0; jj < 16; ++jj) Gt[(16 * seg + jj) * 64 + d] = cs[jj] + off;
    }
    __syncthreads();
    float Gi[16], G63[16];
    {
        const int I = i >> 4;
        float qt[16], qe[16];
#pragma unroll
        for (int e = 0; e < 16; ++e) { Gi[e] = Gt[i * 64 + ds + e]; G63[e] = Gt[63 * 64 + ds + e]; const float gr = Gt[(16 * I) * 64 + ds + e];
            qt[e] = qv[e] * fexp(Gi[e] - gr); qe[e] = qv[e] * fexp(Gi[e]); }
        u32x4 w0, w1;
        w0.x = pk2(qt[0], qt[1]); w0.y = pk2(qt[2], qt[3]); w0.z = pk2(qt[4], qt[5]); w0.w = pk2(qt[6], qt[7]);
        w1.x = pk2(qt[8], qt[9]); w1.y = pk2(qt[10], qt[11]); w1.z = pk2(qt[12], qt[13]); w1.w = pk2(qt[14], qt[15]);
        *(LAS u32x4*)(QT + i * LT + ds) = w0; *(LAS u32x4*)(QT + i * LT + ds + 8) = w1;
        w0.x = pk2(qe[0], qe[1]); w0.y = pk2(qe[2], qe[3]); w0.z = pk2(qe[4], qe[5]); w0.w = pk2(qe[6], qe[7]);
        w1.x = pk2(qe[8], qe[9]); w1.y = pk2(qe[10], qe[11]); w1.z = pk2(qe[12], qe[13]); w1.w = pk2(qe[14], qe[15]);
        bf16_t* qg = WSP(bf16_t, WS_QEFF) + (size_t)uid * 4096 + i * 64 + ds;
        *(u32x4*)qg = w0; *(u32x4*)(qg + 8) = w1;
        w0.x = pk2(kk[0], kk[1]); w0.y = pk2(kk[2], kk[3]); w0.z = pk2(kk[4], kk[5]); w0.w = pk2(kk[6], kk[7]);
        w1.x = pk2(kk[8], kk[9]); w1.y = pk2(kk[10], kk[11]); w1.z = pk2(kk[12], kk[13]); w1.w = pk2(kk[14], kk[15]);
        *(LAS u32x4*)(Kt + i * LT + ds) = w0; *(LAS u32x4*)(Kt + i * LT + ds + 8) = w1;
        if (i == 63) { float* mv = WSP(float, WS_MVEC) + (size_t)(uid - 2 * 2048) * 64 + ds;
#pragma unroll
            for (int e = 0; e < 16; ++e) mv[e] = fexp(G63[e]); }
    }
    __syncthreads();
    const int I = w4;
    LAS bf16_t* KI = opq(KTI + (8 * I * (I + 1)) * LT);
    {
        const int nit = 16 * (I + 1) * 8;
        for (int idx = lane; idx < nit; idx += 64) { const int j = idx >> 3, d8 = (idx & 7) * 8;
            float kf[8]; unpack8(*(const LAS u32x4*)(Kt + j * LT + d8), kf);
            float o[8];
#pragma unroll
            for (int e = 0; e < 8; ++e) o[e] = kf[e] * fexp(fminf(Gt[(16 * I) * 64 + d8 + e] - Gt[j * 64 + d8 + e], 80.f));
            *(LAS u32x4*)(KI + j * LT + d8) = pack8(o); }
    }
    __syncthreads();
    f32x4 acc[4];
    {
        bf16x8 a[2];
#pragma unroll
        for (int ks = 0; ks < 2; ++ks) a[ks] = *(const LAS bf16x8*)(QT + (16 * I + r) * LT + ks * 32 + q * 8);
#pragma unroll
        for (int ct = 0; ct < 4; ++ct) { acc[ct] = (f32x4){0.f, 0.f, 0.f, 0.f};
            if (ct <= I) {
#pragma unroll
                for (int ks = 0; ks < 2; ++ks) { const bf16x8 bb = *(const LAS bf16x8*)(KI + (16 * ct + r) * LT + ks * 32 + q * 8);
                    acc[ct] = __builtin_amdgcn_mfma_f32_16x16x32_bf16(a[ks], bb, acc[ct], 0, 0, 0); } } }
        asm volatile("s_waitcnt lgkmcnt(0)" ::: "memory");
#pragma unroll
        for (int ct = 0; ct < 4; ++ct)
#pragma unroll
            for (int j = 0; j < 4; ++j) { const int ii = 16 * I + 4 * q + j, col = 16 * ct + r;
                QT[ii * LT + col] = f2bf((ct <= I && ii >= col) ? acc[ct][j] : 0.f); }
    }
    __syncthreads();
    {
#pragma unroll
        for (int e = 0; e < 16; ++e) { VT[(ds + e) * LT + i] = f2bf(vv[e]); KDT[(ds + e) * LT + i] = f2bf(kk[e] * fexp(G63[e] - Gi[e])); }
    }
    __syncthreads();
#pragma unroll
    for (int ct = 0; ct < 4; ++ct) acc[ct] = mma16(QT, 16 * w4, VT, 16 * ct, (f32x4){0.f, 0.f, 0.f, 0.f}, r, q);
    store_oloc(WSP(bf16_t, WS_OLOC), uid, w4, lane, acc);
#pragma unroll
    for (int ct = 0; ct < 4; ++ct) acc[ct] = mma16(KDT, 16 * w4, VT, 16 * ct, (f32x4){0.f, 0.f, 0.f, 0.f}, r, q);
    store_bc(WSP(bf16_t, WS_BCS), uid, w4, r, q, acc);
    __syncthreads();
}

__device__ __forceinline__ void gdn_unit(const Ctx& X, LAS unsigned char* hl, int b, int c, int h, int tid_h, int w4, int lane, int layer) {
    LAS bf16_t* Q = opq((LAS bf16_t*)hl); LAS bf16_t* K = opq(Q + 64 * LT); LAS bf16_t* KB = opq(K + 64 * LT); LAS bf16_t* V = opq(KB + 64 * LT); LAS bf16_t* KDT = opq(V + 64 * LT); LAS bf16_t* P = opq(KDT + 64 * LT);
    LAS bf16_t* WT = KB; LAS bf16_t* UT = V;
    LAS bf16_t* AB = opq((LAS bf16_t*)(hl + 55296));
    LAS float* ACCS = opq((LAS float*)(hl + 64512));
    LAS float* Gs = opq((LAS float*)(hl + 72704));
    LAS float* Bs = opq(Gs + 64);
    const bf16_t* proj = WSP(const bf16_t, WS_PROJ);
    const int uid = unit_id(1, b, h, c);
    const int r = lane & 15, q = lane >> 4;
    {
    LAS bf16_t* RAW = opq((LAS bf16_t*)(hl + 46080));
    const int cseg = tid_h & 7, i0 = tid_h >> 3;
    f32x4 wq[3][4][2];
    {
        const float* cw = X.in[8] + (size_t)layer * 4 * 768 + h * 64 + cseg * 8;
#pragma unroll
        for (int tn = 0; tn < 3; ++tn)
#pragma unroll
            for (int k = 0; k < 4; ++k) { const f32x4* wp = (const f32x4*)(cw + k * 768 + tn * 256); wq[tn][k][0] = wp[0]; wq[tn][k][1] = wp[1]; }
        u32x4 rawv[7];
#pragma unroll
        for (int n = 0; n < 7; ++n) { const int item = tid_h + 256 * n; const int seg = item & 7; int rowid = item >> 3; rowid = rowid < 201 ? rowid : 200;
            const int tn = rowid / 67, rr = rowid - tn * 67; const int tt = c * 64 - 3 + rr; const int ttc = tt < 0 ? 0 : tt;
            const u32x4 v = *(const u32x4*)(proj + ((size_t)b * T + ttc) * LDP + C_GQ + tn * 256 + h * 64 + seg * 8);
            rawv[n] = tt < 0 ? (u32x4){0u, 0u, 0u, 0u} : v; }
        float g = 0.f, bt = 0.f;
        if (tid_h < 64) {
            const bf16_t* pr = proj + ((size_t)b * T + c * 64 + tid_h) * LDP;
            const float* gba = WSP(const float, WS_GBA) + ((size_t)b * T + c * 64 + tid_h) * 8; const float gb = gba[h], ga = gba[4 + h];
            g = -fexp(X.in[9][layer * 4 + h]) * softplus_f(ga + X.in[10][layer * 4 + h]);
#pragma unroll
            for (int o = 1; o < 64; o <<= 1) { const float t = __shfl_up(g, o); if (lane >= o) g += t; }
            bt = sigmoid_f(gb);
            Gs[tid_h] = g; Bs[tid_h] = bt;
        }
#pragma unroll
        for (int n = 0; n < 7; ++n) { const int item = tid_h + 256 * n; if (item < 1608) *(LAS u32x4*)(RAW + (item >> 3) * 64 + (item & 7) * 8) = rawv[n]; }
    }
    __syncthreads();
    {
        const float G63 = Gs[63];
#pragma unroll
        for (int rs = 0; rs < 2; ++rs) {
            const int i = i0 + 32 * rs;
            const float bi = Bs[i], Gi = Gs[i];
            float y[3][8];
#pragma unroll
            for (int tn = 0; tn < 3; ++tn) {
#pragma unroll
                for (int e = 0; e < 8; ++e) y[tn][e] = 0.f;
#pragma unroll
                for (int k = 0; k < 4; ++k) { float x8[8]; unpack8(*(const LAS u32x4*)(RAW + (tn * 67 + i + k) * 64 + cseg * 8), x8);
                    y[tn][0] += wq[tn][k][0].x * x8[0]; y[tn][1] += wq[tn][k][0].y * x8[1]; y[tn][2] += wq[tn][k][0].z * x8[2]; y[tn][3] += wq[tn][k][0].w * x8[3];
                    y[tn][4] += wq[tn][k][1].x * x8[4]; y[tn][5] += wq[tn][k][1].y * x8[5]; y[tn][6] += wq[tn][k][1].z * x8[6]; y[tn][7] += wq[tn][k][1].w * x8[7]; }
#pragma unroll
                for (int e = 0; e < 8; ++e) y[tn][e] = silu_acc(y[tn][e]);
            }
            float sq = 0.f, sk = 0.f;
#pragma unroll
            for (int e = 0; e < 8; ++e) { sq += y[0][e] * y[0][e]; sk += y[1][e] * y[1][e]; }
            sq += __shfl_xor(sq, 1); sq += __shfl_xor(sq, 2); sq += __shfl_xor(sq, 4);
            sk += __shfl_xor(sk, 1); sk += __shfl_xor(sk, 2); sk += __shfl_xor(sk, 4);
            const float rq = 0.125f * rsqrtf(sq + 1e-6f), rk = rsqrtf(sk + 1e-6f), kd = rk * fexp(G63 - Gi);
            float t8[8];
#pragma unroll
            for (int e = 0; e < 8; ++e) t8[e] = y[0][e] * rq;
            *(LAS u32x4*)(Q + i * LT + cseg * 8) = pack8(t8);
#pragma unroll
            for (int e = 0; e < 8; ++e) t8[e] = y[1][e] * rk;
            *(LAS u32x4*)(K + i * LT + cseg * 8) = pack8(t8);
#pragma unroll
            for (int e = 0; e < 8; ++e) t8[e] = y[1][e] * rk * bi;
            *(LAS u32x4*)(KB + i * LT + cseg * 8) = pack8(t8);
            *(LAS u32x4*)(V + i * LT + cseg * 8) = pack8(y[2]);
#pragma unroll
            for (int e = 0; e < 8; ++e) KDT[(cseg * 8 + e) * LT + i] = f2bf(y[1][e] * kd);
        }
    }
    __syncthreads();
    }
    {
        f32x4 aA[4], aP[4];
#pragma unroll
        for (int ct = 0; ct < 4; ++ct) { aA[ct] = mma16(KB, 16 * w4, K, 16 * ct, (f32x4){0.f, 0.f, 0.f, 0.f}, r, q); aP[ct] = mma16(Q, 16 * w4, K, 16 * ct, (f32x4){0.f, 0.f, 0.f, 0.f}, r, q); }
#pragma unroll
        for (int ct = 0; ct < 4; ++ct)
#pragma unroll
            for (int j = 0; j < 4; ++j) { const int ii = 16 * w4 + 4 * q + j, col = 16 * ct + r;
                const float L = fexp(fminf(Gs[ii] - Gs[col], 0.f));
                AB[ii * LT + col] = f2bf(ii > col ? aA[ct][j] * L : 0.f);
                P[ii * LT + col] = f2bf(ii >= col ? aP[ct][j] * L : 0.f); }
    }
    __syncthreads();
    float rc[64];
    if (w4 < 2) {
        const int col = tid_h & 63; const LAS bf16_t* src = w4 == 0 ? V : KB;
#pragma unroll
        for (int i = 0; i < 64; ++i) { const float sc = w4 == 0 ? Bs[i] : fexp(Gs[i]); rc[i] = bf2f(src[i * LT + col]) * sc; }
    }
    __syncthreads();
    {
    for (int idx = tid_h; idx < 1152; idx += 256) { const int tl = idx >= 576; const int rem = idx - tl * 576; *(LAS u32x4*)((tl ? KB : V) + rem * 8) = (u32x4){0u, 0u, 0u, 0u}; }
    __syncthreads();
#pragma unroll
    for (int I = 0; I < 4; ++I) {
        if (I > 0) {
#pragma unroll
            for (int t2 = 0; t2 < 2; ++t2) { const int ct8 = 2 * w4 + t2; const LAS bf16_t* Bt = ct8 < 4 ? UT : WT;
                const f32x4 a = mma16(AB, 16 * I, Bt, 16 * (ct8 & 3), (f32x4){0.f, 0.f, 0.f, 0.f}, r, q);
#pragma unroll
                for (int j = 0; j < 4; ++j) ACCS[(4 * q + j) * 128 + 16 * ct8 + r] = a[j]; }
            __syncthreads();
        }
        if (w4 < 2) {
            const int col = tid_h & 63, c128 = w4 * 64 + col;
            float t[16];
#pragma unroll
            for (int ii = 0; ii < 16; ++ii) t[ii] = rc[16 * I + ii] - (I > 0 ? ACCS[ii * 128 + c128] : 0.f);
#pragma unroll
            for (int ii = 1; ii < 16; ++ii) {
                float a16[16];
                { float lo[8]; unpack8(*(const LAS u32x4*)(AB + (16 * I + ii) * LT + 16 * I), lo);
#pragma unroll
                  for (int e = 0; e < 8; ++e) a16[e] = lo[e]; }
                if (ii > 8) { float hi[8]; unpack8(*(const LAS u32x4*)(AB + (16 * I + ii) * LT + 16 * I + 8), hi);
#pragma unroll
                  for (int e = 0; e < 8; ++e) a16[8 + e] = hi[e]; }
                float s0 = t[ii], s1 = 0.f;
#pragma unroll
                for (int kk = 0; kk < ii; ++kk) { if (kk & 1) s1 -= a16[kk] * t[kk]; else s0 -= a16[kk] * t[kk]; }
                t[ii] = s0 + s1;
            }
            LAS bf16_t* dst = (w4 == 0 ? UT : WT) + col * LT + 16 * I;
            u32x4 w0, w1;
            w0.x = pk2(t[0], t[1]); w0.y = pk2(t[2], t[3]); w0.z = pk2(t[4], t[5]); w0.w = pk2(t[6], t[7]);
            w1.x = pk2(t[8], t[9]); w1.y = pk2(t[10], t[11]); w1.z = pk2(t[12], t[13]); w1.w = pk2(t[14], t[15]);
            *(LAS u32x4*)dst = w0; *(LAS u32x4*)(dst + 8) = w1;
        }
        __syncthreads();
    }
    }
    {
        f32x4 acc[4];
        const float eG63 = fexp(Gs[63]);
#pragma unroll
        for (int ct = 0; ct < 4; ++ct) acc[ct] = mma16(P, 16 * w4, WT, 16 * ct, (f32x4){0.f, 0.f, 0.f, 0.f}, r, q);
        bf16_t* qe = WSP(bf16_t, WS_QEFF) + (size_t)uid * 4096;
#pragma unroll
        for (int ct = 0; ct < 4; ++ct)
#pragma unroll
            for (int j = 0; j < 4; ++j) { const int ii = 16 * w4 + 4 * q + j, col = 16 * ct + r;
                qe[ii * 64 + col] = f2bf(bf2f(Q[ii * LT + col]) * fexp(Gs[ii]) - acc[ct][j]); }
#pragma unroll
        for (int ct = 0; ct < 4; ++ct) acc[ct] = mma16(P, 16 * w4, UT, 16 * ct, (f32x4){0.f, 0.f, 0.f, 0.f}, r, q);
        store_oloc(WSP(bf16_t, WS_OLOC), uid, w4, lane, acc);
#pragma unroll
        for (int ct = 0; ct < 4; ++ct) acc[ct] = mma16(KDT, 16 * w4, WT, 16 * ct, (f32x4){0.f, 0.f, 0.f, 0.f}, r, q);
        bf16_t* mm = WSP(bf16_t, WS_MM) + (size_t)(uid - 2048) * 4096;
#pragma unroll
        for (int ct = 0; ct < 4; ++ct)
#pragma unroll
            for (int j = 0; j < 4; ++j) { const int ii = 16 * w4 + 4 * q + j, col = 16 * ct + r;
                mm[((w4 * 2 + (ct >> 1)) * 64 + (r >> 2) * 16 + 4 * q + j) * 8 + (ct & 1) * 4 + (r & 3)] = f2bf((ii == col ? eG63 : 0.f) - acc[ct][j]); }
#pragma unroll
        for (int ct = 0; ct < 4; ++ct) acc[ct] = mma16(KDT, 16 * w4, UT, 16 * ct, (f32x4){0.f, 0.f, 0.f, 0.f}, r, q);
        store_bc(WSP(bf16_t, WS_BCS), uid, w4, r, q, acc);
    }
    __syncthreads();
}

__device__ __forceinline__ void conf_unit(const Ctx& X, LAS unsigned char* lds, int b, int c, int tid, int wave, int lane, int layer) {
    LAS bf16_t* GL = opq((LAS bf16_t*)lds);
    LAS float* Y = opq((LAS float*)(lds + 49152));
    const bf16_t* proj = WSP(const bf16_t, WS_PROJ);
    bf16_t* mix = WSP(bf16_t, WS_MIX);
    const int t0 = c * 64;
    for (int item = tid; item < 94 * 32; item += 512) { const int rr = item >> 5, seg = (item & 31) * 8, tt = t0 - 30 + rr;
        u32x4 w = (u32x4){0u, 0u, 0u, 0u};
        if (tt >= 0) { const bf16_t* pr = proj + ((size_t)b * T + tt) * LDP; float a[8], g[8], o[8]; unpack8(*(const u32x4*)(pr + C_CA + seg), a); unpack8(*(const u32x4*)(pr + C_CG + seg), g);
#pragma unroll
            for (int e = 0; e < 8; ++e) o[e] = a[e] * sigmoid_f(g[e]);
            w = pack8(o); }
        *(LAS u32x4*)(GL + rr * 256 + seg) = w; }
    __syncthreads();
    {
        const int ch = tid & 255, half = tid >> 8;
        const float* cw = X.in[4] + (size_t)layer * 31 * 256 + ch;
        float w[31];
#pragma unroll
        for (int k = 0; k < 31; ++k) w[k] = cw[k * 256];
        const float bias = X.in[5][layer * 256 + ch];
        float acc[32];
#pragma unroll
        for (int tk = 0; tk < 32; ++tk) acc[tk] = bias;
#pragma unroll
        for (int rr = 0; rr < 62; ++rr) { const float g = bf2f(GL[(half * 32 + rr) * 256 + ch]);
#pragma unroll
            for (int tk = 0; tk < 32; ++tk) { const int k = rr - tk; if (k >= 0 && k < 31) acc[tk] += w[k] * g; } }
#pragma unroll
        for (int tk = 0; tk < 32; ++tk) Y[(half * 32 + tk) * 256 + ch] = acc[tk];
    }
    __syncthreads();
    {
        const f32x4 lw = *((const f32x4*)(X.in[6] + layer * 256) + lane), lb = *((const f32x4*)(X.in[7] + layer * 256) + lane);
#pragma unroll 2
        for (int tk = wave * 8; tk < wave * 8 + 8; ++tk) {
            const f32x4 v = *((const LAS f32x4*)(Y + tk * 256) + lane);
            const float mu = wave_sum((v.x + v.y) + (v.z + v.w)) * (1.f / 256.f);
            const f32x4 dv = v - mu;
            const float var = wave_sum((dv.x * dv.x + dv.y * dv.y) + (dv.z * dv.z + dv.w * dv.w)) * (1.f / 256.f);
            const float rs = rsqrtf(var + 1e-5f);
            f32x4 o = dv * rs * lw + lb;
            const bool on = (MIX_MASK & 2) != 0;
            u32x2 p; p.x = on ? pk2(silu_acc(o.x), silu_acc(o.y)) : 0u; p.y = on ? pk2(silu_acc(o.z), silu_acc(o.w)) : 0u;
            *(u32x2*)(mix + ((size_t)b * T + t0 + tk) * D + 256 + lane * 4) = p;
        }
    }
    __syncthreads();
}

__device__ __forceinline__ void mixer_local_phase(const Ctx& X, LAS unsigned char* lds, int layer, int tid, int wave, int lane) {
    const int hs = wave >> 2, w4 = wave & 3; int tid_h = tid & 255;
    LAS unsigned char* hl = lds + hs * HEAD_LDS;
    const int nit_ = (3584 + (int)gridDim.x - 1) / (int)gridDim.x;
    for (int it_ = 0; it_ < nit_; ++it_) {
        const int u = (int)blockIdx.x + (int)gridDim.x * ((it_ + (int)(blockIdx.x >> 3)) % nit_);
        if (u >= 3584) continue;
        asm volatile("" : "+v"(tid_h), "+v"(lane), "+v"(tid));
        if (u < 3072) { const int mixer = u >> 10, idx = u & 1023, hp = idx & 1, cb = idx >> 1, b = cb >> 7, c = cb & 127, h = hp * 2 + hs;
            if (mixer == 0) { ret_unit(X, hl, b, c, h, tid_h, w4, lane);
            } else if (mixer == 1) { gdn_unit(X, hl, b, c, h, tid_h, w4, lane, layer);
            } else { hgrn_unit(X, hl, b, c, h, tid_h, w4, lane, layer);
            }
        } else { const int cb = u - 3072; conf_unit(X, lds, cb >> 7, cb & 127, tid, wave, lane, layer);
        }
    }
}

__device__ __forceinline__ void scan_phase(const Ctx& X, int wave, int lane) {
    const int job = blockIdx.x;
    if (job >= 192 || wave != 0) return;
    asm volatile("" : "+v"(lane));
    const int mixer = job >> 6, rem = job & 63, bh = rem >> 2, vg = rem & 3;
    const int uid0 = (mixer * 16 + bh) * NCH;
    const int r = lane & 15, q = lane >> 4;
    bf16_t* bc0 = WSP(bf16_t, WS_BCS) + (size_t)uid0 * 4096 + (vg * 4 * 64 + lane) * 4;
    float S[4][4];
#pragma unroll
    for (int t = 0; t < 4; ++t)
#pragma unroll
        for (int j = 0; j < 4; ++j) S[t][j] = 0.f;
    if (mixer == 1) {
        const bf16_t* mm0 = WSP(const bf16_t, WS_MM) + (size_t)(uid0 - 2048) * 4096;
        u32x2 cb[4][4], ca[4][4][2][2];
#define SCAN_LOAD_G(slot, cc) { const int c_ = (cc) < NCH ? (cc) : NCH - 1; const bf16_t* bcn = bc0 + (size_t)c_ * 4096; const bf16_t* mmn = mm0 + (size_t)c_ * 4096; \
            _Pragma("unroll") for (int t = 0; t < 4; ++t) { cb[slot][t] = *(const u32x2*)(bcn + 256 * t); \
                _Pragma("unroll") for (int s2 = 0; s2 < 2; ++s2) { const u32x4 w_ = *(const u32x4*)(mmn + ((t * 2 + s2) * 64 + lane) * 8); ca[slot][t][s2][0] = (u32x2){w_.x, w_.y}; ca[slot][t][s2][1] = (u32x2){w_.z, w_.w}; } } }
        SCAN_LOAD_G(0, 0) SCAN_LOAD_G(1, 1) SCAN_LOAD_G(2, 2)
#pragma unroll 1
        for (int c0 = 0; c0 < NCH; c0 += 4) {
#pragma unroll
            for (int k = 0; k < 4; ++k) {
                const int c = c0 + k;
                SCAN_LOAD_G((k + 3) & 3, c + 3)
                bf16_t* bcc = bc0 + (size_t)c * 4096;
                u32x2 sp[4];
#pragma unroll
                for (int t = 0; t < 4; ++t) { sp[t].x = pk2(S[t][0], S[t][1]); sp[t].y = pk2(S[t][2], S[t][3]);
                    asm volatile("" : "+v"(sp[t].x) : "v"(cb[k][t].x));
                    *(u32x2*)(bcc + 256 * t) = sp[t]; }
                bf16x8 bfr[2];
#pragma unroll
                for (int s2 = 0; s2 < 2; ++s2) { u32x4 w; w.x = sp[2 * s2].x; w.y = sp[2 * s2].y; w.z = sp[2 * s2 + 1].x; w.w = sp[2 * s2 + 1].y; bfr[s2] = __builtin_bit_cast(bf16x8, w); }
#pragma unroll
                for (int t = 0; t < 4; ++t) {
                    f32x4 acc = (f32x4){bf_lo(cb[k][t].x), bf_hi(cb[k][t].x), bf_lo(cb[k][t].y), bf_hi(cb[k][t].y)};
#pragma unroll
                    for (int s2 = 0; s2 < 2; ++s2) { u32x4 w; w.x = ca[k][t][s2][0].x; w.y = ca[k][t][s2][0].y; w.z = ca[k][t][s2][1].x; w.w = ca[k][t][s2][1].y;
                        acc = __builtin_amdgcn_mfma_f32_16x16x32_bf16(__builtin_bit_cast(bf16x8, w), bfr[s2], acc, 0, 0, 0); }
                    S[t][0] = acc[0]; S[t][1] = acc[1]; S[t][2] = acc[2]; S[t][3] = acc[3];
                }
            }
        }
#undef SCAN_LOAD_G
    } else {
        const int h = bh & 3;
        const float g64 = __expf(64.0f * log1pf(-exp2f(-5.0f - (float)h)));
        const float* mv0 = WSP(const float, WS_MVEC) + (size_t)(mixer == 2 ? uid0 - 2 * 2048 : 0) * 64 + 4 * q;
        u32x2 cb[4][4]; f32x4 cm[4][4];
#define SCAN_LOAD_D(slot, cc) { const int c_ = (cc) < NCH ? (cc) : NCH - 1; const bf16_t* bcn = bc0 + (size_t)c_ * 4096; \
            _Pragma("unroll") for (int t = 0; t < 4; ++t) { cb[slot][t] = *(const u32x2*)(bcn + 256 * t); cm[slot][t] = mixer == 2 ? *(const f32x4*)(mv0 + (size_t)c_ * 64 + 16 * t) : (f32x4){g64, g64, g64, g64}; } }
        SCAN_LOAD_D(0, 0) SCAN_LOAD_D(1, 1) SCAN_LOAD_D(2, 2)
#pragma unroll 1
        for (int c0 = 0; c0 < NCH; c0 += 4) {
#pragma unroll
            for (int k = 0; k < 4; ++k) {
                const int c = c0 + k;
                SCAN_LOAD_D((k + 3) & 3, c + 3)
                bf16_t* bcc = bc0 + (size_t)c * 4096;
#pragma unroll
                for (int t = 0; t < 4; ++t) { u32x2 sp; sp.x = pk2(S[t][0], S[t][1]); sp.y = pk2(S[t][2], S[t][3]);
                    asm volatile("" : "+v"(sp.x) : "v"(cb[k][t].x));
                    *(u32x2*)(bcc + 256 * t) = sp;
                    S[t][0] = cm[k][t].x * S[t][0] + bf_lo(cb[k][t].x); S[t][1] = cm[k][t].y * S[t][1] + bf_hi(cb[k][t].x);
                    S[t][2] = cm[k][t].z * S[t][2] + bf_lo(cb[k][t].y); S[t][3] = cm[k][t].w * S[t][3] + bf_hi(cb[k][t].y); }
            }
        }
#undef SCAN_LOAD_D
    }
}

__device__ __forceinline__ void mixer_out_phase(const Ctx& X, LAS unsigned char* lds, int layer, int tid, int wave, int lane) {
    constexpr int GP = 264;
    const bf16_t* proj = WSP(const bf16_t, WS_PROJ);
    bf16_t* mix = WSP(bf16_t, WS_MIX);
    for (int u = blockIdx.x; u < 1536; u += gridDim.x) {
        asm volatile("" : "+v"(lane), "+v"(tid));
        LAS bf16_t* GT = opq((LAS bf16_t*)lds);
        const int r = lane & 15, q = lane >> 4, h = wave >> 1, half = wave & 1;
        const int mixer = u >> 9, rem = u & 511, b = rem >> 7, c = rem & 127;
        const int uid = unit_id(mixer, b, h, c);
        const int goff = mixer == 0 ? C_RG : (mixer == 1 ? C_GG : C_HG), moff = mixer == 0 ? 0 : (mixer == 1 ? 512 : 768);
        const size_t row0 = (size_t)b * T + c * 64;
        u32x4 gv[4];
#pragma unroll
        for (int n = 0; n < 4; ++n) { const int idx = tid + 512 * n; gv[n] = *(const u32x4*)(proj + (row0 + (idx >> 5)) * LDP + goff + (idx & 31) * 8); }
        const bf16_t* qe = WSP(const bf16_t, WS_QEFF) + (size_t)uid * 4096;
        const bf16_t* st = WSP(const bf16_t, WS_BCS) + (size_t)uid * 4096;
        bf16x8 a[2][2], bb[4][2]; u32x4 ov[2][2];
#pragma unroll
        for (int rt = 0; rt < 2; ++rt) { const int rt4 = 2 * half + rt;
#pragma unroll
            for (int ks = 0; ks < 2; ++ks) a[rt][ks] = *(const bf16x8*)(qe + (16 * rt4 + r) * 64 + ks * 32 + q * 8);
            const u32x4* ol = (const u32x4*)(WSP(const bf16_t, WS_OLOC) + ((size_t)uid * 4 + rt4) * 1024 + lane * 16); ov[rt][0] = ol[0]; ov[rt][1] = ol[1]; }
#pragma unroll
        for (int ct = 0; ct < 4; ++ct)
#pragma unroll
            for (int ks = 0; ks < 2; ++ks) { const bf16_t* tb = st + (size_t)((ct * 4 + 2 * ks + (q >> 1)) * 64) * 4;
                const u32x2 lo = *(const u32x2*)(tb + ((2 * (q & 1)) * 16 + r) * 4), hi = *(const u32x2*)(tb + ((2 * (q & 1) + 1) * 16 + r) * 4);
                bb[ct][ks] = __builtin_bit_cast(bf16x8, (u32x4){lo.x, lo.y, hi.x, hi.y}); }
        const float* nw = mixer == 0 ? X.in[3] + layer * 256 + h * 64 : (mixer == 1 ? X.in[11] + layer * 64 : X.in[13] + layer * 64);
        float wv[4];
#pragma unroll
        for (int ct = 0; ct < 4; ++ct) wv[ct] = nw[16 * ct + r];
#pragma unroll
        for (int n = 0; n < 4; ++n) { const int idx = tid + 512 * n; *(LAS u32x4*)(GT + (idx >> 5) * GP + (idx & 31) * 8) = gv[n]; }
        __syncthreads();
        const bool on = ((MIX_MASK >> (mixer == 0 ? 0 : (mixer == 1 ? 2 : 3))) & 1) != 0;
#pragma unroll
        for (int rt = 0; rt < 2; ++rt) {
            f32x4 acc[4];
            acc[0] = (f32x4){bf_lo(ov[rt][0].x), bf_hi(ov[rt][0].x), bf_lo(ov[rt][0].y), bf_hi(ov[rt][0].y)}; acc[1] = (f32x4){bf_lo(ov[rt][0].z), bf_hi(ov[rt][0].z), bf_lo(ov[rt][0].w), bf_hi(ov[rt][0].w)};
            acc[2] = (f32x4){bf_lo(ov[rt][1].x), bf_hi(ov[rt][1].x), bf_lo(ov[rt][1].y), bf_hi(ov[rt][1].y)}; acc[3] = (f32x4){bf_lo(ov[rt][1].z), bf_hi(ov[rt][1].z), bf_lo(ov[rt][1].w), bf_hi(ov[rt][1].w)};
#pragma unroll
            for (int ct = 0; ct < 4; ++ct)
#pragma unroll
                for (int ks = 0; ks < 2; ++ks) acc[ct] = __builtin_amdgcn_mfma_f32_16x16x32_bf16(a[rt][ks], bb[ct][ks], acc[ct], 0, 0, 0);
#pragma unroll
            for (int j = 0; j < 4; ++j) {
                float sm = (acc[0][j] + acc[1][j]) + (acc[2][j] + acc[3][j]);
                sm += __shfl_xor(sm, 1); sm += __shfl_xor(sm, 2); sm += __shfl_xor(sm, 4); sm += __shfl_xor(sm, 8);
                const float mu = mixer == 0 ? sm * (1.f / 64.f) : 0.f;
                float d[4], s2 = 0.f;
#pragma unroll
                for (int ct = 0; ct < 4; ++ct) { d[ct] = acc[ct][j] - mu; s2 += d[ct] * d[ct]; }
                s2 += __shfl_xor(s2, 1); s2 += __shfl_xor(s2, 2); s2 += __shfl_xor(s2, 4); s2 += __shfl_xor(s2, 8);
                const float rs = rsqrtf(s2 * (1.f / 64.f) + (mixer == 0 ? 1e-5f : 1e-6f));
                const int ii = 16 * (2 * half + rt) + 4 * q + j;
#pragma unroll
                for (int ct = 0; ct < 4; ++ct) { LAS bf16_t* gp = GT + ii * GP + h * 64 + 16 * ct + r;
                    const float y = d[ct] * rs * wv[ct] * silu_acc(bf2f(*gp));
                    *gp = on ? f2bf(y) : (bf16_t)0; }
            }
        }
        __syncthreads();
#pragma unroll
        for (int n = 0; n < 4; ++n) { const int idx = tid + 512 * n; *(u32x4*)(mix + (row0 + (idx >> 5)) * D + moff + (idx & 31) * 8) = *(const LAS u32x4*)(GT + (idx >> 5) * GP + (idx & 31) * 8); }
        __syncthreads();
    }
}

constexpr int PREP_FIRST = (D / 64) * (NINP / 32), PREP_ALL = DEPTH * ((D / 64) * (NINP / 32) + (D / 64) * (D / 32) + 2 * (D / 64) * (DFF / 32) + (DFF / 64) * (D / 32));
__global__ void __launch_bounds__(512, 2) fwd_kernel(Ctx X) {
    extern __shared__ __attribute__((aligned(16))) unsigned char lds_raw[];
    LAS unsigned char* lds = (LAS unsigned char*)lds_raw;
    cg::grid_group grid = cg::this_grid();
    const int tid = threadIdx.x, lane = tid & 63, wave = __builtin_amdgcn_readfirstlane(tid >> 6);
    const int G = gridDim.x, gw = blockIdx.x * 8 + wave, ngw = G * 8;
    bf16_t* XS = (bf16_t*)X.out;
    bf16_t* XN = WSP(bf16_t, WS_XN); bf16_t* PROJ = WSP(bf16_t, WS_PROJ); bf16_t* ACT = WSP(bf16_t, WS_PROJ); bf16_t* MIX = WSP(bf16_t, WS_MIX);

    if (X.ws == nullptr) grid.sync();
    if (tid < 4) ((LAS unsigned*)(lds + LDS_BAR_OFF))[tid] = 0u;
    __syncthreads();
    const XcdBarrier bar = xcd_barrier_post(WSP(unsigned, WS_CTL), (volatile LAS unsigned*)(lds + LDS_BAR_OFF));
#define GSYNC() xcd_barrier(bar)
    prep_weights(X, lds, gw, ngw, wave, lane, 0, PREP_FIRST);
    for (int idx = blockIdx.x * 512 + tid; idx < DEPTH * 16 * D; idx += G * 512) { const int ll = idx >> 14, n = (idx >> 10) & 15, k = idx & 1023;
        WSP(bf16_t, WS_WBA)[idx] = n < 8 ? f2bf(X.in[2][((size_t)ll * D + k) * DIN + 2560 + n] * X.in[1][ll * D + k]) : (bf16_t)0; }
    cast_phase(X.in[0], XS, WSP(float, WS_RSA), gw, ngw, lane);
    GSYNC();
#pragma unroll 1
    for (int l = 0; l < DEPTH; ++l) {
        {
            pg8::Gemm g{XS, WSP(const bf16_t, WS_WIN) + (size_t)l * NINP * D, M, NINP, D}; pg8::StaticOrder S; S.init(M, NINP, G, (int)blockIdx.x);
            pg8::EpiProj E{PROJ, LDP, DIN, WSP(const float, WS_RSA)};
            pg8::gemm_phase<pg8::EpiProj, pg8::StaticOrder, true, true>(lds, g, S, E);
            int ln = lane; asm volatile("" : "+v"(ln));
            const int r = ln & 15, q = ln >> 4;
            for (int rb = blockIdx.x; rb < M / 128; rb += G) {
                const bf16_t* Ap = XS + (size_t)(rb * 128 + wave * 16 + r) * D + q * 8;
                const bf16_t* Bp = WSP(const bf16_t, WS_WBA) + (size_t)l * 16 * D + r * D + q * 8;
                f32x4 acc = (f32x4){0.f, 0.f, 0.f, 0.f};
#pragma unroll 8
                for (int ks = 0; ks < 32; ++ks) acc = __builtin_amdgcn_mfma_f32_16x16x32_bf16(*(const bf16x8*)(Ap + ks * 32), *(const bf16x8*)(Bp + ks * 32), acc, 0, 0, 0);
                if (r < 8) {
#pragma unroll
                    for (int j = 0; j < 4; ++j) { const int row = rb * 128 + wave * 16 + 4 * q + j;
                        WSP(float, WS_GBA)[(size_t)row * 8 + r] = acc[j] * rsqrtf(WSP(const float, WS_RSA)[row] * (1.0f / 1024.0f) + 1e-6f); } }
            }
        }
        GSYNC();
        int tz = tid; asm volatile("" : "+v"(tz));
        for (int i = blockIdx.x * 512 + tz; i < M; i += G * 512) { WSP(float, WS_RSA)[i] = 0.f; WSP(float, WS_RSB)[i] = 0.f; }
        mixer_local_phase(X, lds, l, tid, wave, lane);
        GSYNC();
        scan_phase(X, wave, lane);
        if (l == 0 && wave != 0) prep_weights(X, lds, blockIdx.x * 7 + wave - 1, G * 7, wave, lane, PREP_FIRST, PREP_ALL);
        GSYNC();
        mixer_out_phase(X, lds, l, tid, wave, lane);
        GSYNC();
        {
            pg8::Gemm g{MIX, WSP(const bf16_t, WS_WOUT) + (size_t)l * D * D, M, D, D}; pg8::StaticOrder S; S.init(M, D, G, (int)blockIdx.x);
            pg8::EpiResid E{l == 0 ? X.in[0] : nullptr, l == 0 ? nullptr : XS, nullptr, XN, D, WSP(float, WS_RSB)};
            pg8::gemm_phase<pg8::EpiResid, pg8::StaticOrder, true, true>(lds, g, S, E);
        }
        GSYNC();
        {
            pg8::Gemm g{XN, WSP(const bf16_t, WS_WGU) + (size_t)l * NGU * D, M, NGU, D}; pg8::StaticOrder S; S.init(M, NGU, G, (int)blockIdx.x);
            pg8::EpiSwiglu E{ACT, DFF, WSP(const float, WS_RSB)};
            pg8::gemm_phase<pg8::EpiSwiglu, pg8::StaticOrder, true, true>(lds, g, S, E);
        }
        GSYNC();
        {
            pg8::Gemm g{ACT, WSP(const bf16_t, WS_WDN) + (size_t)l * D * DFF, M, D, DFF}; pg8::StaticOrder S; S.init(M, D, G, (int)blockIdx.x);
            pg8::EpiResid E{nullptr, XN, l + 1 < DEPTH ? nullptr : X.out, l + 1 < DEPTH ? XS : nullptr, D, l + 1 < DEPTH ? WSP(float, WS_RSA) : nullptr};
            pg8::gemm_phase<pg8::EpiResid, pg8::StaticOrder, true, true>(lds, g, S, E);
        }
        GSYNC();
        if (l + 1 == DEPTH) norm_phase(X.out, X.in[19], nullptr, X.out, gw, ngw, lane);
    }
}

extern "C" void kernel_launch(void* const* d_in, const int* in_sizes, int n_in, void* d_out, int out_size, void* d_ws, size_t ws_size, hipStream_t stream) {
    static int grid = 0;
    if (grid == 0) {
        if (n_in != 20 || out_size != M * D || ws_size < WS_END) { fprintf(stderr, "kernel_launch: unexpected shapes (n_in %d, out %d, ws %zu)\n", n_in, out_size, ws_size); grid = -1; return; }
        int dev = 0, cus = 0, per_cu = 0;
        hipGetDevice(&dev); hipDeviceGetAttribute(&cus, hipDeviceAttributeMultiprocessorCount, dev);
        if (hipFuncSetAttribute((const void*)fwd_kernel, hipFuncAttributeMaxDynamicSharedMemorySize, LDS_BYTES) != hipSuccess) { fprintf(stderr, "kernel_launch: hipFuncSetAttribute failed\n"); grid = -1; return; }
        if (hipOccupancyMaxActiveBlocksPerMultiprocessor(&per_cu, (const void*)fwd_kernel, 512, LDS_BYTES) != hipSuccess || per_cu < 1) { fprintf(stderr, "kernel_launch: occupancy query says %d\n", per_cu); per_cu = 1; }
        (void)hipGetLastError();
        grid = cus * (per_cu > 1 ? 1 : per_cu);
    }
    if (grid < 0) return;
    Ctx X{};
    for (int i = 0; i < 20; ++i) X.in[i] = (const float*)d_in[i];
    X.out = (float*)d_out; X.ws = (unsigned char*)d_ws;
    void* args[] = {&X};
    if (hipMemsetAsync((char*)d_ws + WS_CTL, 0, 16384, stream) != hipSuccess) { fprintf(stderr, "kernel_launch: hipMemsetAsync of the barrier words failed\n"); return; }
    hipError_t e = hipLaunchCooperativeKernel((const void*)fwd_kernel, dim3(grid), dim3(512), args, LDS_BYTES, stream);
    if (e != hipSuccess) fprintf(stderr, "cooperative launch failed: %s (grid %d)\n", hipGetErrorString(e), grid);
}
```

```cpp
#include <hip/hip_runtime.h>
#include <hip/hip_cooperative_groups.h>
#include <cstdio>
#include <cstdint>
namespace cg = cooperative_groups;

#ifndef MIX_MASK
#define MIX_MASK 15
#endif
namespace pg8 {
#define PG8_LAS __attribute__((address_space(3)))
typedef unsigned short bf16_t;
typedef short bf16x8 __attribute__((ext_vector_type(8)));
typedef float f32x4 __attribute__((ext_vector_type(4)));
typedef unsigned u32x4 __attribute__((ext_vector_type(4)));
constexpr int BM = 256, BK = 64, HALF = 128, HTB = HALF * BK * 2  , STAGE_BYTES = 8 * HTB, NXCD = 8, WGM = 8;

__host__ __device__ __forceinline__ int lds_byte(int r, int c) { const int st = (r >> 4) * 2 + (c >> 5), rr = r & 15, cc = c & 31, ob = rr * 64 + cc * 2; return st * 1024 + (ob ^ (((ob >> 9) & 1) << 5)); }
__host__ __device__ __forceinline__ void stage_rc(int b, int& R, int& C) { const int st = b / 1024, sb = b % 1024, swz = sb ^ (((sb >> 9) & 1) << 5); R = (st >> 1) * 16 + swz / 64; C = (st & 1) * 32 + (swz % 64) / 2; }
__host__ __device__ __forceinline__ int perm32(int rho) { const int n = rho >> 4, i = rho & 15; return 8 * (i >> 2) + 4 * n + (i & 3); }

struct Unit { int pm, pn; };
struct Gemm { const bf16_t* A; const bf16_t* Bt; int M, N, K; };

struct StaticOrder {
    int nM, nN, nwg, G, c;
    __host__ __device__ void init(int M, int N, int G_, int c_) { nM = M / BM; nN = N / BM; nwg = nM * nN; G = G_; c = c_; }
    __host__ __device__ bool next(int i, Unit& u) const {
        const long L = (long)i * G + c; if (L >= nwg) return false;
        int wgid = (int)L; { const int q = nwg / NXCD, r = nwg % NXCD, xcd = wgid % NXCD, off = wgid / NXCD; wgid = (xcd < r ? xcd * (q + 1) : r * (q + 1) + (xcd - r) * q) + off; }
        const int nig = WGM * nN, gid = wgid / nig, fm = gid * WGM, gsz = (nM - fm) < WGM ? (nM - fm) : WGM;
        u.pm = fm + ((wgid % nig) % gsz); u.pn = (wgid % nig) / gsz; return true;
    }
    __device__ __forceinline__ void a_ready(const Unit&) const {}
    __device__ __forceinline__ void done(const Unit&) const {}
};

__device__ __forceinline__ unsigned cvt_pk_bf16(float lo, float hi) { unsigned r; asm volatile("v_cvt_pk_bf16_f32 %0, %1, %2" : "=v"(r) : "v"(lo), "v"(hi)); return r; }
__device__ __forceinline__ float silu_f(float g) { return g * __builtin_amdgcn_rcpf(1.0f + __expf(-g)); }

struct EpiProj {
    static constexpr bool PERM = true, AFTER_DRAIN = false;
    bf16_t* O; int ldc; int ncols; const float* rowsq;
    __device__ __forceinline__ void pre(const Unit& u, int wr, int fr, float (&rsv)[8]) const {
#pragma unroll
        for (int i = 0; i < 8; ++i) rsv[i] = rowsq[u.pm * BM + wr * 64 + fr + (i >> 2) * HALF + (i & 3) * 16]; }
    __device__ __forceinline__ void operator()(const f32x4 (&acc)[2][2][4][2], const Unit& u, int wr, int wc, int fr, int fq, const float (&rsv)[8]) const {
        const int row0 = u.pm * BM + wr * 64 + fr; const int col0 = u.pn * BM + wc * 32 + 8 * fq;
#pragma unroll
        for (int ai = 0; ai < 2; ++ai)
#pragma unroll
            for (int m = 0; m < 4; ++m) { bf16_t* rowp = O + (size_t)(row0 + ai * HALF + m * 16) * ldc;
                const float rs = __builtin_amdgcn_rsqf(rsv[ai * 4 + m] * (1.0f / 1024.0f) + 1e-6f);
#pragma unroll
                for (int bj = 0; bj < 2; ++bj) { const int col = col0 + bj * HALF;
                    if (col < ncols) { const f32x4 v0 = acc[ai][bj][m][0] * rs, v1 = acc[ai][bj][m][1] * rs; u32x4 w;
                        w.x = cvt_pk_bf16(v0[0], v0[1]); w.y = cvt_pk_bf16(v0[2], v0[3]); w.z = cvt_pk_bf16(v1[0], v1[1]); w.w = cvt_pk_bf16(v1[2], v1[3]);
                        *(u32x4*)(rowp + col) = w; } } }
    }
};
struct EpiResid {
    static constexpr bool PERM = true, AFTER_DRAIN = false;
    const float* base_f; const bf16_t* base_b; float* out_f; bf16_t* out_b; int ldc; float* rowsq;
    __device__ __forceinline__ void pre(const Unit&, int, int, float (&)[8]) const {}
    __device__ __forceinline__ void operator()(const f32x4 (&acc)[2][2][4][2], const Unit& u, int wr, int wc, int fr, int fq, const float (&rsv)[8]) const {
        const int row0 = u.pm * BM + wr * 64 + fr; const int col0 = u.pn * BM + wc * 32 + 8 * fq;
#pragma unroll
        for (int ai = 0; ai < 2; ++ai)
#pragma unroll
            for (int m = 0; m < 4; ++m) { const size_t off = (size_t)(row0 + ai * HALF + m * 16) * ldc + col0; float sq = 0.f;
#pragma unroll
                for (int bj = 0; bj < 2; ++bj) { const size_t o_ = off + bj * HALF; f32x4 b0, b1;
                    if (base_b) { const u32x4 w = *(const u32x4*)(base_b + o_);
                        b0 = (f32x4){__uint_as_float(w.x << 16), __uint_as_float(w.x & 0xffff0000u), __uint_as_float(w.y << 16), __uint_as_float(w.y & 0xffff0000u)};
                        b1 = (f32x4){__uint_as_float(w.z << 16), __uint_as_float(w.z & 0xffff0000u), __uint_as_float(w.w << 16), __uint_as_float(w.w & 0xffff0000u)}; }
                    else { b0 = *(const f32x4*)(base_f + o_); b1 = *(const f32x4*)(base_f + o_ + 4); }
                    const f32x4 o0 = b0 + acc[ai][bj][m][0], o1 = b1 + acc[ai][bj][m][1];
                    if (out_f) { *(f32x4*)(out_f + o_) = o0; *(f32x4*)(out_f + o_ + 4) = o1; }
                    if (out_b) { u32x4 w; w.x = cvt_pk_bf16(o0[0], o0[1]); w.y = cvt_pk_bf16(o0[2], o0[3]); w.z = cvt_pk_bf16(o1[0], o1[1]); w.w = cvt_pk_bf16(o1[2], o1[3]); *(u32x4*)(out_b + o_) = w; }
                    sq += ((o0[0] * o0[0] + o0[1] * o0[1]) + (o0[2] * o0[2] + o0[3] * o0[3])) + ((o1[0] * o1[0] + o1[1] * o1[1]) + (o1[2] * o1[2] + o1[3] * o1[3])); }
                if (rowsq) { sq += __shfl_xor(sq, 16); sq += __shfl_xor(sq, 32); if (fq == 0) atomicAdd(rowsq + row0 + ai * HALF + m * 16, sq); } }
    }
};
struct EpiSwiglu {
    static constexpr bool PERM = true, AFTER_DRAIN = false;
    bf16_t* O; int ldc; const float* rowsq;
    __device__ __forceinline__ void pre(const Unit& u, int wr, int fr, float (&rsv)[8]) const {
#pragma unroll
        for (int i = 0; i < 8; ++i) rsv[i] = rowsq[u.pm * BM + wr * 64 + fr + (i >> 2) * HALF + (i & 3) * 16]; }
    __device__ __forceinline__ void operator()(const f32x4 (&acc)[2][2][4][2], const Unit& u, int wr, int wc, int fr, int fq, const float (&rsv)[8]) const {
        const int row0 = u.pm * BM + wr * 64 + fr; const int col0 = u.pn * HALF + wc * 32 + 8 * fq;
#pragma unroll
        for (int ai = 0; ai < 2; ++ai)
#pragma unroll
            for (int m = 0; m < 4; ++m) { bf16_t* rowp = O + (size_t)(row0 + ai * HALF + m * 16) * ldc + col0;
                const float rs = __builtin_amdgcn_rsqf(rsv[ai * 4 + m] * (1.0f / 1024.0f) + 1e-6f);
                const f32x4 g0 = acc[ai][0][m][0] * rs, g1 = acc[ai][0][m][1] * rs, u0 = acc[ai][1][m][0] * rs, u1 = acc[ai][1][m][1] * rs; u32x4 w;
                w.x = cvt_pk_bf16(silu_f(g0[0]) * u0[0], silu_f(g0[1]) * u0[1]); w.y = cvt_pk_bf16(silu_f(g0[2]) * u0[2], silu_f(g0[3]) * u0[3]);
                w.z = cvt_pk_bf16(silu_f(g1[0]) * u1[0], silu_f(g1[1]) * u1[1]); w.w = cvt_pk_bf16(silu_f(g1[2]) * u1[2], silu_f(g1[3]) * u1[3]);
                *(u32x4*)rowp = w; }
    }
};

template <class Epi, class Sched, bool ALIGN_EPI = false, bool SP2 = false>
__device__ __forceinline__ void gemm_phase(PG8_LAS unsigned char* lds, const Gemm g, const Sched& S, const Epi& E) {
    int tid_ = threadIdx.x; asm volatile("" : "+v"(tid_));
    const int tid = tid_, wid = __builtin_amdgcn_readfirstlane(tid >> 6), lane = tid & 63, wr = wid >> 2, wc = wid & 3, fr = lane & 15, fq = lane >> 4;
    const int K = g.K, nt = K / BK;
    unsigned voffA[2], voffB[2];
#pragma unroll
    for (int i = 0; i < 2; ++i) { int R, C; stage_rc(tid * 16 + i * 8192, R, C); const int Rb = Epi::PERM ? ((R & ~31) + perm32(R & 31)) : R;
        voffA[i] = (unsigned)(R * K + C) * 2u; voffB[i] = (unsigned)(Rb * K + C) * 2u; }
    const size_t kstep = (size_t)(BK * 2);
    const size_t hstep = (size_t)HALF * K * 2;
    const size_t tstep = 2 * hstep;
    const unsigned ldsw = (unsigned)wid * 1024u;
    const int aoff = lds_byte(wr * 64 + fr, fq * 8), boff = lds_byte(wc * 32 + fr, fq * 8);
#define PG8_SA(b, h) (((b) * 2 + (h)) * HTB)
#define PG8_SB(b, h) ((4 + (b) * 2 + (h)) * HTB)
#define PG8_STAGE(bufoff, gbase, voff) do { _Pragma("unroll") for (int _i = 0; _i < 2; ++_i) \
        __builtin_amdgcn_global_load_lds((const unsigned*)((const char*)(gbase) + (voff)[_i]), (PG8_LAS unsigned*)(lds + (bufoff) + ldsw + _i * 8192), 16, 0, 0); } while (0)
#define PG8_LDA(dst, b, h) do { _Pragma("unroll") for (int m = 0; m < 4; ++m) _Pragma("unroll") for (int k = 0; k < 2; ++k) dst[m][k] = *(const PG8_LAS bf16x8*)(lds + PG8_SA(b, h) + aoff + m * 2048 + k * 1024); } while (0)
#define PG8_LDB(dst, b, h) do { _Pragma("unroll") for (int n = 0; n < 2; ++n) _Pragma("unroll") for (int k = 0; k < 2; ++k) dst[n][k] = *(const PG8_LAS bf16x8*)(lds + PG8_SB(b, h) + boff + n * 2048 + k * 1024); } while (0)
#define PG8_MMA(ai, bj, At, Bt) do { __builtin_amdgcn_s_setprio(1); _Pragma("unroll") for (int m = 0; m < 4; ++m) _Pragma("unroll") for (int n = 0; n < 2; ++n) _Pragma("unroll") for (int k = 0; k < 2; ++k) \
        acc[ai][bj][m][n] = __builtin_amdgcn_mfma_f32_16x16x32_bf16(Bt[n][k], At[m][k], acc[ai][bj][m][n], 0, 0, 0); __builtin_amdgcn_s_setprio(0); } while (0)
#define PG8_WAIT_V(n) asm volatile("s_waitcnt vmcnt(" #n ")" ::: "memory")
#define PG8_WAIT_L(n) asm volatile("s_waitcnt lgkmcnt(" #n ")" ::: "memory")
#define PG8_BAR __builtin_amdgcn_s_barrier()
#define PG8_SCHED __builtin_amdgcn_sched_barrier(0)
    Unit cur, nxt; int ui = 0;
    float rsv[8];
    if (!S.next(0, cur)) return;
    f32x4 acc[2][2][4][2];
#pragma unroll
    for (int a = 0; a < 2; ++a)
#pragma unroll
        for (int b = 0; b < 2; ++b)
#pragma unroll
            for (int m = 0; m < 4; ++m)
#pragma unroll
                for (int n = 0; n < 2; ++n) acc[a][b][m][n] = (f32x4){0.f, 0.f, 0.f, 0.f};
    bf16x8 At[4][2], B0[2][2], B1[2][2];
    const char* cA = (const char*)g.A + (size_t)cur.pm * tstep; const char* cB = (const char*)g.Bt + (size_t)cur.pn * tstep;
    S.a_ready(cur);
    if constexpr (SP2) {
        PG8_STAGE(PG8_SB(0, 0), cB, voffB); PG8_STAGE(PG8_SB(0, 1), cB + hstep, voffB); PG8_STAGE(PG8_SA(0, 0), cA, voffA); PG8_STAGE(PG8_SA(0, 1), cA + hstep, voffA);
        if (wr == 1) PG8_BAR;
        PG8_WAIT_V(2); PG8_BAR;
        PG8_STAGE(PG8_SB(1, 0), cB + kstep, voffB); PG8_STAGE(PG8_SA(1, 0), cA + kstep, voffA); PG8_STAGE(PG8_SB(1, 1), cB + hstep + kstep, voffB);
        PG8_WAIT_V(6); PG8_BAR;
    } else {
        PG8_STAGE(PG8_SB(0, 0), cB, voffB); PG8_STAGE(PG8_SA(0, 0), cA, voffA); PG8_STAGE(PG8_SB(0, 1), cB + hstep, voffB); PG8_STAGE(PG8_SA(0, 1), cA + hstep, voffA);
        if (wr == 1) PG8_BAR;
        PG8_WAIT_V(4); PG8_BAR;
        PG8_STAGE(PG8_SB(1, 0), cB + kstep, voffB); PG8_STAGE(PG8_SA(1, 0), cA + kstep, voffA); PG8_STAGE(PG8_SB(1, 1), cB + hstep + kstep, voffB);
        PG8_WAIT_V(6); PG8_BAR;
    }
    for (;;) {
        const bool has_next = S.next(ui + 1, nxt);
        const char* nA = has_next ? (const char*)g.A + (size_t)nxt.pm * tstep : cA; const char* nB = has_next ? (const char*)g.Bt + (size_t)nxt.pn * tstep : cB;
        for (int t = 0; t < nt; t += 2) {
            const bool last = (t == nt - 2);
            const char* a1 = cA + (size_t)(t + 1) * kstep;
            const char* a2 = last ? nA : cA + (size_t)(t + 2) * kstep; const char* b2 = last ? nB : cB + (size_t)(t + 2) * kstep;
            const char* a3 = a2 + kstep; const char* b3 = b2 + kstep;
            if (last && has_next) S.a_ready(nxt);
            if (last) E.pre(cur, wr, fr, rsv);
            if constexpr (SP2) {
            PG8_LDB(B0, 0, 0); PG8_LDB(B1, 0, 1); PG8_SCHED; PG8_LDA(At, 0, 0); PG8_STAGE(PG8_SA(1, 1), a1 + hstep, voffA);
            PG8_WAIT_V(8); PG8_WAIT_L(0); PG8_BAR; PG8_MMA(0, 0, At, B0); PG8_MMA(0, 1, At, B1); PG8_BAR; PG8_SCHED;
            PG8_LDA(At, 0, 1); PG8_STAGE(PG8_SB(0, 0), b2, voffB); PG8_STAGE(PG8_SB(0, 1), b2 + hstep, voffB); PG8_STAGE(PG8_SA(0, 0), a2, voffA);
            PG8_WAIT_V(8); PG8_WAIT_L(0); PG8_BAR; PG8_MMA(1, 0, At, B0); PG8_MMA(1, 1, At, B1); PG8_BAR; PG8_SCHED;
            PG8_LDB(B0, 1, 0); PG8_LDB(B1, 1, 1); PG8_SCHED; PG8_LDA(At, 1, 0); PG8_STAGE(PG8_SA(0, 1), a2 + hstep, voffA);
            PG8_WAIT_V(8); PG8_WAIT_L(0); PG8_BAR; PG8_MMA(0, 0, At, B0); PG8_MMA(0, 1, At, B1); PG8_BAR; PG8_SCHED;
            PG8_LDA(At, 1, 1); PG8_STAGE(PG8_SB(1, 0), b3, voffB); PG8_STAGE(PG8_SB(1, 1), b3 + hstep, voffB); PG8_STAGE(PG8_SA(1, 0), a3, voffA);
            PG8_WAIT_V(8); PG8_WAIT_L(0); PG8_BAR; PG8_MMA(1, 0, At, B0); PG8_MMA(1, 1, At, B1); PG8_BAR; PG8_SCHED;
            } else {
            PG8_LDB(B0, 0, 0); PG8_SCHED; PG8_LDA(At, 0, 0); PG8_STAGE(PG8_SA(1, 1), a1 + hstep, voffA);
            PG8_WAIT_L(8); PG8_BAR; PG8_WAIT_L(0); PG8_MMA(0, 0, At, B0); PG8_BAR; PG8_SCHED;
            PG8_LDB(B1, 0, 1); PG8_STAGE(PG8_SB(0, 0), b2, voffB);
            PG8_BAR; PG8_WAIT_L(0); PG8_MMA(0, 1, At, B1); PG8_BAR;
            PG8_LDA(At, 0, 1); PG8_STAGE(PG8_SA(0, 0), a2, voffA);
            PG8_BAR; PG8_WAIT_L(0); PG8_MMA(1, 0, At, B0); PG8_BAR; PG8_SCHED;
            PG8_STAGE(PG8_SB(0, 1), b2 + hstep, voffB);
            PG8_WAIT_V(6); PG8_BAR; PG8_MMA(1, 1, At, B1); PG8_BAR;
            PG8_LDB(B0, 1, 0); PG8_SCHED; PG8_LDA(At, 1, 0); PG8_STAGE(PG8_SA(0, 1), a2 + hstep, voffA);
            PG8_WAIT_L(8); PG8_BAR; PG8_WAIT_L(0); PG8_MMA(0, 0, At, B0); PG8_BAR; PG8_SCHED;
            PG8_LDB(B1, 1, 1); PG8_STAGE(PG8_SB(1, 0), b3, voffB);
            PG8_BAR; PG8_WAIT_L(0); PG8_MMA(0, 1, At, B1); PG8_BAR;
            PG8_LDA(At, 1, 1); PG8_STAGE(PG8_SA(1, 0), a3, voffA);
            PG8_BAR; PG8_WAIT_L(0); PG8_MMA(1, 0, At, B0); PG8_BAR; PG8_SCHED;
            PG8_STAGE(PG8_SB(1, 1), b3 + hstep, voffB);
            PG8_WAIT_V(6); PG8_BAR; PG8_MMA(1, 1, At, B1); PG8_BAR;
            }
        }
        if constexpr (ALIGN_EPI) { if (wr == 0) PG8_BAR; }
        if constexpr (!Epi::AFTER_DRAIN) { E(acc, cur, wr, wc, fr, fq, rsv); S.done(cur); }
        if (!has_next) break;
#pragma unroll
        for (int a = 0; a < 2; ++a)
#pragma unroll
            for (int b = 0; b < 2; ++b)
#pragma unroll
                for (int m = 0; m < 4; ++m)
#pragma unroll
                    for (int n = 0; n < 2; ++n) acc[a][b][m][n] = (f32x4){0.f, 0.f, 0.f, 0.f};
        cur = nxt; cA = nA; cB = nB; ++ui;
        if constexpr (ALIGN_EPI) { if (wr == 1) PG8_BAR; }
    }
    PG8_WAIT_V(0);
    if constexpr (!ALIGN_EPI) { if (wr == 0) PG8_BAR; }
    PG8_BAR;
    if constexpr (Epi::AFTER_DRAIN) { E.fused(acc, cur, wr, wc, fr, fq, lds, wid, lane); S.done(cur); }
#undef PG8_SA
#undef PG8_SB
#undef PG8_STAGE
#undef PG8_LDA
#undef PG8_LDB
#undef PG8_MMA
#undef PG8_WAIT_V
#undef PG8_WAIT_L
#undef PG8_BAR
#undef PG8_SCHED
}
}

constexpr int NB = 4, T = 8192, D = 1024, DIN = 3592, NINP = 3584, DFF = 2816, NGU = 2 * DFF, DEPTH = 2;
constexpr int M = NB * T;
constexpr int NCH = T / 64;
constexpr int LDP = NINP;
constexpr int C_RQ = 0, C_RK = 256, C_RV = 512, C_RG = 768, C_CA = 1024, C_CG = 1280, C_GQ = 1536, C_GK = 1792, C_GV = 2048, C_GG = 2304,
              C_HQ = 2560, C_HF = 2816, C_HI = 3072, C_HG = 3328;
constexpr size_t MiB = 1u << 20;
constexpr size_t WS_CTL = 0;
constexpr size_t WS_WIN = 1 * MiB;
constexpr size_t WS_WOUT = 16 * MiB;
constexpr size_t WS_WGU = 20 * MiB;
constexpr size_t WS_WDN = 42 * MiB;
constexpr size_t WS_XN = 53 * MiB;
constexpr size_t WS_BCS = WS_XN;
constexpr size_t WS_MM = WS_XN + 48 * MiB;
constexpr size_t WS_MIX = 117 * MiB;
constexpr size_t WS_PROJ = 181 * MiB;
constexpr size_t WS_QEFF = 406 * MiB;
constexpr size_t WS_OLOC = 454 * MiB;
constexpr size_t WS_MVEC = 502 * MiB;
constexpr size_t WS_RSA = 503 * MiB;
constexpr size_t WS_RSB = 503 * MiB + 131072;
constexpr size_t WS_GBA = 503 * MiB + 262144;
constexpr size_t WS_WBA = 504 * MiB + 524288;
constexpr size_t WS_END = 505 * MiB;
constexpr int LDS_BYTES = 147456 + 256;
constexpr int LDS_BAR_OFF = 147456;
constexpr int HEAD_LDS = 73728;

#define LAS __attribute__((address_space(3)))
typedef unsigned short bf16_t;
typedef short bf16x8 __attribute__((ext_vector_type(8)));
typedef float f32x4 __attribute__((ext_vector_type(4)));
typedef unsigned u32x4 __attribute__((ext_vector_type(4)));
typedef unsigned u32x2 __attribute__((ext_vector_type(2)));
constexpr int LT = 72;
template <class Tp> __device__ __forceinline__ LAS Tp* opq(LAS Tp* p) { asm volatile("" : "+v"(p)); return p; }

__device__ __forceinline__ float bf_lo(unsigned u) { return __uint_as_float(u << 16); }
__device__ __forceinline__ float bf_hi(unsigned u) { return __uint_as_float(u & 0xffff0000u); }
__device__ __forceinline__ float bf2f(bf16_t b) { return __uint_as_float((unsigned)b << 16); }
__device__ __forceinline__ unsigned pk2(float lo, float hi) { return pg8::cvt_pk_bf16(lo, hi); }
__device__ __forceinline__ bf16_t f2bf(float f) { return (bf16_t)(pk2(f, 0.f) & 0xffffu); }
__device__ __forceinline__ float fexp(float x) { return __expf(x); }
__device__ __forceinline__ float frcp(float x) { return __builtin_amdgcn_rcpf(x); }
__device__ __forceinline__ float sigmoid_f(float x) { return frcp(1.0f + fexp(-x)); }
__device__ __forceinline__ float silu_acc(float x) { return x * frcp(1.0f + fexp(-x)); }
__device__ __forceinline__ float softplus_f(float x) { return fmaxf(x, 0.f) + log1pf(expf(-fabsf(x))); }
__device__ __forceinline__ float wave_sum(float v) {
#pragma unroll
    for (int o = 1; o < 64; o <<= 1) v += __shfl_xor(v, o);
    return v;
}
__device__ __forceinline__ void unpack8(const u32x4 w, float (&f)[8]) {
    f[0] = bf_lo(w.x); f[1] = bf_hi(w.x); f[2] = bf_lo(w.y); f[3] = bf_hi(w.y); f[4] = bf_lo(w.z); f[5] = bf_hi(w.z); f[6] = bf_lo(w.w); f[7] = bf_hi(w.w);
}
__device__ __forceinline__ u32x4 pack8(const float (&f)[8]) { u32x4 w; w.x = pk2(f[0], f[1]); w.y = pk2(f[2], f[3]); w.z = pk2(f[4], f[5]); w.w = pk2(f[6], f[7]); return w; }

struct Ctx {
    const float* in[20]; float* out; unsigned char* ws;
};
#define WSP(T_, off) ((T_*)(X.ws + (off)))

__device__ __forceinline__ f32x4 mma16(const LAS bf16_t* A, int a0, const LAS bf16_t* B, int b0, f32x4 acc, int r, int q) {
#pragma unroll
    for (int ks = 0; ks < 2; ++ks) {
        const bf16x8 a = *(const LAS bf16x8*)(A + (a0 + r) * LT + ks * 32 + q * 8);
        const bf16x8 b = *(const LAS bf16x8*)(B + (b0 + r) * LT + ks * 32 + q * 8);
        acc = __builtin_amdgcn_mfma_f32_16x16x32_bf16(a, b, acc, 0, 0, 0);
    }
    return acc;
}
__device__ __forceinline__ void store_oloc(bf16_t* oloc, int uid, int w4, int lane, const f32x4 (&acc)[4]) {
    u32x4* p = (u32x4*)(oloc + ((size_t)uid * 4 + w4) * 1024 + lane * 16);
    u32x4 a, b;
    a.x = pk2(acc[0][0], acc[0][1]); a.y = pk2(acc[0][2], acc[0][3]); a.z = pk2(acc[1][0], acc[1][1]); a.w = pk2(acc[1][2], acc[1][3]);
    b.x = pk2(acc[2][0], acc[2][1]); b.y = pk2(acc[2][2], acc[2][3]); b.z = pk2(acc[3][0], acc[3][1]); b.w = pk2(acc[3][2], acc[3][3]);
    p[0] = a; p[1] = b;
}
__device__ __forceinline__ void store_bc(bf16_t* bcs, int uid, int w4, int r, int q, const f32x4 (&acc)[4]) {
#pragma unroll
    for (int ct = 0; ct < 4; ++ct) { u32x2 w; w.x = pk2(acc[ct][0], acc[ct][1]); w.y = pk2(acc[ct][2], acc[ct][3]);
        *(u32x2*)(bcs + (size_t)uid * 4096 + ((ct * 4 + w4) * 64 + q * 16 + r) * 4) = w; }
}


typedef __attribute__((address_space(1))) unsigned gu32;
#define XB_TMO      128
#define XB_XCNT(j)  (256  + 64 * (j))
#define XB_XSUB(j)  (1280 + 64 * (j))
#define XB_XGEN(j)  (2304 + 64 * (j))
#define XB_TOP      3328
#define XB_TOPGEN   3392
#define XCD_BAR_WORDS 3456
#define XB_SPIN_CAP (1u << 18)

__device__ __forceinline__ unsigned xb_ld(unsigned* p)              { return __hip_atomic_load(p, __ATOMIC_RELAXED, __HIP_MEMORY_SCOPE_AGENT); }
__device__ __forceinline__ unsigned xb_add(unsigned* p, unsigned v) { return __hip_atomic_fetch_add(p, v, __ATOMIC_RELAXED, __HIP_MEMORY_SCOPE_AGENT); }
__device__ __forceinline__ unsigned xb_xcc_id() { return (unsigned)__builtin_amdgcn_s_getreg((3 << 11) | 20) & 0xFu; }
#define XB_SPIN(cond, bar) do { unsigned _sp = 0; while (cond) { __builtin_amdgcn_s_sleep(1); \
    if ((++_sp & 255u) == 0u) { if (xb_ld(&(bar)[XB_TMO])) break; if (_sp > XB_SPIN_CAP) { atomicAdd(&(bar)[XB_TMO], 1u); break; } } } } while (0)

struct XcdBarrier {
    unsigned* bar; unsigned x;
    volatile LAS unsigned* st;
};

__device__ __forceinline__ XcdBarrier xcd_barrier_post(unsigned* bar, volatile LAS unsigned* st) {
    XcdBarrier b; b.bar = bar; b.x = xb_xcc_id(); b.st = st;
    if (threadIdx.x == 0) (void)xb_add(&bar[XB_XCNT(b.x)], 1u);
    return b;
}
__device__ __forceinline__ void xcd_barrier_complete(unsigned* bar, unsigned x, unsigned& nloc, unsigned& nx) {
    const unsigned G = gridDim.x * gridDim.y * gridDim.z;
    unsigned sum, cnt, mine, sp = 0u;
    for (;;) {
        sum = 0u; cnt = 0u; mine = 0u;
#pragma unroll
        for (unsigned j = 0; j < 16; ++j) { const unsigned c = xb_ld(&bar[XB_XCNT(j)]); sum += c; cnt += (c > 0u) ? 1u : 0u; mine = (j == x) ? c : mine; }
        if (sum == G) break;
        __builtin_amdgcn_s_sleep(1);
        if ((++sp & 255u) == 0u) { if (xb_ld(&bar[XB_TMO])) break; if (sp > XB_SPIN_CAP) { atomicAdd(&bar[XB_TMO], 1u); break; } }
    }
    nloc = mine > 0u ? mine : 1u; nx = cnt > 0u ? cnt : 1u;
}

__device__ __forceinline__ void xcd_barrier(const XcdBarrier& b) {
    asm volatile("s_waitcnt vmcnt(0)" ::: "memory");
    __syncthreads();
    if (threadIdx.x == 0) {
        unsigned* bar = b.bar;
        __builtin_amdgcn_s_waitcnt(0);
        unsigned nloc = b.st[0], nx = b.st[1];
        if (nloc == 0u) { xcd_barrier_complete(bar, b.x, nloc, nx); b.st[0] = nloc; b.st[1] = nx; }
        const unsigned old = xb_add(&bar[XB_XSUB(b.x)], 1u);
        const unsigned gen = old / nloc;
        if (old + 1u == (gen + 1u) * nloc) {
            __builtin_amdgcn_fence(__ATOMIC_RELEASE, "agent");
            asm volatile("s_waitcnt vmcnt(0)" ::: "memory");
            const unsigned og = xb_add(&bar[XB_TOP], 1u);
            const unsigned tg = og / nx;
            if (og + 1u == (tg + 1u) * nx) xb_add(&bar[XB_TOPGEN], 1u);
            else XB_SPIN(xb_ld(&bar[XB_TOPGEN]) == tg, bar);
            __builtin_amdgcn_fence(__ATOMIC_ACQUIRE, "agent");
            xb_add(&bar[XB_XGEN(b.x)], 1u);
            asm volatile("s_waitcnt vmcnt(0)" ::: "memory");
        } else {
            XB_SPIN(xb_ld(&bar[XB_XGEN(b.x)]) == gen, bar);
            __builtin_amdgcn_fence(__ATOMIC_ACQUIRE, "agent");
            asm volatile("s_waitcnt vmcnt(0)" ::: "memory");
        }
    }
    __syncthreads();
}

__device__ __forceinline__ void transpose_item(const float* W, int K, int N, bf16_t* WT, int mode, LAS float* scr, int kb, int nb, int lane, const float* kscale, int coff) {
    const int k0 = 64 * kb, n0 = 32 * nb;
    const int nn = n0 + (lane & 31) + coff;
#pragma unroll 8
    for (int i = 0; i < 32; ++i) { const int kk = 2 * i + (lane >> 5); const float ksc = kscale ? kscale[k0 + kk] : 1.0f; scr[kk * 33 + (lane & 31)] = nn < N ? W[(size_t)(k0 + kk) * N + nn] * ksc : 0.f; }
    asm volatile("s_waitcnt lgkmcnt(0)" ::: "memory");
    const int c = lane & 7;
#pragma unroll
    for (int j = 0; j < 4; ++j) { const int n = (lane >> 3) + 8 * j; const LAS float* s = scr + (8 * c) * 33 + n;
        u32x4 o; o.x = pk2(s[0 * 33], s[1 * 33]); o.y = pk2(s[2 * 33], s[3 * 33]); o.z = pk2(s[4 * 33], s[5 * 33]); o.w = pk2(s[6 * 33], s[7 * 33]);
        const int ng = n0 + n; const int row = mode == 0 ? ng : ((ng >> 7) * 256 + (ng & 127) + (mode == 2 ? 128 : 0));
        *(u32x4*)(WT + (size_t)row * K + k0 + 8 * c) = o; }
    asm volatile("s_waitcnt lgkmcnt(0)" ::: "memory");
}
__device__ __forceinline__ void prep_weights(const Ctx& X, LAS unsigned char* lds, int gw, int ngw, int wave, int lane, int it_lo, int it_hi) {
    LAS float* scr = (LAS float*)(lds + wave * 16384);
    constexpr int I_IN = (D / 64) * (NINP / 32), I_OUT = (D / 64) * (D / 32), I_G = (D / 64) * (DFF / 32), I_DN = (DFF / 64) * (D / 32);
    constexpr int PER_L = I_IN + I_OUT + 2 * I_G + I_DN;
    asm volatile("" : "+v"(lane));
    for (int it = it_lo + gw; it < it_hi; it += ngw) {
        const int l = it / PER_L; int r = it % PER_L;
        if (r < I_IN) { transpose_item(X.in[2] + (size_t)l * D * DIN, D, DIN, WSP(bf16_t, WS_WIN) + (size_t)l * NINP * D, 0, scr, r / (NINP / 32), r % (NINP / 32), lane, X.in[1] + l * D, (r % (NINP / 32)) * 32 >= 2560 ? 8 : 0); continue; } r -= I_IN;
        if (r < I_OUT) { transpose_item(X.in[14] + (size_t)l * D * D, D, D, WSP(bf16_t, WS_WOUT) + (size_t)l * D * D, 0, scr, r / (D / 32), r % (D / 32), lane, nullptr, 0); continue; } r -= I_OUT;
        if (r < I_G) { transpose_item(X.in[16] + (size_t)l * D * DFF, D, DFF, WSP(bf16_t, WS_WGU) + (size_t)l * NGU * D, 1, scr, r / (DFF / 32), r % (DFF / 32), lane, X.in[15] + l * D, 0); continue; } r -= I_G;
        if (r < I_G) { transpose_item(X.in[17] + (size_t)l * D * DFF, D, DFF, WSP(bf16_t, WS_WGU) + (size_t)l * NGU * D, 2, scr, r / (DFF / 32), r % (DFF / 32), lane, X.in[15] + l * D, 0); continue; } r -= I_G;
        transpose_item(X.in[18] + (size_t)l * DFF * D, DFF, D, WSP(bf16_t, WS_WDN) + (size_t)l * D * DFF, 0, scr, r / (D / 32), r % (D / 32), lane, nullptr, 0);
    }
}
__device__ __forceinline__ void rms_row(const float* xrow, const float* w, bf16_t* orow, float* of, int lane) {
    const f32x4* xr = (const f32x4*)xrow + lane; const f32x4* wr = (const f32x4*)w + lane;
    f32x4 v[4]; float s = 0.f;
#pragma unroll
    for (int j = 0; j < 4; ++j) { v[j] = xr[64 * j]; s += (v[j].x * v[j].x + v[j].y * v[j].y) + (v[j].z * v[j].z + v[j].w * v[j].w); }
    const float rstd = 1.0f / sqrtf(wave_sum(s) * (1.f / D) + 1e-6f);
#pragma unroll
    for (int j = 0; j < 4; ++j) { const f32x4 ww = wr[64 * j]; const f32x4 o = v[j] * rstd * ww;
        if (of) ((f32x4*)of + lane)[64 * j] = o;
        else { u32x2 p; p.x = pk2(o.x, o.y); p.y = pk2(o.z, o.w); ((u32x2*)orow + lane)[64 * j] = p; } }
}
__device__ __forceinline__ void cast_phase(const float* x, bf16_t* xb, float* rowsq, int gw, int ngw, int lane) {
    asm volatile("" : "+v"(lane));
    for (int m = gw; m < M; m += ngw) {
        const f32x4* xr = (const f32x4*)(x + (size_t)m * D) + lane; float s = 0.f;
#pragma unroll
        for (int j = 0; j < 4; ++j) { const f32x4 v = xr[64 * j]; s += (v.x * v.x + v.y * v.y) + (v.z * v.z + v.w * v.w); u32x2 p; p.x = pk2(v.x, v.y); p.y = pk2(v.z, v.w); ((u32x2*)(xb + (size_t)m * D) + lane)[64 * j] = p; }
        s = wave_sum(s); if (lane == 0) rowsq[m] = s;
    }
}
__device__ __forceinline__ void norm_phase(const float* x, const float* w, bf16_t* xn, float* of, int gw, int ngw, int lane) {
    asm volatile("" : "+v"(lane));
    for (int m = gw; m < M; m += ngw) rms_row(x + (size_t)m * D, w, xn ? xn + (size_t)m * D : nullptr, of ? of + (size_t)m * D : nullptr, lane);
}

__device__ __forceinline__ int unit_id(int mixer, int b, int h, int c) { return ((mixer * 4 + b) * 4 + h) * NCH + c; }

__device__ __forceinline__ void ret_unit(const Ctx& X, LAS unsigned char* hl, int b, int c, int h, int tid_h, int w4, int lane) {
    LAS bf16_t* QR = opq((LAS bf16_t*)hl); LAS bf16_t* KR = opq(QR + 64 * LT); LAS bf16_t* KDT = opq(KR + 64 * LT); LAS bf16_t* VT = opq(KDT + 64 * LT); LAS bf16_t* P = opq(VT + 64 * LT);
    const bf16_t* proj = WSP(const bf16_t, WS_PROJ);
    const int uid = unit_id(0, b, h, c);
    const int r = lane & 15, q = lane >> 4;
    const float lg = log1pf(-exp2f(-5.0f - (float)h));
    {
        const int i = tid_h >> 2, sg = tid_h & 3, d0 = sg * 8;
        const bf16_t* pr = proj + ((size_t)b * T + c * 64 + i) * LDP;
        const u32x4 q1 = *(const u32x4*)(pr + C_RQ + h * 64 + d0), q2 = *(const u32x4*)(pr + C_RQ + h * 64 + d0 + 32);
        const u32x4 k1 = *(const u32x4*)(pr + C_RK + h * 64 + d0), k2 = *(const u32x4*)(pr + C_RK + h * 64 + d0 + 32);
        const u32x4 v1 = *(const u32x4*)(pr + C_RV + h * 64 + sg * 16), v2 = *(const u32x4*)(pr + C_RV + h * 64 + sg * 16 + 8);
        float qa[8], qb[8], ka[8], kb[8], va[8], vb[8];
        unpack8(q1, qa); unpack8(q2, qb); unpack8(k1, ka); unpack8(k2, kb); unpack8(v1, va); unpack8(v2, vb);
        const float pos = (float)(c * 64 + i);
        const float qd = fexp(lg * (float)(i + 1)), kd = fexp(lg * (float)(63 - i));
        float qr1[8], qr2[8], kr1[8], kr2[8], qe1[8], qe2[8];
#pragma unroll
        for (int e = 0; e < 8; ++e) {
            const float inv = exp2f(-(float)(d0 + e) * (13.287712379549449f / 32.0f));
            const float rev = __builtin_amdgcn_fractf(pos * inv * 0.15915494309189535f); const float sn = __builtin_amdgcn_sinf(rev), cs = __builtin_amdgcn_cosf(rev);
            qr1[e] = qa[e] * cs - qb[e] * sn; qr2[e] = qa[e] * sn + qb[e] * cs;
            kr1[e] = (ka[e] * cs - kb[e] * sn) * 0.125f; kr2[e] = (ka[e] * sn + kb[e] * cs) * 0.125f;
            qe1[e] = qr1[e] * qd; qe2[e] = qr2[e] * qd;
            KDT[(d0 + e) * LT + i] = f2bf(kr1[e] * kd); KDT[(d0 + 32 + e) * LT + i] = f2bf(kr2[e] * kd);
            VT[(sg * 16 + e) * LT + i] = f2bf(va[e]); VT[(sg * 16 + 8 + e) * LT + i] = f2bf(vb[e]);
        }
        *(LAS u32x4*)(QR + i * LT + d0) = pack8(qr1); *(LAS u32x4*)(QR + i * LT + d0 + 32) = pack8(qr2);
        *(LAS u32x4*)(KR + i * LT + d0) = pack8(kr1); *(LAS u32x4*)(KR + i * LT + d0 + 32) = pack8(kr2);
        bf16_t* qe = WSP(bf16_t, WS_QEFF) + (size_t)uid * 4096 + i * 64;
        *(u32x4*)(qe + d0) = pack8(qe1); *(u32x4*)(qe + d0 + 32) = pack8(qe2);
    }
    __syncthreads();
    f32x4 acc[4];
#pragma unroll
    for (int ct = 0; ct < 4; ++ct) acc[ct] = mma16(QR, 16 * w4, KR, 16 * ct, (f32x4){0.f, 0.f, 0.f, 0.f}, r, q);
#pragma unroll
    for (int ct = 0; ct < 4; ++ct)
#pragma unroll
        for (int j = 0; j < 4; ++j) { const int ii = 16 * w4 + 4 * q + j, col = 16 * ct + r;
            P[ii * LT + col] = f2bf(ii >= col ? acc[ct][j] * fexp(lg * (float)(ii - col)) : 0.f); }
    __syncthreads();
#pragma unroll
    for (int ct = 0; ct < 4; ++ct) acc[ct] = mma16(P, 16 * w4, VT, 16 * ct, (f32x4){0.f, 0.f, 0.f, 0.f}, r, q);
    store_oloc(WSP(bf16_t, WS_OLOC), uid, w4, lane, acc);
#pragma unroll
    for (int ct = 0; ct < 4; ++ct) acc[ct] = mma16(KDT, 16 * w4, VT, 16 * ct, (f32x4){0.f, 0.f, 0.f, 0.f}, r, q);
    store_bc(WSP(bf16_t, WS_BCS), uid, w4, r, q, acc);
    __syncthreads();
}

__device__ __forceinline__ void hgrn_unit(const Ctx& X, LAS unsigned char* hl, int b, int c, int h, int tid_h, int w4, int lane, int layer) {
    LAS bf16_t* QT = opq((LAS bf16_t*)hl);
    LAS float* Gt = opq((LAS float*)(hl + 9216));
    LAS bf16_t* Kt = opq((LAS bf16_t*)(hl + 25600));
    LAS bf16_t* KTI = opq((LAS bf16_t*)(hl + 34816));
    LAS bf16_t* VT = KTI; LAS bf16_t* KDT = opq(KTI + 64 * LT);
    LAS float* tot = opq((LAS float*)(hl + 57856));
    const bf16_t* proj = WSP(const bf16_t, WS_PROJ);
    const int uid = unit_id(2, b, h, c);
    const int r = lane & 15, q = lane >> 4;
    const int i = tid_h >> 2, ds = (tid_h & 3) * 16;
    const bf16_t* pr = proj + ((size_t)b * T + c * 64 + i) * LDP;
    float kk[16], qv[16], vv[16];
    {
        float ff[16];
        { float t0[8], t1[8]; unpack8(*(const u32x4*)(pr + C_HF + h * 64 + ds), t0); unpack8(*(const u32x4*)(pr + C_HF + h * 64 + ds + 8), t1);
#pragma unroll
          for (int e = 0; e < 8; ++e) { ff[e] = t0[e]; ff[8 + e] = t1[e]; } }
        { float t0[8], t1[8]; unpack8(*(const u32x4*)(pr + C_HQ + h * 64 + ds), t0); unpack8(*(const u32x4*)(pr + C_HQ + h * 64 + ds + 8), t1);
#pragma unroll
          for (int e = 0; e < 8; ++e) { qv[e] = t0[e]; qv[8 + e] = t1[e]; } }
        { float t0[8], t1[8]; unpack8(*(const u32x4*)(pr + C_HI + h * 64 + ds), t0); unpack8(*(const u32x4*)(pr + C_HI + h * 64 + ds + 8), t1);
#pragma unroll
          for (int e = 0; e < 8; ++e) { vv[e] = t0[e]; vv[8 + e] = t1[e]; } }
#pragma unroll
        for (int e = 0; e < 16; ++e) {
            const int ch = h * 64 + ds + e;
            const float lb = layer == 0 ? 0.f : sigmoid_f(X.in[12][256 + ch] - X.in[12][ch]);
            const float f = ff[e];
            const float ls = fminf(f, 0.f) - __logf(1.0f + fexp(-fabsf(f)));
            const float lf = layer == 0 ? ls : __logf(lb + (1.f - lb) * fexp(ls));
            kk[e] = (1.f - lb) * frcp(1.f + fexp(f));
            Gt[i * 64 + ds + e] = lf;
        }
    }
    __syncthreads();
    {
        const int d = tid_h & 63, seg = tid_h >> 6; float cs[16]; float run = 0.f;
#pragma unroll
        for (int jj = 0; jj < 16; ++jj) { run += Gt[(16 * seg + jj) * 64 + d]; cs[jj] = run; }
        tot[seg * 64 + d] = run;
        __syncthreads();
        float off = 0.f;
#pragma unroll
        for (int s = 0; s < 3; ++s) off += (s < seg) ? tot[s * 64 + d] : 0.f;
#pragma unroll
        for (int jj = 0; jj < 16; ++jj) Gt[(16 * seg + jj) * 64 + d] = cs[jj] + off;
    }
    __syncthreads();
    float Gi[16], G63[16];
    {
        const int I = i >> 4;
        float qt[16], qe[16];
#pragma unroll
        for (int e = 0; e < 16; ++e) { Gi[e] = Gt[i * 64 + ds + e]; G63[e] = Gt[63 * 64 + ds + e]; const float gr = Gt[(16 * I) * 64 + ds + e];
            qt[e] = qv[e] * fexp(Gi[e] - gr); qe[e] = qv[e] * fexp(Gi[e]); }
        u32x4 w0, w1;
        w0.x = pk2(qt[0], qt[1]); w0.y = pk2(qt[2], qt[3]); w0.z = pk2(qt[4], qt[5]); w0.w = pk2(qt[6], qt[7]);
        w1.x = pk2(qt[8], qt[9]); w1.y = pk2(qt[10], qt[11]); w1.z = pk2(qt[12], qt[13]); w1.w = pk2(qt[14], qt[15]);
        *(LAS u32x4*)(QT + i * LT + ds) = w0; *(LAS u32x4*)(QT + i * LT + ds + 8) = w1;
        w0.x = pk2(qe[0], qe[1]); w0.y = pk2(qe[2], qe[3]); w0.z = pk2(qe[4], qe[5]); w0.w = pk2(qe[6], qe[7]);
        w1.x = pk2(qe[8], qe[9]); w1.y = pk2(qe[10], qe[11]); w1.z = pk2(qe[12], qe[13]); w1.w = pk2(qe[14], qe[15]);
        bf16_t* qg = WSP(bf16_t, WS_QEFF) + (size_t)uid * 4096 + i * 64 + ds;
        *(u32x4*)qg = w0; *(u32x4*)(qg + 8) = w1;
        w0.x = pk2(kk[0], kk[1]); w0.y = pk2(kk[2], kk[3]); w0.z = pk2(kk[4], kk[5]); w0.w = pk2(kk[6], kk[7]);
        w1.x = pk2(kk[8], kk[9]); w1.y = pk2(kk[10], kk[11]); w1.z = pk2(kk[12], kk[13]); w1.w = pk2(kk[14], kk[15]);
        *(LAS u32x4*)(Kt + i * LT + ds) = w0; *(LAS u32x4*)(Kt + i * LT + ds + 8) = w1;
        if (i == 63) { float* mv = WSP(float, WS_MVEC) + (size_t)(uid - 2 * 2048) * 64 + ds;
#pragma unroll
            for (int e = 0; e < 16; ++e) mv[e] = fexp(G63[e]); }
    }
    __syncthreads();
    const int I = w4;
    LAS bf16_t* KI = opq(KTI + (8 * I * (I + 1)) * LT);
    {
        const int nit = 16 * (I + 1) * 8;
        for (int idx = lane; idx < nit; idx += 64) { const int j = idx >> 3, d8 = (idx & 7) * 8;
            float kf[8]; unpack8(*(const LAS u32x4*)(Kt + j * LT + d8), kf);
            float o[8];
#pragma unroll
            for (int e = 0; e < 8; ++e) o[e] = kf[e] * fexp(fminf(Gt[(16 * I) * 64 + d8 + e] - Gt[j * 64 + d8 + e], 80.f));
            *(LAS u32x4*)(KI + j * LT + d8) = pack8(o); }
    }
    __syncthreads();
    f32x4 acc[4];
    {
        bf16x8 a[2];
#pragma unroll
        for (int ks = 0; ks < 2; ++ks) a[ks] = *(const LAS bf16x8*)(QT + (16 * I + r) * LT + ks * 32 + q * 8);
#pragma unroll
        for (int ct = 0; ct < 4; ++ct) { acc[ct] = (f32x4){0.f, 0.f, 0.f, 0.f};
            if (ct <= I) {
#pragma unroll
                for (int ks = 0; ks < 2; ++ks) { const bf16x8 bb = *(const LAS bf16x8*)(KI + (16 * ct + r) * LT + ks * 32 + q * 8);
                    acc[ct] = __builtin_amdgcn_mfma_f32_16x16x32_bf16(a[ks], bb, acc[ct], 0, 0, 0); } } }
        asm volatile("s_waitcnt lgkmcnt(0)" ::: "memory");
#pragma unroll
        for (int ct = 0; ct < 4; ++ct)
#pragma unroll
            for (int j = 0; j < 4; ++j) { const int ii = 16 * I + 4 * q + j, col = 16 * ct + r;
                QT[ii * LT + col] = f2bf((ct <= I && ii >= col) ? acc[ct][j] : 0.f); }
    }
    __syncthreads();
    {
#pragma unroll
        for (int e = 0; e < 16; ++e) { VT[(ds + e) * LT + i] = f2bf(vv[e]); KDT[(ds + e) * LT + i] = f2bf(kk[e] * fexp(G63[e] - Gi[e])); }
    }
    __syncthreads();
#pragma unroll
    for (int ct = 0; ct < 4; ++ct) acc[ct] = mma16(QT, 16 * w4, VT, 16 * ct, (f32x4){0.f, 0.f, 0.f, 0.f}, r, q);
    store_oloc(WSP(bf16_t, WS_OLOC), uid, w4, lane, acc);
#pragma unroll
    for (int ct = 0; ct < 4; ++ct) acc[ct] = mma16(KDT, 16 * w4, VT, 16 * ct, (f32x4){0.f, 0.f, 0.f, 0.f}, r, q);
    store_bc(WSP(bf16_t, WS_BCS), uid, w4, r, q, acc);
    __syncthreads();
}

__device__ __forceinline__ void gdn_unit(const Ctx& X, LAS unsigned char* hl, int b, int c, int h, int tid_h, int w4, int lane, int layer) {
    LAS bf16_t* Q = opq((LAS bf16_t*)hl); LAS bf16_t* K = opq(Q + 64 * LT); LAS bf16_t* KB = opq(K + 64 * LT); LAS bf16_t* V = opq(KB + 64 * LT); LAS bf16_t* KDT = opq(V + 64 * LT); LAS bf16_t* P = opq(KDT + 64 * LT);
    LAS bf16_t* WT = KB; LAS bf16_t* UT = V;
    LAS bf16_t* AB = opq((LAS bf16_t*)(hl + 55296));
    LAS float* ACCS = opq((LAS float*)(hl + 64512));
    LAS float* Gs = opq((LAS float*)(hl + 72704));
    LAS float* Bs = opq(Gs + 64);
    const bf16_t* proj = WSP(const bf16_t, WS_PROJ);
    const int uid = unit_id(1, b, h, c);
    const int r = lane & 15, q = lane >> 4;
    {
    LAS bf16_t* RAW = opq((LAS bf16_t*)(hl + 46080));
    const int cseg = tid_h & 7, i0 = tid_h >> 3;
    f32x4 wq[3][4][2];
    {
        const float* cw = X.in[8] + (size_t)layer * 4 * 768 + h * 64 + cseg * 8;
#pragma unroll
        for (int tn = 0; tn < 3; ++tn)
#pragma unroll
            for (int k = 0; k < 4; ++k) { const f32x4* wp = (const f32x4*)(cw + k * 768 + tn * 256); wq[tn][k][0] = wp[0]; wq[tn][k][1] = wp[1]; }
        u32x4 rawv[7];
#pragma unroll
        for (int n = 0; n < 7; ++n) { const int item = tid_h + 256 * n; const int seg = item & 7; int rowid = item >> 3; rowid = rowid < 201 ? rowid : 200;
            const int tn = rowid / 67, rr = rowid - tn * 67; const int tt = c * 64 - 3 + rr; const int ttc = tt < 0 ? 0 : tt;
            const u32x4 v = *(const u32x4*)(proj + ((size_t)b * T + ttc) * LDP + C_GQ + tn * 256 + h * 64 + seg * 8);
            rawv[n] = tt < 0 ? (u32x4){0u, 0u, 0u, 0u} : v; }
        float g = 0.f, bt = 0.f;
        if (tid_h < 64) {
            const bf16_t* pr = proj + ((size_t)b * T + c * 64 + tid_h) * LDP;
            const float* gba = WSP(const float, WS_GBA) + ((size_t)b * T + c * 64 + tid_h) * 8; const float gb = gba[h], ga = gba[4 + h];
            g = -fexp(X.in[9][layer * 4 + h]) * softplus_f(ga + X.in[10][layer * 4 + h]);
#pragma unroll
            for (int o = 1; o < 64; o <<= 1) { const float t = __shfl_up(g, o); if (lane >= o) g += t; }
            bt = sigmoid_f(gb);
            Gs[tid_h] = g; Bs[tid_h] = bt;
        }
#pragma unroll
        for (int n = 0; n < 7; ++n) { const int item = tid_h + 256 * n; if (item < 1608) *(LAS u32x4*)(RAW + (item >> 3) * 64 + (item & 7) * 8) = rawv[n]; }
    }
    __syncthreads();
    {
        const float G63 = Gs[63];
#pragma unroll
        for (int rs = 0; rs < 2; ++rs) {
            const int i = i0 + 32 * rs;
            const float bi = Bs[i], Gi = Gs[i];
            float y[3][8];
#pragma unroll
            for (int tn = 0; tn < 3; ++tn) {
#pragma unroll
                for (int e = 0; e < 8; ++e) y[tn][e] = 0.f;
#pragma unroll
                for (int k = 0; k < 4; ++k) { float x8[8]; unpack8(*(const LAS u32x4*)(RAW + (tn * 67 + i + k) * 64 + cseg * 8), x8);
                    y[tn][0] += wq[tn][k][0].x * x8[0]; y[tn][1] += wq[tn][k][0].y * x8[1]; y[tn][2] += wq[tn][k][0].z * x8[2]; y[tn][3] += wq[tn][k][0].w * x8[3];
                    y[tn][4] += wq[tn][k][1].x * x8[4]; y[tn][5] += wq[tn][k][1].y * x8[5]; y[tn][6] += wq[tn][k][1].z * x8[6]; y[tn][7] += wq[tn][k][1].w * x8[7]; }
#pragma unroll
                for (int e = 0; e < 8; ++e) y[tn][e] = silu_acc(y[tn][e]);
            }
            float sq = 0.f, sk = 0.f;
#pragma unroll
            for (int e = 0; e < 8; ++e) { sq += y[0][e] * y[0][e]; sk += y[1][e] * y[1][e]; }
            sq += __shfl_xor(sq, 1); sq += __shfl_xor(sq, 2); sq += __shfl_xor(sq, 4);
            sk += __shfl_xor(sk, 1); sk += __shfl_xor(sk, 2); sk += __shfl_xor(sk, 4);
            const float rq = 0.125f * rsqrtf(sq + 1e-6f), rk = rsqrtf(sk + 1e-6f), kd = rk * fexp(G63 - Gi);
            float t8[8];
#pragma unroll
            for (int e = 0; e < 8; ++e) t8[e] = y[0][e] * rq;
            *(LAS u32x4*)(Q + i * LT + cseg * 8) = pack8(t8);
#pragma unroll
            for (int e = 0; e < 8; ++e) t8[e] = y[1][e] * rk;
            *(LAS u32x4*)(K + i * LT + cseg * 8) = pack8(t8);
#pragma unroll
            for (int e = 0; e < 8; ++e) t8[e] = y[1][e] * rk * bi;
            *(LAS u32x4*)(KB + i * LT + cseg * 8) = pack8(t8);
            *(LAS u32x4*)(V + i * LT + cseg * 8) = pack8(y[2]);
#pragma unroll
            for (int e = 0; e < 8; ++e) KDT[(cseg * 8 + e) * LT + i] = f2bf(y[1][e] * kd);
        }
    }
    __syncthreads();
    }
    {
        f32x4 aA[4], aP[4];
#pragma unroll
        for (int ct = 0; ct < 4; ++ct) { aA[ct] = mma16(KB, 16 * w4, K, 16 * ct, (f32x4){0.f, 0.f, 0.f, 0.f}, r, q); aP[ct] = mma16(Q, 16 * w4, K, 16 * ct, (f32x4){0.f, 0.f, 0.f, 0.f}, r, q); }
#pragma unroll
        for (int ct = 0; ct < 4; ++ct)
#pragma unroll
            for (int j = 0; j < 4; ++j) { const int ii = 16 * w4 + 4 * q + j, col = 16 * ct + r;
                const float L = fexp(fminf(Gs[ii] - Gs[col], 0.f));
                AB[ii * LT + col] = f2bf(ii > col ? aA[ct][j] * L : 0.f);
                P[ii * LT + col] = f2bf(ii >= col ? aP[ct][j] * L : 0.f); }
    }
    __syncthreads();
    float rc[64];
    if (w4 < 2) {
        const int col = tid_h & 63; const LAS bf16_t* src = w4 == 0 ? V : KB;
#pragma unroll
        for (int i = 0; i < 64; ++i) { const float sc = w4 == 0 ? Bs[i] : fexp(Gs[i]); rc[i] = bf2f(src[i * LT + col]) * sc; }
    }
    __syncthreads();
    {
    for (int idx = tid_h; idx < 1152; idx += 256) { const int tl = idx >= 576; const int rem = idx - tl * 576; *(LAS u32x4*)((tl ? KB : V) + rem * 8) = (u32x4){0u, 0u, 0u, 0u}; }
    __syncthreads();
#pragma unroll
    for (int I = 0; I < 4; ++I) {
        if (I > 0) {
#pragma unroll
            for (int t2 = 0; t2 < 2; ++t2) { const int ct8 = 2 * w4 + t2; const LAS bf16_t* Bt = ct8 < 4 ? UT : WT;
                const f32x4 a = mma16(AB, 16 * I, Bt, 16 * (ct8 & 3), (f32x4){0.f, 0.f, 0.f, 0.f}, r, q);
#pragma unroll
                for (int j = 0; j < 4; ++j) ACCS[(4 * q + j) * 128 + 16 * ct8 + r] = a[j]; }
            __syncthreads();
        }
        if (w4 < 2) {
            const int col = tid_h & 63, c128 = w4 * 64 + col;
            float t[16];
#pragma unroll
            for (int ii = 0; ii < 16; ++ii) t[ii] = rc[16 * I + ii] - (I > 0 ? ACCS[ii * 128 + c128] : 0.f);
#pragma unroll
            for (int ii = 1; ii < 16; ++ii) {
                float a16[16];
                { float lo[8]; unpack8(*(const LAS u32x4*)(AB + (16 * I + ii) * LT + 16 * I), lo);
#pragma unroll
                  for (int e = 0; e < 8; ++e) a16[e] = lo[e]; }
                if (ii > 8) { float hi[8]; unpack8(*(const LAS u32x4*)(AB + (16 * I + ii) * LT + 16 * I + 8), hi);
#pragma unroll
                  for (int e = 0; e < 8; ++e) a16[8 + e] = hi[e]; }
                float s0 = t[ii], s1 = 0.f;
#pragma unroll
                for (int kk = 0; kk < ii; ++kk) { if (kk & 1) s1 -= a16[kk] * t[kk]; else s0 -= a16[kk] * t[kk]; }
                t[ii] = s0 + s1;
            }
            LAS bf16_t* dst = (w4 == 0 ? UT : WT) + col * LT + 16 * I;
            u32x4 w0, w1;
            w0.x = pk2(t[0], t[1]); w0.y = pk2(t[2], t[3]); w0.z = pk2(t[4], t[5]); w0.w = pk2(t[6], t[7]);
            w1.x = pk2(t[8], t[9]); w1.y = pk2(t[10], t[11]); w1.z = pk2(t[12], t[13]); w1.w = pk2(t[14], t[15]);
            *(LAS u32x4*)dst = w0; *(LAS u32x4*)(dst + 8) = w1;
        }
        __syncthreads();
    }
    }
    {
        f32x4 acc[4];
        const float eG63 = fexp(Gs[63]);
#pragma unroll
        for (int ct = 0; ct < 4; ++ct) acc[ct] = mma16(P, 16 * w4, WT, 16 * ct, (f32x4){0.f, 0.f, 0.f, 0.f}, r, q);
        bf16_t* qe = WSP(bf16_t, WS_QEFF) + (size_t)uid * 4096;
#pragma unroll
        for (int ct = 0; ct < 4; ++ct)
#pragma unroll
            for (int j = 0; j < 4; ++j) { const int ii = 16 * w4 + 4 * q + j, col = 16 * ct + r;
                qe[ii * 64 + col] = f2bf(bf2f(Q[ii * LT + col]) * fexp(Gs[ii]) - acc[ct][j]); }
#pragma unroll
        for (int ct = 0; ct < 4; ++ct) acc[ct] = mma16(P, 16 * w4, UT, 16 * ct, (f32x4){0.f, 0.f, 0.f, 0.f}, r, q);
        store_oloc(WSP(bf16_t, WS_OLOC), uid, w4, lane, acc);
#pragma unroll
        for (int ct = 0; ct < 4; ++ct) acc[ct] = mma16(KDT, 16 * w4, WT, 16 * ct, (f32x4){0.f, 0.f, 0.f, 0.f}, r, q);
        bf16_t* mm = WSP(bf16_t, WS_MM) + (size_t)(uid - 2048) * 4096;
#pragma unroll
        for (int ct = 0; ct < 4; ++ct)
#pragma unroll
            for (int j = 0; j < 4; ++j) { const int ii = 16 * w4 + 4 * q + j, col = 16 * ct + r;
                mm[((w4 * 2 + (ct >> 1)) * 64 + (r >> 2) * 16 + 4 * q + j) * 8 + (ct & 1) * 4 + (r & 3)] = f2bf((ii == col ? eG63 : 0.f) - acc[ct][j]); }
#pragma unroll
        for (int ct = 0; ct < 4; ++ct) acc[ct] = mma16(KDT, 16 * w4, UT, 16 * ct, (f32x4){0.f, 0.f, 0.f, 0.f}, r, q);
        store_bc(WSP(bf16_t, WS_BCS), uid, w4, r, q, acc);
    }
    __syncthreads();
}

__device__ __forceinline__ void conf_unit(const Ctx& X, LAS unsigned char* lds, int b, int c, int tid, int wave, int lane, int layer) {
    LAS bf16_t* GL = opq((LAS bf16_t*)lds);
    LAS float* Y = opq((LAS float*)(lds + 49152));
    const bf16_t* proj = WSP(const bf16_t, WS_PROJ);
    bf16_t* mix = WSP(bf16_t, WS_MIX);
    const int t0 = c * 64;
    for (int item = tid; item < 94 * 32; item += 512) { const int rr = item >> 5, seg = (item & 31) * 8, tt = t0 - 30 + rr;
        u32x4 w = (u32x4){0u, 0u, 0u, 0u};
        if (tt >= 0) { const bf16_t* pr = proj + ((size_t)b * T + tt) * LDP; float a[8], g[8], o[8]; unpack8(*(const u32x4*)(pr + C_CA + seg), a); unpack8(*(const u32x4*)(pr + C_CG + seg), g);
#pragma unroll
            for (int e = 0; e < 8; ++e) o[e] = a[e] * sigmoid_f(g[e]);
            w = pack8(o); }
        *(LAS u32x4*)(GL + rr * 256 + seg) = w; }
    __syncthreads();
    {
        const int ch = tid & 255, half = tid >> 8;
        const float* cw = X.in[4] + (size_t)layer * 31 * 256 + ch;
        float w[31];
#pragma unroll
        for (int k = 0; k < 31; ++k) w[k] = cw[k * 256];
        const float bias = X.in[5][layer * 256 + ch];
        float acc[32];
#pragma unroll
        for (int tk = 0; tk < 32; ++tk) acc[tk] = bias;
#pragma unroll
        for (int rr = 0; rr < 62; ++rr) { const float g = bf2f(GL[(half * 32 + rr) * 256 + ch]);
#pragma unroll
            for (int tk = 0; tk < 32; ++tk) { const int k = rr - tk; if (k >= 0 && k < 31) acc[tk] += w[k] * g; } }
#pragma unroll
        for (int tk = 0; tk < 32; ++tk) Y[(half * 32 + tk) * 256 + ch] = acc[tk];
    }
    __syncthreads();
    {
        const f32x4 lw = *((const f32x4*)(X.in[6] + layer * 256) + lane), lb = *((const f32x4*)(X.in[7] + layer * 256) + lane);
#pragma unroll 2
        for (int tk = wave * 8; tk < wave * 8 + 8; ++tk) {
            const f32x4 v = *((const LAS f32x4*)(Y + tk * 256) + lane);
            const float mu = wave_sum((v.x + v.y) + (v.z + v.w)) * (1.f / 256.f);
            const f32x4 dv = v - mu;
            const float var = wave_sum((dv.x * dv.x + dv.y * dv.y) + (dv.z * dv.z + dv.w * dv.w)) * (1.f / 256.f);
            const float rs = rsqrtf(var + 1e-5f);
            f32x4 o = dv * rs * lw + lb;
            const bool on = (MIX_MASK & 2) != 0;
            u32x2 p; p.x = on ? pk2(silu_acc(o.x), silu_acc(o.y)) : 0u; p.y = on ? pk2(silu_acc(o.z), silu_acc(o.w)) : 0u;
            *(u32x2*)(mix + ((size_t)b * T + t0 + tk) * D + 256 + lane * 4) = p;
        }
    }
    __syncthreads();
}

__device__ __forceinline__ void mixer_local_phase(const Ctx& X, LAS unsigned char* lds, int layer, int tid, int wave, int lane) {
    const int hs = wave >> 2, w4 = wave & 3; int tid_h = tid & 255;
    LAS unsigned char* hl = lds + hs * HEAD_LDS;
    const int nit_ = (3584 + (int)gridDim.x - 1) / (int)gridDim.x;
    for (int it_ = 0; it_ < nit_; ++it_) {
        const int u = (int)blockIdx.x + (int)gridDim.x * ((it_ + (int)(blockIdx.x >> 3)) % nit_);
        if (u >= 3584) continue;
        asm volatile("" : "+v"(tid_h), "+v"(lane), "+v"(tid));
        if (u < 3072) { const int mixer = u >> 10, idx = u & 1023, hp = idx & 1, cb = idx >> 1, b = cb >> 7, c = cb & 127, h = hp * 2 + hs;
            if (mixer == 0) { ret_unit(X, hl, b, c, h, tid_h, w4, lane);
            } else if (mixer == 1) { gdn_unit(X, hl, b, c, h, tid_h, w4, lane, layer);
            } else { hgrn_unit(X, hl, b, c, h, tid_h, w4, lane, layer);
            }
        } else { const int cb = u - 3072; conf_unit(X, lds, cb >> 7, cb & 127, tid, wave, lane, layer);
        }
    }
}

__device__ __forceinline__ void scan_phase(const Ctx& X, int wave, int lane) {
    const int job = blockIdx.x;
    if (job >= 192 || wave != 0) return;
    asm volatile("" : "+v"(lane));
    const int mixer = job >> 6, rem = job & 63, bh = rem >> 2, vg = rem & 3;
    const int uid0 = (mixer * 16 + bh) * NCH;
    const int r = lane & 15, q = lane >> 4;
    bf16_t* bc0 = WSP(bf16_t, WS_BCS) + (size_t)uid0 * 4096 + (vg * 4 * 64 + lane) * 4;
    float S[4][4];
#pragma unroll
    for (int t = 0; t < 4; ++t)
#pragma unroll
        for (int j = 0; j < 4; ++j) S[t][j] = 0.f;
    if (mixer == 1) {
        const bf16_t* mm0 = WSP(const bf16_t, WS_MM) + (size_t)(uid0 - 2048) * 4096;
        u32x2 cb[4][4], ca[4][4][2][2];
#define SCAN_LOAD_G(slot, cc) { const int c_ = (cc) < NCH ? (cc) : NCH - 1; const bf16_t* bcn = bc0 + (size_t)c_ * 4096; const bf16_t* mmn = mm0 + (size_t)c_ * 4096; \
            _Pragma("unroll") for (int t = 0; t < 4; ++t) { cb[slot][t] = *(const u32x2*)(bcn + 256 * t); \
                _Pragma("unroll") for (int s2 = 0; s2 < 2; ++s2) { const u32x4 w_ = *(const u32x4*)(mmn + ((t * 2 + s2) * 64 + lane) * 8); ca[slot][t][s2][0] = (u32x2){w_.x, w_.y}; ca[slot][t][s2][1] = (u32x2){w_.z, w_.w}; } } }
        SCAN_LOAD_G(0, 0) SCAN_LOAD_G(1, 1) SCAN_LOAD_G(2, 2)
#pragma unroll 1
        for (int c0 = 0; c0 < NCH; c0 += 4) {
#pragma unroll
            for (int k = 0; k < 4; ++k) {
                const int c = c0 + k;
                SCAN_LOAD_G((k + 3) & 3, c + 3)
                bf16_t* bcc = bc0 + (size_t)c * 4096;
                u32x2 sp[4];
#pragma unroll
                for (int t = 0; t < 4; ++t) { sp[t].x = pk2(S[t][0], S[t][1]); sp[t].y = pk2(S[t][2], S[t][3]);
                    asm volatile("" : "+v"(sp[t].x) : "v"(cb[k][t].x));
                    *(u32x2*)(bcc + 256 * t) = sp[t]; }
                bf16x8 bfr[2];
#pragma unroll
                for (int s2 = 0; s2 < 2; ++s2) { u32x4 w; w.x = sp[2 * s2].x; w.y = sp[2 * s2].y; w.z = sp[2 * s2 + 1].x; w.w = sp[2 * s2 + 1].y; bfr[s2] = __builtin_bit_cast(bf16x8, w); }
#pragma unroll
                for (int t = 0; t < 4; ++t) {
                    f32x4 acc = (f32x4){bf_lo(cb[k][t].x), bf_hi(cb[k][t].x), bf_lo(cb[k][t].y), bf_hi(cb[k][t].y)};
#pragma unroll
                    for (int s2 = 0; s2 < 2; ++s2) { u32x4 w; w.x = ca[k][t][s2][0].x; w.y = ca[k][t][s2][0].y; w.z = ca[k][t][s2][1].x; w.w = ca[k][t][s2][1].y;
                        acc = __builtin_amdgcn_mfma_f32_16x16x32_bf16(__builtin_bit_cast(bf16x8, w), bfr[s2], acc, 0, 0, 0); }
                    S[t][0] = acc[0]; S[t][1] = acc[1]; S[t][2] = acc[2]; S[t][3] = acc[3];
                }
            }
        }
#undef SCAN_LOAD_G
    } else {
        const int h = bh & 3;
        const float g64 = __expf(64.0f * log1pf(-exp2f(-5.0f - (float)h)));
        const float* mv0 = WSP(const float, WS_MVEC) + (size_t)(mixer == 2 ? uid0 - 2 * 2048 : 0) * 64 + 4 * q;
        u32x2 cb[4][4]; f32x4 cm[4][4];
#define SCAN_LOAD_D(slot, cc) { const int c_ = (cc) < NCH ? (cc) : NCH - 1; const bf16_t* bcn = bc0 + (size_t)c_ * 4096; \
            _Pragma("unroll") for (int t = 0; t < 4; ++t) { cb[slot][t] = *(const u32x2*)(bcn + 256 * t); cm[slot][t] = mixer == 2 ? *(const f32x4*)(mv0 + (size_t)c_ * 64 + 16 * t) : (f32x4){g64, g64, g64, g64}; } }
        SCAN_LOAD_D(0, 0) SCAN_LOAD_D(1, 1) SCAN_LOAD_D(2, 2)
#pragma unroll 1
        for (int c0 = 0; c0 < NCH; c0 += 4) {
#pragma unroll
            for (int k = 0; k < 4; ++k) {
                const int c = c0 + k;
                SCAN_LOAD_D((k + 3) & 3, c + 3)
                bf16_t* bcc = bc0 + (size_t)c * 4096;
#pragma unroll
                for (int t = 0; t < 4; ++t) { u32x2 sp; sp.x = pk2(S[t][0], S[t][1]); sp.y = pk2(S[t][2], S[t][3]);
                    asm volatile("" : "+v"(sp.x) : "v"(cb[k][t].x));
                    *(u32x2*)(bcc + 256 * t) = sp;
                    S[t][0] = cm[k][t].x * S[t][0] + bf_lo(cb[k][t].x); S[t][1] = cm[k][t].y * S[t][1] + bf_hi(cb[k][t].x);
                    S[t][2] = cm[k][t].z * S[t][2] + bf_lo(cb[k][t].y); S[t][3] = cm[k][t].w * S[t][3] + bf_hi(cb[k][t].y); }
            }
        }
#undef SCAN_LOAD_D
    }
}

__device__ __forceinline__ void mixer_out_phase(const Ctx& X, LAS unsigned char* lds, int layer, int tid, int wave, int lane) {
    constexpr int GP = 264;
    const bf16_t* proj = WSP(const bf16_t, WS_PROJ);
    bf16_t* mix = WSP(bf16_t, WS_MIX);
    for (int u = blockIdx.x; u < 1536; u += gridDim.x) {
        asm volatile("" : "+v"(lane), "+v"(tid));
        LAS bf16_t* GT = opq((LAS bf16_t*)lds);
        const int r = lane & 15, q = lane >> 4, h = wave >> 1, half = wave & 1;
        const int mixer = u >> 9, rem = u & 511, b = rem >> 7, c = rem & 127;
        const int uid = unit_id(mixer, b, h, c);
        const int goff = mixer == 0 ? C_RG : (mixer == 1 ? C_GG : C_HG), moff = mixer == 0 ? 0 : (mixer == 1 ? 512 : 768);
        const size_t row0 = (size_t)b * T + c * 64;
        u32x4 gv[4];
#pragma unroll
        for (int n = 0; n < 4; ++n) { const int idx = tid + 512 * n; gv[n] = *(const u32x4*)(proj + (row0 + (idx >> 5)) * LDP + goff + (idx & 31) * 8); }
        const bf16_t* qe = WSP(const bf16_t, WS_QEFF) + (size_t)uid * 4096;
        const bf16_t* st = WSP(const bf16_t, WS_BCS) + (size_t)uid * 4096;
        bf16x8 a[2][2], bb[4][2]; u32x4 ov[2][2];
#pragma unroll
        for (int rt = 0; rt < 2; ++rt) { const int rt4 = 2 * half + rt;
#pragma unroll
            for (int ks = 0; ks < 2; ++ks) a[rt][ks] = *(const bf16x8*)(qe + (16 * rt4 + r) * 64 + ks * 32 + q * 8);
            const u32x4* ol = (const u32x4*)(WSP(const bf16_t, WS_OLOC) + ((size_t)uid * 4 + rt4) * 1024 + lane * 16); ov[rt][0] = ol[0]; ov[rt][1] = ol[1]; }
#pragma unroll
        for (int ct = 0; ct < 4; ++ct)
#pragma unroll
            for (int ks = 0; ks < 2; ++ks) { const bf16_t* tb = st + (size_t)((ct * 4 + 2 * ks + (q >> 1)) * 64) * 4;
                const u32x2 lo = *(const u32x2*)(tb + ((2 * (q & 1)) * 16 + r) * 4), hi = *(const u32x2*)(tb + ((2 * (q & 1) + 1) * 16 + r) * 4);
                bb[ct][ks] = __builtin_bit_cast(bf16x8, (u32x4){lo.x, lo.y, hi.x, hi.y}); }
        const float* nw = mixer == 0 ? X.in[3] + layer * 256 + h * 64 : (mixer == 1 ? X.in[11] + layer * 64 : X.in[13] + layer * 64);
        float wv[4];
#pragma unroll
        for (int ct = 0; ct < 4; ++ct) wv[ct] = nw[16 * ct + r];
#pragma unroll
        for (int n = 0; n < 4; ++n) { const int idx = tid + 512 * n; *(LAS u32x4*)(GT + (idx >> 5) * GP + (idx & 31) * 8) = gv[n]; }
        __syncthreads();
        const bool on = ((MIX_MASK >> (mixer == 0 ? 0 : (mixer == 1 ? 2 : 3))) & 1) != 0;
#pragma unroll
        for (int rt = 0; rt < 2; ++rt) {
            f32x4 acc[4];
            acc[0] = (f32x4){bf_lo(ov[rt][0].x), bf_hi(ov[rt][0].x), bf_lo(ov[rt][0].y), bf_hi(ov[rt][0].y)}; acc[1] = (f32x4){bf_lo(ov[rt][0].z), bf_hi(ov[rt][0].z), bf_lo(ov[rt][0].w), bf_hi(ov[rt][0].w)};
            acc[2] = (f32x4){bf_lo(ov[rt][1].x), bf_hi(ov[rt][1].x), bf_lo(ov[rt][1].y), bf_hi(ov[rt][1].y)}; acc[3] = (f32x4){bf_lo(ov[rt][1].z), bf_hi(ov[rt][1].z), bf_lo(ov[rt][1].w), bf_hi(ov[rt][1].w)};
#pragma unroll
            for (int ct = 0; ct < 4; ++ct)
#pragma unroll
                for (int ks = 0; ks < 2; ++ks) acc[ct] = __builtin_amdgcn_mfma_f32_16x16x32_bf16(a[rt][ks], bb[ct][ks], acc[ct], 0, 0, 0);
#pragma unroll
            for (int j = 0; j < 4; ++j) {
                float sm = (acc[0][j] + acc[1][j]) + (acc[2][j] + acc[3][j]);
                sm += __shfl_xor(sm, 1); sm += __shfl_xor(sm, 2); sm += __shfl_xor(sm, 4); sm += __shfl_xor(sm, 8);
                const float mu = mixer == 0 ? sm * (1.f / 64.f) : 0.f;
                float d[4], s2 = 0.f;
#pragma unroll
                for (int ct = 0; ct < 4; ++ct) { d[ct] = acc[ct][j] - mu; s2 += d[ct] * d[ct]; }
                s2 += __shfl_xor(s2, 1); s2 += __shfl_xor(s2, 2); s2 += __shfl_xor(s2, 4); s2 += __shfl_xor(s2, 8);
                const float rs = rsqrtf(s2 * (1.f / 64.f) + (mixer == 0 ? 1e-5f : 1e-6f));
                const int ii = 16 * (2 * half + rt) + 4 * q + j;
#pragma unroll
                for (int ct = 0; ct < 4; ++ct) { LAS bf16_t* gp = GT + ii * GP + h * 64 + 16 * ct + r;
                    const float y = d[ct] * rs * wv[ct] * silu_acc(bf2f(*gp));
                    *gp = on ? f2bf(y) : (bf16_t)0; }
            }
        }
        __syncthreads();
#pragma unroll
        for (int n = 0; n < 4; ++n) { const int idx = tid + 512 * n; *(u32x4*)(mix + (row0 + (idx >> 5)) * D + moff + (idx & 31) * 8) = *(const LAS u32x4*)(GT + (idx >> 5) * GP + (idx & 31) * 8); }
        __syncthreads();
    }
}

constexpr int PREP_FIRST = (D / 64) * (NINP / 32), PREP_ALL = DEPTH * ((D / 64) * (NINP / 32) + (D / 64) * (D / 32) + 2 * (D / 64) * (DFF / 32) + (DFF / 64) * (D / 32));
__global__ void __launch_bounds__(512, 2) fwd_kernel(Ctx X) {
    extern __shared__ __attribute__((aligned(16))) unsigned char lds_raw[];
    LAS unsigned char* lds = (LAS unsigned char*)lds_raw;
    cg::grid_group grid = cg::this_grid();
    const int tid = threadIdx.x, lane = tid & 63, wave = __builtin_amdgcn_readfirstlane(tid >> 6);
    const int G = gridDim.x, gw = blockIdx.x * 8 + wave, ngw = G * 8;
    bf16_t* XS = (bf16_t*)X.out;
    bf16_t* XN = WSP(bf16_t, WS_XN); bf16_t* PROJ = WSP(bf16_t, WS_PROJ); bf16_t* ACT = WSP(bf16_t, WS_PROJ); bf16_t* MIX = WSP(bf16_t, WS_MIX);

    if (X.ws == nullptr) grid.sync();
    if (tid < 4) ((LAS unsigned*)(lds + LDS_BAR_OFF))[tid] = 0u;
    __syncthreads();
    (void)xcd_barrier_post(WSP(unsigned, WS_CTL), (volatile LAS unsigned*)(lds + LDS_BAR_OFF));
#define GSYNC() do { XcdBarrier b_; b_.bar = WSP(unsigned, WS_CTL); b_.x = xb_xcc_id(); b_.st = (volatile LAS unsigned*)(lds + LDS_BAR_OFF); xcd_barrier(b_); } while (0)
    prep_weights(X, lds, gw, ngw, wave, lane, 0, PREP_FIRST);
    for (int idx = blockIdx.x * 512 + tid; idx < DEPTH * 16 * D; idx += G * 512) { const int ll = idx >> 14, n = (idx >> 10) & 15, k = idx & 1023;
        WSP(bf16_t, WS_WBA)[idx] = n < 8 ? f2bf(X.in[2][((size_t)ll * D + k) * DIN + 2560 + n] * X.in[1][ll * D + k]) : (bf16_t)0; }
    cast_phase(X.in[0], XS, WSP(float, WS_RSA), gw, ngw, lane);
    GSYNC();
#pragma unroll 1
    for (int l = 0; l < DEPTH; ++l) {
        {
            pg8::Gemm g{XS, WSP(const bf16_t, WS_WIN) + (size_t)l * NINP * D, M, NINP, D}; pg8::StaticOrder S; S.init(M, NINP, G, (int)blockIdx.x);
            pg8::EpiProj E{PROJ, LDP, DIN, WSP(const float, WS_RSA)};
            pg8::gemm_phase<pg8::EpiProj, pg8::StaticOrder, true, true>(lds, g, S, E);
            int ln = lane; asm volatile("" : "+v"(ln));
            const int r = ln & 15, q = ln >> 4;
            for (int rb = blockIdx.x; rb < M / 128; rb += G) {
                const bf16_t* Ap = XS + (size_t)(rb * 128 + wave * 16 + r) * D + q * 8;
                const bf16_t* Bp = WSP(const bf16_t, WS_WBA) + (size_t)l * 16 * D + r * D + q * 8;
                f32x4 acc = (f32x4){0.f, 0.f, 0.f, 0.f};
#pragma unroll 8
                for (int ks = 0; ks < 32; ++ks) acc = __builtin_amdgcn_mfma_f32_16x16x32_bf16(*(const bf16x8*)(Ap + ks * 32), *(const bf16x8*)(Bp + ks * 32), acc, 0, 0, 0);
                if (r < 8) {
#pragma unroll
                    for (int j = 0; j < 4; ++j) { const int row = rb * 128 + wave * 16 + 4 * q + j;
                        WSP(float, WS_GBA)[(size_t)row * 8 + r] = acc[j] * rsqrtf(WSP(const float, WS_RSA)[row] * (1.0f / 1024.0f) + 1e-6f); } }
            }
        }
        GSYNC();
        int tz = tid; asm volatile("" : "+v"(tz));
        for (int i = blockIdx.x * 512 + tz; i < M; i += G * 512) { WSP(float, WS_RSA)[i] = 0.f; WSP(float, WS_RSB)[i] = 0.f; }
        mixer_local_phase(X, lds, l, tid, wave, lane);
        GSYNC();
        scan_phase(X, wave, lane);
        if (l == 0 && wave != 0) prep_weights(X, lds, blockIdx.x * 7 + wave - 1, G * 7, wave, lane, PREP_FIRST, PREP_ALL);
        GSYNC();
        mixer_out_phase(X, lds, l, tid, wave, lane);
        GSYNC();
        {
            pg8::Gemm g{MIX, WSP(const bf16_t, WS_WOUT) + (size_t)l * D * D, M, D, D}; pg8::StaticOrder S; S.init(M, D, G, (int)blockIdx.x);
            pg8::EpiResid E{l == 0 ? X.in[0] : nullptr, l == 0 ? nullptr : XS, nullptr, XN, D, WSP(float, WS_RSB)};
            pg8::gemm_phase<pg8::EpiResid, pg8::StaticOrder, true, true>(lds, g, S, E);
        }
        GSYNC();
        {
            pg8::Gemm g{XN, WSP(const bf16_t, WS_WGU) + (size_t)l * NGU * D, M, NGU, D}; pg8::StaticOrder S; S.init(M, NGU, G, (int)blockIdx.x);
            pg8::EpiSwiglu E{ACT, DFF, WSP(const float, WS_RSB)};
            pg8::gemm_phase<pg8::EpiSwiglu, pg8::StaticOrder, true, true>(lds, g, S, E);
        }
        GSYNC();
        {
            pg8::Gemm g{ACT, WSP(const bf16_t, WS_WDN) + (size_t)l * D * DFF, M, D, DFF}; pg8::StaticOrder S; S.init(M, D, G, (int)blockIdx.x);
            pg8::EpiResid E{nullptr, XN, l + 1 < DEPTH ? nullptr : X.out, l + 1 < DEPTH ? XS : nullptr, D, l + 1 < DEPTH ? WSP(float, WS_RSA) : nullptr};
            pg8::gemm_phase<pg8::EpiResid, pg8::StaticOrder, true, true>(lds, g, S, E);
        }
        GSYNC();
        if (l + 1 == DEPTH) norm_phase(X.out, X.in[19], nullptr, X.out, gw, ngw, lane);
    }
}

extern "C" void kernel_launch(void* const* d_in, const int* in_sizes, int n_in, void* d_out, int out_size, void* d_ws, size_t ws_size, hipStream_t stream) {
    static int grid = 0;
    if (grid == 0) {
        if (n_in != 20 || out_size != M * D || ws_size < WS_END) { fprintf(stderr, "kernel_launch: unexpected shapes (n_in %d, out %d, ws %zu)\n", n_in, out_size, ws_size); grid = -1; return; }
        int dev = 0, cus = 0, per_cu = 0;
        hipGetDevice(&dev); hipDeviceGetAttribute(&cus, hipDeviceAttributeMultiprocessorCount, dev);
        if (hipFuncSetAttribute((const void*)fwd_kernel, hipFuncAttributeMaxDynamicSharedMemorySize, LDS_BYTES) != hipSuccess) { fprintf(stderr, "kernel_launch: hipFuncSetAttribute failed\n"); grid = -1; return; }
        if (hipOccupancyMaxActiveBlocksPerMultiprocessor(&per_cu, (const void*)fwd_kernel, 512, LDS_BYTES) != hipSuccess || per_cu < 1) { fprintf(stderr, "kernel_launch: occupancy query says %d\n", per_cu); per_cu = 1; }
        (void)hipGetLastError();
        grid = cus * (per_cu > 1 ? 1 : per_cu);
    }
    if (grid < 0) return;
    Ctx X{};
    for (int i = 0; i < 20; ++i) X.in[i] = (const float*)d_in[i];
    X.out = (float*)d_out; X.ws = (unsigned char*)d_ws;
    void* args[] = {&X};
    if (hipMemsetAsync((char*)d_ws + WS_CTL, 0, 16384, stream) != hipSuccess) { fprintf(stderr, "kernel_launch: hipMemsetAsync of the barrier words failed\n"); return; }
    hipError_t e = hipLaunchCooperativeKernel((const void*)fwd_kernel, dim3(grid), dim3(512), args, LDS_BYTES, stream);
    if (e != hipSuccess) fprintf(stderr, "cooperative launch failed: %s (grid %d)\n", hipGetErrorString(e), grid);
}
```

```cpp
#include <hip/hip_runtime.h>
#include <hip/hip_cooperative_groups.h>
#include <cstdio>
#include <cstdint>
namespace cg = cooperative_groups;

#ifndef MIX_MASK
#define MIX_MASK 15
#endif
namespace pg8 {
#define PG8_LAS __attribute__((address_space(3)))
typedef unsigned short bf16_t;
typedef short bf16x8 __attribute__((ext_vector_type(8)));
typedef float f32x4 __attribute__((ext_vector_type(4)));
typedef unsigned u32x4 __attribute__((ext_vector_type(4)));
constexpr int BM = 256, BK = 64, HALF = 128, HTB = HALF * BK * 2  , STAGE_BYTES = 8 * HTB, NXCD = 8, WGM = 8;

__host__ __device__ __forceinline__ int lds_byte(int r, int c) { const int st = (r >> 4) * 2 + (c >> 5), rr = r & 15, cc = c & 31, ob = rr * 64 + cc * 2; return st * 1024 + (ob ^ (((ob >> 9) & 1) << 5)); }
__host__ __device__ __forceinline__ void stage_rc(int b, int& R, int& C) { const int st = b / 1024, sb = b % 1024, swz = sb ^ (((sb >> 9) & 1) << 5); R = (st >> 1) * 16 + swz / 64; C = (st & 1) * 32 + (swz % 64) / 2; }
__host__ __device__ __forceinline__ int perm32(int rho) { const int n = rho >> 4, i = rho & 15; return 8 * (i >> 2) + 4 * n + (i & 3); }

struct Unit { int pm, pn; };
struct Gemm { const bf16_t* A; const bf16_t* Bt; int M, N, K; };

struct StaticOrder {
    int nM, nN, nwg, G, c;
    __host__ __device__ void init(int M, int N, int G_, int c_) { nM = M / BM; nN = N / BM; nwg = nM * nN; G = G_; c = c_; }
    __host__ __device__ bool next(int i, Unit& u) const {
        const long L = (long)i * G + c; if (L >= nwg) return false;
        int wgid = (int)L; { const int q = nwg / NXCD, r = nwg % NXCD, xcd = wgid % NXCD, off = wgid / NXCD; wgid = (xcd < r ? xcd * (q + 1) : r * (q + 1) + (xcd - r) * q) + off; }
        const int nig = WGM * nN, gid = wgid / nig, fm = gid * WGM, gsz = (nM - fm) < WGM ? (nM - fm) : WGM;
        u.pm = fm + ((wgid % nig) % gsz); u.pn = (wgid % nig) / gsz; return true;
    }
    __device__ __forceinline__ void a_ready(const Unit&) const {}
    __device__ __forceinline__ void done(const Unit&) const {}
};

__device__ __forceinline__ unsigned cvt_pk_bf16(float lo, float hi) { unsigned r; asm volatile("v_cvt_pk_bf16_f32 %0, %1, %2" : "=v"(r) : "v"(lo), "v"(hi)); return r; }
__device__ __forceinline__ float silu_f(float g) { return g * __builtin_amdgcn_rcpf(1.0f + __expf(-g)); }

struct EpiProj {
    static constexpr bool PERM = true, AFTER_DRAIN = false;
    bf16_t* O; int ldc; int ncols; const float* rowsq;
    __device__ __forceinline__ void pre(const Unit& u, int wr, int fr, float (&rsv)[8]) const {
#pragma unroll
        for (int i = 0; i < 8; ++i) rsv[i] = rowsq[u.pm * BM + wr * 64 + fr + (i >> 2) * HALF + (i & 3) * 16]; }
    __device__ __forceinline__ void operator()(const f32x4 (&acc)[2][2][4][2], const Unit& u, int wr, int wc, int fr, int fq, const float (&rsv)[8]) const {
        const int row0 = u.pm * BM + wr * 64 + fr; const int col0 = u.pn * BM + wc * 32 + 8 * fq;
#pragma unroll
        for (int ai = 0; ai < 2; ++ai)
#pragma unroll
            for (int m = 0; m < 4; ++m) { bf16_t* rowp = O + (size_t)(row0 + ai * HALF + m * 16) * ldc;
                const float rs = __builtin_amdgcn_rsqf(rsv[ai * 4 + m] * (1.0f / 1024.0f) + 1e-6f);
#pragma unroll
                for (int bj = 0; bj < 2; ++bj) { const int col = col0 + bj * HALF;
                    if (col < ncols) { const f32x4 v0 = acc[ai][bj][m][0] * rs, v1 = acc[ai][bj][m][1] * rs; u32x4 w;
                        w.x = cvt_pk_bf16(v0[0], v0[1]); w.y = cvt_pk_bf16(v0[2], v0[3]); w.z = cvt_pk_bf16(v1[0], v1[1]); w.w = cvt_pk_bf16(v1[2], v1[3]);
                        *(u32x4*)(rowp + col) = w; } } }
    }
};
struct EpiResid {
    static constexpr bool PERM = true, AFTER_DRAIN = false;
    const float* base_f; const bf16_t* base_b; float* out_f; bf16_t* out_b; int ldc; float* rowsq;
    __device__ __forceinline__ void pre(const Unit&, int, int, float (&)[8]) const {}
    __device__ __forceinline__ void operator()(const f32x4 (&acc)[2][2][4][2], const Unit& u, int wr, int wc, int fr, int fq, const float (&rsv)[8]) const {
        const int row0 = u.pm * BM + wr * 64 + fr; const int col0 = u.pn * BM + wc * 32 + 8 * fq;
#pragma unroll
        for (int ai = 0; ai < 2; ++ai)
#pragma unroll
            for (int m = 0; m < 4; ++m) { const size_t off = (size_t)(row0 + ai * HALF + m * 16) * ldc + col0; float sq = 0.f;
#pragma unroll
                for (int bj = 0; bj < 2; ++bj) { const size_t o_ = off + bj * HALF; f32x4 b0, b1;
                    if (base_b) { const u32x4 w = *(const u32x4*)(base_b + o_);
                        b0 = (f32x4){__uint_as_float(w.x << 16), __uint_as_float(w.x & 0xffff0000u), __uint_as_float(w.y << 16), __uint_as_float(w.y & 0xffff0000u)};
                        b1 = (f32x4){__uint_as_float(w.z << 16), __uint_as_float(w.z & 0xffff0000u), __uint_as_float(w.w << 16), __uint_as_float(w.w & 0xffff0000u)}; }
                    else { b0 = *(const f32x4*)(base_f + o_); b1 = *(const f32x4*)(base_f + o_ + 4); }
                    const f32x4 o0 = b0 + acc[ai][bj][m][0], o1 = b1 + acc[ai][bj][m][1];
                    if (out_f) { *(f32x4*)(out_f + o_) = o0; *(f32x4*)(out_f + o_ + 4) = o1; }
                    if (out_b) { u32x4 w; w.x = cvt_pk_bf16(o0[0], o0[1]); w.y = cvt_pk_bf16(o0[2], o0[3]); w.z = cvt_pk_bf16(o1[0], o1[1]); w.w = cvt_pk_bf16(o1[2], o1[3]); *(u32x4*)(out_b + o_) = w; }
                    sq += ((o0[0] * o0[0] + o0[1] * o0[1]) + (o0[2] * o0[2] + o0[3] * o0[3])) + ((o1[0] * o1[0] + o1[1] * o1[1]) + (o1[2] * o1[2] + o1[3] * o1[3])); }
                if (rowsq) { sq += __shfl_xor(sq, 16); sq += __shfl_xor(sq, 32); if (fq == 0) atomicAdd(rowsq + row0 + ai * HALF + m * 16, sq); } }
    }
};
struct EpiSwiglu {
    static constexpr bool PERM = true, AFTER_DRAIN = false;
    bf16_t* O; int ldc; const float* rowsq;
    __device__ __forceinline__ void pre(const Unit& u, int wr, int fr, float (&rsv)[8]) const {
#pragma unroll
        for (int i = 0; i < 8; ++i) rsv[i] = rowsq[u.pm * BM + wr * 64 + fr + (i >> 2) * HALF + (i & 3) * 16]; }
    __device__ __forceinline__ void operator()(const f32x4 (&acc)[2][2][4][2], const Unit& u, int wr, int wc, int fr, int fq, const float (&rsv)[8]) const {
        const int row0 = u.pm * BM + wr * 64 + fr; const int col0 = u.pn * HALF + wc * 32 + 8 * fq;
#pragma unroll
        for (int ai = 0; ai < 2; ++ai)
#pragma unroll
            for (int m = 0; m < 4; ++m) { bf16_t* rowp = O + (size_t)(row0 + ai * HALF + m * 16) * ldc + col0;
                const float rs = __builtin_amdgcn_rsqf(rsv[ai * 4 + m] * (1.0f / 1024.0f) + 1e-6f);
                const f32x4 g0 = acc[ai][0][m][0] * rs, g1 = acc[ai][0][m][1] * rs, u0 = acc[ai][1][m][0] * rs, u1 = acc[ai][1][m][1] * rs; u32x4 w;
                w.x = cvt_pk_bf16(silu_f(g0[0]) * u0[0], silu_f(g0[1]) * u0[1]); w.y = cvt_pk_bf16(silu_f(g0[2]) * u0[2], silu_f(g0[3]) * u0[3]);
                w.z = cvt_pk_bf16(silu_f(g1[0]) * u1[0], silu_f(g1[1]) * u1[1]); w.w = cvt_pk_bf16(silu_f(g1[2]) * u1[2], silu_f(g1[3]) * u1[3]);
                *(u32x4*)rowp = w; }
    }
};

template <class Epi, class Sched, bool ALIGN_EPI = false, bool SP2 = false>
__device__ __forceinline__ void gemm_phase(PG8_LAS unsigned char* lds, const Gemm g, const Sched& S, const Epi& E) {
    int tid_ = threadIdx.x; asm volatile("" : "+v"(tid_));
    const int tid = tid_, wid = __builtin_amdgcn_readfirstlane(tid >> 6), lane = tid & 63, wr = wid >> 2, wc = wid & 3, fr = lane & 15, fq = lane >> 4;
    const int K = g.K, nt = K / BK;
    unsigned voffA[2], voffB[2];
#pragma unroll
    for (int i = 0; i < 2; ++i) { int R, C; stage_rc(tid * 16 + i * 8192, R, C); const int Rb = Epi::PERM ? ((R & ~31) + perm32(R & 31)) : R;
        voffA[i] = (unsigned)(R * K + C) * 2u; voffB[i] = (unsigned)(Rb * K + C) * 2u; }
    const size_t kstep = (size_t)(BK * 2);
    const size_t hstep = (size_t)HALF * K * 2;
    const size_t tstep = 2 * hstep;
    const unsigned ldsw = (unsigned)wid * 1024u;
    const int aoff = lds_byte(wr * 64 + fr, fq * 8), boff = lds_byte(wc * 32 + fr, fq * 8);
#define PG8_SA(b, h) (((b) * 2 + (h)) * HTB)
#define PG8_SB(b, h) ((4 + (b) * 2 + (h)) * HTB)
#define PG8_STAGE(bufoff, gbase, voff) do { _Pragma("unroll") for (int _i = 0; _i < 2; ++_i) \
        __builtin_amdgcn_global_load_lds((const unsigned*)((const char*)(gbase) + (voff)[_i]), (PG8_LAS unsigned*)(lds + (bufoff) + ldsw + _i * 8192), 16, 0, 0); } while (0)
#define PG8_LDA(dst, b, h) do { _Pragma("unroll") for (int m = 0; m < 4; ++m) _Pragma("unroll") for (int k = 0; k < 2; ++k) dst[m][k] = *(const PG8_LAS bf16x8*)(lds + PG8_SA(b, h) + aoff + m * 2048 + k * 1024); } while (0)
#define PG8_LDB(dst, b, h) do { _Pragma("unroll") for (int n = 0; n < 2; ++n) _Pragma("unroll") for (int k = 0; k < 2; ++k) dst[n][k] = *(const PG8_LAS bf16x8*)(lds + PG8_SB(b, h) + boff + n * 2048 + k * 1024); } while (0)
#define PG8_MMA(ai, bj, At, Bt) do { __builtin_amdgcn_s_setprio(1); _Pragma("unroll") for (int m = 0; m < 4; ++m) _Pragma("unroll") for (int n = 0; n < 2; ++n) _Pragma("unroll") for (int k = 0; k < 2; ++k) \
        acc[ai][bj][m][n] = __builtin_amdgcn_mfma_f32_16x16x32_bf16(Bt[n][k], At[m][k], acc[ai][bj][m][n], 0, 0, 0); __builtin_amdgcn_s_setprio(0); } while (0)
#define PG8_WAIT_V(n) asm volatile("s_waitcnt vmcnt(" #n ")" ::: "memory")
#define PG8_WAIT_L(n) asm volatile("s_waitcnt lgkmcnt(" #n ")" ::: "memory")
#define PG8_BAR __builtin_amdgcn_s_barrier()
#define PG8_SCHED __builtin_amdgcn_sched_barrier(0)
    Unit cur, nxt; int ui = 0;
    float rsv[8];
    if (!S.next(0, cur)) return;
    f32x4 acc[2][2][4][2];
#pragma unroll
    for (int a = 0; a < 2; ++a)
#pragma unroll
        for (int b = 0; b < 2; ++b)
#pragma unroll
            for (int m = 0; m < 4; ++m)
#pragma unroll
                for (int n = 0; n < 2; ++n) acc[a][b][m][n] = (f32x4){0.f, 0.f, 0.f, 0.f};
    bf16x8 At[4][2], B0[2][2], B1[2][2];
    const char* cA = (const char*)g.A + (size_t)cur.pm * tstep; const char* cB = (const char*)g.Bt + (size_t)cur.pn * tstep;
    S.a_ready(cur);
    if constexpr (SP2) {
        PG8_STAGE(PG8_SB(0, 0), cB, voffB); PG8_STAGE(PG8_SB(0, 1), cB + hstep, voffB); PG8_STAGE(PG8_SA(0, 0), cA, voffA); PG8_STAGE(PG8_SA(0, 1), cA + hstep, voffA);
        if (wr == 1) PG8_BAR;
        PG8_WAIT_V(2); PG8_BAR;
        PG8_STAGE(PG8_SB(1, 0), cB + kstep, voffB); PG8_STAGE(PG8_SA(1, 0), cA + kstep, voffA); PG8_STAGE(PG8_SB(1, 1), cB + hstep + kstep, voffB);
        PG8_WAIT_V(6); PG8_BAR;
    } else {
        PG8_STAGE(PG8_SB(0, 0), cB, voffB); PG8_STAGE(PG8_SA(0, 0), cA, voffA); PG8_STAGE(PG8_SB(0, 1), cB + hstep, voffB); PG8_STAGE(PG8_SA(0, 1), cA + hstep, voffA);
        if (wr == 1) PG8_BAR;
        PG8_WAIT_V(4); PG8_BAR;
        PG8_STAGE(PG8_SB(1, 0), cB + kstep, voffB); PG8_STAGE(PG8_SA(1, 0), cA + kstep, voffA); PG8_STAGE(PG8_SB(1, 1), cB + hstep + kstep, voffB);
        PG8_WAIT_V(6); PG8_BAR;
    }
    for (;;) {
        const bool has_next = S.next(ui + 1, nxt);
        const char* nA = has_next ? (const char*)g.A + (size_t)nxt.pm * tstep : cA; const char* nB = has_next ? (const char*)g.Bt + (size_t)nxt.pn * tstep : cB;
        for (int t = 0; t < nt; t += 2) {
            const bool last = (t == nt - 2);
            const char* a1 = cA + (size_t)(t + 1) * kstep;
            const char* a2 = last ? nA : cA + (size_t)(t + 2) * kstep; const char* b2 = last ? nB : cB + (size_t)(t + 2) * kstep;
            const char* a3 = a2 + kstep; const char* b3 = b2 + kstep;
            if (last && has_next) S.a_ready(nxt);
            if (last) E.pre(cur, wr, fr, rsv);
            if constexpr (SP2) {
            PG8_LDB(B0, 0, 0); PG8_LDB(B1, 0, 1); PG8_SCHED; PG8_LDA(At, 0, 0); PG8_STAGE(PG8_SA(1, 1), a1 + hstep, voffA);
            PG8_WAIT_V(8); PG8_WAIT_L(0); PG8_BAR; PG8_MMA(0, 0, At, B0); PG8_MMA(0, 1, At, B1); PG8_BAR; PG8_SCHED;
            PG8_LDA(At, 0, 1); PG8_STAGE(PG8_SB(0, 0), b2, voffB); PG8_STAGE(PG8_SB(0, 1), b2 + hstep, voffB); PG8_STAGE(PG8_SA(0, 0), a2, voffA);
            PG8_WAIT_V(8); PG8_WAIT_L(0); PG8_BAR; PG8_MMA(1, 0, At, B0); PG8_MMA(1, 1, At, B1); PG8_BAR; PG8_SCHED;
            PG8_LDB(B0, 1, 0); PG8_LDB(B1, 1, 1); PG8_SCHED; PG8_LDA(At, 1, 0); PG8_STAGE(PG8_SA(0, 1), a2 + hstep, voffA);
            PG8_WAIT_V(8); PG8_WAIT_L(0); PG8_BAR; PG8_MMA(0, 0, At, B0); PG8_MMA(0, 1, At, B1); PG8_BAR; PG8_SCHED;
            PG8_LDA(At, 1, 1); PG8_STAGE(PG8_SB(1, 0), b3, voffB); PG8_STAGE(PG8_SB(1, 1), b3 + hstep, voffB); PG8_STAGE(PG8_SA(1, 0), a3, voffA);
            PG8_WAIT_V(8); PG8_WAIT_L(0); PG8_BAR; PG8_MMA(1, 0, At, B0); PG8_MMA(1, 1, At, B1); PG8_BAR; PG8_SCHED;
            } else {
            PG8_LDB(B0, 0, 0); PG8_SCHED; PG8_LDA(At, 0, 0); PG8_STAGE(PG8_SA(1, 1), a1 + hstep, voffA);
            PG8_WAIT_L(8); PG8_BAR; PG8_WAIT_L(0); PG8_MMA(0, 0, At, B0); PG8_BAR; PG8_SCHED;
            PG8_LDB(B1, 0, 1); PG8_STAGE(PG8_SB(0, 0), b2, voffB);
            PG8_BAR; PG8_WAIT_L(0); PG8_MMA(0, 1, At, B1); PG8_BAR;
            PG8_LDA(At, 0, 1); PG8_STAGE(PG8_SA(0, 0), a2, voffA);
            PG8_BAR; PG8_WAIT_L(0); PG8_MMA(1, 0, At, B0); PG8_BAR; PG8_SCHED;
            PG8_STAGE(PG8_SB(0, 1), b2 + hstep, voffB);
            PG8_WAIT_V(6); PG8_BAR; PG8_MMA(1, 1, At, B1); PG8_BAR;
            PG8_LDB(B0, 1, 0); PG8_SCHED; PG8_LDA(At, 1, 0); PG8_STAGE(PG8_SA(0, 1), a2 + hstep, voffA);
            PG8_WAIT_L(8); PG8_BAR; PG8_WAIT_L(0); PG8_MMA(0, 0, At, B0); PG8_BAR; PG8_SCHED;
            PG8_LDB(B1, 1, 1); PG8_STAGE(PG8_SB(1, 0), b3, voffB);
            PG8_BAR; PG8_WAIT_L(0); PG8_MMA(0, 1, At, B1); PG8_BAR;
            PG8_LDA(At, 1, 1); PG8_STAGE(PG8_SA(1, 0), a3, voffA);
            PG8_BAR; PG8_WAIT_L(0); PG8_MMA(1, 0, At, B0); PG8_BAR; PG8_SCHED;
            PG8_STAGE(PG8_SB(1, 1), b3 + hstep, voffB);
            PG8_WAIT_V(6); PG8_BAR; PG8_MMA(1, 1, At, B1); PG8_BAR;
            }
        }
        if constexpr (ALIGN_EPI) { if (wr == 0) PG8_BAR; }
        if constexpr (!Epi::AFTER_DRAIN) { E(acc, cur, wr, wc, fr, fq, rsv); S.done(cur); }
        if (!has_next) break;
#pragma unroll
        for (int a = 0; a < 2; ++a)
#pragma unroll
            for (int b = 0; b < 2; ++b)
#pragma unroll
                for (int m = 0; m < 4; ++m)
#pragma unroll
                    for (int n = 0; n < 2; ++n) acc[a][b][m][n] = (f32x4){0.f, 0.f, 0.f, 0.f};
        cur = nxt; cA = nA; cB = nB; ++ui;
        if constexpr (ALIGN_EPI) { if (wr == 1) PG8_BAR; }
    }
    PG8_WAIT_V(0);
    if constexpr (!ALIGN_EPI) { if (wr == 0) PG8_BAR; }
    PG8_BAR;
    if constexpr (Epi::AFTER_DRAIN) { E.fused(acc, cur, wr, wc, fr, fq, lds, wid, lane); S.done(cur); }
#undef PG8_SA
#undef PG8_SB
#undef PG8_STAGE
#undef PG8_LDA
#undef PG8_LDB
#undef PG8_MMA
#undef PG8_WAIT_V
#undef PG8_WAIT_L
#undef PG8_BAR
#undef PG8_SCHED
}
}

constexpr int NB = 4, T = 8192, D = 1024, DIN = 3592, NINP = 3584, DFF = 2816, NGU = 2 * DFF, DEPTH = 2;
constexpr int M = NB * T;
constexpr int NCH = T / 64;
constexpr int LDP = NINP;
constexpr int C_RQ = 0, C_RK = 256, C_RV = 512, C_RG = 768, C_CA = 1024, C_CG = 1280, C_GQ = 1536, C_GK = 1792, C_GV = 2048, C_GG = 2304,
              C_HQ = 2560, C_HF = 2816, C_HI = 3072, C_HG = 3328;
constexpr size_t MiB = 1u << 20;
constexpr size_t WS_CTL = 0;
constexpr size_t WS_WIN = 1 * MiB;
constexpr size_t WS_WOUT = 16 * MiB;
constexpr size_t WS_WGU = 20 * MiB;
constexpr size_t WS_WDN = 42 * MiB;
constexpr size_t WS_XN = 53 * MiB;
constexpr size_t WS_BCS = WS_XN;
constexpr size_t WS_MM = WS_XN + 48 * MiB;
constexpr size_t WS_MIX = 117 * MiB;
constexpr size_t WS_PROJ = 181 * MiB;
constexpr size_t WS_QEFF = 406 * MiB;
constexpr size_t WS_OLOC = 454 * MiB;
constexpr size_t WS_MVEC = 502 * MiB;
constexpr size_t WS_RSA = 503 * MiB;
constexpr size_t WS_RSB = 503 * MiB + 131072;
constexpr size_t WS_GBA = 503 * MiB + 262144;
constexpr size_t WS_WBA = 504 * MiB + 524288;
constexpr size_t WS_END = 505 * MiB;
constexpr int LDS_BYTES = 147456 + 256;
constexpr int LDS_BAR_OFF = 147456;
constexpr int HEAD_LDS = 73728;

#define LAS __attribute__((address_space(3)))
typedef unsigned short bf16_t;
typedef short bf16x8 __attribute__((ext_vector_type(8)));
typedef float f32x4 __attribute__((ext_vector_type(4)));
typedef unsigned u32x4 __attribute__((ext_vector_type(4)));
typedef unsigned u32x2 __attribute__((ext_vector_type(2)));
constexpr int LT = 72;
template <class Tp> __device__ __forceinline__ LAS Tp* opq(LAS Tp* p) { asm volatile("" : "+v"(p)); return p; }

__device__ __forceinline__ float bf_lo(unsigned u) { return __uint_as_float(u << 16); }
__device__ __forceinline__ float bf_hi(unsigned u) { return __uint_as_float(u & 0xffff0000u); }
__device__ __forceinline__ float bf2f(bf16_t b) { return __uint_as_float((unsigned)b << 16); }
__device__ __forceinline__ unsigned pk2(float lo, float hi) { return pg8::cvt_pk_bf16(lo, hi); }
__device__ __forceinline__ bf16_t f2bf(float f) { return (bf16_t)(pk2(f, 0.f) & 0xffffu); }
__device__ __forceinline__ float fexp(float x) { return __expf(x); }
__device__ __forceinline__ float frcp(float x) { return __builtin_amdgcn_rcpf(x); }
__device__ __forceinline__ float sigmoid_f(float x) { return frcp(1.0f + fexp(-x)); }
__device__ __forceinline__ float silu_acc(float x) { return x * frcp(1.0f + fexp(-x)); }
__device__ __forceinline__ float softplus_f(float x) { return fmaxf(x, 0.f) + log1pf(expf(-fabsf(x))); }
__device__ __forceinline__ float wave_sum(float v) {
#pragma unroll
    for (int o = 1; o < 64; o <<= 1) v += __shfl_xor(v, o);
    return v;
}
__device__ __forceinline__ void unpack8(const u32x4 w, float (&f)[8]) {
    f[0] = bf_lo(w.x); f[1] = bf_hi(w.x); f[2] = bf_lo(w.y); f[3] = bf_hi(w.y); f[4] = bf_lo(w.z); f[5] = bf_hi(w.z); f[6] = bf_lo(w.w); f[7] = bf_hi(w.w);
}
__device__ __forceinline__ u32x4 pack8(const float (&f)[8]) { u32x4 w; w.x = pk2(f[0], f[1]); w.y = pk2(f[2], f[3]); w.z = pk2(f[4], f[5]); w.w = pk2(f[6], f[7]); return w; }

struct Ctx {
    const float* in[20]; float* out; unsigned char* ws;
};
#define WSP(T_, off) ((T_*)(X.ws + (off)))

__device__ __forceinline__ f32x4 mma16(const LAS bf16_t* A, int a0, const LAS bf16_t* B, int b0, f32x4 acc, int r, int q) {
#pragma unroll
    for (int ks = 0; ks < 2; ++ks) {
        const bf16x8 a = *(const LAS bf16x8*)(A + (a0 + r) * LT + ks * 32 + q * 8);
        const bf16x8 b = *(const LAS bf16x8*)(B + (b0 + r) * LT + ks * 32 + q * 8);
        acc = __builtin_amdgcn_mfma_f32_16x16x32_bf16(a, b, acc, 0, 0, 0);
    }
    return acc;
}
__device__ __forceinline__ void store_oloc(bf16_t* oloc, int uid, int w4, int lane, const f32x4 (&acc)[4]) {
    u32x4* p = (u32x4*)(oloc + ((size_t)uid * 4 + w4) * 1024 + lane * 16);
    u32x4 a, b;
    a.x = pk2(acc[0][0], acc[0][1]); a.y = pk2(acc[0][2], acc[0][3]); a.z = pk2(acc[1][0], acc[1][1]); a.w = pk2(acc[1][2], acc[1][3]);
    b.x = pk2(acc[2][0], acc[2][1]); b.y = pk2(acc[2][2], acc[2][3]); b.z = pk2(acc[3][0], acc[3][1]); b.w = pk2(acc[3][2], acc[3][3]);
    p[0] = a; p[1] = b;
}
__device__ __forceinline__ void store_bc(bf16_t* bcs, int uid, int w4, int r, int q, const f32x4 (&acc)[4]) {
#pragma unroll
    for (int ct = 0; ct < 4; ++ct) { u32x2 w; w.x = pk2(acc[ct][0], acc[ct][1]); w.y = pk2(acc[ct][2], acc[ct][3]);
        *(u32x2*)(bcs + (size_t)uid * 4096 + ((ct * 4 + w4) * 64 + q * 16 + r) * 4) = w; }
}


typedef __attribute__((address_space(1))) unsigned gu32;
#define XB_TMO      128
#define XB_XCNT(j)  (256  + 64 * (j))
#define XB_XSUB(j)  (1280 + 64 * (j))
#define XB_XGEN(j)  (2304 + 64 * (j))
#define XB_TOP      3328
#define XB_TOPGEN   3392
#define XCD_BAR_WORDS 3456
#define XB_SPIN_CAP (1u << 18)

__device__ __forceinline__ unsigned xb_ld(unsigned* p)              { return __hip_atomic_load(p, __ATOMIC_RELAXED, __HIP_MEMORY_SCOPE_AGENT); }
__device__ __forceinline__ unsigned xb_add(unsigned* p, unsigned v) { return __hip_atomic_fetch_add(p, v, __ATOMIC_RELAXED, __HIP_MEMORY_SCOPE_AGENT); }
__device__ __forceinline__ unsigned xb_xcc_id() { return (unsigned)__builtin_amdgcn_s_getreg((3 << 11) | 20) & 0xFu; }
#define XB_SPIN(cond, bar) do { unsigned _sp = 0; while (cond) { __builtin_amdgcn_s_sleep(1); \
    if ((++_sp & 255u) == 0u) { if (xb_ld(&(bar)[XB_TMO])) break; if (_sp > XB_SPIN_CAP) { atomicAdd(&(bar)[XB_TMO], 1u); break; } } } } while (0)

struct XcdBarrier {
    unsigned* bar; unsigned x;
    volatile LAS unsigned* st;
};

__device__ __forceinline__ XcdBarrier xcd_barrier_post(unsigned* bar, volatile LAS unsigned* st) {
    XcdBarrier b; b.bar = bar; b.x = xb_xcc_id(); b.st = st;
    if (threadIdx.x == 0) (void)xb_add(&bar[XB_XCNT(b.x)], 1u);
    return b;
}
__device__ __forceinline__ void xcd_barrier_complete(unsigned* bar, unsigned x, unsigned& nloc, unsigned& nx) {
    const unsigned G = gridDim.x * gridDim.y * gridDim.z;
    unsigned sum, cnt, mine, sp = 0u;
    for (;;) {
        sum = 0u; cnt = 0u; mine = 0u;
#pragma unroll
        for (unsigned j = 0; j < 16; ++j) { const unsigned c = xb_ld(&bar[XB_XCNT(j)]); sum += c; cnt += (c > 0u) ? 1u : 0u; mine = (j == x) ? c : mine; }
        if (sum == G) break;
        __builtin_amdgcn_s_sleep(1);
        if ((++sp & 255u) == 0u) { if (xb_ld(&bar[XB_TMO])) break; if (sp > XB_SPIN_CAP) { atomicAdd(&bar[XB_TMO], 1u); break; } }
    }
    nloc = mine > 0u ? mine : 1u; nx = cnt > 0u ? cnt : 1u;
}

__device__ __forceinline__ void xcd_barrier(const XcdBarrier& b) {
    asm volatile("s_waitcnt vmcnt(0)" ::: "memory");
    __syncthreads();
    if (threadIdx.x == 0) {
        unsigned* bar = b.bar;
        __builtin_amdgcn_s_waitcnt(0);
        unsigned nloc = b.st[0], nx = b.st[1];
        if (nloc == 0u) { xcd_barrier_complete(bar, b.x, nloc, nx); b.st[0] = nloc; b.st[1] = nx; }
        const unsigned old = xb_add(&bar[XB_XSUB(b.x)], 1u);
        const unsigned gen = old / nloc;
        if (old + 1u == (gen + 1u) * nloc) {
            __builtin_amdgcn_fence(__ATOMIC_RELEASE, "agent");
            asm volatile("s_waitcnt vmcnt(0)" ::: "memory");
            const unsigned og = xb_add(&bar[XB_TOP], 1u);
            const unsigned tg = og / nx;
            if (og + 1u == (tg + 1u) * nx) xb_add(&bar[XB_TOPGEN], 1u);
            else XB_SPIN(xb_ld(&bar[XB_TOPGEN]) == tg, bar);
            __builtin_amdgcn_fence(__ATOMIC_ACQUIRE, "agent");
            xb_add(&bar[XB_XGEN(b.x)], 1u);
            asm volatile("s_waitcnt vmcnt(0)" ::: "memory");
        } else {
            XB_SPIN(xb_ld(&bar[XB_XGEN(b.x)]) == gen, bar);
            __builtin_amdgcn_fence(__ATOMIC_ACQUIRE, "agent");
            asm volatile("s_waitcnt vmcnt(0)" ::: "memory");
        }
    }
    __syncthreads();
}

__device__ __forceinline__ void transpose_item(const float* W, int K, int N, bf16_t* WT, int mode, LAS float* scr, int kb, int nb, int lane, const float* kscale, int coff) {
    const int k0 = 64 * kb, n0 = 32 * nb;
    const int nn = n0 + (lane & 31) + coff;
#pragma unroll 8
    for (int i = 0; i < 32; ++i) { const int kk = 2 * i + (lane >> 5); const float ksc = kscale ? kscale[k0 + kk] : 1.0f; scr[kk * 33 + (lane & 31)] = nn < N ? W[(size_t)(k0 + kk) * N + nn] * ksc : 0.f; }
    asm volatile("s_waitcnt lgkmcnt(0)" ::: "memory");
    const int c = lane & 7;
#pragma unroll
    for (int j = 0; j < 4; ++j) { const int n = (lane >> 3) + 8 * j; const LAS float* s = scr + (8 * c) * 33 + n;
        u32x4 o; o.x = pk2(s[0 * 33], s[1 * 33]); o.y = pk2(s[2 * 33], s[3 * 33]); o.z = pk2(s[4 * 33], s[5 * 33]); o.w = pk2(s[6 * 33], s[7 * 33]);
        const int ng = n0 + n; const int row = mode == 0 ? ng : ((ng >> 7) * 256 + (ng & 127) + (mode == 2 ? 128 : 0));
        *(u32x4*)(WT + (size_t)row * K + k0 + 8 * c) = o; }
    asm volatile("s_waitcnt lgkmcnt(0)" ::: "memory");
}
__device__ __forceinline__ void prep_weights(const Ctx& X, LAS unsigned char* lds, int gw, int ngw, int wave, int lane, int it_lo, int it_hi) {
    LAS float* scr = (LAS float*)(lds + wave * 16384);
    constexpr int I_IN = (D / 64) * (NINP / 32), I_OUT = (D / 64) * (D / 32), I_G = (D / 64) * (DFF / 32), I_DN = (DFF / 64) * (D / 32);
    constexpr int PER_L = I_IN + I_OUT + 2 * I_G + I_DN;
    asm volatile("" : "+v"(lane));
    for (int it = it_lo + gw; it < it_hi; it += ngw) {
        const int l = it / PER_L; int r = it % PER_L;
        if (r < I_IN) { transpose_item(X.in[2] + (size_t)l * D * DIN, D, DIN, WSP(bf16_t, WS_WIN) + (size_t)l * NINP * D, 0, scr, r / (NINP / 32), r % (NINP / 32), lane, X.in[1] + l * D, (r % (NINP / 32)) * 32 >= 2560 ? 8 : 0); continue; } r -= I_IN;
        if (r < I_OUT) { transpose_item(X.in[14] + (size_t)l * D * D, D, D, WSP(bf16_t, WS_WOUT) + (size_t)l * D * D, 0, scr, r / (D / 32), r % (D / 32), lane, nullptr, 0); continue; } r -= I_OUT;
        if (r < I_G) { transpose_item(X.in[16] + (size_t)l * D * DFF, D, DFF, WSP(bf16_t, WS_WGU) + (size_t)l * NGU * D, 1, scr, r / (DFF / 32), r % (DFF / 32), lane, X.in[15] + l * D, 0); continue; } r -= I_G;
        if (r < I_G) { transpose_item(X.in[17] + (size_t)l * D * DFF, D, DFF, WSP(bf16_t, WS_WGU) + (size_t)l * NGU * D, 2, scr, r / (DFF / 32), r % (DFF / 32), lane, X.in[15] + l * D, 0); continue; } r -= I_G;
        transpose_item(X.in[18] + (size_t)l * DFF * D, DFF, D, WSP(bf16_t, WS_WDN) + (size_t)l * D * DFF, 0, scr, r / (D / 32), r % (D / 32), lane, nullptr, 0);
    }
}
__device__ __forceinline__ void rms_row(const float* xrow, const float* w, bf16_t* orow, float* of, int lane) {
    const f32x4* xr = (const f32x4*)xrow + lane; const f32x4* wr = (const f32x4*)w + lane;
    f32x4 v[4]; float s = 0.f;
#pragma unroll
    for (int j = 0; j < 4; ++j) { v[j] = xr[64 * j]; s += (v[j].x * v[j].x + v[j].y * v[j].y) + (v[j].z * v[j].z + v[j].w * v[j].w); }
    const float rstd = 1.0f / sqrtf(wave_sum(s) * (1.f / D) + 1e-6f);
#pragma unroll
    for (int j = 0; j < 4; ++j) { const f32x4 ww = wr[64 * j]; const f32x4 o = v[j] * rstd * ww;
        if (of) ((f32x4*)of + lane)[64 * j] = o;
        else { u32x2 p; p.x = pk2(o.x, o.y); p.y = pk2(o.z, o.w); ((u32x2*)orow + lane)[64 * j] = p; } }
}
__device__ __forceinline__ void cast_phase(const float* x, bf16_t* xb, float* rowsq, int gw, int ngw, int lane) {
    asm volatile("" : "+v"(lane));
    for (int m = gw; m < M; m += ngw) {
        const f32x4* xr = (const f32x4*)(x + (size_t)m * D) + lane; float s = 0.f;
#pragma unroll
        for (int j = 0; j < 4; ++j) { const f32x4 v = xr[64 * j]; s += (v.x * v.x + v.y * v.y) + (v.z * v.z + v.w * v.w); u32x2 p; p.x = pk2(v.x, v.y); p.y = pk2(v.z, v.w); ((u32x2*)(xb + (size_t)m * D) + lane)[64 * j] = p; }
        s = wave_sum(s); if (lane == 0) rowsq[m] = s;
    }
}
__device__ __forceinline__ void norm_phase(const float* x, const float* w, bf16_t* xn, float* of, int gw, int ngw, int lane) {
    asm volatile("" : "+v"(lane));
    for (int m = gw; m < M; m += ngw) rms_row(x + (size_t)m * D, w, xn ? xn + (size_t)m * D : nullptr, of ? of + (size_t)m * D : nullptr, lane);
}

__device__ __forceinline__ int unit_id(int mixer, int b, int h, int c) { return ((mixer * 4 + b) * 4 + h) * NCH + c; }

__device__ __forceinline__ void ret_unit(const Ctx& X, LAS unsigned char* hl, int b, int c, int h, int tid_h, int w4, int lane) {
    LAS bf16_t* QR = opq((LAS bf16_t*)hl); LAS bf16_t* KR = opq(QR + 64 * LT); LAS bf16_t* KDT = opq(KR + 64 * LT); LAS bf16_t* VT = opq(KDT + 64 * LT); LAS bf16_t* P = opq(VT + 64 * LT);
    const bf16_t* proj = WSP(const bf16_t, WS_PROJ);
    const int uid = unit_id(0, b, h, c);
    const int r = lane & 15, q = lane >> 4;
    const float lg = log1pf(-exp2f(-5.0f - (float)h));
    {
        const int i = tid_h >> 2, sg = tid_h & 3, d0 = sg * 8;
        const bf16_t* pr = proj + ((size_t)b * T + c * 64 + i) * LDP;
        const u32x4 q1 = *(const u32x4*)(pr + C_RQ + h * 64 + d0), q2 = *(const u32x4*)(pr + C_RQ + h * 64 + d0 + 32);
        const u32x4 k1 = *(const u32x4*)(pr + C_RK + h * 64 + d0), k2 = *(const u32x4*)(pr + C_RK + h * 64 + d0 + 32);
        const u32x4 v1 = *(const u32x4*)(pr + C_RV + h * 64 + sg * 16), v2 = *(const u32x4*)(pr + C_RV + h * 64 + sg * 16 + 8);
        float qa[8], qb[8], ka[8], kb[8], va[8], vb[8];
        unpack8(q1, qa); unpack8(q2, qb); unpack8(k1, ka); unpack8(k2, kb); unpack8(v1, va); unpack8(v2, vb);
        const float pos = (float)(c * 64 + i);
        const float qd = fexp(lg * (float)(i + 1)), kd = fexp(lg * (float)(63 - i));
        float qr1[8], qr2[8], kr1[8], kr2[8], qe1[8], qe2[8];
#pragma unroll
        for (int e = 0; e < 8; ++e) {
            const float inv = exp2f(-(float)(d0 + e) * (13.287712379549449f / 32.0f));
            const float rev = __builtin_amdgcn_fractf(pos * inv * 0.15915494309189535f); const float sn = __builtin_amdgcn_sinf(rev), cs = __builtin_amdgcn_cosf(rev);
            qr1[e] = qa[e] * cs - qb[e] * sn; qr2[e] = qa[e] * sn + qb[e] * cs;
            kr1[e] = (ka[e] * cs - kb[e] * sn) * 0.125f; kr2[e] = (ka[e] * sn + kb[e] * cs) * 0.125f;
            qe1[e] = qr1[e] * qd; qe2[e] = qr2[e] * qd;
            KDT[(d0 + e) * LT + i] = f2bf(kr1[e] * kd); KDT[(d0 + 32 + e) * LT + i] = f2bf(kr2[e] * kd);
            VT[(sg * 16 + e) * LT + i] = f2bf(va[e]); VT[(sg * 16 + 8 + e) * LT + i] = f2bf(vb[e]);
        }
        *(LAS u32x4*)(QR + i * LT + d0) = pack8(qr1); *(LAS u32x4*)(QR + i * LT + d0 + 32) = pack8(qr2);
        *(LAS u32x4*)(KR + i * LT + d0) = pack8(kr1); *(LAS u32x4*)(KR + i * LT + d0 + 32) = pack8(kr2);
        bf16_t* qe = WSP(bf16_t, WS_QEFF) + (size_t)uid * 4096 + i * 64;
        *(u32x4*)(qe + d0) = pack8(qe1); *(u32x4*)(qe + d0 + 32) = pack8(qe2);
    }
    __syncthreads();
    f32x4 acc[4];
#pragma unroll
    for (int ct = 0; ct < 4; ++ct) acc[ct] = mma16(QR, 16 * w4, KR, 16 * ct, (f32x4){0.f, 0.f, 0.f, 0.f}, r, q);
#pragma unroll
    for (int ct = 0; ct < 4; ++ct)
#pragma unroll
        for (int j = 0; j < 4; ++j) { const int ii = 16 * w4 + 4 * q + j, col = 16 * ct + r;
            P[ii * LT + col] = f2bf(ii >= col ? acc[ct][j] * fexp(lg * (float)(ii - col)) : 0.f); }
    __syncthreads();
#pragma unroll
    for (int ct = 0; ct < 4; ++ct) acc[ct] = mma16(P, 16 * w4, VT, 16 * ct, (f32x4){0.f, 0.f, 0.f, 0.f}, r, q);
    store_oloc(WSP(bf16_t, WS_OLOC), uid, w4, lane, acc);
#pragma unroll
    for (int ct = 0; ct < 4; ++ct) acc[ct] = mma16(KDT, 16 * w4, VT, 16 * ct, (f32x4){0.f, 0.f, 0.f, 0.f}, r, q);
    store_bc(WSP(bf16_t, WS_BCS), uid, w4, r, q, acc);
    __syncthreads();
}

__device__ __forceinline__ void hgrn_unit(const Ctx& X, LAS unsigned char* hl, int b, int c, int h, int tid_h, int w4, int lane, int layer) {
    LAS bf16_t* QT = opq((LAS bf16_t*)hl);
    LAS float* Gt = opq((LAS float*)(hl + 9216));
    LAS bf16_t* Kt = opq((LAS bf16_t*)(hl + 25600));
    LAS bf16_t* KTI = opq((LAS bf16_t*)(hl + 34816));
    LAS bf16_t* VT = KTI; LAS bf16_t* KDT = opq(KTI + 64 * LT);
    LAS float* tot = opq((LAS float*)(hl + 57856));
    const bf16_t* proj = WSP(const bf16_t, WS_PROJ);
    const int uid = unit_id(2, b, h, c);
    const int r = lane & 15, q = lane >> 4;
    const int i = tid_h >> 2, ds = (tid_h & 3) * 16;
    const bf16_t* pr = proj + ((size_t)b * T + c * 64 + i) * LDP;
    float kk[16], qv[16], vv[16];
    {
        float ff[16];
        { float t0[8], t1[8]; unpack8(*(const u32x4*)(pr + C_HF + h * 64 + ds), t0); unpack8(*(const u32x4*)(pr + C_HF + h * 64 + ds + 8), t1);
#pragma unroll
          for (int e = 0; e < 8; ++e) { ff[e] = t0[e]; ff[8 + e] = t1[e]; } }
        { float t0[8], t1[8]; unpack8(*(const u32x4*)(pr + C_HQ + h * 64 + ds), t0); unpack8(*(const u32x4*)(pr + C_HQ + h * 64 + ds + 8), t1);
#pragma unroll
          for (int e = 0; e < 8; ++e) { qv[e] = t0[e]; qv[8 + e] = t1[e]; } }
        { float t0[8], t1[8]; unpack8(*(const u32x4*)(pr + C_HI + h * 64 + ds), t0); unpack8(*(const u32x4*)(pr + C_HI + h * 64 + ds + 8), t1);
#pragma unroll
          for (int e = 0; e < 8; ++e) { vv[e] = t0[e]; vv[8 + e] = t1[e]; } }
#pragma unroll
        for (int e = 0; e < 16; ++e) {
            const int ch = h * 64 + ds + e;
            const float lb = layer == 0 ? 0.f : sigmoid_f(X.in[12][256 + ch] - X.in[12][ch]);
            const float f = ff[e];
            const float ls = fminf(f, 0.f) - __logf(1.0f + fexp(-fabsf(f)));
            const float lf = layer == 0 ? ls : __logf(lb + (1.f - lb) * fexp(ls));
            kk[e] = (1.f - lb) * frcp(1.f + fexp(f));
            Gt[i * 64 + ds + e] = lf;
        }
    }
    __syncthreads();
    {
        const int d = tid_h & 63, seg = tid_h >> 6; float cs[16]; float run = 0.f;
#pragma unroll
        for (int jj = 0; jj < 16; ++jj) { run += Gt[(16 * seg + jj) * 64 + d]; cs[jj] = run; }
        tot[seg * 64 + d] = run;
        __syncthreads();
        float off = 0.f;
#pragma unroll
        for (int s = 0; s < 3; ++s) off += (s < seg) ? tot[s * 64 + d] : 0.f;
#pragma unroll
        for (int jj = 0; jj < 16; ++jj) Gt[(16 * seg + jj) * 64 + d] = cs[jj] + off;
    }
    __syncthreads();
    float Gi[16], G63[16];
    {
        const int I = i >> 4;
        float qt[16], qe[16];
#pragma unroll
        for (int e = 0; e < 16; ++e) { Gi[e] = Gt[i * 64 + ds + e]; G63[e] = Gt[63 * 64 + ds + e]; const float gr = Gt[(16 * I) * 64 + ds + e];
            qt[e] = qv[e] * fexp(Gi[e] - gr); qe[e] = qv[e] * fexp(Gi[e]); }
        u32x4 w0, w1;
        w0.x = pk2(qt[0], qt[1]); w0.y = pk2(qt[2], qt[3]); w0.z = pk2(qt[4], qt[5]); w0.w = pk2(qt[6], qt[7]);
        w1.x = pk2(qt[8], qt[9]); w1.y = pk2(qt[10], qt[11]); w1.z = pk2(qt[12], qt[13]); w1.w = pk2(qt[14], qt[15]);
        *(LAS u32x4*)(QT + i * LT + ds) = w0; *(LAS u32x4*)(QT + i * LT + ds + 8) = w1;
        w0.x = pk2(qe[0], qe[1]); w0.y = pk2(qe[2], qe[3]); w0.z = pk2(qe[4], qe[5]); w0.w = pk2(qe[6], qe[7]);
        w1.x = pk2(qe[8], qe[9]); w1.y = pk2(qe[10], qe[11]); w1.z = pk2(qe[12], qe[13]); w1.w = pk2(qe[14], qe[15]);
        bf16_t* qg = WSP(bf16_t, WS_QEFF) + (size_t)uid * 4096 + i * 64 + ds;
        *(u32x4*)qg = w0; *(u32x4*)(qg + 8) = w1;
        w0.x = pk2(kk[0], kk[1]); w0.y = pk2(kk[2], kk[3]); w0.z = pk2(kk[4], kk[5]); w0.w = pk2(kk[6], kk[7]);
        w1.x = pk2(kk[8], kk[9]); w1.y = pk2(kk[10], kk[11]); w1.z = pk2(kk[12], kk[13]); w1.w = pk2(kk[14], kk[15]);
        *(LAS u32x4*)(Kt + i * LT + ds) = w0; *(LAS u32x4*)(Kt + i * LT + ds + 8) = w1;
        if (i == 63) { float* mv = WSP(float, WS_MVEC) + (size_t)(uid - 2 * 2048) * 64 + ds;
#pragma unroll
            for (int e = 0; e < 16; ++e) mv[e] = fexp(G63[e]); }
    }
    __syncthreads();
    const int I = w4;
    LAS bf16_t* KI = opq(KTI + (8 * I * (I + 1)) * LT);
    {
        const int nit = 16 * (I + 1) * 8;
        for (int idx = lane; idx < nit; idx += 64) { const int j = idx >> 3, d8 = (idx & 7) * 8;
            float kf[8]; unpack8(*(const LAS u32x4*)(Kt + j * LT + d8), kf);
            float o[8];
#pragma unroll
            for (int e = 0; e < 8; ++e) o[e] = kf[e] * fexp(fminf(Gt[(16 * I) * 64 + d8 + e] - Gt[j * 64 + d8 + e], 80.f));
            *(LAS u32x4*)(KI + j * LT + d8) = pack8(o); }
    }
    __syncthreads();
    f32x4 acc[4];
    {
        bf16x8 a[2];
#pragma unroll
        for (int ks = 0; ks < 2; ++ks) a[ks] = *(const LAS bf16x8*)(QT + (16 * I + r) * LT + ks * 32 + q * 8);
#pragma unroll
        for (int ct = 0; ct < 4; ++ct) { acc[ct] = (f32x4){0.f, 0.f, 0.f, 0.f};
            if (ct <= I) {
#pragma unroll
                for (int ks = 0; ks < 2; ++ks) { const bf16x8 bb = *(const LAS bf16x8*)(KI + (16 * ct + r) * LT + ks * 32 + q * 8);
                    acc[ct] = __builtin_amdgcn_mfma_f32_16x16x32_bf16(a[ks], bb, acc[ct], 0, 0, 0); } } }
        asm volatile("s_waitcnt lgkmcnt(0)" ::: "memory");
#pragma unroll
        for (int ct = 0; ct < 4; ++ct)
#pragma unroll
            for (int j = 0; j < 4; ++j) { const int ii = 16 * I + 4 * q + j, col = 16 * ct + r;
                QT[ii * LT + col] = f2bf((ct <= I && ii >= col) ? acc[ct][j] : 0.f); }
    }
    __syncthreads();
    {
#pragma unroll
        for (int e = 0; e < 16; ++e) { VT[(ds + e) * LT + i] = f2bf(vv[e]); KDT[(ds + e) * LT + i] = f2bf(kk[e] * fexp(G63[e] - Gi[e])); }
    }
    __syncthreads();
#pragma unroll
    for (int ct = 0; ct < 4; ++ct) acc[ct] = mma16(QT, 16 * w4, VT, 16 * ct, (f32x4){0.f, 0.f, 0.f, 0.f}, r, q);
    store_oloc(WSP(bf16_t, WS_OLOC), uid, w4, lane, acc);
#pragma unroll
    for (int ct = 0; ct < 4; ++ct) acc[ct] = mma16(KDT, 16 * w4, VT, 16 * ct, (f32x4){0.f, 0.f, 0.f, 0.f}, r, q);
    store_bc(WSP(bf16_t, WS_BCS), uid, w4, r, q, acc);
    __syncthreads();
}

__device__ __forceinline__ void gdn_unit(const Ctx& X, LAS unsigned char* hl, int b, int c, int h, int tid_h, int w4, int lane, int layer) {
    LAS bf16_t* Q = opq((LAS bf16_t*)hl); LAS bf16_t* K = opq(Q + 64 * LT); LAS bf16_t* KB = opq(K + 64 * LT); LAS bf16_t* V = opq(KB + 64 * LT); LAS bf16_t* KDT = opq(V + 64 * LT); LAS bf16_t* P = opq(KDT + 64 * LT);
    LAS bf16_t* WT = KB; LAS bf16_t* UT = V;
    LAS bf16_t* AB = opq((LAS bf16_t*)(hl + 55296));
    LAS float* ACCS = opq((LAS float*)(hl + 64512));
    LAS float* Gs = opq((LAS float*)(hl + 72704));
    LAS float* Bs = opq(Gs + 64);
    const bf16_t* proj = WSP(const bf16_t, WS_PROJ);
    const int uid = unit_id(1, b, h, c);
    const int r = lane & 15, q = lane >> 4;
    {
    LAS bf16_t* RAW = opq((LAS bf16_t*)(hl + 46080));
    const int cseg = tid_h & 7, i0 = tid_h >> 3;
    f32x4 wq[3][4][2];
    {
        const float* cw = X.in[8] + (size_t)layer * 4 * 768 + h * 64 + cseg * 8;
#pragma unroll
        for (int tn = 0; tn < 3; ++tn)
#pragma unroll
            for (int k = 0; k < 4; ++k) { const f32x4* wp = (const f32x4*)(cw + k * 768 + tn * 256); wq[tn][k][0] = wp[0]; wq[tn][k][1] = wp[1]; }
        u32x4 rawv[7];
#pragma unroll
        for (int n = 0; n < 7; ++n) { const int item = tid_h + 256 * n; const int seg = item & 7; int rowid = item >> 3; rowid = rowid < 201 ? rowid : 200;
            const int tn = rowid / 67, rr = rowid - tn * 67; const int tt = c * 64 - 3 + rr; const int ttc = tt < 0 ? 0 : tt;
            const u32x4 v = *(const u32x4*)(proj + ((size_t)b * T + ttc) * LDP + C_GQ + tn * 256 + h * 64 + seg * 8);
            rawv[n] = tt < 0 ? (u32x4){0u, 0u, 0u, 0u} : v; }
        float g = 0.f, bt = 0.f;
        if (tid_h < 64) {
            const bf16_t* pr = proj + ((size_t)b * T + c * 64 + tid_h) * LDP;
            const float* gba = WSP(const float, WS_GBA) + ((size_t)b * T + c * 64 + tid_h) * 8; const float gb = gba[h], ga = gba[4 + h];
            g = -fexp(X.in[9][layer * 4 + h]) * softplus_f(ga + X.in[10][layer * 4 + h]);
#pragma unroll
            for (int o = 1; o < 64; o <<= 1) { const float t = __shfl_up(g, o); if (lane >= o) g += t; }
            bt = sigmoid_f(gb);
            Gs[tid_h] = g; Bs[tid_h] = bt;
        }
#pragma unroll
        for (int n = 0; n < 7; ++n) { const int item = tid_h + 256 * n; if (item < 1608) *(LAS u32x4*)(RAW + (item >> 3) * 64 + (item & 7) * 8) = rawv[n]; }
    }
    __syncthreads();
    {
        const float G63 = Gs[63];
#pragma unroll
        for (int rs = 0; rs < 2; ++rs) {
            const int i = i0 + 32 * rs;
            const float bi = Bs[i], Gi = Gs[i];
            float y[3][8];
#pragma unroll
            for (int tn = 0; tn < 3; ++tn) {
#pragma unroll
                for (int e = 0; e < 8; ++e) y[tn][e] = 0.f;
#pragma unroll
                for (int k = 0; k < 4; ++k) { float x8[8]; unpack8(*(const LAS u32x4*)(RAW + (tn * 67 + i + k) * 64 + cseg * 8), x8);
                    y[tn][0] += wq[tn][k][0].x * x8[0]; y[tn][1] += wq[tn][k][0].y * x8[1]; y[tn][2] += wq[tn][k][0].z * x8[2]; y[tn][3] += wq[tn][k][0].w * x8[3];
                    y[tn][4] += wq[tn][k][1].x * x8[4]; y[tn][5] += wq[tn][k][1].y * x8[5]; y[tn][6] += wq[tn][k][1].z * x8[6]; y[tn][7] += wq[tn][k][1].w * x8[7]; }
#pragma unroll
                for (int e = 0; e < 8; ++e) y[tn][e] = silu_acc(y[tn][e]);
            }
            float sq = 0.f, sk = 0.f;
#pragma unroll
            for (int e = 0; e < 8; ++e) { sq += y[0][e] * y[0][e]; sk += y[1][e] * y[1][e]; }
            sq += __shfl_xor(sq, 1); sq += __shfl_xor(sq, 2); sq += __shfl_xor(sq, 4);
            sk += __shfl_xor(sk, 1); sk += __shfl_xor(sk, 2); sk += __shfl_xor(sk, 4);
            const float rq = 0.125f * rsqrtf(sq + 1e-6f), rk = rsqrtf(sk + 1e-6f), kd = rk * fexp(G63 - Gi);
            float t8[8];
#pragma unroll
            for (int e = 0; e < 8; ++e) t8[e] = y[0][e] * rq;
            *(LAS u32x4*)(Q + i * LT + cseg * 8) = pack8(t8);
#pragma unroll
            for (int e = 0; e < 8; ++e) t8[e] = y[1][e] * rk;
            *(LAS u32x4*)(K + i * LT + cseg * 8) = pack8(t8);
#pragma unroll
            for (int e = 0; e < 8; ++e) t8[e] = y[1][e] * rk * bi;
            *(LAS u32x4*)(KB + i * LT + cseg * 8) = pack8(t8);
            *(LAS u32x4*)(V + i * LT + cseg * 8) = pack8(y[2]);
#pragma unroll
            for (int e = 0; e < 8; ++e) KDT[(cseg * 8 + e) * LT + i] = f2bf(y[1][e] * kd);
        }
    }
    __syncthreads();
    }
    {
        f32x4 aA[4], aP[4];
#pragma unroll
        for (int ct = 0; ct < 4; ++ct) { aA[ct] = mma16(KB, 16 * w4, K, 16 * ct, (f32x4){0.f, 0.f, 0.f, 0.f}, r, q); aP[ct] = mma16(Q, 16 * w4, K, 16 * ct, (f32x4){0.f, 0.f, 0.f, 0.f}, r, q); }
#pragma unroll
        for (int ct = 0; ct < 4; ++ct)
#pragma unroll
            for (int j = 0; j < 4; ++j) { const int ii = 16 * w4 + 4 * q + j, col = 16 * ct + r;
                const float L = fexp(fminf(Gs[ii] - Gs[col], 0.f));
                AB[ii * LT + col] = f2bf(ii > col ? aA[ct][j] * L : 0.f);
                P[ii * LT + col] = f2bf(ii >= col ? aP[ct][j] * L : 0.f); }
    }
    __syncthreads();
    float rc[64];
    if (w4 < 2) {
        const int col = tid_h & 63; const LAS bf16_t* src = w4 == 0 ? V : KB;
#pragma unroll
        for (int i = 0; i < 64; ++i) { const float sc = w4 == 0 ? Bs[i] : fexp(Gs[i]); rc[i] = bf2f(src[i * LT + col]) * sc; }
    }
    __syncthreads();
    {
    for (int idx = tid_h; idx < 1152; idx += 256) { const int tl = idx >= 576; const int rem = idx - tl * 576; *(LAS u32x4*)((tl ? KB : V) + rem * 8) = (u32x4){0u, 0u, 0u, 0u}; }
    __syncthreads();
#pragma unroll
    for (int I = 0; I < 4; ++I) {
        if (I > 0) {
#pragma unroll
            for (int t2 = 0; t2 < 2; ++t2) { const int ct8 = 2 * w4 + t2; const LAS bf16_t* Bt = ct8 < 4 ? UT : WT;
                const f32x4 a = mma16(AB, 16 * I, Bt, 16 * (ct8 & 3), (f32x4){0.f, 0.f, 0.f, 0.f}, r, q);
#pragma unroll
                for (int j = 0; j < 4; ++j) ACCS[(4 * q + j) * 128 + 16 * ct8 + r] = a[j]; }
            __syncthreads();
        }
        if (w4 < 2) {
            const int col = tid_h & 63, c128 = w4 * 64 + col;
            float t[16];
#pragma unroll
            for (int ii = 0; ii < 16; ++ii) t[ii] = rc[16 * I + ii] - (I > 0 ? ACCS[ii * 128 + c128] : 0.f);
#pragma unroll
            for (int ii = 1; ii < 16; ++ii) {
                float a16[16];
                { float lo[8]; unpack8(*(const LAS u32x4*)(AB + (16 * I + ii) * LT + 16 * I), lo);
#pragma unroll
                  for (int e = 0; e < 8; ++e) a16[e] = lo[e]; }
                if (ii > 8) { float hi[8]; unpack8(*(const LAS u32x4*)(AB + (16 * I + ii) * LT + 16 * I + 8), hi);
#pragma unroll
                  for (int e = 0; e < 8; ++e) a16[8 + e] = hi[e]; }
                float s0 = t[ii], s1 = 0.f;
#pragma unroll
                for (int kk = 0; kk < ii; ++kk) { if (kk & 1) s1 -= a16[kk] * t[kk]; else s0 -= a16[kk] * t[kk]; }
                t[ii] = s0 + s1;
            }
            LAS bf16_t* dst = (w4 == 0 ? UT : WT) + col * LT + 16 * I;
            u32x4 w0, w1;
            w0.x = pk2(t[0], t[1]); w0.y = pk2(t[2], t[3]); w0.z = pk2(t[4], t[5]); w0.w = pk2(t[6], t[7]);
            w1.x = pk2(t[8], t[9]); w1.y = pk2(t[10], t[11]); w1.z = pk2(t[12], t[13]); w1.w = pk2(t[14], t[15]);
            *(LAS u32x4*)dst = w0; *(LAS u32x4*)(dst + 8) = w1;
        }
        __syncthreads();
    }
    }
    {
        f32x4 acc[4];
        const float eG63 = fexp(Gs[63]);
#pragma unroll
        for (int ct = 0; ct < 4; ++ct) acc[ct] = mma16(P, 16 * w4, WT, 16 * ct, (f32x4){0.f, 0.f, 0.f, 0.f}, r, q);
        bf16_t* qe = WSP(bf16_t, WS_QEFF) + (size_t)uid * 4096;
#pragma unroll
        for (int ct = 0; ct < 4; ++ct)
#pragma unroll
            for (int j = 0; j < 4; ++j) { const int ii = 16 * w4 + 4 * q + j, col = 16 * ct + r;
                qe[ii * 64 + col] = f2bf(bf2f(Q[ii * LT + col]) * fexp(Gs[ii]) - acc[ct][j]); }
#pragma unroll
        for (int ct = 0; ct < 4; ++ct) acc[ct] = mma16(P, 16 * w4, UT, 16 * ct, (f32x4){0.f, 0.f, 0.f, 0.f}, r, q);
        store_oloc(WSP(bf16_t, WS_OLOC), uid, w4, lane, acc);
#pragma unroll
        for (int ct = 0; ct < 4; ++ct) acc[ct] = mma16(KDT, 16 * w4, WT, 16 * ct, (f32x4){0.f, 0.f, 0.f, 0.f}, r, q);
        bf16_t* mm = WSP(bf16_t, WS_MM) + (size_t)(uid - 2048) * 4096;
#pragma unroll
        for (int ct = 0; ct < 4; ++ct)
#pragma unroll
            for (int j = 0; j < 4; ++j) { const int ii = 16 * w4 + 4 * q + j, col = 16 * ct + r;
                mm[((w4 * 2 + (ct >> 1)) * 64 + (r >> 2) * 16 + 4 * q + j) * 8 + (ct & 1) * 4 + (r & 3)] = f2bf((ii == col ? eG63 : 0.f) - acc[ct][j]); }
#pragma unroll
        for (int ct = 0; ct < 4; ++ct) acc[ct] = mma16(KDT, 16 * w4, UT, 16 * ct, (f32x4){0.f, 0.f, 0.f, 0.f}, r, q);
        store_bc(WSP(bf16_t, WS_BCS), uid, w4, r, q, acc);
    }
    __syncthreads();
}

__device__ __forceinline__ void conf_unit(const Ctx& X, LAS unsigned char* lds, int b, int c, int tid, int wave, int lane, int layer) {
    LAS bf16_t* GL = opq((LAS bf16_t*)lds);
    LAS float* Y = opq((LAS float*)(lds + 49152));
    const bf16_t* proj = WSP(const bf16_t, WS_PROJ);
    bf16_t* mix = WSP(bf16_t, WS_MIX);
    const int t0 = c * 64;
    float w[31]; float bias;
    { const int ch = tid & 255; const float* cw = X.in[4] + (size_t)layer * 31 * 256 + ch;
#pragma unroll
      for (int k = 0; k < 31; ++k) w[k] = cw[k * 256];
      bias = X.in[5][layer * 256 + ch]; }
    {
        u32x4 av[6], gvv[6];
#pragma unroll
        for (int n = 0; n < 6; ++n) { int item = tid + 512 * n; item = item < 94 * 32 ? item : 94 * 32 - 1; const int rr = item >> 5, seg = (item & 31) * 8; int tt = t0 - 30 + rr; tt = tt < 0 ? 0 : tt;
            const bf16_t* pr = proj + ((size_t)b * T + tt) * LDP; av[n] = *(const u32x4*)(pr + C_CA + seg); gvv[n] = *(const u32x4*)(pr + C_CG + seg); }
#pragma unroll
        for (int n = 0; n < 6; ++n) { const int item = tid + 512 * n; if (item < 94 * 32) { const int rr = item >> 5, seg = (item & 31) * 8, tt = t0 - 30 + rr;
            u32x4 w = (u32x4){0u, 0u, 0u, 0u};
            if (tt >= 0) { float a[8], g[8], o[8]; unpack8(av[n], a); unpack8(gvv[n], g);
#pragma unroll
                for (int e = 0; e < 8; ++e) o[e] = a[e] * sigmoid_f(g[e]);
                w = pack8(o); }
            *(LAS u32x4*)(GL + rr * 256 + seg) = w; } }
    }
    __syncthreads();
    {
        const int ch = tid & 255, half = tid >> 8;
        float acc[32];
#pragma unroll
        for (int tk = 0; tk < 32; ++tk) acc[tk] = bias;
#pragma unroll
        for (int rr = 0; rr < 62; ++rr) { const float g = bf2f(GL[(half * 32 + rr) * 256 + ch]);
#pragma unroll
            for (int tk = 0; tk < 32; ++tk) { const int k = rr - tk; if (k >= 0 && k < 31) acc[tk] += w[k] * g; } }
#pragma unroll
        for (int tk = 0; tk < 32; ++tk) Y[(half * 32 + tk) * 256 + ch] = acc[tk];
    }
    __syncthreads();
    {
        const f32x4 lw = *((const f32x4*)(X.in[6] + layer * 256) + lane), lb = *((const f32x4*)(X.in[7] + layer * 256) + lane);
#pragma unroll 2
        for (int tk = wave * 8; tk < wave * 8 + 8; ++tk) {
            const f32x4 v = *((const LAS f32x4*)(Y + tk * 256) + lane);
            const float mu = wave_sum((v.x + v.y) + (v.z + v.w)) * (1.f / 256.f);
            const f32x4 dv = v - mu;
            const float var = wave_sum((dv.x * dv.x + dv.y * dv.y) + (dv.z * dv.z + dv.w * dv.w)) * (1.f / 256.f);
            const float rs = rsqrtf(var + 1e-5f);
            f32x4 o = dv * rs * lw + lb;
            const bool on = (MIX_MASK & 2) != 0;
            u32x2 p; p.x = on ? pk2(silu_acc(o.x), silu_acc(o.y)) : 0u; p.y = on ? pk2(silu_acc(o.z), silu_acc(o.w)) : 0u;
            *(u32x2*)(mix + ((size_t)b * T + t0 + tk) * D + 256 + lane * 4) = p;
        }
    }
    __syncthreads();
}

__device__ __forceinline__ void mixer_local_phase(const Ctx& X, LAS unsigned char* lds, int layer, int tid, int wave, int lane) {
    const int hs = wave >> 2, w4 = wave & 3; int tid_h = tid & 255;
    LAS unsigned char* hl = lds + hs * HEAD_LDS;
    const int nit_ = (3584 + (int)gridDim.x - 1) / (int)gridDim.x;
    for (int it_ = 0; it_ < nit_; ++it_) {
        const int u = (int)blockIdx.x + (int)gridDim.x * ((it_ + (int)(blockIdx.x >> 3)) % nit_);
        if (u >= 3584) continue;
        asm volatile("" : "+v"(tid_h), "+v"(lane), "+v"(tid));
        if (u < 3072) { const int mixer = u >> 10, idx = u & 1023, hp = idx & 1, cb = idx >> 1, b = cb >> 7, c = cb & 127, h = hp * 2 + hs;
            if (mixer == 0) { ret_unit(X, hl, b, c, h, tid_h, w4, lane);
            } else if (mixer == 1) { gdn_unit(X, hl, b, c, h, tid_h, w4, lane, layer);
            } else { hgrn_unit(X, hl, b, c, h, tid_h, w4, lane, layer);
            }
        } else { const int cb = u - 3072; conf_unit(X, lds, cb >> 7, cb & 127, tid, wave, lane, layer);
        }
    }
}

__device__ __forceinline__ void scan_phase(const Ctx& X, int wave, int lane) {
    const int job = blockIdx.x;
    if (job >= 192 || wave != 0) return;
    asm volatile("" : "+v"(lane));
    const int mixer = job >> 6, rem = job & 63, bh = rem >> 2, vg = rem & 3;
    const int uid0 = (mixer * 16 + bh) * NCH;
    const int r = lane & 15, q = lane >> 4;
    bf16_t* bc0 = WSP(bf16_t, WS_BCS) + (size_t)uid0 * 4096 + (vg * 4 * 64 + lane) * 4;
    float S[4][4];
#pragma unroll
    for (int t = 0; t < 4; ++t)
#pragma unroll
        for (int j = 0; j < 4; ++j) S[t][j] = 0.f;
    if (mixer == 1) {
        const bf16_t* mm0 = WSP(const bf16_t, WS_MM) + (size_t)(uid0 - 2048) * 4096;
        u32x2 cb[4][4], ca[4][4][2][2];
#define SCAN_LOAD_G(slot, cc) { const int c_ = (cc) < NCH ? (cc) : NCH - 1; const bf16_t* bcn = bc0 + (size_t)c_ * 4096; const bf16_t* mmn = mm0 + (size_t)c_ * 4096; \
            _Pragma("unroll") for (int t = 0; t < 4; ++t) { cb[slot][t] = *(const u32x2*)(bcn + 256 * t); \
                _Pragma("unroll") for (int s2 = 0; s2 < 2; ++s2) { const u32x4 w_ = *(const u32x4*)(mmn + ((t * 2 + s2) * 64 + lane) * 8); ca[slot][t][s2][0] = (u32x2){w_.x, w_.y}; ca[slot][t][s2][1] = (u32x2){w_.z, w_.w}; } } }
        SCAN_LOAD_G(0, 0) SCAN_LOAD_G(1, 1) SCAN_LOAD_G(2, 2)
#pragma unroll 1
        for (int c0 = 0; c0 < NCH; c0 += 4) {
#pragma unroll
            for (int k = 0; k < 4; ++k) {
                const int c = c0 + k;
                SCAN_LOAD_G((k + 3) & 3, c + 3)
                bf16_t* bcc = bc0 + (size_t)c * 4096;
                u32x2 sp[4];
#pragma unroll
                for (int t = 0; t < 4; ++t) { sp[t].x = pk2(S[t][0], S[t][1]); sp[t].y = pk2(S[t][2], S[t][3]);
                    asm volatile("" : "+v"(sp[t].x) : "v"(cb[k][t].x));
                    *(u32x2*)(bcc + 256 * t) = sp[t]; }
                bf16x8 bfr[2];
#pragma unroll
                for (int s2 = 0; s2 < 2; ++s2) { u32x4 w; w.x = sp[2 * s2].x; w.y = sp[2 * s2].y; w.z = sp[2 * s2 + 1].x; w.w = sp[2 * s2 + 1].y; bfr[s2] = __builtin_bit_cast(bf16x8, w); }
#pragma unroll
                for (int t = 0; t < 4; ++t) {
                    f32x4 acc = (f32x4){bf_lo(cb[k][t].x), bf_hi(cb[k][t].x), bf_lo(cb[k][t].y), bf_hi(cb[k][t].y)};
#pragma unroll
                    for (int s2 = 0; s2 < 2; ++s2) { u32x4 w; w.x = ca[k][t][s2][0].x; w.y = ca[k][t][s2][0].y; w.z = ca[k][t][s2][1].x; w.w = ca[k][t][s2][1].y;
                        acc = __builtin_amdgcn_mfma_f32_16x16x32_bf16(__builtin_bit_cast(bf16x8, w), bfr[s2], acc, 0, 0, 0); }
                    S[t][0] = acc[0]; S[t][1] = acc[1]; S[t][2] = acc[2]; S[t][3] = acc[3];
                }
            }
        }
#undef SCAN_LOAD_G
    } else {
        const int h = bh & 3;
        const float g64 = __expf(64.0f * log1pf(-exp2f(-5.0f - (float)h)));
        const float* mv0 = WSP(const float, WS_MVEC) + (size_t)(mixer == 2 ? uid0 - 2 * 2048 : 0) * 64 + 4 * q;
        u32x2 cb[4][4]; f32x4 cm[4][4];
#define SCAN_LOAD_D(slot, cc) { const int c_ = (cc) < NCH ? (cc) : NCH - 1; const bf16_t* bcn = bc0 + (size_t)c_ * 4096; \
            _Pragma("unroll") for (int t = 0; t < 4; ++t) { cb[slot][t] = *(const u32x2*)(bcn + 256 * t); cm[slot][t] = mixer == 2 ? *(const f32x4*)(mv0 + (size_t)c_ * 64 + 16 * t) : (f32x4){g64, g64, g64, g64}; } }
        SCAN_LOAD_D(0, 0) SCAN_LOAD_D(1, 1) SCAN_LOAD_D(2, 2)
#pragma unroll 1
        for (int c0 = 0; c0 < NCH; c0 += 4) {
#pragma unroll
            for (int k = 0; k < 4; ++k) {
                const int c = c0 + k;
                SCAN_LOAD_D((k + 3) & 3, c + 3)
                bf16_t* bcc = bc0 + (size_t)c * 4096;
#pragma unroll
                for (int t = 0; t < 4; ++t) { u32x2 sp; sp.x = pk2(S[t][0], S[t][1]); sp.y = pk2(S[t][2], S[t][3]);
                    asm volatile("" : "+v"(sp.x) : "v"(cb[k][t].x));
                    *(u32x2*)(bcc + 256 * t) = sp;
                    S[t][0] = cm[k][t].x * S[t][0] + bf_lo(cb[k][t].x); S[t][1] = cm[k][t].y * S[t][1] + bf_hi(cb[k][t].x);
                    S[t][2] = cm[k][t].z * S[t][2] + bf_lo(cb[k][t].y); S[t][3] = cm[k][t].w * S[t][3] + bf_hi(cb[k][t].y); }
            }
        }
#undef SCAN_LOAD_D
    }
}

__device__ __forceinline__ void mixer_out_phase(const Ctx& X, LAS unsigned char* lds, int layer, int tid, int wave, int lane) {
    constexpr int GP = 264;
    const bf16_t* proj = WSP(const bf16_t, WS_PROJ);
    bf16_t* mix = WSP(bf16_t, WS_MIX);
    for (int u = blockIdx.x; u < 1536; u += gridDim.x) {
        asm volatile("" : "+v"(lane), "+v"(tid));
        LAS bf16_t* GT = opq((LAS bf16_t*)lds);
        const int r = lane & 15, q = lane >> 4, h = wave >> 1, half = wave & 1;
        const int mixer = u >> 9, rem = u & 511, b = rem >> 7, c = rem & 127;
        const int uid = unit_id(mixer, b, h, c);
        const int goff = mixer == 0 ? C_RG : (mixer == 1 ? C_GG : C_HG), moff = mixer == 0 ? 0 : (mixer == 1 ? 512 : 768);
        const size_t row0 = (size_t)b * T + c * 64;
        u32x4 gv[4];
#pragma unroll
        for (int n = 0; n < 4; ++n) { const int idx = tid + 512 * n; gv[n] = *(const u32x4*)(proj + (row0 + (idx >> 5)) * LDP + goff + (idx & 31) * 8); }
        const bf16_t* qe = WSP(const bf16_t, WS_QEFF) + (size_t)uid * 4096;
        const bf16_t* st = WSP(const bf16_t, WS_BCS) + (size_t)uid * 4096;
        bf16x8 a[2][2], bb[4][2]; u32x4 ov[2][2];
#pragma unroll
        for (int rt = 0; rt < 2; ++rt) { const int rt4 = 2 * half + rt;
#pragma unroll
            for (int ks = 0; ks < 2; ++ks) a[rt][ks] = *(const bf16x8*)(qe + (16 * rt4 + r) * 64 + ks * 32 + q * 8);
            const u32x4* ol = (const u32x4*)(WSP(const bf16_t, WS_OLOC) + ((size_t)uid * 4 + rt4) * 1024 + lane * 16); ov[rt][0] = ol[0]; ov[rt][1] = ol[1]; }
#pragma unroll
        for (int ct = 0; ct < 4; ++ct)
#pragma unroll
            for (int ks = 0; ks < 2; ++ks) { const bf16_t* tb = st + (size_t)((ct * 4 + 2 * ks + (q >> 1)) * 64) * 4;
                const u32x2 lo = *(const u32x2*)(tb + ((2 * (q & 1)) * 16 + r) * 4), hi = *(const u32x2*)(tb + ((2 * (q & 1) + 1) * 16 + r) * 4);
                bb[ct][ks] = __builtin_bit_cast(bf16x8, (u32x4){lo.x, lo.y, hi.x, hi.y}); }
        const float* nw = mixer == 0 ? X.in[3] + layer * 256 + h * 64 : (mixer == 1 ? X.in[11] + layer * 64 : X.in[13] + layer * 64);
        float wv[4];
#pragma unroll
        for (int ct = 0; ct < 4; ++ct) wv[ct] = nw[16 * ct + r];
#pragma unroll
        for (int n = 0; n < 4; ++n) { const int idx = tid + 512 * n; *(LAS u32x4*)(GT + (idx >> 5) * GP + (idx & 31) * 8) = gv[n]; }
        __syncthreads();
        const bool on = ((MIX_MASK >> (mixer == 0 ? 0 : (mixer == 1 ? 2 : 3))) & 1) != 0;
#pragma unroll
        for (int rt = 0; rt < 2; ++rt) {
            f32x4 acc[4];
            acc[0] = (f32x4){bf_lo(ov[rt][0].x), bf_hi(ov[rt][0].x), bf_lo(ov[rt][0].y), bf_hi(ov[rt][0].y)}; acc[1] = (f32x4){bf_lo(ov[rt][0].z), bf_hi(ov[rt][0].z), bf_lo(ov[rt][0].w), bf_hi(ov[rt][0].w)};
            acc[2] = (f32x4){bf_lo(ov[rt][1].x), bf_hi(ov[rt][1].x), bf_lo(ov[rt][1].y), bf_hi(ov[rt][1].y)}; acc[3] = (f32x4){bf_lo(ov[rt][1].z), bf_hi(ov[rt][1].z), bf_lo(ov[rt][1].w), bf_hi(ov[rt][1].w)};
#pragma unroll
            for (int ct = 0; ct < 4; ++ct)
#pragma unroll
                for (int ks = 0; ks < 2; ++ks) acc[ct] = __builtin_amdgcn_mfma_f32_16x16x32_bf16(a[rt][ks], bb[ct][ks], acc[ct], 0, 0, 0);
#pragma unroll
            for (int j = 0; j < 4; ++j) {
                float sm = (acc[0][j] + acc[1][j]) + (acc[2][j] + acc[3][j]);
                sm += __shfl_xor(sm, 1); sm += __shfl_xor(sm, 2); sm += __shfl_xor(sm, 4); sm += __shfl_xor(sm, 8);
                const float mu = mixer == 0 ? sm * (1.f / 64.f) : 0.f;
                float d[4], s2 = 0.f;
#pragma unroll
                for (int ct = 0; ct < 4; ++ct) { d[ct] = acc[ct][j] - mu; s2 += d[ct] * d[ct]; }
                s2 += __shfl_xor(s2, 1); s2 += __shfl_xor(s2, 2); s2 += __shfl_xor(s2, 4); s2 += __shfl_xor(s2, 8);
                const float rs = rsqrtf(s2 * (1.f / 64.f) + (mixer == 0 ? 1e-5f : 1e-6f));
                const int ii = 16 * (2 * half + rt) + 4 * q + j;
#pragma unroll
                for (int ct = 0; ct < 4; ++ct) { LAS bf16_t* gp = GT + ii * GP + h * 64 + 16 * ct + r;
                    const float y = d[ct] * rs * wv[ct] * silu_acc(bf2f(*gp));
                    *gp = on ? f2bf(y) : (bf16_t)0; }
            }
        }
        __syncthreads();
#pragma unroll
        for (int n = 0; n < 4; ++n) { const int idx = tid + 512 * n; *(u32x4*)(mix + (row0 + (idx >> 5)) * D + moff + (idx & 31) * 8) = *(const LAS u32x4*)(GT + (idx >> 5) * GP + (idx & 31) * 8); }
        __syncthreads();
    }
}

constexpr int PREP_FIRST = (D / 64) * (NINP / 32), PREP_ALL = DEPTH * ((D / 64) * (NINP / 32) + (D / 64) * (D / 32) + 2 * (D / 64) * (DFF / 32) + (DFF / 64) * (D / 32));
__global__ void __launch_bounds__(512, 2) fwd_kernel(Ctx X) {
    extern __shared__ __attribute__((aligned(16))) unsigned char lds_raw[];
    LAS unsigned char* lds = (LAS unsigned char*)lds_raw;
    cg::grid_group grid = cg::this_grid();
    const int tid = threadIdx.x, lane = tid & 63, wave = __builtin_amdgcn_readfirstlane(tid >> 6);
    const int G = gridDim.x, gw = blockIdx.x * 8 + wave, ngw = G * 8;
    bf16_t* XS = (bf16_t*)X.out;
    bf16_t* XN = WSP(bf16_t, WS_XN); bf16_t* PROJ = WSP(bf16_t, WS_PROJ); bf16_t* ACT = WSP(bf16_t, WS_PROJ); bf16_t* MIX = WSP(bf16_t, WS_MIX);

    if (X.ws == nullptr) grid.sync();
    if (tid < 4) ((LAS unsigned*)(lds + LDS_BAR_OFF))[tid] = 0u;
    __syncthreads();
    (void)xcd_barrier_post(WSP(unsigned, WS_CTL), (volatile LAS unsigned*)(lds + LDS_BAR_OFF));
#define GSYNC() do { XcdBarrier b_; b_.bar = WSP(unsigned, WS_CTL); b_.x = xb_xcc_id(); b_.st = (volatile LAS unsigned*)(lds + LDS_BAR_OFF); xcd_barrier(b_); } while (0)
    prep_weights(X, lds, gw, ngw, wave, lane, 0, PREP_FIRST);
    for (int idx = blockIdx.x * 512 + tid; idx < DEPTH * 16 * D; idx += G * 512) { const int ll = idx >> 14, n = (idx >> 10) & 15, k = idx & 1023;
        WSP(bf16_t, WS_WBA)[idx] = n < 8 ? f2bf(X.in[2][((size_t)ll * D + k) * DIN + 2560 + n] * X.in[1][ll * D + k]) : (bf16_t)0; }
    cast_phase(X.in[0], XS, WSP(float, WS_RSA), gw, ngw, lane);
    GSYNC();
#pragma unroll 1
    for (int l = 0; l < DEPTH; ++l) {
        {
            pg8::Gemm g{XS, WSP(const bf16_t, WS_WIN) + (size_t)l * NINP * D, M, NINP, D}; pg8::StaticOrder S; S.init(M, NINP, G, (int)blockIdx.x);
            pg8::EpiProj E{PROJ, LDP, DIN, WSP(const float, WS_RSA)};
            pg8::gemm_phase<pg8::EpiProj, pg8::StaticOrder, true, true>(lds, g, S, E);
            int ln = lane; asm volatile("" : "+v"(ln));
            const int r = ln & 15, q = ln >> 4;
            for (int rb = blockIdx.x; rb < M / 128; rb += G) {
                const bf16_t* Ap = XS + (size_t)(rb * 128 + wave * 16 + r) * D + q * 8;
                const bf16_t* Bp = WSP(const bf16_t, WS_WBA) + (size_t)l * 16 * D + r * D + q * 8;
                f32x4 acc = (f32x4){0.f, 0.f, 0.f, 0.f};
#pragma unroll 8
                for (int ks = 0; ks < 32; ++ks) acc = __builtin_amdgcn_mfma_f32_16x16x32_bf16(*(const bf16x8*)(Ap + ks * 32), *(const bf16x8*)(Bp + ks * 32), acc, 0, 0, 0);
                if (r < 8) {
#pragma unroll
                    for (int j = 0; j < 4; ++j) { const int row = rb * 128 + wave * 16 + 4 * q + j;
                        WSP(float, WS_GBA)[(size_t)row * 8 + r] = acc[j] * rsqrtf(WSP(const float, WS_RSA)[row] * (1.0f / 1024.0f) + 1e-6f); } }
            }
        }
        GSYNC();
        int tz = tid; asm volatile("" : "+v"(tz));
        for (int i = blockIdx.x * 512 + tz; i < M; i += G * 512) { WSP(float, WS_RSA)[i] = 0.f; WSP(float, WS_RSB)[i] = 0.f; }
        mixer_local_phase(X, lds, l, tid, wave, lane);
        GSYNC();
        scan_phase(X, wave, lane);
        if (l == 0 && wave != 0) prep_weights(X, lds, blockIdx.x * 7 + wave - 1, G * 7, wave, lane, PREP_FIRST, PREP_ALL);
        GSYNC();
        mixer_out_phase(X, lds, l, tid, wave, lane);
        GSYNC();
        {
            pg8::Gemm g{MIX, WSP(const bf16_t, WS_WOUT) + (size_t)l * D * D, M, D, D}; pg8::StaticOrder S; S.init(M, D, G, (int)blockIdx.x);
            pg8::EpiResid E{l == 0 ? X.in[0] : nullptr, l == 0 ? nullptr : XS, nullptr, XN, D, WSP(float, WS_RSB)};
            pg8::gemm_phase<pg8::EpiResid, pg8::StaticOrder, true, true>(lds, g, S, E);
        }
        GSYNC();
        {
            pg8::Gemm g{XN, WSP(const bf16_t, WS_WGU) + (size_t)l * NGU * D, M, NGU, D}; pg8::StaticOrder S; S.init(M, NGU, G, (int)blockIdx.x);
            pg8::EpiSwiglu E{ACT, DFF, WSP(const float, WS_RSB)};
            pg8::gemm_phase<pg8::EpiSwiglu, pg8::StaticOrder, true, true>(lds, g, S, E);
        }
        GSYNC();
        {
            pg8::Gemm g{ACT, WSP(const bf16_t, WS_WDN) + (size_t)l * D * DFF, M, D, DFF}; pg8::StaticOrder S; S.init(M, D, G, (int)blockIdx.x);
            pg8::EpiResid E{nullptr, XN, l + 1 < DEPTH ? nullptr : X.out, l + 1 < DEPTH ? XS : nullptr, D, l + 1 < DEPTH ? WSP(float, WS_RSA) : nullptr};
            pg8::gemm_phase<pg8::EpiResid, pg8::StaticOrder, true, true>(lds, g, S, E);
        }
        GSYNC();
        if (l + 1 == DEPTH) norm_phase(X.out, X.in[19], nullptr, X.out, gw, ngw, lane);
    }
}

extern "C" void kernel_launch(void* const* d_in, const int* in_sizes, int n_in, void* d_out, int out_size, void* d_ws, size_t ws_size, hipStream_t stream) {
    static int grid = 0;
    if (grid == 0) {
        if (n_in != 20 || out_size != M * D || ws_size < WS_END) { fprintf(stderr, "kernel_launch: unexpected shapes (n_in %d, out %d, ws %zu)\n", n_in, out_size, ws_size); grid = -1; return; }
        int dev = 0, cus = 0, per_cu = 0;
        hipGetDevice(&dev); hipDeviceGetAttribute(&cus, hipDeviceAttributeMultiprocessorCount, dev);
        if (hipFuncSetAttribute((const void*)fwd_kernel, hipFuncAttributeMaxDynamicSharedMemorySize, LDS_BYTES) != hipSuccess) { fprintf(stderr, "kernel_launch: hipFuncSetAttribute failed\n"); grid = -1; return; }
        if (hipOccupancyMaxActiveBlocksPerMultiprocessor(&per_cu, (const void*)fwd_kernel, 512, LDS_BYTES) != hipSuccess || per_cu < 1) { fprintf(stderr, "kernel_launch: occupancy query says %d\n", per_cu); per_cu = 1; }
        (void)hipGetLastError();
        grid = cus * (per_cu > 1 ? 1 : per_cu);
    }
    if (grid < 0) return;
    Ctx X{};
    for (int i = 0; i < 20; ++i) X.in[i] = (const float*)d_in[i];
    X.out = (float*)d_out; X.ws = (unsigned char*)d_ws;
    void* args[] = {&X};
    if (hipMemsetAsync((char*)d_ws + WS_CTL, 0, 16384, stream) != hipSuccess) { fprintf(stderr, "kernel_launch: hipMemsetAsync of the barrier words failed\n"); return; }
    hipError_t e = hipLaunchCooperativeKernel((const void*)fwd_kernel, dim3(grid), dim3(512), args, LDS_BYTES, stream);
    if (e != hipSuccess) fprintf(stderr, "cooperative launch failed: %s (grid %d)\n", hipGetErrorString(e), grid);
}
```

```cpp
#include <hip/hip_runtime.h>
#include <hip/hip_cooperative_groups.h>
#include <cstdio>
#include <cstdint>
namespace cg = cooperative_groups;

#ifndef MIX_MASK
#define MIX_MASK 15
#endif
namespace pg8 {
#define PG8_LAS __attribute__((address_space(3)))
typedef unsigned short bf16_t;
typedef short bf16x8 __attribute__((ext_vector_type(8)));
typedef float f32x4 __attribute__((ext_vector_type(4)));
typedef unsigned u32x4 __attribute__((ext_vector_type(4)));
constexpr int BM = 256, BK = 64, HALF = 128, HTB = HALF * BK * 2  , STAGE_BYTES = 8 * HTB, NXCD = 8, WGM = 8;

__host__ __device__ __forceinline__ int lds_byte(int r, int c) { const int st = (r >> 4) * 2 + (c >> 5), rr = r & 15, cc = c & 31, ob = rr * 64 + cc * 2; return st * 1024 + (ob ^ (((ob >> 9) & 1) << 5)); }
__host__ __device__ __forceinline__ void stage_rc(int b, int& R, int& C) { const int st = b / 1024, sb = b % 1024, swz = sb ^ (((sb >> 9) & 1) << 5); R = (st >> 1) * 16 + swz / 64; C = (st & 1) * 32 + (swz % 64) / 2; }
__host__ __device__ __forceinline__ int perm32(int rho) { const int n = rho >> 4, i = rho & 15; return 8 * (i >> 2) + 4 * n + (i & 3); }

struct Unit { int pm, pn; };
struct Gemm { const bf16_t* A; const bf16_t* Bt; int M, N, K; };

struct StaticOrder {
    int nM, nN, nwg, G, c;
    __host__ __device__ void init(int M, int N, int G_, int c_) { nM = M / BM; nN = N / BM; nwg = nM * nN; G = G_; c = c_; }
    __host__ __device__ bool next(int i, Unit& u) const {
        const long L = (long)i * G + c; if (L >= nwg) return false;
        int wgid = (int)L; { const int q = nwg / NXCD, r = nwg % NXCD, xcd = wgid % NXCD, off = wgid / NXCD; wgid = (xcd < r ? xcd * (q + 1) : r * (q + 1) + (xcd - r) * q) + off; }
        const int nig = WGM * nN, gid = wgid / nig, fm = gid * WGM, gsz = (nM - fm) < WGM ? (nM - fm) : WGM;
        u.pm = fm + ((wgid % nig) % gsz); u.pn = (wgid % nig) / gsz; return true;
    }
    __device__ __forceinline__ void a_ready(const Unit&) const {}
    __device__ __forceinline__ void done(const Unit&) const {}
};

__device__ __forceinline__ unsigned cvt_pk_bf16(float lo, float hi) { unsigned r; asm volatile("v_cvt_pk_bf16_f32 %0, %1, %2" : "=v"(r) : "v"(lo), "v"(hi)); return r; }
__device__ __forceinline__ float silu_f(float g) { return g * __builtin_amdgcn_rcpf(1.0f + __expf(-g)); }

struct EpiProj {
    static constexpr bool PERM = true, AFTER_DRAIN = false;
    bf16_t* O; int ldc; int ncols; const float* rowsq;
    __device__ __forceinline__ void pre(const Unit& u, int wr, int fr, float (&rsv)[8]) const {
#pragma unroll
        for (int i = 0; i < 8; ++i) rsv[i] = rowsq[u.pm * BM + wr * 64 + fr + (i >> 2) * HALF + (i & 3) * 16]; }
    __device__ __forceinline__ void operator()(const f32x4 (&acc)[2][2][4][2], const Unit& u, int wr, int wc, int fr, int fq, const float (&rsv)[8]) const {
        const int row0 = u.pm * BM + wr * 64 + fr; const int col0 = u.pn * BM + wc * 32 + 8 * fq;
#pragma unroll
        for (int ai = 0; ai < 2; ++ai)
#pragma unroll
            for (int m = 0; m < 4; ++m) { bf16_t* rowp = O + (size_t)(row0 + ai * HALF + m * 16) * ldc;
                const float rs = __builtin_amdgcn_rsqf(rsv[ai * 4 + m] * (1.0f / 1024.0f) + 1e-6f);
#pragma unroll
                for (int bj = 0; bj < 2; ++bj) { const int col = col0 + bj * HALF;
                    if (col < ncols) { const f32x4 v0 = acc[ai][bj][m][0] * rs, v1 = acc[ai][bj][m][1] * rs; u32x4 w;
                        w.x = cvt_pk_bf16(v0[0], v0[1]); w.y = cvt_pk_bf16(v0[2], v0[3]); w.z = cvt_pk_bf16(v1[0], v1[1]); w.w = cvt_pk_bf16(v1[2], v1[3]);
                        __builtin_nontemporal_store(w, (u32x4*)(rowp + col)); } } }
    }
};
struct EpiResid {
    static constexpr bool PERM = true, AFTER_DRAIN = false;
    const float* base_f; const bf16_t* base_b; float* out_f; bf16_t* out_b; int ldc; float* rowsq;
    __device__ __forceinline__ void pre(const Unit&, int, int, float (&)[8]) const {}
    __device__ __forceinline__ void operator()(const f32x4 (&acc)[2][2][4][2], const Unit& u, int wr, int wc, int fr, int fq, const float (&rsv)[8]) const {
        const int row0 = u.pm * BM + wr * 64 + fr; const int col0 = u.pn * BM + wc * 32 + 8 * fq;
#pragma unroll
        for (int ai = 0; ai < 2; ++ai)
#pragma unroll
            for (int m = 0; m < 4; ++m) { const size_t off = (size_t)(row0 + ai * HALF + m * 16) * ldc + col0; float sq = 0.f;
#pragma unroll
                for (int bj = 0; bj < 2; ++bj) { const size_t o_ = off + bj * HALF; f32x4 b0, b1;
                    if (base_b) { const u32x4 w = *(const u32x4*)(base_b + o_);
                        b0 = (f32x4){__uint_as_float(w.x << 16), __uint_as_float(w.x & 0xffff0000u), __uint_as_float(w.y << 16), __uint_as_float(w.y & 0xffff0000u)};
                        b1 = (f32x4){__uint_as_float(w.z << 16), __uint_as_float(w.z & 0xffff0000u), __uint_as_float(w.w << 16), __uint_as_float(w.w & 0xffff0000u)}; }
                    else { b0 = *(const f32x4*)(base_f + o_); b1 = *(const f32x4*)(base_f + o_ + 4); }
                    const f32x4 o0 = b0 + acc[ai][bj][m][0], o1 = b1 + acc[ai][bj][m][1];
                    if (out_f) { *(f32x4*)(out_f + o_) = o0; *(f32x4*)(out_f + o_ + 4) = o1; }
                    if (out_b) { u32x4 w; w.x = cvt_pk_bf16(o0[0], o0[1]); w.y = cvt_pk_bf16(o0[2], o0[3]); w.z = cvt_pk_bf16(o1[0], o1[1]); w.w = cvt_pk_bf16(o1[2], o1[3]); *(u32x4*)(out_b + o_) = w; }
                    sq += ((o0[0] * o0[0] + o0[1] * o0[1]) + (o0[2] * o0[2] + o0[3] * o0[3])) + ((o1[0] * o1[0] + o1[1] * o1[1]) + (o1[2] * o1[2] + o1[3] * o1[3])); }
                if (rowsq) { sq += __shfl_xor(sq, 16); sq += __shfl_xor(sq, 32); if (fq == 0) atomicAdd(rowsq + row0 + ai * HALF + m * 16, sq); } }
    }
};
struct EpiSwiglu {
    static constexpr bool PERM = true, AFTER_DRAIN = false;
    bf16_t* O; int ldc; const float* rowsq;
    __device__ __forceinline__ void pre(const Unit& u, int wr, int fr, float (&rsv)[8]) const {
#pragma unroll
        for (int i = 0; i < 8; ++i) rsv[i] = rowsq[u.pm * BM + wr * 64 + fr + (i >> 2) * HALF + (i & 3) * 16]; }
    __device__ __forceinline__ void operator()(const f32x4 (&acc)[2][2][4][2], const Unit& u, int wr, int wc, int fr, int fq, const float (&rsv)[8]) const {
        const int row0 = u.pm * BM + wr * 64 + fr; const int col0 = u.pn * HALF + wc * 32 + 8 * fq;
#pragma unroll
        for (int ai = 0; ai < 2; ++ai)
#pragma unroll
            for (int m = 0; m < 4; ++m) { bf16_t* rowp = O + (size_t)(row0 + ai * HALF + m * 16) * ldc + col0;
                const float rs = __builtin_amdgcn_rsqf(rsv[ai * 4 + m] * (1.0f / 1024.0f) + 1e-6f);
                const f32x4 g0 = acc[ai][0][m][0] * rs, g1 = acc[ai][0][m][1] * rs, u0 = acc[ai][1][m][0] * rs, u1 = acc[ai][1][m][1] * rs; u32x4 w;
                w.x = cvt_pk_bf16(silu_f(g0[0]) * u0[0], silu_f(g0[1]) * u0[1]); w.y = cvt_pk_bf16(silu_f(g0[2]) * u0[2], silu_f(g0[3]) * u0[3]);
                w.z = cvt_pk_bf16(silu_f(g1[0]) * u1[0], silu_f(g1[1]) * u1[1]); w.w = cvt_pk_bf16(silu_f(g1[2]) * u1[2], silu_f(g1[3]) * u1[3]);
                __builtin_nontemporal_store(w, (u32x4*)rowp); }
    }
};

template <class Epi, class Sched, bool ALIGN_EPI = false, bool SP2 = false>
__device__ __forceinline__ void gemm_phase(PG8_LAS unsigned char* lds, const Gemm g, const Sched& S, const Epi& E) {
    int tid_ = threadIdx.x; asm volatile("" : "+v"(tid_));
    const int tid = tid_, wid = __builtin_amdgcn_readfirstlane(tid >> 6), lane = tid & 63, wr = wid >> 2, wc = wid & 3, fr = lane & 15, fq = lane >> 4;
    const int K = g.K, nt = K / BK;
    unsigned voffA[2], voffB[2];
#pragma unroll
    for (int i = 0; i < 2; ++i) { int R, C; stage_rc(tid * 16 + i * 8192, R, C); const int Rb = Epi::PERM ? ((R & ~31) + perm32(R & 31)) : R;
        voffA[i] = (unsigned)(R * K + C) * 2u; voffB[i] = (unsigned)(Rb * K + C) * 2u; }
    const size_t kstep = (size_t)(BK * 2);
    const size_t hstep = (size_t)HALF * K * 2;
    const size_t tstep = 2 * hstep;
    const unsigned ldsw = (unsigned)wid * 1024u;
    const int aoff = lds_byte(wr * 64 + fr, fq * 8), boff = lds_byte(wc * 32 + fr, fq * 8);
#define PG8_SA(b, h) (((b) * 2 + (h)) * HTB)
#define PG8_SB(b, h) ((4 + (b) * 2 + (h)) * HTB)
#define PG8_STAGE(bufoff, gbase, voff) do { _Pragma("unroll") for (int _i = 0; _i < 2; ++_i) \
        __builtin_amdgcn_global_load_lds((const unsigned*)((const char*)(gbase) + (voff)[_i]), (PG8_LAS unsigned*)(lds + (bufoff) + ldsw + _i * 8192), 16, 0, 0); } while (0)
#define PG8_LDA(dst, b, h) do { _Pragma("unroll") for (int m = 0; m < 4; ++m) _Pragma("unroll") for (int k = 0; k < 2; ++k) dst[m][k] = *(const PG8_LAS bf16x8*)(lds + PG8_SA(b, h) + aoff + m * 2048 + k * 1024); } while (0)
#define PG8_LDB(dst, b, h) do { _Pragma("unroll") for (int n = 0; n < 2; ++n) _Pragma("unroll") for (int k = 0; k < 2; ++k) dst[n][k] = *(const PG8_LAS bf16x8*)(lds + PG8_SB(b, h) + boff + n * 2048 + k * 1024); } while (0)
#define PG8_MMA(ai, bj, At, Bt) do { __builtin_amdgcn_s_setprio(1); _Pragma("unroll") for (int m = 0; m < 4; ++m) _Pragma("unroll") for (int n = 0; n < 2; ++n) _Pragma("unroll") for (int k = 0; k < 2; ++k) \
        acc[ai][bj][m][n] = __builtin_amdgcn_mfma_f32_16x16x32_bf16(Bt[n][k], At[m][k], acc[ai][bj][m][n], 0, 0, 0); __builtin_amdgcn_s_setprio(0); } while (0)
#define PG8_WAIT_V(n) asm volatile("s_waitcnt vmcnt(" #n ")" ::: "memory")
#define PG8_WAIT_L(n) asm volatile("s_waitcnt lgkmcnt(" #n ")" ::: "memory")
#define PG8_BAR __builtin_amdgcn_s_barrier()
#define PG8_SCHED __builtin_amdgcn_sched_barrier(0)
    Unit cur, nxt; int ui = 0;
    float rsv[8];
    if (!S.next(0, cur)) return;
    f32x4 acc[2][2][4][2];
#pragma unroll
    for (int a = 0; a < 2; ++a)
#pragma unroll
        for (int b = 0; b < 2; ++b)
#pragma unroll
            for (int m = 0; m < 4; ++m)
#pragma unroll
                for (int n = 0; n < 2; ++n) acc[a][b][m][n] = (f32x4){0.f, 0.f, 0.f, 0.f};
    bf16x8 At[4][2], B0[2][2], B1[2][2];
    const char* cA = (const char*)g.A + (size_t)cur.pm * tstep; const char* cB = (const char*)g.Bt + (size_t)cur.pn * tstep;
    S.a_ready(cur);
    if constexpr (SP2) {
        PG8_STAGE(PG8_SB(0, 0), cB, voffB); PG8_STAGE(PG8_SB(0, 1), cB + hstep, voffB); PG8_STAGE(PG8_SA(0, 0), cA, voffA); PG8_STAGE(PG8_SA(0, 1), cA + hstep, voffA);
        if (wr == 1) PG8_BAR;
        PG8_WAIT_V(2); PG8_BAR;
        PG8_STAGE(PG8_SB(1, 0), cB + kstep, voffB); PG8_STAGE(PG8_SA(1, 0), cA + kstep, voffA); PG8_STAGE(PG8_SB(1, 1), cB + hstep + kstep, voffB);
        PG8_WAIT_V(6); PG8_BAR;
    } else {
        PG8_STAGE(PG8_SB(0, 0), cB, voffB); PG8_STAGE(PG8_SA(0, 0), cA, voffA); PG8_STAGE(PG8_SB(0, 1), cB + hstep, voffB); PG8_STAGE(PG8_SA(0, 1), cA + hstep, voffA);
        if (wr == 1) PG8_BAR;
        PG8_WAIT_V(4); PG8_BAR;
        PG8_STAGE(PG8_SB(1, 0), cB + kstep, voffB); PG8_STAGE(PG8_SA(1, 0), cA + kstep, voffA); PG8_STAGE(PG8_SB(1, 1), cB + hstep + kstep, voffB);
        PG8_WAIT_V(6); PG8_BAR;
    }
    for (;;) {
        const bool has_next = S.next(ui + 1, nxt);
        const char* nA = has_next ? (const char*)g.A + (size_t)nxt.pm * tstep : cA; const char* nB = has_next ? (const char*)g.Bt + (size_t)nxt.pn * tstep : cB;
        for (int t = 0; t < nt; t += 2) {
            const bool last = (t == nt - 2);
            const char* a1 = cA + (size_t)(t + 1) * kstep;
            const char* a2 = last ? nA : cA + (size_t)(t + 2) * kstep; const char* b2 = last ? nB : cB + (size_t)(t + 2) * kstep;
            const char* a3 = a2 + kstep; const char* b3 = b2 + kstep;
            if (last && has_next) S.a_ready(nxt);
            if (last) E.pre(cur, wr, fr, rsv);
            if constexpr (SP2) {
            PG8_LDB(B0, 0, 0); PG8_LDB(B1, 0, 1); PG8_SCHED; PG8_LDA(At, 0, 0); PG8_STAGE(PG8_SA(1, 1), a1 + hstep, voffA);
            PG8_WAIT_V(8); PG8_WAIT_L(0); PG8_BAR; PG8_MMA(0, 0, At, B0); PG8_MMA(0, 1, At, B1); PG8_BAR; PG8_SCHED;
            PG8_LDA(At, 0, 1); PG8_STAGE(PG8_SB(0, 0), b2, voffB); PG8_STAGE(PG8_SB(0, 1), b2 + hstep, voffB); PG8_STAGE(PG8_SA(0, 0), a2, voffA);
            PG8_WAIT_V(8); PG8_WAIT_L(0); PG8_BAR; PG8_MMA(1, 0, At, B0); PG8_MMA(1, 1, At, B1); PG8_BAR; PG8_SCHED;
            PG8_LDB(B0, 1, 0); PG8_LDB(B1, 1, 1); PG8_SCHED; PG8_LDA(At, 1, 0); PG8_STAGE(PG8_SA(0, 1), a2 + hstep, voffA);
            PG8_WAIT_V(8); PG8_WAIT_L(0); PG8_BAR; PG8_MMA(0, 0, At, B0); PG8_MMA(0, 1, At, B1); PG8_BAR; PG8_SCHED;
            PG8_LDA(At, 1, 1); PG8_STAGE(PG8_SB(1, 0), b3, voffB); PG8_STAGE(PG8_SB(1, 1), b3 + hstep, voffB); PG8_STAGE(PG8_SA(1, 0), a3, voffA);
            PG8_WAIT_V(8); PG8_WAIT_L(0); PG8_BAR; PG8_MMA(1, 0, At, B0); PG8_MMA(1, 1, At, B1); PG8_BAR; PG8_SCHED;
            } else {
            PG8_LDB(B0, 0, 0); PG8_SCHED; PG8_LDA(At, 0, 0); PG8_STAGE(PG8_SA(1, 1), a1 + hstep, voffA);
            PG8_WAIT_L(8); PG8_BAR; PG8_WAIT_L(0); PG8_MMA(0, 0, At, B0); PG8_BAR; PG8_SCHED;
            PG8_LDB(B1, 0, 1); PG8_STAGE(PG8_SB(0, 0), b2, voffB);
            PG8_BAR; PG8_WAIT_L(0); PG8_MMA(0, 1, At, B1); PG8_BAR;
            PG8_LDA(At, 0, 1); PG8_STAGE(PG8_SA(0, 0), a2, voffA);
            PG8_BAR; PG8_WAIT_L(0); PG8_MMA(1, 0, At, B0); PG8_BAR; PG8_SCHED;
            PG8_STAGE(PG8_SB(0, 1), b2 + hstep, voffB);
            PG8_WAIT_V(6); PG8_BAR; PG8_MMA(1, 1, At, B1); PG8_BAR;
            PG8_LDB(B0, 1, 0); PG8_SCHED; PG8_LDA(At, 1, 0); PG8_STAGE(PG8_SA(0, 1), a2 + hstep, voffA);
            PG8_WAIT_L(8); PG8_BAR; PG8_WAIT_L(0); PG8_MMA(0, 0, At, B0); PG8_BAR; PG8_SCHED;
            PG8_LDB(B1, 1, 1); PG8_STAGE(PG8_SB(1, 0), b3, voffB);
            PG8_BAR; PG8_WAIT_L(0); PG8_MMA(0, 1, At, B1); PG8_BAR;
            PG8_LDA(At, 1, 1); PG8_STAGE(PG8_SA(1, 0), a3, voffA);
            PG8_BAR; PG8_WAIT_L(0); PG8_MMA(1, 0, At, B0); PG8_BAR; PG8_SCHED;
            PG8_STAGE(PG8_SB(1, 1), b3 + hstep, voffB);
            PG8_WAIT_V(6); PG8_BAR; PG8_MMA(1, 1, At, B1); PG8_BAR;
            }
        }
        if constexpr (ALIGN_EPI) { if (wr == 0) PG8_BAR; }
        if constexpr (!Epi::AFTER_DRAIN) { E(acc, cur, wr, wc, fr, fq, rsv); S.done(cur); }
        if (!has_next) break;
#pragma unroll
        for (int a = 0; a < 2; ++a)
#pragma unroll
            for (int b = 0; b < 2; ++b)
#pragma unroll
                for (int m = 0; m < 4; ++m)
#pragma unroll
                    for (int n = 0; n < 2; ++n) acc[a][b][m][n] = (f32x4){0.f, 0.f, 0.f, 0.f};
        cur = nxt; cA = nA; cB = nB; ++ui;
        if constexpr (ALIGN_EPI) { if (wr == 1) PG8_BAR; }
    }
    PG8_WAIT_V(0);
    if constexpr (!ALIGN_EPI) { if (wr == 0) PG8_BAR; }
    PG8_BAR;
    if constexpr (Epi::AFTER_DRAIN) { E.fused(acc, cur, wr, wc, fr, fq, lds, wid, lane); S.done(cur); }
#undef PG8_SA
#undef PG8_SB
#undef PG8_STAGE
#undef PG8_LDA
#undef PG8_LDB
#undef PG8_MMA
#undef PG8_WAIT_V
#undef PG8_WAIT_L
#undef PG8_BAR
#undef PG8_SCHED
}
}

constexpr int NB = 4, T = 8192, D = 1024, DIN = 3592, NINP = 3584, DFF = 2816, NGU = 2 * DFF, DEPTH = 2;
constexpr int M = NB * T;
constexpr int NCH = T / 64;
constexpr int LDP = NINP;
constexpr int C_RQ = 0, C_RK = 256, C_RV = 512, C_RG = 768, C_CA = 1024, C_CG = 1280, C_GQ = 1536, C_GK = 1792, C_GV = 2048, C_GG = 2304,
              C_HQ = 2560, C_HF = 2816, C_HI = 3072, C_HG = 3328;
constexpr size_t MiB = 1u << 20;
constexpr size_t WS_CTL = 0;
constexpr size_t WS_WIN = 1 * MiB;
constexpr size_t WS_WOUT = 16 * MiB;
constexpr size_t WS_WGU = 20 * MiB;
constexpr size_t WS_WDN = 42 * MiB;
constexpr size_t WS_XN = 53 * MiB;
constexpr size_t WS_BCS = WS_XN;
constexpr size_t WS_MM = WS_XN + 48 * MiB;
constexpr size_t WS_MIX = 117 * MiB;
constexpr size_t WS_PROJ = 181 * MiB;
constexpr size_t WS_QEFF = 406 * MiB;
constexpr size_t WS_OLOC = 454 * MiB;
constexpr size_t WS_MVEC = 502 * MiB;
constexpr size_t WS_RSA = 503 * MiB;
constexpr size_t WS_RSB = 503 * MiB + 131072;
constexpr size_t WS_GBA = 503 * MiB + 262144;
constexpr size_t WS_WBA = 504 * MiB + 524288;
constexpr size_t WS_END = 505 * MiB;
constexpr int LDS_BYTES = 147456 + 256;
constexpr int LDS_BAR_OFF = 147456;
constexpr int HEAD_LDS = 73728;

#define LAS __attribute__((address_space(3)))
typedef unsigned short bf16_t;
typedef short bf16x8 __attribute__((ext_vector_type(8)));
typedef float f32x4 __attribute__((ext_vector_type(4)));
typedef unsigned u32x4 __attribute__((ext_vector_type(4)));
typedef unsigned u32x2 __attribute__((ext_vector_type(2)));
constexpr int LT = 72;
template <class Tp> __device__ __forceinline__ LAS Tp* opq(LAS Tp* p) { asm volatile("" : "+v"(p)); return p; }

__device__ __forceinline__ float bf_lo(unsigned u) { return __uint_as_float(u << 16); }
__device__ __forceinline__ float bf_hi(unsigned u) { return __uint_as_float(u & 0xffff0000u); }
__device__ __forceinline__ float bf2f(bf16_t b) { return __uint_as_float((unsigned)b << 16); }
__device__ __forceinline__ unsigned pk2(float lo, float hi) { return pg8::cvt_pk_bf16(lo, hi); }
__device__ __forceinline__ bf16_t f2bf(float f) { return (bf16_t)(pk2(f, 0.f) & 0xffffu); }
__device__ __forceinline__ float fexp(float x) { return __expf(x); }
__device__ __forceinline__ float frcp(float x) { return __builtin_amdgcn_rcpf(x); }
__device__ __forceinline__ float sigmoid_f(float x) { return frcp(1.0f + fexp(-x)); }
__device__ __forceinline__ float silu_acc(float x) { return x * frcp(1.0f + fexp(-x)); }
__device__ __forceinline__ float softplus_f(float x) { return fmaxf(x, 0.f) + log1pf(expf(-fabsf(x))); }
__device__ __forceinline__ float wave_sum(float v) {
#pragma unroll
    for (int o = 1; o < 64; o <<= 1) v += __shfl_xor(v, o);
    return v;
}
__device__ __forceinline__ void unpack8(const u32x4 w, float (&f)[8]) {
    f[0] = bf_lo(w.x); f[1] = bf_hi(w.x); f[2] = bf_lo(w.y); f[3] = bf_hi(w.y); f[4] = bf_lo(w.z); f[5] = bf_hi(w.z); f[6] = bf_lo(w.w); f[7] = bf_hi(w.w);
}
__device__ __forceinline__ u32x4 pack8(const float (&f)[8]) { u32x4 w; w.x = pk2(f[0], f[1]); w.y = pk2(f[2], f[3]); w.z = pk2(f[4], f[5]); w.w = pk2(f[6], f[7]); return w; }

struct Ctx {
    const float* in[20]; float* out; unsigned char* ws;
};
#define WSP(T_, off) ((T_*)(X.ws + (off)))

__device__ __forceinline__ f32x4 mma16(const LAS bf16_t* A, int a0, const LAS bf16_t* B, int b0, f32x4 acc, int r, int q) {
#pragma unroll
    for (int ks = 0; ks < 2; ++ks) {
        const bf16x8 a = *(const LAS bf16x8*)(A + (a0 + r) * LT + ks * 32 + q * 8);
        const bf16x8 b = *(const LAS bf16x8*)(B + (b0 + r) * LT + ks * 32 + q * 8);
        acc = __builtin_amdgcn_mfma_f32_16x16x32_bf16(a, b, acc, 0, 0, 0);
    }
    return acc;
}
__device__ __forceinline__ void store_oloc(bf16_t* oloc, int uid, int w4, int lane, const f32x4 (&acc)[4]) {
    u32x4* p = (u32x4*)(oloc + ((size_t)uid * 4 + w4) * 1024 + lane * 16);
    u32x4 a, b;
    a.x = pk2(acc[0][0], acc[0][1]); a.y = pk2(acc[0][2], acc[0][3]); a.z = pk2(acc[1][0], acc[1][1]); a.w = pk2(acc[1][2], acc[1][3]);
    b.x = pk2(acc[2][0], acc[2][1]); b.y = pk2(acc[2][2], acc[2][3]); b.z = pk2(acc[3][0], acc[3][1]); b.w = pk2(acc[3][2], acc[3][3]);
    p[0] = a; p[1] = b;
}
__device__ __forceinline__ void store_bc(bf16_t* bcs, int uid, int w4, int r, int q, const f32x4 (&acc)[4]) {
#pragma unroll
    for (int ct = 0; ct < 4; ++ct) { u32x2 w; w.x = pk2(acc[ct][0], acc[ct][1]); w.y = pk2(acc[ct][2], acc[ct][3]);
        *(u32x2*)(bcs + (size_t)uid * 4096 + ((ct * 4 + w4) * 64 + q * 16 + r) * 4) = w; }
}


typedef __attribute__((address_space(1))) unsigned gu32;
#define XB_TMO      128
#define XB_XCNT(j)  (256  + 64 * (j))
#define XB_XSUB(j)  (1280 + 64 * (j))
#define XB_XGEN(j)  (2304 + 64 * (j))
#define XB_TOP      3328
#define XB_TOPGEN   3392
#define XCD_BAR_WORDS 3456
#define XB_SPIN_CAP (1u << 18)

__device__ __forceinline__ unsigned xb_ld(unsigned* p)              { return __hip_atomic_load(p, __ATOMIC_RELAXED, __HIP_MEMORY_SCOPE_AGENT); }
__device__ __forceinline__ unsigned xb_add(unsigned* p, unsigned v) { return __hip_atomic_fetch_add(p, v, __ATOMIC_RELAXED, __HIP_MEMORY_SCOPE_AGENT); }
__device__ __forceinline__ unsigned xb_xcc_id() { return (unsigned)__builtin_amdgcn_s_getreg((3 << 11) | 20) & 0xFu; }
#define XB_SPIN(cond, bar) do { unsigned _sp = 0; while (cond) { __builtin_amdgcn_s_sleep(1); \
    if ((++_sp & 255u) == 0u) { if (xb_ld(&(bar)[XB_TMO])) break; if (_sp > XB_SPIN_CAP) { atomicAdd(&(bar)[XB_TMO], 1u); break; } } } } while (0)

struct XcdBarrier {
    unsigned* bar; unsigned x;
    volatile LAS unsigned* st;
};

__device__ __forceinline__ XcdBarrier xcd_barrier_post(unsigned* bar, volatile LAS unsigned* st) {
    XcdBarrier b; b.bar = bar; b.x = xb_xcc_id(); b.st = st;
    if (threadIdx.x == 0) (void)xb_add(&bar[XB_XCNT(b.x)], 1u);
    return b;
}
__device__ __forceinline__ void xcd_barrier_complete(unsigned* bar, unsigned x, unsigned& nloc, unsigned& nx) {
    const unsigned G = gridDim.x * gridDim.y * gridDim.z;
    unsigned sum, cnt, mine, sp = 0u;
    for (;;) {
        sum = 0u; cnt = 0u; mine = 0u;
#pragma unroll
        for (unsigned j = 0; j < 16; ++j) { const unsigned c = xb_ld(&bar[XB_XCNT(j)]); sum += c; cnt += (c > 0u) ? 1u : 0u; mine = (j == x) ? c : mine; }
        if (sum == G) break;
        __builtin_amdgcn_s_sleep(1);
        if ((++sp & 255u) == 0u) { if (xb_ld(&bar[XB_TMO])) break; if (sp > XB_SPIN_CAP) { atomicAdd(&bar[XB_TMO], 1u); break; } }
    }
    nloc = mine > 0u ? mine : 1u; nx = cnt > 0u ? cnt : 1u;
}

__device__ __forceinline__ void xcd_barrier(const XcdBarrier& b) {
    asm volatile("s_waitcnt vmcnt(0)" ::: "memory");
    __syncthreads();
    if (threadIdx.x == 0) {
        unsigned* bar = b.bar;
        __builtin_amdgcn_s_waitcnt(0);
        unsigned nloc = b.st[0], nx = b.st[1];
        if (nloc == 0u) { xcd_barrier_complete(bar, b.x, nloc, nx); b.st[0] = nloc; b.st[1] = nx; }
        const unsigned old = xb_add(&bar[XB_XSUB(b.x)], 1u);
        const unsigned gen = old / nloc;
        if (old + 1u == (gen + 1u) * nloc) {
            __builtin_amdgcn_fence(__ATOMIC_RELEASE, "agent");
            asm volatile("s_waitcnt vmcnt(0)" ::: "memory");
            const unsigned og = xb_add(&bar[XB_TOP], 1u);
            const unsigned tg = og / nx;
            if (og + 1u == (tg + 1u) * nx) xb_add(&bar[XB_TOPGEN], 1u);
            else XB_SPIN(xb_ld(&bar[XB_TOPGEN]) == tg, bar);
            __builtin_amdgcn_fence(__ATOMIC_ACQUIRE, "agent");
            xb_add(&bar[XB_XGEN(b.x)], 1u);
            asm volatile("s_waitcnt vmcnt(0)" ::: "memory");
        } else {
            XB_SPIN(xb_ld(&bar[XB_XGEN(b.x)]) == gen, bar);
            __builtin_amdgcn_fence(__ATOMIC_ACQUIRE, "agent");
            asm volatile("s_waitcnt vmcnt(0)" ::: "memory");
        }
    }
    __syncthreads();
}

__device__ __forceinline__ void transpose_item(const float* W, int K, int N, bf16_t* WT, int mode, LAS float* scr, int kb, int nb, int lane, const float* kscale, int coff) {
    const int k0 = 64 * kb, n0 = 32 * nb;
    const int nn = n0 + (lane & 31) + coff;
#pragma unroll 8
    for (int i = 0; i < 32; ++i) { const int kk = 2 * i + (lane >> 5); const float ksc = kscale ? kscale[k0 + kk] : 1.0f; scr[kk * 33 + (lane & 31)] = nn < N ? W[(size_t)(k0 + kk) * N + nn] * ksc : 0.f; }
    asm volatile("s_waitcnt lgkmcnt(0)" ::: "memory");
    const int c = lane & 7;
#pragma unroll
    for (int j = 0; j < 4; ++j) { const int n = (lane >> 3) + 8 * j; const LAS float* s = scr + (8 * c) * 33 + n;
        u32x4 o; o.x = pk2(s[0 * 33], s[1 * 33]); o.y = pk2(s[2 * 33], s[3 * 33]); o.z = pk2(s[4 * 33], s[5 * 33]); o.w = pk2(s[6 * 33], s[7 * 33]);
        const int ng = n0 + n; const int row = mode == 0 ? ng : ((ng >> 7) * 256 + (ng & 127) + (mode == 2 ? 128 : 0));
        *(u32x4*)(WT + (size_t)row * K + k0 + 8 * c) = o; }
    asm volatile("s_waitcnt lgkmcnt(0)" ::: "memory");
}
__device__ __forceinline__ void prep_weights(const Ctx& X, LAS unsigned char* lds, int gw, int ngw, int wave, int lane, int it_lo, int it_hi) {
    LAS float* scr = (LAS float*)(lds + wave * 16384);
    constexpr int I_IN = (D / 64) * (NINP / 32), I_OUT = (D / 64) * (D / 32), I_G = (D / 64) * (DFF / 32), I_DN = (DFF / 64) * (D / 32);
    constexpr int PER_L = I_IN + I_OUT + 2 * I_G + I_DN;
    asm volatile("" : "+v"(lane));
    for (int it = it_lo + gw; it < it_hi; it += ngw) {
        const int l = it / PER_L; int r = it % PER_L;
        if (r < I_IN) { transpose_item(X.in[2] + (size_t)l * D * DIN, D, DIN, WSP(bf16_t, WS_WIN) + (size_t)l * NINP * D, 0, scr, r / (NINP / 32), r % (NINP / 32), lane, X.in[1] + l * D, (r % (NINP / 32)) * 32 >= 2560 ? 8 : 0); continue; } r -= I_IN;
        if (r < I_OUT) { transpose_item(X.in[14] + (size_t)l * D * D, D, D, WSP(bf16_t, WS_WOUT) + (size_t)l * D * D, 0, scr, r / (D / 32), r % (D / 32), lane, nullptr, 0); continue; } r -= I_OUT;
        if (r < I_G) { transpose_item(X.in[16] + (size_t)l * D * DFF, D, DFF, WSP(bf16_t, WS_WGU) + (size_t)l * NGU * D, 1, scr, r / (DFF / 32), r % (DFF / 32), lane, X.in[15] + l * D, 0); continue; } r -= I_G;
        if (r < I_G) { transpose_item(X.in[17] + (size_t)l * D * DFF, D, DFF, WSP(bf16_t, WS_WGU) + (size_t)l * NGU * D, 2, scr, r / (DFF / 32), r % (DFF / 32), lane, X.in[15] + l * D, 0); continue; } r -= I_G;
        transpose_item(X.in[18] + (size_t)l * DFF * D, DFF, D, WSP(bf16_t, WS_WDN) + (size_t)l * D * DFF, 0, scr, r / (D / 32), r % (D / 32), lane, nullptr, 0);
    }
}
__device__ __forceinline__ void rms_row(const float* xrow, const float* w, bf16_t* orow, float* of, int lane) {
    const f32x4* xr = (const f32x4*)xrow + lane; const f32x4* wr = (const f32x4*)w + lane;
    f32x4 v[4]; float s = 0.f;
#pragma unroll
    for (int j = 0; j < 4; ++j) { v[j] = xr[64 * j]; s += (v[j].x * v[j].x + v[j].y * v[j].y) + (v[j].z * v[j].z + v[j].w * v[j].w); }
    const float rstd = 1.0f / sqrtf(wave_sum(s) * (1.f / D) + 1e-6f);
#pragma unroll
    for (int j = 0; j < 4; ++j) { const f32x4 ww = wr[64 * j]; const f32x4 o = v[j] * rstd * ww;
        if (of) ((f32x4*)of + lane)[64 * j] = o;
        else { u32x2 p; p.x = pk2(o.x, o.y); p.y = pk2(o.z, o.w); ((u32x2*)orow + lane)[64 * j] = p; } }
}
__device__ __forceinline__ void cast_phase(const float* x, bf16_t* xb, float* rowsq, int gw, int ngw, int lane) {
    asm volatile("" : "+v"(lane));
    for (int m = gw; m < M; m += ngw) {
        const f32x4* xr = (const f32x4*)(x + (size_t)m * D) + lane; float s = 0.f;
#pragma unroll
        for (int j = 0; j < 4; ++j) { const f32x4 v = xr[64 * j]; s += (v.x * v.x + v.y * v.y) + (v.z * v.z + v.w * v.w); u32x2 p; p.x = pk2(v.x, v.y); p.y = pk2(v.z, v.w); ((u32x2*)(xb + (size_t)m * D) + lane)[64 * j] = p; }
        s = wave_sum(s); if (lane == 0) rowsq[m] = s;
    }
}
__device__ __forceinline__ void norm_phase(const float* x, const float* w, bf16_t* xn, float* of, int gw, int ngw, int lane) {
    asm volatile("" : "+v"(lane));
    for (int m = gw; m < M; m += ngw) rms_row(x + (size_t)m * D, w, xn ? xn + (size_t)m * D : nullptr, of ? of + (size_t)m * D : nullptr, lane);
}

__device__ __forceinline__ int unit_id(int mixer, int b, int h, int c) { return ((mixer * 4 + b) * 4 + h) * NCH + c; }

__device__ __forceinline__ void ret_unit(const Ctx& X, LAS unsigned char* hl, int b, int c, int h, int tid_h, int w4, int lane) {
    LAS bf16_t* QR = opq((LAS bf16_t*)hl); LAS bf16_t* KR = opq(QR + 64 * LT); LAS bf16_t* KDT = opq(KR + 64 * LT); LAS bf16_t* VT = opq(KDT + 64 * LT); LAS bf16_t* P = opq(VT + 64 * LT);
    const bf16_t* proj = WSP(const bf16_t, WS_PROJ);
    const int uid = unit_id(0, b, h, c);
    const int r = lane & 15, q = lane >> 4;
    const float lg = log1pf(-exp2f(-5.0f - (float)h));
    {
        const int i = tid_h >> 2, sg = tid_h & 3, d0 = sg * 8;
        const bf16_t* pr = proj + ((size_t)b * T + c * 64 + i) * LDP;
        const u32x4 q1 = *(const u32x4*)(pr + C_RQ + h * 64 + d0), q2 = *(const u32x4*)(pr + C_RQ + h * 64 + d0 + 32);
        const u32x4 k1 = *(const u32x4*)(pr + C_RK + h * 64 + d0), k2 = *(const u32x4*)(pr + C_RK + h * 64 + d0 + 32);
        const u32x4 v1 = *(const u32x4*)(pr + C_RV + h * 64 + sg * 16), v2 = *(const u32x4*)(pr + C_RV + h * 64 + sg * 16 + 8);
        float qa[8], qb[8], ka[8], kb[8], va[8], vb[8];
        unpack8(q1, qa); unpack8(q2, qb); unpack8(k1, ka); unpack8(k2, kb); unpack8(v1, va); unpack8(v2, vb);
        const float pos = (float)(c * 64 + i);
        const float qd = fexp(lg * (float)(i + 1)), kd = fexp(lg * (float)(63 - i));
        float qr1[8], qr2[8], kr1[8], kr2[8], qe1[8], qe2[8];
#pragma unroll
        for (int e = 0; e < 8; ++e) {
            const float inv = exp2f(-(float)(d0 + e) * (13.287712379549449f / 32.0f));
            const float rev = __builtin_amdgcn_fractf(pos * inv * 0.15915494309189535f); const float sn = __builtin_amdgcn_sinf(rev), cs = __builtin_amdgcn_cosf(rev);
            qr1[e] = qa[e] * cs - qb[e] * sn; qr2[e] = qa[e] * sn + qb[e] * cs;
            kr1[e] = (ka[e] * cs - kb[e] * sn) * 0.125f; kr2[e] = (ka[e] * sn + kb[e] * cs) * 0.125f;
            qe1[e] = qr1[e] * qd; qe2[e] = qr2[e] * qd;
            KDT[(d0 + e) * LT + i] = f2bf(kr1[e] * kd); KDT[(d0 + 32 + e) * LT + i] = f2bf(kr2[e] * kd);
            VT[(sg * 16 + e) * LT + i] = f2bf(va[e]); VT[(sg * 16 + 8 + e) * LT + i] = f2bf(vb[e]);
        }
        *(LAS u32x4*)(QR + i * LT + d0) = pack8(qr1); *(LAS u32x4*)(QR + i * LT + d0 + 32) = pack8(qr2);
        *(LAS u32x4*)(KR + i * LT + d0) = pack8(kr1); *(LAS u32x4*)(KR + i * LT + d0 + 32) = pack8(kr2);
        bf16_t* qe = WSP(bf16_t, WS_QEFF) + (size_t)uid * 4096 + i * 64;
        *(u32x4*)(qe + d0) = pack8(qe1); *(u32x4*)(qe + d0 + 32) = pack8(qe2);
    }
    __syncthreads();
    f32x4 acc[4];
#pragma unroll
    for (int ct = 0; ct < 4; ++ct) acc[ct] = mma16(QR, 16 * w4, KR, 16 * ct, (f32x4){0.f, 0.f, 0.f, 0.f}, r, q);
#pragma unroll
    for (int ct = 0; ct < 4; ++ct)
#pragma unroll
        for (int j = 0; j < 4; ++j) { const int ii = 16 * w4 + 4 * q + j, col = 16 * ct + r;
            P[ii * LT + col] = f2bf(ii >= col ? acc[ct][j] * fexp(lg * (float)(ii - col)) : 0.f); }
    __syncthreads();
#pragma unroll
    for (int ct = 0; ct < 4; ++ct) acc[ct] = mma16(P, 16 * w4, VT, 16 * ct, (f32x4){0.f, 0.f, 0.f, 0.f}, r, q);
    store_oloc(WSP(bf16_t, WS_OLOC), uid, w4, lane, acc);
#pragma unroll
    for (int ct = 0; ct < 4; ++ct) acc[ct] = mma16(KDT, 16 * w4, VT, 16 * ct, (f32x4){0.f, 0.f, 0.f, 0.f}, r, q);
    store_bc(WSP(bf16_t, WS_BCS), uid, w4, r, q, acc);
    __syncthreads();
}

__device__ __forceinline__ void hgrn_unit(const Ctx& X, LAS unsigned char* hl, int b, int c, int h, int tid_h, int w4, int lane, int layer) {
    LAS bf16_t* QT = opq((LAS bf16_t*)hl);
    LAS float* Gt = opq((LAS float*)(hl + 9216));
    LAS bf16_t* Kt = opq((LAS bf16_t*)(hl + 25600));
    LAS bf16_t* KTI = opq((LAS bf16_t*)(hl + 34816));
    LAS bf16_t* VT = KTI; LAS bf16_t* KDT = opq(KTI + 64 * LT);
    LAS float* tot = opq((LAS float*)(hl + 57856));
    const bf16_t* proj = WSP(const bf16_t, WS_PROJ);
    const int uid = unit_id(2, b, h, c);
    const int r = lane & 15, q = lane >> 4;
    const int i = tid_h >> 2, ds = (tid_h & 3) * 16;
    const bf16_t* pr = proj + ((size_t)b * T + c * 64 + i) * LDP;
    float kk[16], qv[16], vv[16];
    {
        float ff[16];
        { float t0[8], t1[8]; unpack8(*(const u32x4*)(pr + C_HF + h * 64 + ds), t0); unpack8(*(const u32x4*)(pr + C_HF + h * 64 + ds + 8), t1);
#pragma unroll
          for (int e = 0; e < 8; ++e) { ff[e] = t0[e]; ff[8 + e] = t1[e]; } }
        { float t0[8], t1[8]; unpack8(*(const u32x4*)(pr + C_HQ + h * 64 + ds), t0); unpack8(*(const u32x4*)(pr + C_HQ + h * 64 + ds + 8), t1);
#pragma unroll
          for (int e = 0; e < 8; ++e) { qv[e] = t0[e]; qv[8 + e] = t1[e]; } }
        { float t0[8], t1[8]; unpack8(*(const u32x4*)(pr + C_HI + h * 64 + ds), t0); unpack8(*(const u32x4*)(pr + C_HI + h * 64 + ds + 8), t1);
#pragma unroll
          for (int e = 0; e < 8; ++e) { vv[e] = t0[e]; vv[8 + e] = t1[e]; } }
#pragma unroll
        for (int e = 0; e < 16; ++e) {
            const int ch = h * 64 + ds + e;
            const float lb = layer == 0 ? 0.f : sigmoid_f(X.in[12][256 + ch] - X.in[12][ch]);
            const float f = ff[e];
            const float ls = fminf(f, 0.f) - __logf(1.0f + fexp(-fabsf(f)));
            const float lf = layer == 0 ? ls : __logf(lb + (1.f - lb) * fexp(ls));
            kk[e] = (1.f - lb) * frcp(1.f + fexp(f));
            Gt[i * 64 + ds + e] = lf;
        }
    }
    __syncthreads();
    {
        const int d = tid_h & 63, seg = tid_h >> 6; float cs[16]; float run = 0.f;
#pragma unroll
        for (int jj = 0; jj < 16; ++jj) { run += Gt[(16 * seg + jj) * 64 + d]; cs[jj] = run; }
        tot[seg * 64 + d] = run;
        __syncthreads();
        float off = 0.f;
#pragma unroll
        for (int s = 0; s < 3; ++s) off += (s < seg) ? tot[s * 64 + d] : 0.f;
#pragma unroll
        for (int jj = 0; jj < 16; ++jj) Gt[(16 * seg + jj) * 64 + d] = cs[jj] + off;
    }
    __syncthreads();
    float Gi[16], G63[16];
    {
        const int I = i >> 4;
        float qt[16], qe[16];
#pragma unroll
        for (int e = 0; e < 16; ++e) { Gi[e] = Gt[i * 64 + ds + e]; G63[e] = Gt[63 * 64 + ds + e]; const float gr = Gt[(16 * I) * 64 + ds + e];
            qt[e] = qv[e] * fexp(Gi[e] - gr); qe[e] = qv[e] * fexp(Gi[e]); }
        u32x4 w0, w1;
        w0.x = pk2(qt[0], qt[1]); w0.y = pk2(qt[2], qt[3]); w0.z = pk2(qt[4], qt[5]); w0.w = pk2(qt[6], qt[7]);
        w1.x = pk2(qt[8], qt[9]); w1.y = pk2(qt[10], qt[11]); w1.z = pk2(qt[12], qt[13]); w1.w = pk2(qt[14], qt[15]);
        *(LAS u32x4*)(QT + i * LT + ds) = w0; *(LAS u32x4*)(QT + i * LT + ds + 8) = w1;
        w0.x = pk2(qe[0], qe[1]); w0.y = pk2(qe[2], qe[3]); w0.z = pk2(qe[4], qe[5]); w0.w = pk2(qe[6], qe[7]);
        w1.x = pk2(qe[8], qe[9]); w1.y = pk2(qe[10], qe[11]); w1.z = pk2(qe[12], qe[13]); w1.w = pk2(qe[14], qe[15]);
        bf16_t* qg = WSP(bf16_t, WS_QEFF) + (size_t)uid * 4096 + i * 64 + ds;
        *(u32x4*)qg = w0; *(u32x4*)(qg + 8) = w1;
        w0.x = pk2(kk[0], kk[1]); w0.y = pk2(kk[2], kk[3]); w0.z = pk2(kk[4], kk[5]); w0.w = pk2(kk[6], kk[7]);
        w1.x = pk2(kk[8], kk[9]); w1.y = pk2(kk[10], kk[11]); w1.z = pk2(kk[12], kk[13]); w1.w = pk2(kk[14], kk[15]);
        *(LAS u32x4*)(Kt + i * LT + ds) = w0; *(LAS u32x4*)(Kt + i * LT + ds + 8) = w1;
        if (i == 63) { float* mv = WSP(float, WS_MVEC) + (size_t)(uid - 2 * 2048) * 64 + ds;
#pragma unroll
            for (int e = 0; e < 16; ++e) mv[e] = fexp(G63[e]); }
    }
    __syncthreads();
    const int I = w4;
    LAS bf16_t* KI = opq(KTI + (8 * I * (I + 1)) * LT);
    {
        const int nit = 16 * (I + 1) * 8;
        for (int idx = lane; idx < nit; idx += 64) { const int j = idx >> 3, d8 = (idx & 7) * 8;
            float kf[8]; unpack8(*(const LAS u32x4*)(Kt + j * LT + d8), kf);
            float o[8];
#pragma unroll
            for (int e = 0; e < 8; ++e) o[e] = kf[e] * fexp(fminf(Gt[(16 * I) * 64 + d8 + e] - Gt[j * 64 + d8 + e], 80.f));
            *(LAS u32x4*)(KI + j * LT + d8) = pack8(o); }
    }
    __syncthreads();
    f32x4 acc[4];
    {
        bf16x8 a[2];
#pragma unroll
        for (int ks = 0; ks < 2; ++ks) a[ks] = *(const LAS bf16x8*)(QT + (16 * I + r) * LT + ks * 32 + q * 8);
#pragma unroll
        for (int ct = 0; ct < 4; ++ct) { acc[ct] = (f32x4){0.f, 0.f, 0.f, 0.f};
            if (ct <= I) {
#pragma unroll
                for (int ks = 0; ks < 2; ++ks) { const bf16x8 bb = *(const LAS bf16x8*)(KI + (16 * ct + r) * LT + ks * 32 + q * 8);
                    acc[ct] = __builtin_amdgcn_mfma_f32_16x16x32_bf16(a[ks], bb, acc[ct], 0, 0, 0); } } }
        asm volatile("s_waitcnt lgkmcnt(0)" ::: "memory");
#pragma unroll
        for (int ct = 0; ct < 4; ++ct)
#pragma unroll
            for (int j = 0; j < 4; ++j) { const int ii = 16 * I + 4 * q + j, col = 16 * ct + r;
                QT[ii * LT + col] = f2bf((ct <= I && ii >= col) ? acc[ct][j] : 0.f); }
    }
    __syncthreads();
    {
#pragma unroll
        for (int e = 0; e < 16; ++e) { VT[(ds + e) * LT + i] = f2bf(vv[e]); KDT[(ds + e) * LT + i] = f2bf(kk[e] * fexp(G63[e] - Gi[e])); }
    }
    __syncthreads();
#pragma unroll
    for (int ct = 0; ct < 4; ++ct) acc[ct] = mma16(QT, 16 * w4, VT, 16 * ct, (f32x4){0.f, 0.f, 0.f, 0.f}, r, q);
    store_oloc(WSP(bf16_t, WS_OLOC), uid, w4, lane, acc);
#pragma unroll
    for (int ct = 0; ct < 4; ++ct) acc[ct] = mma16(KDT, 16 * w4, VT, 16 * ct, (f32x4){0.f, 0.f, 0.f, 0.f}, r, q);
    store_bc(WSP(bf16_t, WS_BCS), uid, w4, r, q, acc);
    __syncthreads();
}

__device__ __forceinline__ void gdn_unit(const Ctx& X, LAS unsigned char* hl, int b, int c, int h, int tid_h, int w4, int lane, int layer) {
    LAS bf16_t* Q = opq((LAS bf16_t*)hl); LAS bf16_t* K = opq(Q + 64 * LT); LAS bf16_t* KB = opq(K + 64 * LT); LAS bf16_t* V = opq(KB + 64 * LT); LAS bf16_t* KDT = opq(V + 64 * LT); LAS bf16_t* P = opq(KDT + 64 * LT);
    LAS bf16_t* WT = KB; LAS bf16_t* UT = V;
    LAS bf16_t* AB = opq((LAS bf16_t*)(hl + 55296));
    LAS float* ACCS = opq((LAS float*)(hl + 64512));
    LAS float* Gs = opq((LAS float*)(hl + 72704));
    LAS float* Bs = opq(Gs + 64);
    const bf16_t* proj = WSP(const bf16_t, WS_PROJ);
    const int uid = unit_id(1, b, h, c);
    const int r = lane & 15, q = lane >> 4;
    {
    LAS bf16_t* RAW = opq((LAS bf16_t*)(hl + 46080));
    const int cseg = tid_h & 7, i0 = tid_h >> 3;
    f32x4 wq[3][4][2];
    {
        const float* cw = X.in[8] + (size_t)layer * 4 * 768 + h * 64 + cseg * 8;
#pragma unroll
        for (int tn = 0; tn < 3; ++tn)
#pragma unroll
            for (int k = 0; k < 4; ++k) { const f32x4* wp = (const f32x4*)(cw + k * 768 + tn * 256); wq[tn][k][0] = wp[0]; wq[tn][k][1] = wp[1]; }
        u32x4 rawv[7];
#pragma unroll
        for (int n = 0; n < 7; ++n) { const int item = tid_h + 256 * n; const int seg = item & 7; int rowid = item >> 3; rowid = rowid < 201 ? rowid : 200;
            const int tn = rowid / 67, rr = rowid - tn * 67; const int tt = c * 64 - 3 + rr; const int ttc = tt < 0 ? 0 : tt;
            const u32x4 v = *(const u32x4*)(proj + ((size_t)b * T + ttc) * LDP + C_GQ + tn * 256 + h * 64 + seg * 8);
            rawv[n] = tt < 0 ? (u32x4){0u, 0u, 0u, 0u} : v; }
        float g = 0.f, bt = 0.f;
        if (tid_h < 64) {
            const bf16_t* pr = proj + ((size_t)b * T + c * 64 + tid_h) * LDP;
            const float* gba = WSP(const float, WS_GBA) + ((size_t)b * T + c * 64 + tid_h) * 8; const float gb = gba[h], ga = gba[4 + h];
            g = -fexp(X.in[9][layer * 4 + h]) * softplus_f(ga + X.in[10][layer * 4 + h]);
#pragma unroll
            for (int o = 1; o < 64; o <<= 1) { const float t = __shfl_up(g, o); if (lane >= o) g += t; }
            bt = sigmoid_f(gb);
            Gs[tid_h] = g; Bs[tid_h] = bt;
        }
#pragma unroll
        for (int n = 0; n < 7; ++n) { const int item = tid_h + 256 * n; if (item < 1608) *(LAS u32x4*)(RAW + (item >> 3) * 64 + (item & 7) * 8) = rawv[n]; }
    }
    __syncthreads();
    {
        const float G63 = Gs[63];
#pragma unroll
        for (int rs = 0; rs < 2; ++rs) {
            const int i = i0 + 32 * rs;
            const float bi = Bs[i], Gi = Gs[i];
            float y[3][8];
#pragma unroll
            for (int tn = 0; tn < 3; ++tn) {
#pragma unroll
                for (int e = 0; e < 8; ++e) y[tn][e] = 0.f;
#pragma unroll
                for (int k = 0; k < 4; ++k) { float x8[8]; unpack8(*(const LAS u32x4*)(RAW + (tn * 67 + i + k) * 64 + cseg * 8), x8);
                    y[tn][0] += wq[tn][k][0].x * x8[0]; y[tn][1] += wq[tn][k][0].y * x8[1]; y[tn][2] += wq[tn][k][0].z * x8[2]; y[tn][3] += wq[tn][k][0].w * x8[3];
                    y[tn][4] += wq[tn][k][1].x * x8[4]; y[tn][5] += wq[tn][k][1].y * x8[5]; y[tn][6] += wq[tn][k][1].z * x8[6]; y[tn][7] += wq[tn][k][1].w * x8[7]; }
#pragma unroll
                for (int e = 0; e < 8; ++e) y[tn][e] = silu_acc(y[tn][e]);
            }
            float sq = 0.f, sk = 0.f;
#pragma unroll
            for (int e = 0; e < 8; ++e) { sq += y[0][e] * y[0][e]; sk += y[1][e] * y[1][e]; }
            sq += __shfl_xor(sq, 1); sq += __shfl_xor(sq, 2); sq += __shfl_xor(sq, 4);
            sk += __shfl_xor(sk, 1); sk += __shfl_xor(sk, 2); sk += __shfl_xor(sk, 4);
            const float rq = 0.125f * rsqrtf(sq + 1e-6f), rk = rsqrtf(sk + 1e-6f), kd = rk * fexp(G63 - Gi);
            float t8[8];
#pragma unroll
            for (int e = 0; e < 8; ++e) t8[e] = y[0][e] * rq;
            *(LAS u32x4*)(Q + i * LT + cseg * 8) = pack8(t8);
#pragma unroll
            for (int e = 0; e < 8; ++e) t8[e] = y[1][e] * rk;
            *(LAS u32x4*)(K + i * LT + cseg * 8) = pack8(t8);
#pragma unroll
            for (int e = 0; e < 8; ++e) t8[e] = y[1][e] * rk * bi;
            *(LAS u32x4*)(KB + i * LT + cseg * 8) = pack8(t8);
            *(LAS u32x4*)(V + i * LT + cseg * 8) = pack8(y[2]);
#pragma unroll
            for (int e = 0; e < 8; ++e) KDT[(cseg * 8 + e) * LT + i] = f2bf(y[1][e] * kd);
        }
    }
    __syncthreads();
    }
    {
        f32x4 aA[4], aP[4];
#pragma unroll
        for (int ct = 0; ct < 4; ++ct) { aA[ct] = mma16(KB, 16 * w4, K, 16 * ct, (f32x4){0.f, 0.f, 0.f, 0.f}, r, q); aP[ct] = mma16(Q, 16 * w4, K, 16 * ct, (f32x4){0.f, 0.f, 0.f, 0.f}, r, q); }
#pragma unroll
        for (int ct = 0; ct < 4; ++ct)
#pragma unroll
            for (int j = 0; j < 4; ++j) { const int ii = 16 * w4 + 4 * q + j, col = 16 * ct + r;
                const float L = fexp(fminf(Gs[ii] - Gs[col], 0.f));
                AB[ii * LT + col] = f2bf(ii > col ? aA[ct][j] * L : 0.f);
                P[ii * LT + col] = f2bf(ii >= col ? aP[ct][j] * L : 0.f); }
    }
    __syncthreads();
    float rc[64];
    if (w4 < 2) {
        const int col = tid_h & 63; const LAS bf16_t* src = w4 == 0 ? V : KB;
#pragma unroll
        for (int i = 0; i < 64; ++i) { const float sc = w4 == 0 ? Bs[i] : fexp(Gs[i]); rc[i] = bf2f(src[i * LT + col]) * sc; }
    }
    __syncthreads();
    {
    for (int idx = tid_h; idx < 1152; idx += 256) { const int tl = idx >= 576; const int rem = idx - tl * 576; *(LAS u32x4*)((tl ? KB : V) + rem * 8) = (u32x4){0u, 0u, 0u, 0u}; }
    __syncthreads();
#pragma unroll
    for (int I = 0; I < 4; ++I) {
        if (I > 0) {
#pragma unroll
            for (int t2 = 0; t2 < 2; ++t2) { const int ct8 = 2 * w4 + t2; const LAS bf16_t* Bt = ct8 < 4 ? UT : WT;
                const f32x4 a = mma16(AB, 16 * I, Bt, 16 * (ct8 & 3), (f32x4){0.f, 0.f, 0.f, 0.f}, r, q);
#pragma unroll
                for (int j = 0; j < 4; ++j) ACCS[(4 * q + j) * 128 + 16 * ct8 + r] = a[j]; }
            __syncthreads();
        }
        if (w4 < 2) {
            const int col = tid_h & 63, c128 = w4 * 64 + col;
            float t[16];
#pragma unroll
            for (int ii = 0; ii < 16; ++ii) t[ii] = rc[16 * I + ii] - (I > 0 ? ACCS[ii * 128 + c128] : 0.f);
#pragma unroll
            for (int ii = 1; ii < 16; ++ii) {
                float a16[16];
                { float lo[8]; unpack8(*(const LAS u32x4*)(AB + (16 * I + ii) * LT + 16 * I), lo);
#pragma unroll
                  for (int e = 0; e < 8; ++e) a16[e] = lo[e]; }
                if (ii > 8) { float hi[8]; unpack8(*(const LAS u32x4*)(AB + (16 * I + ii) * LT + 16 * I + 8), hi);
#pragma unroll
                  for (int e = 0; e < 8; ++e) a16[8 + e] = hi[e]; }
                float s0 = t[ii], s1 = 0.f;
#pragma unroll
                for (int kk = 0; kk < ii; ++kk) { if (kk & 1) s1 -= a16[kk] * t[kk]; else s0 -= a16[kk] * t[kk]; }
                t[ii] = s0 + s1;
            }
            LAS bf16_t* dst = (w4 == 0 ? UT : WT) + col * LT + 16 * I;
            u32x4 w0, w1;
            w0.x = pk2(t[0], t[1]); w0.y = pk2(t[2], t[3]); w0.z = pk2(t[4], t[5]); w0.w = pk2(t[6], t[7]);
            w1.x = pk2(t[8], t[9]); w1.y = pk2(t[10], t[11]); w1.z = pk2(t[12], t[13]); w1.w = pk2(t[14], t[15]);
            *(LAS u32x4*)dst = w0; *(LAS u32x4*)(dst + 8) = w1;
        }
        __syncthreads();
    }
    }
    {
        f32x4 acc[4];
        const float eG63 = fexp(Gs[63]);
#pragma unroll
        for (int ct = 0; ct < 4; ++ct) acc[ct] = mma16(P, 16 * w4, WT, 16 * ct, (f32x4){0.f, 0.f, 0.f, 0.f}, r, q);
        bf16_t* qe = WSP(bf16_t, WS_QEFF) + (size_t)uid * 4096;
#pragma unroll
        for (int ct = 0; ct < 4; ++ct)
#pragma unroll
            for (int j = 0; j < 4; ++j) { const int ii = 16 * w4 + 4 * q + j, col = 16 * ct + r;
                qe[ii * 64 + col] = f2bf(bf2f(Q[ii * LT + col]) * fexp(Gs[ii]) - acc[ct][j]); }
#pragma unroll
        for (int ct = 0; ct < 4; ++ct) acc[ct] = mma16(P, 16 * w4, UT, 16 * ct, (f32x4){0.f, 0.f, 0.f, 0.f}, r, q);
        store_oloc(WSP(bf16_t, WS_OLOC), uid, w4, lane, acc);
#pragma unroll
        for (int ct = 0; ct < 4; ++ct) acc[ct] = mma16(KDT, 16 * w4, WT, 16 * ct, (f32x4){0.f, 0.f, 0.f, 0.f}, r, q);
        bf16_t* mm = WSP(bf16_t, WS_MM) + (size_t)(uid - 2048) * 4096;
#pragma unroll
        for (int ct = 0; ct < 4; ++ct)
#pragma unroll
            for (int j = 0; j < 4; ++j) { const int ii = 16 * w4 + 4 * q + j, col = 16 * ct + r;
                mm[((w4 * 2 + (ct >> 1)) * 64 + (r >> 2) * 16 + 4 * q + j) * 8 + (ct & 1) * 4 + (r & 3)] = f2bf((ii == col ? eG63 : 0.f) - acc[ct][j]); }
#pragma unroll
        for (int ct = 0; ct < 4; ++ct) acc[ct] = mma16(KDT, 16 * w4, UT, 16 * ct, (f32x4){0.f, 0.f, 0.f, 0.f}, r, q);
        store_bc(WSP(bf16_t, WS_BCS), uid, w4, r, q, acc);
    }
    __syncthreads();
}

__device__ __forceinline__ void conf_unit(const Ctx& X, LAS unsigned char* lds, int b, int c, int tid, int wave, int lane, int layer) {
    LAS bf16_t* GL = opq((LAS bf16_t*)lds);
    LAS float* Y = opq((LAS float*)(lds + 49152));
    const bf16_t* proj = WSP(const bf16_t, WS_PROJ);
    bf16_t* mix = WSP(bf16_t, WS_MIX);
    const int t0 = c * 64;
    float w[31]; float bias;
    { const int ch = tid & 255; const float* cw = X.in[4] + (size_t)layer * 31 * 256 + ch;
#pragma unroll
      for (int k = 0; k < 31; ++k) w[k] = cw[k * 256];
      bias = X.in[5][layer * 256 + ch]; }
    {
        u32x4 av[6], gvv[6];
#pragma unroll
        for (int n = 0; n < 6; ++n) { int item = tid + 512 * n; item = item < 94 * 32 ? item : 94 * 32 - 1; const int rr = item >> 5, seg = (item & 31) * 8; int tt = t0 - 30 + rr; tt = tt < 0 ? 0 : tt;
            const bf16_t* pr = proj + ((size_t)b * T + tt) * LDP; av[n] = *(const u32x4*)(pr + C_CA + seg); gvv[n] = *(const u32x4*)(pr + C_CG + seg); }
#pragma unroll
        for (int n = 0; n < 6; ++n) { const int item = tid + 512 * n; if (item < 94 * 32) { const int rr = item >> 5, seg = (item & 31) * 8, tt = t0 - 30 + rr;
            u32x4 w = (u32x4){0u, 0u, 0u, 0u};
            if (tt >= 0) { float a[8], g[8], o[8]; unpack8(av[n], a); unpack8(gvv[n], g);
#pragma unroll
                for (int e = 0; e < 8; ++e) o[e] = a[e] * sigmoid_f(g[e]);
                w = pack8(o); }
            *(LAS u32x4*)(GL + rr * 256 + seg) = w; } }
    }
    __syncthreads();
    {
        const int ch = tid & 255, half = tid >> 8;
        float acc[32];
#pragma unroll
        for (int tk = 0; tk < 32; ++tk) acc[tk] = bias;
#pragma unroll
        for (int rr = 0; rr < 62; ++rr) { const float g = bf2f(GL[(half * 32 + rr) * 256 + ch]);
#pragma unroll
            for (int tk = 0; tk < 32; ++tk) { const int k = rr - tk; if (k >= 0 && k < 31) acc[tk] += w[k] * g; } }
#pragma unroll
        for (int tk = 0; tk < 32; ++tk) Y[(half * 32 + tk) * 256 + ch] = acc[tk];
    }
    __syncthreads();
    {
        const f32x4 lw = *((const f32x4*)(X.in[6] + layer * 256) + lane), lb = *((const f32x4*)(X.in[7] + layer * 256) + lane);
#pragma unroll 2
        for (int tk = wave * 8; tk < wave * 8 + 8; ++tk) {
            const f32x4 v = *((const LAS f32x4*)(Y + tk * 256) + lane);
            const float mu = wave_sum((v.x + v.y) + (v.z + v.w)) * (1.f / 256.f);
            const f32x4 dv = v - mu;
            const float var = wave_sum((dv.x * dv.x + dv.y * dv.y) + (dv.z * dv.z + dv.w * dv.w)) * (1.f / 256.f);
            const float rs = rsqrtf(var + 1e-5f);
            f32x4 o = dv * rs * lw + lb;
            const bool on = (MIX_MASK & 2) != 0;
            u32x2 p; p.x = on ? pk2(silu_acc(o.x), silu_acc(o.y)) : 0u; p.y = on ? pk2(silu_acc(o.z), silu_acc(o.w)) : 0u;
            *(u32x2*)(mix + ((size_t)b * T + t0 + tk) * D + 256 + lane * 4) = p;
        }
    }
    __syncthreads();
}

__device__ __forceinline__ void mixer_local_phase(const Ctx& X, LAS unsigned char* lds, int layer, int tid, int wave, int lane) {
    const int hs = wave >> 2, w4 = wave & 3; int tid_h = tid & 255;
    LAS unsigned char* hl = lds + hs * HEAD_LDS;
    const int nit_ = (3584 + (int)gridDim.x - 1) / (int)gridDim.x;
    for (int it_ = 0; it_ < nit_; ++it_) {
        const int u = (int)blockIdx.x + (int)gridDim.x * ((it_ + (int)(blockIdx.x >> 3)) % nit_);
        if (u >= 3584) continue;
        asm volatile("" : "+v"(tid_h), "+v"(lane), "+v"(tid));
        if (u < 3072) { const int mixer = u >> 10, idx = u & 1023, hp = idx & 1, cb = idx >> 1, b = cb >> 7, c = cb & 127, h = hp * 2 + hs;
            if (mixer == 0) { ret_unit(X, hl, b, c, h, tid_h, w4, lane);
            } else if (mixer == 1) { gdn_unit(X, hl, b, c, h, tid_h, w4, lane, layer);
            } else { hgrn_unit(X, hl, b, c, h, tid_h, w4, lane, layer);
            }
        } else { const int cb = u - 3072; conf_unit(X, lds, cb >> 7, cb & 127, tid, wave, lane, layer);
        }
    }
}

__device__ __forceinline__ void scan_phase(const Ctx& X, int wave, int lane) {
    const int job = blockIdx.x;
    if (job >= 192 || wave != 0) return;
    asm volatile("" : "+v"(lane));
    const int mixer = job >> 6, rem = job & 63, bh = rem >> 2, vg = rem & 3;
    const int uid0 = (mixer * 16 + bh) * NCH;
    const int r = lane & 15, q = lane >> 4;
    bf16_t* bc0 = WSP(bf16_t, WS_BCS) + (size_t)uid0 * 4096 + (vg * 4 * 64 + lane) * 4;
    float S[4][4];
#pragma unroll
    for (int t = 0; t < 4; ++t)
#pragma unroll
        for (int j = 0; j < 4; ++j) S[t][j] = 0.f;
    if (mixer == 1) {
        const bf16_t* mm0 = WSP(const bf16_t, WS_MM) + (size_t)(uid0 - 2048) * 4096;
        u32x2 cb[4][4], ca[4][4][2][2];
#define SCAN_LOAD_G(slot, cc) { const int c_ = (cc) < NCH ? (cc) : NCH - 1; const bf16_t* bcn = bc0 + (size_t)c_ * 4096; const bf16_t* mmn = mm0 + (size_t)c_ * 4096; \
            _Pragma("unroll") for (int t = 0; t < 4; ++t) { cb[slot][t] = *(const u32x2*)(bcn + 256 * t); \
                _Pragma("unroll") for (int s2 = 0; s2 < 2; ++s2) { const u32x4 w_ = *(const u32x4*)(mmn + ((t * 2 + s2) * 64 + lane) * 8); ca[slot][t][s2][0] = (u32x2){w_.x, w_.y}; ca[slot][t][s2][1] = (u32x2){w_.z, w_.w}; } } }
        SCAN_LOAD_G(0, 0) SCAN_LOAD_G(1, 1) SCAN_LOAD_G(2, 2)
#pragma unroll 1
        for (int c0 = 0; c0 < NCH; c0 += 4) {
#pragma unroll
            for (int k = 0; k < 4; ++k) {
                const int c = c0 + k;
                SCAN_LOAD_G((k + 3) & 3, c + 3)
                bf16_t* bcc = bc0 + (size_t)c * 4096;
                u32x2 sp[4];
#pragma unroll
                for (int t = 0; t < 4; ++t) { sp[t].x = pk2(S[t][0], S[t][1]); sp[t].y = pk2(S[t][2], S[t][3]);
                    asm volatile("" : "+v"(sp[t].x) : "v"(cb[k][t].x));
                    *(u32x2*)(bcc + 256 * t) = sp[t]; }
                bf16x8 bfr[2];
#pragma unroll
                for (int s2 = 0; s2 < 2; ++s2) { u32x4 w; w.x = sp[2 * s2].x; w.y = sp[2 * s2].y; w.z = sp[2 * s2 + 1].x; w.w = sp[2 * s2 + 1].y; bfr[s2] = __builtin_bit_cast(bf16x8, w); }
#pragma unroll
                for (int t = 0; t < 4; ++t) {
                    f32x4 acc = (f32x4){bf_lo(cb[k][t].x), bf_hi(cb[k][t].x), bf_lo(cb[k][t].y), bf_hi(cb[k][t].y)};
#pragma unroll
                    for (int s2 = 0; s2 < 2; ++s2) { u32x4 w; w.x = ca[k][t][s2][0].x; w.y = ca[k][t][s2][0].y; w.z = ca[k][t][s2][1].x; w.w = ca[k][t][s2][1].y;
                        acc = __builtin_amdgcn_mfma_f32_16x16x32_bf16(__builtin_bit_cast(bf16x8, w), bfr[s2], acc, 0, 0, 0); }
                    S[t][0] = acc[0]; S[t][1] = acc[1]; S[t][2] = acc[2]; S[t][3] = acc[3];
                }
            }
        }
#undef SCAN_LOAD_G
    } else {
        const int h = bh & 3;
        const float g64 = __expf(64.0f * log1pf(-exp2f(-5.0f - (float)h)));
        const float* mv0 = WSP(const float, WS_MVEC) + (size_t)(mixer == 2 ? uid0 - 2 * 2048 : 0) * 64 + 4 * q;
        u32x2 cb[4][4]; f32x4 cm[4][4];
#define SCAN_LOAD_D(slot, cc) { const int c_ = (cc) < NCH ? (cc) : NCH - 1; const bf16_t* bcn = bc0 + (size_t)c_ * 4096; \
            _Pragma("unroll") for (int t = 0; t < 4; ++t) { cb[slot][t] = *(const u32x2*)(bcn + 256 * t); cm[slot][t] = mixer == 2 ? *(const f32x4*)(mv0 + (size_t)c_ * 64 + 16 * t) : (f32x4){g64, g64, g64, g64}; } }
        SCAN_LOAD_D(0, 0) SCAN_LOAD_D(1, 1) SCAN_LOAD_D(2, 2)
#pragma unroll 1
        for (int c0 = 0; c0 < NCH; c0 += 4) {
#pragma unroll
            for (int k = 0; k < 4; ++k) {
                const int c = c0 + k;
                SCAN_LOAD_D((k + 3) & 3, c + 3)
                bf16_t* bcc = bc0 + (size_t)c * 4096;
#pragma unroll
                for (int t = 0; t < 4; ++t) { u32x2 sp; sp.x = pk2(S[t][0], S[t][1]); sp.y = pk2(S[t][2], S[t][3]);
                    asm volatile("" : "+v"(sp.x) : "v"(cb[k][t].x));
                    *(u32x2*)(bcc + 256 * t) = sp;
                    S[t][0] = cm[k][t].x * S[t][0] + bf_lo(cb[k][t].x); S[t][1] = cm[k][t].y * S[t][1] + bf_hi(cb[k][t].x);
                    S[t][2] = cm[k][t].z * S[t][2] + bf_lo(cb[k][t].y); S[t][3] = cm[k][t].w * S[t][3] + bf_hi(cb[k][t].y); }
            }
        }
#undef SCAN_LOAD_D
    }
}

__device__ __forceinline__ void mixer_out_phase(const Ctx& X, LAS unsigned char* lds, int layer, int tid, int wave, int lane) {
    constexpr int GP = 264;
    const bf16_t* proj = WSP(const bf16_t, WS_PROJ);
    bf16_t* mix = WSP(bf16_t, WS_MIX);
    for (int u = blockIdx.x; u < 1536; u += gridDim.x) {
        asm volatile("" : "+v"(lane), "+v"(tid));
        LAS bf16_t* GT = opq((LAS bf16_t*)lds);
        const int r = lane & 15, q = lane >> 4, h = wave >> 1, half = wave & 1;
        const int mixer = u >> 9, rem = u & 511, b = rem >> 7, c = rem & 127;
        const int uid = unit_id(mixer, b, h, c);
        const int goff = mixer == 0 ? C_RG : (mixer == 1 ? C_GG : C_HG), moff = mixer == 0 ? 0 : (mixer == 1 ? 512 : 768);
        const size_t row0 = (size_t)b * T + c * 64;
        u32x4 gv[4];
#pragma unroll
        for (int n = 0; n < 4; ++n) { const int idx = tid + 512 * n; gv[n] = *(const u32x4*)(proj + (row0 + (idx >> 5)) * LDP + goff + (idx & 31) * 8); }
        const bf16_t* qe = WSP(const bf16_t, WS_QEFF) + (size_t)uid * 4096;
        const bf16_t* st = WSP(const bf16_t, WS_BCS) + (size_t)uid * 4096;
        bf16x8 a[2][2], bb[4][2]; u32x4 ov[2][2];
#pragma unroll
        for (int rt = 0; rt < 2; ++rt) { const int rt4 = 2 * half + rt;
#pragma unroll
            for (int ks = 0; ks < 2; ++ks) a[rt][ks] = *(const bf16x8*)(qe + (16 * rt4 + r) * 64 + ks * 32 + q * 8);
            const u32x4* ol = (const u32x4*)(WSP(const bf16_t, WS_OLOC) + ((size_t)uid * 4 + rt4) * 1024 + lane * 16); ov[rt][0] = ol[0]; ov[rt][1] = ol[1]; }
#pragma unroll
        for (int ct = 0; ct < 4; ++ct)
#pragma unroll
            for (int ks = 0; ks < 2; ++ks) { const bf16_t* tb = st + (size_t)((ct * 4 + 2 * ks + (q >> 1)) * 64) * 4;
                const u32x2 lo = *(const u32x2*)(tb + ((2 * (q & 1)) * 16 + r) * 4), hi = *(const u32x2*)(tb + ((2 * (q & 1) + 1) * 16 + r) * 4);
                bb[ct][ks] = __builtin_bit_cast(bf16x8, (u32x4){lo.x, lo.y, hi.x, hi.y}); }
        const float* nw = mixer == 0 ? X.in[3] + layer * 256 + h * 64 : (mixer == 1 ? X.in[11] + layer * 64 : X.in[13] + layer * 64);
        float wv[4];
#pragma unroll
        for (int ct = 0; ct < 4; ++ct) wv[ct] = nw[16 * ct + r];
#pragma unroll
        for (int n = 0; n < 4; ++n) { const int idx = tid + 512 * n; *(LAS u32x4*)(GT + (idx >> 5) * GP + (idx & 31) * 8) = gv[n]; }
        __syncthreads();
        const bool on = ((MIX_MASK >> (mixer == 0 ? 0 : (mixer == 1 ? 2 : 3))) & 1) != 0;
#pragma unroll
        for (int rt = 0; rt < 2; ++rt) {
            f32x4 acc[4];
            acc[0] = (f32x4){bf_lo(ov[rt][0].x), bf_hi(ov[rt][0].x), bf_lo(ov[rt][0].y), bf_hi(ov[rt][0].y)}; acc[1] = (f32x4){bf_lo(ov[rt][0].z), bf_hi(ov[rt][0].z), bf_lo(ov[rt][0].w), bf_hi(ov[rt][0].w)};
            acc[2] = (f32x4){bf_lo(ov[rt][1].x), bf_hi(ov[rt][1].x), bf_lo(ov[rt][1].y), bf_hi(ov[rt][1].y)}; acc[3] = (f32x4){bf_lo(ov[rt][1].z), bf_hi(ov[rt][1].z), bf_lo(ov[rt][1].w), bf_hi(ov[rt][1].w)};
#pragma unroll
            for (int ct = 0; ct < 4; ++ct)
#pragma unroll
                for (int ks = 0; ks < 2; ++ks) acc[ct] = __builtin_amdgcn_mfma_f32_16x16x32_bf16(a[rt][ks], bb[ct][ks], acc[ct], 0, 0, 0);
#pragma unroll
            for (int j = 0; j < 4; ++j) {
                float sm = (acc[0][j] + acc[1][j]) + (acc[2][j] + acc[3][j]);
                sm += __shfl_xor(sm, 1); sm += __shfl_xor(sm, 2); sm += __shfl_xor(sm, 4); sm += __shfl_xor(sm, 8);
                const float mu = mixer == 0 ? sm * (1.f / 64.f) : 0.f;
                float d[4], s2 = 0.f;
#pragma unroll
                for (int ct = 0; ct < 4; ++ct) { d[ct] = acc[ct][j] - mu; s2 += d[ct] * d[ct]; }
                s2 += __shfl_xor(s2, 1); s2 += __shfl_xor(s2, 2); s2 += __shfl_xor(s2, 4); s2 += __shfl_xor(s2, 8);
                const float rs = rsqrtf(s2 * (1.f / 64.f) + (mixer == 0 ? 1e-5f : 1e-6f));
                const int ii = 16 * (2 * half + rt) + 4 * q + j;
#pragma unroll
                for (int ct = 0; ct < 4; ++ct) { LAS bf16_t* gp = GT + ii * GP + h * 64 + 16 * ct + r;
                    const float y = d[ct] * rs * wv[ct] * silu_acc(bf2f(*gp));
                    *gp = on ? f2bf(y) : (bf16_t)0; }
            }
        }
        __syncthreads();
#pragma unroll
        for (int n = 0; n < 4; ++n) { const int idx = tid + 512 * n; *(u32x4*)(mix + (row0 + (idx >> 5)) * D + moff + (idx & 31) * 8) = *(const LAS u32x4*)(GT + (idx >> 5) * GP + (idx & 31) * 8); }
        __syncthreads();
    }
}

constexpr int PREP_FIRST = (D / 64) * (NINP / 32), PREP_ALL = DEPTH * ((D / 64) * (NINP / 32) + (D / 64) * (D / 32) + 2 * (D / 64) * (DFF / 32) + (DFF / 64) * (D / 32));
__global__ void __launch_bounds__(512, 2) fwd_kernel(Ctx X) {
    extern __shared__ __attribute__((aligned(16))) unsigned char lds_raw[];
    LAS unsigned char* lds = (LAS unsigned char*)lds_raw;
    cg::grid_group grid = cg::this_grid();
    const int tid = threadIdx.x, lane = tid & 63, wave = __builtin_amdgcn_readfirstlane(tid >> 6);
    const int G = gridDim.x, gw = blockIdx.x * 8 + wave, ngw = G * 8;
    bf16_t* XS = (bf16_t*)X.out;
    bf16_t* XN = WSP(bf16_t, WS_XN); bf16_t* PROJ = WSP(bf16_t, WS_PROJ); bf16_t* ACT = WSP(bf16_t, WS_PROJ); bf16_t* MIX = WSP(bf16_t, WS_MIX);

    if (X.ws == nullptr) grid.sync();
    if (tid < 4) ((LAS unsigned*)(lds + LDS_BAR_OFF))[tid] = 0u;
    __syncthreads();
    (void)xcd_barrier_post(WSP(unsigned, WS_CTL), (volatile LAS unsigned*)(lds + LDS_BAR_OFF));
#define GSYNC() do { XcdBarrier b_; b_.bar = WSP(unsigned, WS_CTL); b_.x = xb_xcc_id(); b_.st = (volatile LAS unsigned*)(lds + LDS_BAR_OFF); xcd_barrier(b_); } while (0)
    prep_weights(X, lds, gw, ngw, wave, lane, 0, PREP_FIRST);
    for (int idx = blockIdx.x * 512 + tid; idx < DEPTH * 16 * D; idx += G * 512) { const int ll = idx >> 14, n = (idx >> 10) & 15, k = idx & 1023;
        WSP(bf16_t, WS_WBA)[idx] = n < 8 ? f2bf(X.in[2][((size_t)ll * D + k) * DIN + 2560 + n] * X.in[1][ll * D + k]) : (bf16_t)0; }
    cast_phase(X.in[0], XS, WSP(float, WS_RSA), gw, ngw, lane);
    GSYNC();
#pragma unroll 1
    for (int l = 0; l < DEPTH; ++l) {
        {
            pg8::Gemm g{XS, WSP(const bf16_t, WS_WIN) + (size_t)l * NINP * D, M, NINP, D}; pg8::StaticOrder S; S.init(M, NINP, G, (int)blockIdx.x);
            pg8::EpiProj E{PROJ, LDP, DIN, WSP(const float, WS_RSA)};
            pg8::gemm_phase<pg8::EpiProj, pg8::StaticOrder, true, true>(lds, g, S, E);
            int ln = lane; asm volatile("" : "+v"(ln));
            const int r = ln & 15, q = ln >> 4;
            for (int rb = blockIdx.x; rb < M / 128; rb += G) {
                const bf16_t* Ap = XS + (size_t)(rb * 128 + wave * 16 + r) * D + q * 8;
                const bf16_t* Bp = WSP(const bf16_t, WS_WBA) + (size_t)l * 16 * D + r * D + q * 8;
                f32x4 acc = (f32x4){0.f, 0.f, 0.f, 0.f};
#pragma unroll 8
                for (int ks = 0; ks < 32; ++ks) acc = __builtin_amdgcn_mfma_f32_16x16x32_bf16(*(const bf16x8*)(Ap + ks * 32), *(const bf16x8*)(Bp + ks * 32), acc, 0, 0, 0);
                if (r < 8) {
#pragma unroll
                    for (int j = 0; j < 4; ++j) { const int row = rb * 128 + wave * 16 + 4 * q + j;
                        WSP(float, WS_GBA)[(size_t)row * 8 + r] = acc[j] * rsqrtf(WSP(const float, WS_RSA)[row] * (1.0f / 1024.0f) + 1e-6f); } }
            }
        }
        GSYNC();
        int tz = tid; asm volatile("" : "+v"(tz));
        for (int i = blockIdx.x * 512 + tz; i < M; i += G * 512) { WSP(float, WS_RSA)[i] = 0.f; WSP(float, WS_RSB)[i] = 0.f; }
        mixer_local_phase(X, lds, l, tid, wave, lane);
        GSYNC();
        scan_phase(X, wave, lane);
        if (l == 0 && wave != 0) prep_weights(X, lds, blockIdx.x * 7 + wave - 1, G * 7, wave, lane, PREP_FIRST, PREP_ALL);
        GSYNC();
        mixer_out_phase(X, lds, l, tid, wave, lane);
        GSYNC();
        {
            pg8::Gemm g{MIX, WSP(const bf16_t, WS_WOUT) + (size_t)l * D * D, M, D, D}; pg8::StaticOrder S; S.init(M, D, G, (int)blockIdx.x);
            pg8::EpiResid E{l == 0 ? X.in[0] : nullptr, l == 0 ? nullptr : XS, nullptr, XN, D, WSP(float, WS_RSB)};
            pg8::gemm_phase<pg8::EpiResid, pg8::StaticOrder, true, true>(lds, g, S, E);
        }
        GSYNC();
        {
            pg8::Gemm g{XN, WSP(const bf16_t, WS_WGU) + (size_t)l * NGU * D, M, NGU, D}; pg8::StaticOrder S; S.init(M, NGU, G, (int)blockIdx.x);
            pg8::EpiSwiglu E{ACT, DFF, WSP(const float, WS_RSB)};
            pg8::gemm_phase<pg8::EpiSwiglu, pg8::StaticOrder, true, true>(lds, g, S, E);
        }
        GSYNC();
        {
            pg8::Gemm g{ACT, WSP(const bf16_t, WS_WDN) + (size_t)l * D * DFF, M, D, DFF}; pg8::StaticOrder S; S.init(M, D, G, (int)blockIdx.x);
            pg8::EpiResid E{nullptr, XN, l + 1 < DEPTH ? nullptr : X.out, l + 1 < DEPTH ? XS : nullptr, D, l + 1 < DEPTH ? WSP(float, WS_RSA) : nullptr};
            pg8::gemm_phase<pg8::EpiResid, pg8::StaticOrder, true, true>(lds, g, S, E);
        }
        GSYNC();
        if (l + 1 == DEPTH) norm_phase(X.out, X.in[19], nullptr, X.out, gw, ngw, lane);
    }
}

extern "C" void kernel_launch(void* const* d_in, const int* in_sizes, int n_in, void* d_out, int out_size, void* d_ws, size_t ws_size, hipStream_t stream) {
    static int grid = 0;
    if (grid == 0) {
        if (n_in != 20 || out_size != M * D || ws_size < WS_END) { fprintf(stderr, "kernel_launch: unexpected shapes (n_in %d, out %d, ws %zu)\n", n_in, out_size, ws_size); grid = -1; return; }
        int dev = 0, cus = 0, per_cu = 0;
        hipGetDevice(&dev); hipDeviceGetAttribute(&cus, hipDeviceAttributeMultiprocessorCount, dev);
        if (hipFuncSetAttribute((const void*)fwd_kernel, hipFuncAttributeMaxDynamicSharedMemorySize, LDS_BYTES) != hipSuccess) { fprintf(stderr, "kernel_launch: hipFuncSetAttribute failed\n"); grid = -1; return; }
        if (hipOccupancyMaxActiveBlocksPerMultiprocessor(&per_cu, (const void*)fwd_kernel, 512, LDS_BYTES) != hipSuccess || per_cu < 1) { fprintf(stderr, "kernel_launch: occupancy query says %d\n", per_cu); per_cu = 1; }
        (void)hipGetLastError();
        grid = cus * (per_cu > 1 ? 1 : per_cu);
    }
    if (grid < 0) return;
    Ctx X{};
    for (int i = 0; i < 20; ++i) X.in[i] = (const float*)d_in[i];
    X.out = (float*)d_out; X.ws = (unsigned char*)d_ws;
    void* args[] = {&X};
    if (hipMemsetAsync((char*)d_ws + WS_CTL, 0, 16384, stream) != hipSuccess) { fprintf(stderr, "kernel_launch: hipMemsetAsync of the barrier words failed\n"); return; }
    hipError_t e = hipLaunchCooperativeKernel((const void*)fwd_kernel, dim3(grid), dim3(512), args, LDS_BYTES, stream);
    if (e != hipSuccess) fprintf(stderr, "cooperative launch failed: %s (grid %d)\n", hipGetErrorString(e), grid);
}
```

```cpp
#include <hip/hip_runtime.h>
#include <hip/hip_cooperative_groups.h>
#include <cstdio>
#include <cstdint>
namespace cg = cooperative_groups;

#ifndef MIX_MASK
#define MIX_MASK 15
#endif
namespace pg8 {
#define PG8_LAS __attribute__((address_space(3)))
typedef unsigned short bf16_t;
typedef short bf16x8 __attribute__((ext_vector_type(8)));
typedef float f32x4 __attribute__((ext_vector_type(4)));
typedef unsigned u32x4 __attribute__((ext_vector_type(4)));
constexpr int BM = 256, BK = 64, HALF = 128, HTB = HALF * BK * 2  , STAGE_BYTES = 8 * HTB, NXCD = 8, WGM = 8;

__host__ __device__ __forceinline__ int lds_byte(int r, int c) { const int st = (r >> 4) * 2 + (c >> 5), rr = r & 15, cc = c & 31, ob = rr * 64 + cc * 2; return st * 1024 + (ob ^ (((ob >> 9) & 1) << 5)); }
__host__ __device__ __forceinline__ void stage_rc(int b, int& R, int& C) { const int st = b / 1024, sb = b % 1024, swz = sb ^ (((sb >> 9) & 1) << 5); R = (st >> 1) * 16 + swz / 64; C = (st & 1) * 32 + (swz % 64) / 2; }
__host__ __device__ __forceinline__ int perm32(int rho) { const int n = rho >> 4, i = rho & 15; return 8 * (i >> 2) + 4 * n + (i & 3); }

struct Unit { int pm, pn; };
struct Gemm { const bf16_t* A; const bf16_t* Bt; int M, N, K; };

struct StaticOrder {
    int nM, nN, nwg, G, c;
    __host__ __device__ void init(int M, int N, int G_, int c_) { nM = M / BM; nN = N / BM; nwg = nM * nN; G = G_; c = c_; }
    __host__ __device__ bool next(int i, Unit& u) const {
        const long L = (long)i * G + c; if (L >= nwg) return false;
        int wgid = (int)L; { const int q = nwg / NXCD, r = nwg % NXCD, xcd = wgid % NXCD, off = wgid / NXCD; wgid = (xcd < r ? xcd * (q + 1) : r * (q + 1) + (xcd - r) * q) + off; }
        const int nig = WGM * nN, gid = wgid / nig, fm = gid * WGM, gsz = (nM - fm) < WGM ? (nM - fm) : WGM;
        u.pm = fm + ((wgid % nig) % gsz); u.pn = (wgid % nig) / gsz; return true;
    }
    __device__ __forceinline__ void a_ready(const Unit&) const {}
    __device__ __forceinline__ void done(const Unit&) const {}
};

__device__ __forceinline__ unsigned cvt_pk_bf16(float lo, float hi) { unsigned r; asm volatile("v_cvt_pk_bf16_f32 %0, %1, %2" : "=v"(r) : "v"(lo), "v"(hi)); return r; }
__device__ __forceinline__ float silu_f(float g) { return g * __builtin_amdgcn_rcpf(1.0f + __expf(-g)); }

struct EpiProj {
    static constexpr bool PERM = true, AFTER_DRAIN = false;
    bf16_t* O; int ldc; int ncols; const float* rowsq;
    __device__ __forceinline__ void pre(const Unit& u, int wr, int fr, float (&rsv)[8]) const {
#pragma unroll
        for (int i = 0; i < 8; ++i) rsv[i] = rowsq[u.pm * BM + wr * 64 + fr + (i >> 2) * HALF + (i & 3) * 16]; }
    __device__ __forceinline__ void operator()(const f32x4 (&acc)[2][2][4][2], const Unit& u, int wr, int wc, int fr, int fq, const float (&rsv)[8]) const {
        const int row0 = u.pm * BM + wr * 64 + fr; const int col0 = u.pn * BM + wc * 32 + 8 * fq;
#pragma unroll
        for (int ai = 0; ai < 2; ++ai)
#pragma unroll
            for (int m = 0; m < 4; ++m) { bf16_t* rowp = O + (size_t)(row0 + ai * HALF + m * 16) * ldc;
                const float rs = __builtin_amdgcn_rsqf(rsv[ai * 4 + m] * (1.0f / 1024.0f) + 1e-6f);
#pragma unroll
                for (int bj = 0; bj < 2; ++bj) { const int col = col0 + bj * HALF;
                    if (col < ncols) { const f32x4 v0 = acc[ai][bj][m][0] * rs, v1 = acc[ai][bj][m][1] * rs; u32x4 w;
                        w.x = cvt_pk_bf16(v0[0], v0[1]); w.y = cvt_pk_bf16(v0[2], v0[3]); w.z = cvt_pk_bf16(v1[0], v1[1]); w.w = cvt_pk_bf16(v1[2], v1[3]);
                        __builtin_nontemporal_store(w, (u32x4*)(rowp + col)); } } }
    }
};
struct EpiResid {
    static constexpr bool PERM = true, AFTER_DRAIN = false;
    const float* base_f; const bf16_t* base_b; float* out_f; bf16_t* out_b; int ldc; float* rowsq;
    __device__ __forceinline__ void pre(const Unit&, int, int, float (&)[8]) const {}
    __device__ __forceinline__ void operator()(const f32x4 (&acc)[2][2][4][2], const Unit& u, int wr, int wc, int fr, int fq, const float (&rsv)[8]) const {
        const int row0 = u.pm * BM + wr * 64 + fr; const int col0 = u.pn * BM + wc * 32 + 8 * fq;
#pragma unroll
        for (int ai = 0; ai < 2; ++ai)
#pragma unroll
            for (int m = 0; m < 4; ++m) { const size_t off = (size_t)(row0 + ai * HALF + m * 16) * ldc + col0; float sq = 0.f;
#pragma unroll
                for (int bj = 0; bj < 2; ++bj) { const size_t o_ = off + bj * HALF; f32x4 b0, b1;
                    if (base_b) { const u32x4 w = *(const u32x4*)(base_b + o_);
                        b0 = (f32x4){__uint_as_float(w.x << 16), __uint_as_float(w.x & 0xffff0000u), __uint_as_float(w.y << 16), __uint_as_float(w.y & 0xffff0000u)};
                        b1 = (f32x4){__uint_as_float(w.z << 16), __uint_as_float(w.z & 0xffff0000u), __uint_as_float(w.w << 16), __uint_as_float(w.w & 0xffff0000u)}; }
                    else { b0 = *(const f32x4*)(base_f + o_); b1 = *(const f32x4*)(base_f + o_ + 4); }
                    const f32x4 o0 = b0 + acc[ai][bj][m][0], o1 = b1 + acc[ai][bj][m][1];
                    if (out_f) { *(f32x4*)(out_f + o_) = o0; *(f32x4*)(out_f + o_ + 4) = o1; }
                    if (out_b) { u32x4 w; w.x = cvt_pk_bf16(o0[0], o0[1]); w.y = cvt_pk_bf16(o0[2], o0[3]); w.z = cvt_pk_bf16(o1[0], o1[1]); w.w = cvt_pk_bf16(o1[2], o1[3]); *(u32x4*)(out_b + o_) = w; }
                    sq += ((o0[0] * o0[0] + o0[1] * o0[1]) + (o0[2] * o0[2] + o0[3] * o0[3])) + ((o1[0] * o1[0] + o1[1] * o1[1]) + (o1[2] * o1[2] + o1[3] * o1[3])); }
                if (rowsq) { sq += __shfl_xor(sq, 16); sq += __shfl_xor(sq, 32); if (fq == 0) atomicAdd(rowsq + row0 + ai * HALF + m * 16, sq); } }
    }
};
struct EpiSwiglu {
    static constexpr bool PERM = true, AFTER_DRAIN = false;
    bf16_t* O; int ldc; const float* rowsq;
    __device__ __forceinline__ void pre(const Unit& u, int wr, int fr, float (&rsv)[8]) const {
#pragma unroll
        for (int i = 0; i < 8; ++i) rsv[i] = rowsq[u.pm * BM + wr * 64 + fr + (i >> 2) * HALF + (i & 3) * 16]; }
    __device__ __forceinline__ void operator()(const f32x4 (&acc)[2][2][4][2], const Unit& u, int wr, int wc, int fr, int fq, const float (&rsv)[8]) const {
        const int row0 = u.pm * BM + wr * 64 + fr; const int col0 = u.pn * HALF + wc * 32 + 8 * fq;
#pragma unroll
        for (int ai = 0; ai < 2; ++ai)
#pragma unroll
            for (int m = 0; m < 4; ++m) { bf16_t* rowp = O + (size_t)(row0 + ai * HALF + m * 16) * ldc + col0;
                const float rs = __builtin_amdgcn_rsqf(rsv[ai * 4 + m] * (1.0f / 1024.0f) + 1e-6f);
                const f32x4 g0 = acc[ai][0][m][0] * rs, g1 = acc[ai][0][m][1] * rs, u0 = acc[ai][1][m][0] * rs, u1 = acc[ai][1][m][1] * rs; u32x4 w;
                w.x = cvt_pk_bf16(silu_f(g0[0]) * u0[0], silu_f(g0[1]) * u0[1]); w.y = cvt_pk_bf16(silu_f(g0[2]) * u0[2], silu_f(g0[3]) * u0[3]);
                w.z = cvt_pk_bf16(silu_f(g1[0]) * u1[0], silu_f(g1[1]) * u1[1]); w.w = cvt_pk_bf16(silu_f(g1[2]) * u1[2], silu_f(g1[3]) * u1[3]);
                __builtin_nontemporal_store(w, (u32x4*)rowp); }
    }
};

template <class Epi, class Sched, bool ALIGN_EPI = false, bool SP2 = false>
__device__ __forceinline__ void gemm_phase(PG8_LAS unsigned char* lds, const Gemm g, const Sched& S, const Epi& E) {
    int tid_ = threadIdx.x; asm volatile("" : "+v"(tid_));
    const int tid = tid_, wid = __builtin_amdgcn_readfirstlane(tid >> 6), lane = tid & 63, wr = wid >> 2, wc = wid & 3, fr = lane & 15, fq = lane >> 4;
    const int K = g.K, nt = K / BK;
    unsigned voffA[2], voffB[2];
#pragma unroll
    for (int i = 0; i < 2; ++i) { int R, C; stage_rc(tid * 16 + i * 8192, R, C); const int Rb = Epi::PERM ? ((R & ~31) + perm32(R & 31)) : R;
        voffA[i] = (unsigned)(R * K + C) * 2u; voffB[i] = (unsigned)(Rb * K + C) * 2u; }
    const size_t kstep = (size_t)(BK * 2);
    const size_t hstep = (size_t)HALF * K * 2;
    const size_t tstep = 2 * hstep;
    const unsigned ldsw = (unsigned)wid * 1024u;
    const int aoff = lds_byte(wr * 64 + fr, fq * 8), boff = lds_byte(wc * 32 + fr, fq * 8);
#define PG8_SA(b, h) (((b) * 2 + (h)) * HTB)
#define PG8_SB(b, h) ((4 + (b) * 2 + (h)) * HTB)
#define PG8_STAGE(bufoff, gbase, voff) do { _Pragma("unroll") for (int _i = 0; _i < 2; ++_i) \
        __builtin_amdgcn_global_load_lds((const unsigned*)((const char*)(gbase) + (voff)[_i]), (PG8_LAS unsigned*)(lds + (bufoff) + ldsw + _i * 8192), 16, 0, 0); } while (0)
#define PG8_LDA(dst, b, h) do { _Pragma("unroll") for (int m = 0; m < 4; ++m) _Pragma("unroll") for (int k = 0; k < 2; ++k) dst[m][k] = *(const PG8_LAS bf16x8*)(lds + PG8_SA(b, h) + aoff + m * 2048 + k * 1024); } while (0)
#define PG8_LDB(dst, b, h) do { _Pragma("unroll") for (int n = 0; n < 2; ++n) _Pragma("unroll") for (int k = 0; k < 2; ++k) dst[n][k] = *(const PG8_LAS bf16x8*)(lds + PG8_SB(b, h) + boff + n * 2048 + k * 1024); } while (0)
#define PG8_MMA(ai, bj, At, Bt) do { __builtin_amdgcn_s_setprio(1); _Pragma("unroll") for (int m = 0; m < 4; ++m) _Pragma("unroll") for (int n = 0; n < 2; ++n) _Pragma("unroll") for (int k = 0; k < 2; ++k) \
        acc[ai][bj][m][n] = __builtin_amdgcn_mfma_f32_16x16x32_bf16(Bt[n][k], At[m][k], acc[ai][bj][m][n], 0, 0, 0); __builtin_amdgcn_s_setprio(0); } while (0)
#define PG8_WAIT_V(n) asm volatile("s_waitcnt vmcnt(" #n ")" ::: "memory")
#define PG8_WAIT_L(n) asm volatile("s_waitcnt lgkmcnt(" #n ")" ::: "memory")
#define PG8_BAR __builtin_amdgcn_s_barrier()
#define PG8_SCHED __builtin_amdgcn_sched_barrier(0)
    Unit cur, nxt; int ui = 0;
    float rsv[8];
    if (!S.next(0, cur)) return;
    f32x4 acc[2][2][4][2];
#pragma unroll
    for (int a = 0; a < 2; ++a)
#pragma unroll
        for (int b = 0; b < 2; ++b)
#pragma unroll
            for (int m = 0; m < 4; ++m)
#pragma unroll
                for (int n = 0; n < 2; ++n) acc[a][b][m][n] = (f32x4){0.f, 0.f, 0.f, 0.f};
    bf16x8 At[4][2], B0[2][2], B1[2][2];
    const char* cA = (const char*)g.A + (size_t)cur.pm * tstep; const char* cB = (const char*)g.Bt + (size_t)cur.pn * tstep;
    S.a_ready(cur);
    if constexpr (SP2) {
        PG8_STAGE(PG8_SB(0, 0), cB, voffB); PG8_STAGE(PG8_SB(0, 1), cB + hstep, voffB); PG8_STAGE(PG8_SA(0, 0), cA, voffA); PG8_STAGE(PG8_SA(0, 1), cA + hstep, voffA);
        if (wr == 1) PG8_BAR;
        PG8_WAIT_V(2); PG8_BAR;
        PG8_STAGE(PG8_SB(1, 0), cB + kstep, voffB); PG8_STAGE(PG8_SA(1, 0), cA + kstep, voffA); PG8_STAGE(PG8_SB(1, 1), cB + hstep + kstep, voffB);
        PG8_WAIT_V(6); PG8_BAR;
    } else {
        PG8_STAGE(PG8_SB(0, 0), cB, voffB); PG8_STAGE(PG8_SA(0, 0), cA, voffA); PG8_STAGE(PG8_SB(0, 1), cB + hstep, voffB); PG8_STAGE(PG8_SA(0, 1), cA + hstep, voffA);
        if (wr == 1) PG8_BAR;
        PG8_WAIT_V(4); PG8_BAR;
        PG8_STAGE(PG8_SB(1, 0), cB + kstep, voffB); PG8_STAGE(PG8_SA(1, 0), cA + kstep, voffA); PG8_STAGE(PG8_SB(1, 1), cB + hstep + kstep, voffB);
        PG8_WAIT_V(6); PG8_BAR;
    }
    for (;;) {
        const bool has_next = S.next(ui + 1, nxt);
        const char* nA = has_next ? (const char*)g.A + (size_t)nxt.pm * tstep : cA; const char* nB = has_next ? (const char*)g.Bt + (size_t)nxt.pn * tstep : cB;
        for (int t = 0; t < nt; t += 2) {
            const bool last = (t == nt - 2);
            const char* a1 = cA + (size_t)(t + 1) * kstep;
            const char* a2 = last ? nA : cA + (size_t)(t + 2) * kstep; const char* b2 = last ? nB : cB + (size_t)(t + 2) * kstep;
            const char* a3 = a2 + kstep; const char* b3 = b2 + kstep;
            if (last && has_next) S.a_ready(nxt);
            if (last) E.pre(cur, wr, fr, rsv);
            if constexpr (SP2) {
            PG8_LDB(B0, 0, 0); PG8_LDB(B1, 0, 1); PG8_SCHED; PG8_LDA(At, 0, 0); PG8_STAGE(PG8_SA(1, 1), a1 + hstep, voffA);
            PG8_WAIT_V(8); PG8_WAIT_L(0); PG8_BAR; PG8_MMA(0, 0, At, B0); PG8_MMA(0, 1, At, B1); PG8_BAR; PG8_SCHED;
            PG8_LDA(At, 0, 1); PG8_STAGE(PG8_SB(0, 0), b2, voffB); PG8_STAGE(PG8_SB(0, 1), b2 + hstep, voffB); PG8_STAGE(PG8_SA(0, 0), a2, voffA);
            PG8_WAIT_V(8); PG8_WAIT_L(0); PG8_BAR; PG8_MMA(1, 0, At, B0); PG8_MMA(1, 1, At, B1); PG8_BAR; PG8_SCHED;
            PG8_LDB(B0, 1, 0); PG8_LDB(B1, 1, 1); PG8_SCHED; PG8_LDA(At, 1, 0); PG8_STAGE(PG8_SA(0, 1), a2 + hstep, voffA);
            PG8_WAIT_V(8); PG8_WAIT_L(0); PG8_BAR; PG8_MMA(0, 0, At, B0); PG8_MMA(0, 1, At, B1); PG8_BAR; PG8_SCHED;
            PG8_LDA(At, 1, 1); PG8_STAGE(PG8_SB(1, 0), b3, voffB); PG8_STAGE(PG8_SB(1, 1), b3 + hstep, voffB); PG8_STAGE(PG8_SA(1, 0), a3, voffA);
            PG8_WAIT_V(8); PG8_WAIT_L(0); PG8_BAR; PG8_MMA(1, 0, At, B0); PG8_MMA(1, 1, At, B1); PG8_BAR; PG8_SCHED;
            } else {
            PG8_LDB(B0, 0, 0); PG8_SCHED; PG8_LDA(At, 0, 0); PG8_STAGE(PG8_SA(1, 1), a1 + hstep, voffA);
            PG8_WAIT_L(8); PG8_BAR; PG8_WAIT_L(0); PG8_MMA(0, 0, At, B0); PG8_BAR; PG8_SCHED;
            PG8_LDB(B1, 0, 1); PG8_STAGE(PG8_SB(0, 0), b2, voffB);
            PG8_BAR; PG8_WAIT_L(0); PG8_MMA(0, 1, At, B1); PG8_BAR;
            PG8_LDA(At, 0, 1); PG8_STAGE(PG8_SA(0, 0), a2, voffA);
            PG8_BAR; PG8_WAIT_L(0); PG8_MMA(1, 0, At, B0); PG8_BAR; PG8_SCHED;
            PG8_STAGE(PG8_SB(0, 1), b2 + hstep, voffB);
            PG8_WAIT_V(6); PG8_BAR; PG8_MMA(1, 1, At, B1); PG8_BAR;
            PG8_LDB(B0, 1, 0); PG8_SCHED; PG8_LDA(At, 1, 0); PG8_STAGE(PG8_SA(0, 1), a2 + hstep, voffA);
            PG8_WAIT_L(8); PG8_BAR; PG8_WAIT_L(0); PG8_MMA(0, 0, At, B0); PG8_BAR; PG8_SCHED;
            PG8_LDB(B1, 1, 1); PG8_STAGE(PG8_SB(1, 0), b3, voffB);
            PG8_BAR; PG8_WAIT_L(0); PG8_MMA(0, 1, At, B1); PG8_BAR;
            PG8_LDA(At, 1, 1); PG8_STAGE(PG8_SA(1, 0), a3, voffA);
            PG8_BAR; PG8_WAIT_L(0); PG8_MMA(1, 0, At, B0); PG8_BAR; PG8_SCHED;
            PG8_STAGE(PG8_SB(1, 1), b3 + hstep, voffB);
            PG8_WAIT_V(6); PG8_BAR; PG8_MMA(1, 1, At, B1); PG8_BAR;
            }
        }
        if constexpr (ALIGN_EPI) { if (wr == 0) PG8_BAR; }
        if constexpr (!Epi::AFTER_DRAIN) { E(acc, cur, wr, wc, fr, fq, rsv); S.done(cur); }
        if (!has_next) break;
#pragma unroll
        for (int a = 0; a < 2; ++a)
#pragma unroll
            for (int b = 0; b < 2; ++b)
#pragma unroll
                for (int m = 0; m < 4; ++m)
#pragma unroll
                    for (int n = 0; n < 2; ++n) acc[a][b][m][n] = (f32x4){0.f, 0.f, 0.f, 0.f};
        cur = nxt; cA = nA; cB = nB; ++ui;
        if constexpr (ALIGN_EPI) { if (wr == 1) PG8_BAR; }
    }
    PG8_WAIT_V(0);
    if constexpr (!ALIGN_EPI) { if (wr == 0) PG8_BAR; }
    PG8_BAR;
    if constexpr (Epi::AFTER_DRAIN) { E.fused(acc, cur, wr, wc, fr, fq, lds, wid, lane); S.done(cur); }
#undef PG8_SA
#undef PG8_SB
#undef PG8_STAGE
#undef PG8_LDA
#undef PG8_LDB
#undef PG8_MMA
#undef PG8_WAIT_V
#undef PG8_WAIT_L
#undef PG8_BAR
#undef PG8_SCHED
}
}

constexpr int NB = 4, T = 8192, D = 1024, DIN = 3592, NINP = 3584, DFF = 2816, NGU = 2 * DFF, DEPTH = 2;
constexpr int M = NB * T;
constexpr int NCH = T / 64;
constexpr int LDP = NINP;
constexpr int C_RQ = 0, C_RK = 256, C_RV = 512, C_RG = 768, C_CA = 1024, C_CG = 1280, C_GQ = 1536, C_GK = 1792, C_GV = 2048, C_GG = 2304,
              C_HQ = 2560, C_HF = 2816, C_HI = 3072, C_HG = 3328;
constexpr size_t MiB = 1u << 20;
constexpr size_t WS_CTL = 0;
constexpr size_t WS_WIN = 1 * MiB;
constexpr size_t WS_WOUT = 16 * MiB;
constexpr size_t WS_WGU = 20 * MiB;
constexpr size_t WS_WDN = 42 * MiB;
constexpr size_t WS_XN = 53 * MiB;
constexpr size_t WS_BCS = WS_XN;
constexpr size_t WS_MM = WS_XN + 48 * MiB;
constexpr size_t WS_MIX = 117 * MiB;
constexpr size_t WS_PROJ = 181 * MiB;
constexpr size_t WS_QEFF = 406 * MiB;
constexpr size_t WS_OLOC = 454 * MiB;
constexpr size_t WS_MVEC = 502 * MiB;
constexpr size_t WS_RSA = 503 * MiB;
constexpr size_t WS_RSB = 503 * MiB + 131072;
constexpr size_t WS_GBA = 503 * MiB + 262144;
constexpr size_t WS_WBA = 504 * MiB + 524288;
constexpr size_t WS_END = 505 * MiB;
constexpr int LDS_BYTES = 147456 + 256;
constexpr int LDS_BAR_OFF = 147456;
constexpr int HEAD_LDS = 73728;

#define LAS __attribute__((address_space(3)))
typedef unsigned short bf16_t;
typedef short bf16x8 __attribute__((ext_vector_type(8)));
typedef float f32x4 __attribute__((ext_vector_type(4)));
typedef unsigned u32x4 __attribute__((ext_vector_type(4)));
typedef unsigned u32x2 __attribute__((ext_vector_type(2)));
constexpr int LT = 72;
template <class Tp> __device__ __forceinline__ LAS Tp* opq(LAS Tp* p) { asm volatile("" : "+v"(p)); return p; }

__device__ __forceinline__ float bf_lo(unsigned u) { return __uint_as_float(u << 16); }
__device__ __forceinline__ float bf_hi(unsigned u) { return __uint_as_float(u & 0xffff0000u); }
__device__ __forceinline__ float bf2f(bf16_t b) { return __uint_as_float((unsigned)b << 16); }
__device__ __forceinline__ unsigned pk2(float lo, float hi) { return pg8::cvt_pk_bf16(lo, hi); }
__device__ __forceinline__ bf16_t f2bf(float f) { return (bf16_t)(pk2(f, 0.f) & 0xffffu); }
__device__ __forceinline__ float fexp(float x) { return __expf(x); }
__device__ __forceinline__ float frcp(float x) { return __builtin_amdgcn_rcpf(x); }
__device__ __forceinline__ float sigmoid_f(float x) { return frcp(1.0f + fexp(-x)); }
__device__ __forceinline__ float silu_acc(float x) { return x * frcp(1.0f + fexp(-x)); }
__device__ __forceinline__ float softplus_f(float x) { return fmaxf(x, 0.f) + log1pf(expf(-fabsf(x))); }
__device__ __forceinline__ float wave_sum(float v) {
#pragma unroll
    for (int o = 1; o < 64; o <<= 1) v += __shfl_xor(v, o);
    return v;
}
__device__ __forceinline__ void unpack8(const u32x4 w, float (&f)[8]) {
    f[0] = bf_lo(w.x); f[1] = bf_hi(w.x); f[2] = bf_lo(w.y); f[3] = bf_hi(w.y); f[4] = bf_lo(w.z); f[5] = bf_hi(w.z); f[6] = bf_lo(w.w); f[7] = bf_hi(w.w);
}
__device__ __forceinline__ u32x4 pack8(const float (&f)[8]) { u32x4 w; w.x = pk2(f[0], f[1]); w.y = pk2(f[2], f[3]); w.z = pk2(f[4], f[5]); w.w = pk2(f[6], f[7]); return w; }

struct Ctx {
    const float* in[20]; float* out; unsigned char* ws;
};
#define WSP(T_, off) ((T_*)(X.ws + (off)))

__device__ __forceinline__ f32x4 mma16(const LAS bf16_t* A, int a0, const LAS bf16_t* B, int b0, f32x4 acc, int r, int q) {
#pragma unroll
    for (int ks = 0; ks < 2; ++ks) {
        const bf16x8 a = *(const LAS bf16x8*)(A + (a0 + r) * LT + ks * 32 + q * 8);
        const bf16x8 b = *(const LAS bf16x8*)(B + (b0 + r) * LT + ks * 32 + q * 8);
        acc = __builtin_amdgcn_mfma_f32_16x16x32_bf16(a, b, acc, 0, 0, 0);
    }
    return acc;
}
__device__ __forceinline__ void store_oloc(bf16_t* oloc, int uid, int w4, int lane, const f32x4 (&acc)[4]) {
    u32x4* p = (u32x4*)(oloc + ((size_t)uid * 4 + w4) * 1024 + lane * 16);
    u32x4 a, b;
    a.x = pk2(acc[0][0], acc[0][1]); a.y = pk2(acc[0][2], acc[0][3]); a.z = pk2(acc[1][0], acc[1][1]); a.w = pk2(acc[1][2], acc[1][3]);
    b.x = pk2(acc[2][0], acc[2][1]); b.y = pk2(acc[2][2], acc[2][3]); b.z = pk2(acc[3][0], acc[3][1]); b.w = pk2(acc[3][2], acc[3][3]);
    __builtin_nontemporal_store(a, p); __builtin_nontemporal_store(b, p + 1);
}
__device__ __forceinline__ void store_bc(bf16_t* bcs, int uid, int w4, int r, int q, const f32x4 (&acc)[4]) {
#pragma unroll
    for (int ct = 0; ct < 4; ++ct) { u32x2 w; w.x = pk2(acc[ct][0], acc[ct][1]); w.y = pk2(acc[ct][2], acc[ct][3]);
        *(u32x2*)(bcs + (size_t)uid * 4096 + ((ct * 4 + w4) * 64 + q * 16 + r) * 4) = w; }
}


typedef __attribute__((address_space(1))) unsigned gu32;
#define XB_TMO      128
#define XB_XCNT(j)  (256  + 64 * (j))
#define XB_XSUB(j)  (1280 + 64 * (j))
#define XB_XGEN(j)  (2304 + 64 * (j))
#define XB_TOP      3328
#define XB_TOPGEN   3392
#define XCD_BAR_WORDS 3456
#define XB_SPIN_CAP (1u << 18)

__device__ __forceinline__ unsigned xb_ld(unsigned* p)              { return __hip_atomic_load(p, __ATOMIC_RELAXED, __HIP_MEMORY_SCOPE_AGENT); }
__device__ __forceinline__ unsigned xb_add(unsigned* p, unsigned v) { return __hip_atomic_fetch_add(p, v, __ATOMIC_RELAXED, __HIP_MEMORY_SCOPE_AGENT); }
__device__ __forceinline__ unsigned xb_xcc_id() { return (unsigned)__builtin_amdgcn_s_getreg((3 << 11) | 20) & 0xFu; }
#define XB_SPIN(cond, bar) do { unsigned _sp = 0; while (cond) { __builtin_amdgcn_s_sleep(1); \
    if ((++_sp & 255u) == 0u) { if (xb_ld(&(bar)[XB_TMO])) break; if (_sp > XB_SPIN_CAP) { atomicAdd(&(bar)[XB_TMO], 1u); break; } } } } while (0)

struct XcdBarrier {
    unsigned* bar; unsigned x;
    volatile LAS unsigned* st;
};

__device__ __forceinline__ XcdBarrier xcd_barrier_post(unsigned* bar, volatile LAS unsigned* st) {
    XcdBarrier b; b.bar = bar; b.x = xb_xcc_id(); b.st = st;
    if (threadIdx.x == 0) (void)xb_add(&bar[XB_XCNT(b.x)], 1u);
    return b;
}
__device__ __forceinline__ void xcd_barrier_complete(unsigned* bar, unsigned x, unsigned& nloc, unsigned& nx) {
    const unsigned G = gridDim.x * gridDim.y * gridDim.z;
    unsigned sum, cnt, mine, sp = 0u;
    for (;;) {
        sum = 0u; cnt = 0u; mine = 0u;
#pragma unroll
        for (unsigned j = 0; j < 16; ++j) { const unsigned c = xb_ld(&bar[XB_XCNT(j)]); sum += c; cnt += (c > 0u) ? 1u : 0u; mine = (j == x) ? c : mine; }
        if (sum == G) break;
        __builtin_amdgcn_s_sleep(1);
        if ((++sp & 255u) == 0u) { if (xb_ld(&bar[XB_TMO])) break; if (sp > XB_SPIN_CAP) { atomicAdd(&bar[XB_TMO], 1u); break; } }
    }
    nloc = mine > 0u ? mine : 1u; nx = cnt > 0u ? cnt : 1u;
}

__device__ __forceinline__ void xcd_barrier(const XcdBarrier& b) {
    asm volatile("s_waitcnt vmcnt(0)" ::: "memory");
    __syncthreads();
    if (threadIdx.x == 0) {
        unsigned* bar = b.bar;
        __builtin_amdgcn_s_waitcnt(0);
        unsigned nloc = b.st[0], nx = b.st[1];
        if (nloc == 0u) { xcd_barrier_complete(bar, b.x, nloc, nx); b.st[0] = nloc; b.st[1] = nx; }
        const unsigned old = xb_add(&bar[XB_XSUB(b.x)], 1u);
        const unsigned gen = old / nloc;
        if (old + 1u == (gen + 1u) * nloc) {
            __builtin_amdgcn_fence(__ATOMIC_RELEASE, "agent");
            asm volatile("s_waitcnt vmcnt(0)" ::: "memory");
            const unsigned og = xb_add(&bar[XB_TOP], 1u);
            const unsigned tg = og / nx;
            if (og + 1u == (tg + 1u) * nx) xb_add(&bar[XB_TOPGEN], 1u);
            else XB_SPIN(xb_ld(&bar[XB_TOPGEN]) == tg, bar);
            __builtin_amdgcn_fence(__ATOMIC_ACQUIRE, "agent");
            xb_add(&bar[XB_XGEN(b.x)], 1u);
            asm volatile("s_waitcnt vmcnt(0)" ::: "memory");
        } else {
            XB_SPIN(xb_ld(&bar[XB_XGEN(b.x)]) == gen, bar);
            __builtin_amdgcn_fence(__ATOMIC_ACQUIRE, "agent");
            asm volatile("s_waitcnt vmcnt(0)" ::: "memory");
        }
    }
    __syncthreads();
}

__device__ __forceinline__ void transpose_item(const float* W, int K, int N, bf16_t* WT, int mode, LAS float* scr, int kb, int nb, int lane, const float* kscale, int coff) {
    const int k0 = 64 * kb, n0 = 32 * nb;
    const int nn = n0 + (lane & 31) + coff;
#pragma unroll 8
    for (int i = 0; i < 32; ++i) { const int kk = 2 * i + (lane >> 5); const float ksc = kscale ? kscale[k0 + kk] : 1.0f; scr[kk * 33 + (lane & 31)] = nn < N ? W[(size_t)(k0 + kk) * N + nn] * ksc : 0.f; }
    asm volatile("s_waitcnt lgkmcnt(0)" ::: "memory");
    const int c = lane & 7;
#pragma unroll
    for (int j = 0; j < 4; ++j) { const int n = (lane >> 3) + 8 * j; const LAS float* s = scr + (8 * c) * 33 + n;
        u32x4 o; o.x = pk2(s[0 * 33], s[1 * 33]); o.y = pk2(s[2 * 33], s[3 * 33]); o.z = pk2(s[4 * 33], s[5 * 33]); o.w = pk2(s[6 * 33], s[7 * 33]);
        const int ng = n0 + n; const int row = mode == 0 ? ng : ((ng >> 7) * 256 + (ng & 127) + (mode == 2 ? 128 : 0));
        *(u32x4*)(WT + (size_t)row * K + k0 + 8 * c) = o; }
    asm volatile("s_waitcnt lgkmcnt(0)" ::: "memory");
}
__device__ __forceinline__ void prep_weights(const Ctx& X, LAS unsigned char* lds, int gw, int ngw, int wave, int lane, int it_lo, int it_hi) {
    LAS float* scr = (LAS float*)(lds + wave * 16384);
    constexpr int I_IN = (D / 64) * (NINP / 32), I_OUT = (D / 64) * (D / 32), I_G = (D / 64) * (DFF / 32), I_DN = (DFF / 64) * (D / 32);
    constexpr int PER_L = I_IN + I_OUT + 2 * I_G + I_DN;
    asm volatile("" : "+v"(lane));
    for (int it = it_lo + gw; it < it_hi; it += ngw) {
        const int l = it / PER_L; int r = it % PER_L;
        if (r < I_IN) { transpose_item(X.in[2] + (size_t)l * D * DIN, D, DIN, WSP(bf16_t, WS_WIN) + (size_t)l * NINP * D, 0, scr, r / (NINP / 32), r % (NINP / 32), lane, X.in[1] + l * D, (r % (NINP / 32)) * 32 >= 2560 ? 8 : 0); continue; } r -= I_IN;
        if (r < I_OUT) { transpose_item(X.in[14] + (size_t)l * D * D, D, D, WSP(bf16_t, WS_WOUT) + (size_t)l * D * D, 0, scr, r / (D / 32), r % (D / 32), lane, nullptr, 0); continue; } r -= I_OUT;
        if (r < I_G) { transpose_item(X.in[16] + (size_t)l * D * DFF, D, DFF, WSP(bf16_t, WS_WGU) + (size_t)l * NGU * D, 1, scr, r / (DFF / 32), r % (DFF / 32), lane, X.in[15] + l * D, 0); continue; } r -= I_G;
        if (r < I_G) { transpose_item(X.in[17] + (size_t)l * D * DFF, D, DFF, WSP(bf16_t, WS_WGU) + (size_t)l * NGU * D, 2, scr, r / (DFF / 32), r % (DFF / 32), lane, X.in[15] + l * D, 0); continue; } r -= I_G;
        transpose_item(X.in[18] + (size_t)l * DFF * D, DFF, D, WSP(bf16_t, WS_WDN) + (size_t)l * D * DFF, 0, scr, r / (D / 32), r % (D / 32), lane, nullptr, 0);
    }
}
__device__ __forceinline__ void rms_row(const float* xrow, const float* w, bf16_t* orow, float* of, int lane) {
    const f32x4* xr = (const f32x4*)xrow + lane; const f32x4* wr = (const f32x4*)w + lane;
    f32x4 v[4]; float s = 0.f;
#pragma unroll
    for (int j = 0; j < 4; ++j) { v[j] = xr[64 * j]; s += (v[j].x * v[j].x + v[j].y * v[j].y) + (v[j].z * v[j].z + v[j].w * v[j].w); }
    const float rstd = 1.0f / sqrtf(wave_sum(s) * (1.f / D) + 1e-6f);
#pragma unroll
    for (int j = 0; j < 4; ++j) { const f32x4 ww = wr[64 * j]; const f32x4 o = v[j] * rstd * ww;
        if (of) ((f32x4*)of + lane)[64 * j] = o;
        else { u32x2 p; p.x = pk2(o.x, o.y); p.y = pk2(o.z, o.w); ((u32x2*)orow + lane)[64 * j] = p; } }
}
__device__ __forceinline__ void cast_phase(const float* x, bf16_t* xb, float* rowsq, int gw, int ngw, int lane) {
    asm volatile("" : "+v"(lane));
    for (int m = gw; m < M; m += ngw) {
        const f32x4* xr = (const f32x4*)(x + (size_t)m * D) + lane; float s = 0.f;
#pragma unroll
        for (int j = 0; j < 4; ++j) { const f32x4 v = xr[64 * j]; s += (v.x * v.x + v.y * v.y) + (v.z * v.z + v.w * v.w); u32x2 p; p.x = pk2(v.x, v.y); p.y = pk2(v.z, v.w); ((u32x2*)(xb + (size_t)m * D) + lane)[64 * j] = p; }
        s = wave_sum(s); if (lane == 0) rowsq[m] = s;
    }
}
__device__ __forceinline__ void norm_phase(const float* x, const float* w, bf16_t* xn, float* of, int gw, int ngw, int lane) {
    asm volatile("" : "+v"(lane));
    for (int m = gw; m < M; m += ngw) rms_row(x + (size_t)m * D, w, xn ? xn + (size_t)m * D : nullptr, of ? of + (size_t)m * D : nullptr, lane);
}

__device__ __forceinline__ int unit_id(int mixer, int b, int h, int c) { return ((mixer * 4 + b) * 4 + h) * NCH + c; }

__device__ __forceinline__ void ret_unit(const Ctx& X, LAS unsigned char* hl, int b, int c, int h, int tid_h, int w4, int lane) {
    LAS bf16_t* QR = opq((LAS bf16_t*)hl); LAS bf16_t* KR = opq(QR + 64 * LT); LAS bf16_t* KDT = opq(KR + 64 * LT); LAS bf16_t* VT = opq(KDT + 64 * LT); LAS bf16_t* P = opq(VT + 64 * LT);
    const bf16_t* proj = WSP(const bf16_t, WS_PROJ);
    const int uid = unit_id(0, b, h, c);
    const int r = lane & 15, q = lane >> 4;
    const float lg = log1pf(-exp2f(-5.0f - (float)h));
    {
        const int i = tid_h >> 2, sg = tid_h & 3, d0 = sg * 8;
        const bf16_t* pr = proj + ((size_t)b * T + c * 64 + i) * LDP;
        const u32x4 q1 = *(const u32x4*)(pr + C_RQ + h * 64 + d0), q2 = *(const u32x4*)(pr + C_RQ + h * 64 + d0 + 32);
        const u32x4 k1 = *(const u32x4*)(pr + C_RK + h * 64 + d0), k2 = *(const u32x4*)(pr + C_RK + h * 64 + d0 + 32);
        const u32x4 v1 = *(const u32x4*)(pr + C_RV + h * 64 + sg * 16), v2 = *(const u32x4*)(pr + C_RV + h * 64 + sg * 16 + 8);
        float qa[8], qb[8], ka[8], kb[8], va[8], vb[8];
        unpack8(q1, qa); unpack8(q2, qb); unpack8(k1, ka); unpack8(k2, kb); unpack8(v1, va); unpack8(v2, vb);
        const float pos = (float)(c * 64 + i);
        const float qd = fexp(lg * (float)(i + 1)), kd = fexp(lg * (float)(63 - i));
        float qr1[8], qr2[8], kr1[8], kr2[8], qe1[8], qe2[8];
#pragma unroll
        for (int e = 0; e < 8; ++e) {
            const float inv = exp2f(-(float)(d0 + e) * (13.287712379549449f / 32.0f));
            const float rev = __builtin_amdgcn_fractf(pos * inv * 0.15915494309189535f); const float sn = __builtin_amdgcn_sinf(rev), cs = __builtin_amdgcn_cosf(rev);
            qr1[e] = qa[e] * cs - qb[e] * sn; qr2[e] = qa[e] * sn + qb[e] * cs;
            kr1[e] = (ka[e] * cs - kb[e] * sn) * 0.125f; kr2[e] = (ka[e] * sn + kb[e] * cs) * 0.125f;
            qe1[e] = qr1[e] * qd; qe2[e] = qr2[e] * qd;
            KDT[(d0 + e) * LT + i] = f2bf(kr1[e] * kd); KDT[(d0 + 32 + e) * LT + i] = f2bf(kr2[e] * kd);
            VT[(sg * 16 + e) * LT + i] = f2bf(va[e]); VT[(sg * 16 + 8 + e) * LT + i] = f2bf(vb[e]);
        }
        *(LAS u32x4*)(QR + i * LT + d0) = pack8(qr1); *(LAS u32x4*)(QR + i * LT + d0 + 32) = pack8(qr2);
        *(LAS u32x4*)(KR + i * LT + d0) = pack8(kr1); *(LAS u32x4*)(KR + i * LT + d0 + 32) = pack8(kr2);
        bf16_t* qe = WSP(bf16_t, WS_QEFF) + (size_t)uid * 4096 + i * 64;
        *(u32x4*)(qe + d0) = pack8(qe1); *(u32x4*)(qe + d0 + 32) = pack8(qe2);
    }
    __syncthreads();
    f32x4 acc[4];
#pragma unroll
    for (int ct = 0; ct < 4; ++ct) acc[ct] = mma16(QR, 16 * w4, KR, 16 * ct, (f32x4){0.f, 0.f, 0.f, 0.f}, r, q);
#pragma unroll
    for (int ct = 0; ct < 4; ++ct)
#pragma unroll
        for (int j = 0; j < 4; ++j) { const int ii = 16 * w4 + 4 * q + j, col = 16 * ct + r;
            P[ii * LT + col] = f2bf(ii >= col ? acc[ct][j] * fexp(lg * (float)(ii - col)) : 0.f); }
    __syncthreads();
#pragma unroll
    for (int ct = 0; ct < 4; ++ct) acc[ct] = mma16(P, 16 * w4, VT, 16 * ct, (f32x4){0.f, 0.f, 0.f, 0.f}, r, q);
    store_oloc(WSP(bf16_t, WS_OLOC), uid, w4, lane, acc);
#pragma unroll
    for (int ct = 0; ct < 4; ++ct) acc[ct] = mma16(KDT, 16 * w4, VT, 16 * ct, (f32x4){0.f, 0.f, 0.f, 0.f}, r, q);
    store_bc(WSP(bf16_t, WS_BCS), uid, w4, r, q, acc);
    __syncthreads();
}

__device__ __forceinline__ void hgrn_unit(const Ctx& X, LAS unsigned char* hl, int b, int c, int h, int tid_h, int w4, int lane, int layer) {
    LAS bf16_t* QT = opq((LAS bf16_t*)hl);
    LAS float* Gt = opq((LAS float*)(hl + 9216));
    LAS bf16_t* Kt = opq((LAS bf16_t*)(hl + 25600));
    LAS bf16_t* KTI = opq((LAS bf16_t*)(hl + 34816));
    LAS bf16_t* VT = KTI; LAS bf16_t* KDT = opq(KTI + 64 * LT);
    LAS float* tot = opq((LAS float*)(hl + 57856));
    const bf16_t* proj = WSP(const bf16_t, WS_PROJ);
    const int uid = unit_id(2, b, h, c);
    const int r = lane & 15, q = lane >> 4;
    const int i = tid_h >> 2, ds = (tid_h & 3) * 16;
    const bf16_t* pr = proj + ((size_t)b * T + c * 64 + i) * LDP;
    float kk[16], qv[16], vv[16];
    {
        float ff[16];
        { float t0[8], t1[8]; unpack8(*(const u32x4*)(pr + C_HF + h * 64 + ds), t0); unpack8(*(const u32x4*)(pr + C_HF + h * 64 + ds + 8), t1);
#pragma unroll
          for (int e = 0; e < 8; ++e) { ff[e] = t0[e]; ff[8 + e] = t1[e]; } }
        { float t0[8], t1[8]; unpack8(*(const u32x4*)(pr + C_HQ + h * 64 + ds), t0); unpack8(*(const u32x4*)(pr + C_HQ + h * 64 + ds + 8), t1);
#pragma unroll
          for (int e = 0; e < 8; ++e) { qv[e] = t0[e]; qv[8 + e] = t1[e]; } }
        { float t0[8], t1[8]; unpack8(*(const u32x4*)(pr + C_HI + h * 64 + ds), t0); unpack8(*(const u32x4*)(pr + C_HI + h * 64 + ds + 8), t1);
#pragma unroll
          for (int e = 0; e < 8; ++e) { vv[e] = t0[e]; vv[8 + e] = t1[e]; } }
#pragma unroll
        for (int e = 0; e < 16; ++e) {
            const int ch = h * 64 + ds + e;
            const float lb = layer == 0 ? 0.f : sigmoid_f(X.in[12][256 + ch] - X.in[12][ch]);
            const float f = ff[e];
            const float ls = fminf(f, 0.f) - __logf(1.0f + fexp(-fabsf(f)));
            const float lf = layer == 0 ? ls : __logf(lb + (1.f - lb) * fexp(ls));
            kk[e] = (1.f - lb) * frcp(1.f + fexp(f));
            Gt[i * 64 + ds + e] = lf;
        }
    }
    __syncthreads();
    {
        const int d = tid_h & 63, seg = tid_h >> 6; float cs[16]; float run = 0.f;
#pragma unroll
        for (int jj = 0; jj < 16; ++jj) { run += Gt[(16 * seg + jj) * 64 + d]; cs[jj] = run; }
        tot[seg * 64 + d] = run;
        __syncthreads();
        float off = 0.f;
#pragma unroll
        for (int s = 0; s < 3; ++s) off += (s < seg) ? tot[s * 64 + d] : 0.f;
#pragma unroll
        for (int jj = 0; jj < 16; ++jj) Gt[(16 * seg + jj) * 64 + d] = cs[jj] + off;
    }
    __syncthreads();
    float Gi[16], G63[16];
    {
        const int I = i >> 4;
        float qt[16], qe[16];
#pragma unroll
        for (int e = 0; e < 16; ++e) { Gi[e] = Gt[i * 64 + ds + e]; G63[e] = Gt[63 * 64 + ds + e]; const float gr = Gt[(16 * I) * 64 + ds + e];
            qt[e] = qv[e] * fexp(Gi[e] - gr); qe[e] = qv[e] * fexp(Gi[e]); }
        u32x4 w0, w1;
        w0.x = pk2(qt[0], qt[1]); w0.y = pk2(qt[2], qt[3]); w0.z = pk2(qt[4], qt[5]); w0.w = pk2(qt[6], qt[7]);
        w1.x = pk2(qt[8], qt[9]); w1.y = pk2(qt[10], qt[11]); w1.z = pk2(qt[12], qt[13]); w1.w = pk2(qt[14], qt[15]);
        *(LAS u32x4*)(QT + i * LT + ds) = w0; *(LAS u32x4*)(QT + i * LT + ds + 8) = w1;
        w0.x = pk2(qe[0], qe[1]); w0.y = pk2(qe[2], qe[3]); w0.z = pk2(qe[4], qe[5]); w0.w = pk2(qe[6], qe[7]);
        w1.x = pk2(qe[8], qe[9]); w1.y = pk2(qe[10], qe[11]); w1.z = pk2(qe[12], qe[13]); w1.w = pk2(qe[14], qe[15]);
        bf16_t* qg = WSP(bf16_t, WS_QEFF) + (size_t)uid * 4096 + i * 64 + ds;
        *(u32x4*)qg = w0; *(u32x4*)(qg + 8) = w1;
        w0.x = pk2(kk[0], kk[1]); w0.y = pk2(kk[2], kk[3]); w0.z = pk2(kk[4], kk[5]); w0.w = pk2(kk[6], kk[7]);
        w1.x = pk2(kk[8], kk[9]); w1.y = pk2(kk[10], kk[11]); w1.z = pk2(kk[12], kk[13]); w1.w = pk2(kk[14], kk[15]);
        *(LAS u32x4*)(Kt + i * LT + ds) = w0; *(LAS u32x4*)(Kt + i * LT + ds + 8) = w1;
        if (i == 63) { float* mv = WSP(float, WS_MVEC) + (size_t)(uid - 2 * 2048) * 64 + ds;
#pragma unroll
            for (int e = 0; e < 16; ++e) mv[e] = fexp(G63[e]); }
    }
    __syncthreads();
    const int I = w4;
    LAS bf16_t* KI = opq(KTI + (8 * I * (I + 1)) * LT);
    {
        const int nit = 16 * (I + 1) * 8;
        for (int idx = lane; idx < nit; idx += 64) { const int j = idx >> 3, d8 = (idx & 7) * 8;
            float kf[8]; unpack8(*(const LAS u32x4*)(Kt + j * LT + d8), kf);
            float o[8];
#pragma unroll
            for (int e = 0; e < 8; ++e) o[e] = kf[e] * fexp(fminf(Gt[(16 * I) * 64 + d8 + e] - Gt[j * 64 + d8 + e], 80.f));
            *(LAS u32x4*)(KI + j * LT + d8) = pack8(o); }
    }
    __syncthreads();
    f32x4 acc[4];
    {
        bf16x8 a[2];
#pragma unroll
        for (int ks = 0; ks < 2; ++ks) a[ks] = *(const LAS bf16x8*)(QT + (16 * I + r) * LT + ks * 32 + q * 8);
#pragma unroll
        for (int ct = 0; ct < 4; ++ct) { acc[ct] = (f32x4){0.f, 0.f, 0.f, 0.f};
            if (ct <= I) {
#pragma unroll
                for (int ks = 0; ks < 2; ++ks) { const bf16x8 bb = *(const LAS bf16x8*)(KI + (16 * ct + r) * LT + ks * 32 + q * 8);
                    acc[ct] = __builtin_amdgcn_mfma_f32_16x16x32_bf16(a[ks], bb, acc[ct], 0, 0, 0); } } }
        asm volatile("s_waitcnt lgkmcnt(0)" ::: "memory");
#pragma unroll
        for (int ct = 0; ct < 4; ++ct)
#pragma unroll
            for (int j = 0; j < 4; ++j) { const int ii = 16 * I + 4 * q + j, col = 16 * ct + r;
                QT[ii * LT + col] = f2bf((ct <= I && ii >= col) ? acc[ct][j] : 0.f); }
    }
    __syncthreads();
    {
#pragma unroll
        for (int e = 0; e < 16; ++e) { VT[(ds + e) * LT + i] = f2bf(vv[e]); KDT[(ds + e) * LT + i] = f2bf(kk[e] * fexp(G63[e] - Gi[e])); }
    }
    __syncthreads();
#pragma unroll
    for (int ct = 0; ct < 4; ++ct) acc[ct] = mma16(QT, 16 * w4, VT, 16 * ct, (f32x4){0.f, 0.f, 0.f, 0.f}, r, q);
    store_oloc(WSP(bf16_t, WS_OLOC), uid, w4, lane, acc);
#pragma unroll
    for (int ct = 0; ct < 4; ++ct) acc[ct] = mma16(KDT, 16 * w4, VT, 16 * ct, (f32x4){0.f, 0.f, 0.f, 0.f}, r, q);
    store_bc(WSP(bf16_t, WS_BCS), uid, w4, r, q, acc);
    __syncthreads();
}

__device__ __forceinline__ void gdn_unit(const Ctx& X, LAS unsigned char* hl, int b, int c, int h, int tid_h, int w4, int lane, int layer) {
    LAS bf16_t* Q = opq((LAS bf16_t*)hl); LAS bf16_t* K = opq(Q + 64 * LT); LAS bf16_t* KB = opq(K + 64 * LT); LAS bf16_t* V = opq(KB + 64 * LT); LAS bf16_t* KDT = opq(V + 64 * LT); LAS bf16_t* P = opq(KDT + 64 * LT);
    LAS bf16_t* WT = KB; LAS bf16_t* UT = V;
    LAS bf16_t* AB = opq((LAS bf16_t*)(hl + 55296));
    LAS float* ACCS = opq((LAS float*)(hl + 64512));
    LAS float* Gs = opq((LAS float*)(hl + 72704));
    LAS float* Bs = opq(Gs + 64);
    const bf16_t* proj = WSP(const bf16_t, WS_PROJ);
    const int uid = unit_id(1, b, h, c);
    const int r = lane & 15, q = lane >> 4;
    {
    LAS bf16_t* RAW = opq((LAS bf16_t*)(hl + 46080));
    const int cseg = tid_h & 7, i0 = tid_h >> 3;
    f32x4 wq[3][4][2];
    {
        const float* cw = X.in[8] + (size_t)layer * 4 * 768 + h * 64 + cseg * 8;
#pragma unroll
        for (int tn = 0; tn < 3; ++tn)
#pragma unroll
            for (int k = 0; k < 4; ++k) { const f32x4* wp = (const f32x4*)(cw + k * 768 + tn * 256); wq[tn][k][0] = wp[0]; wq[tn][k][1] = wp[1]; }
        u32x4 rawv[7];
#pragma unroll
        for (int n = 0; n < 7; ++n) { const int item = tid_h + 256 * n; const int seg = item & 7; int rowid = item >> 3; rowid = rowid < 201 ? rowid : 200;
            const int tn = rowid / 67, rr = rowid - tn * 67; const int tt = c * 64 - 3 + rr; const int ttc = tt < 0 ? 0 : tt;
            const u32x4 v = *(const u32x4*)(proj + ((size_t)b * T + ttc) * LDP + C_GQ + tn * 256 + h * 64 + seg * 8);
            rawv[n] = tt < 0 ? (u32x4){0u, 0u, 0u, 0u} : v; }
        float g = 0.f, bt = 0.f;
        if (tid_h < 64) {
            const bf16_t* pr = proj + ((size_t)b * T + c * 64 + tid_h) * LDP;
            const float* gba = WSP(const float, WS_GBA) + ((size_t)b * T + c * 64 + tid_h) * 8; const float gb = gba[h], ga = gba[4 + h];
            g = -fexp(X.in[9][layer * 4 + h]) * softplus_f(ga + X.in[10][layer * 4 + h]);
#pragma unroll
            for (int o = 1; o < 64; o <<= 1) { const float t = __shfl_up(g, o); if (lane >= o) g += t; }
            bt = sigmoid_f(gb);
            Gs[tid_h] = g; Bs[tid_h] = bt;
        }
#pragma unroll
        for (int n = 0; n < 7; ++n) { const int item = tid_h + 256 * n; if (item < 1608) *(LAS u32x4*)(RAW + (item >> 3) * 64 + (item & 7) * 8) = rawv[n]; }
    }
    __syncthreads();
    {
        const float G63 = Gs[63];
#pragma unroll
        for (int rs = 0; rs < 2; ++rs) {
            const int i = i0 + 32 * rs;
            const float bi = Bs[i], Gi = Gs[i];
            float y[3][8];
#pragma unroll
            for (int tn = 0; tn < 3; ++tn) {
#pragma unroll
                for (int e = 0; e < 8; ++e) y[tn][e] = 0.f;
#pragma unroll
                for (int k = 0; k < 4; ++k) { float x8[8]; unpack8(*(const LAS u32x4*)(RAW + (tn * 67 + i + k) * 64 + cseg * 8), x8);
                    y[tn][0] += wq[tn][k][0].x * x8[0]; y[tn][1] += wq[tn][k][0].y * x8[1]; y[tn][2] += wq[tn][k][0].z * x8[2]; y[tn][3] += wq[tn][k][0].w * x8[3];
                    y[tn][4] += wq[tn][k][1].x * x8[4]; y[tn][5] += wq[tn][k][1].y * x8[5]; y[tn][6] += wq[tn][k][1].z * x8[6]; y[tn][7] += wq[tn][k][1].w * x8[7]; }
#pragma unroll
                for (int e = 0; e < 8; ++e) y[tn][e] = silu_acc(y[tn][e]);
            }
            float sq = 0.f, sk = 0.f;
#pragma unroll
            for (int e = 0; e < 8; ++e) { sq += y[0][e] * y[0][e]; sk += y[1][e] * y[1][e]; }
            sq += __shfl_xor(sq, 1); sq += __shfl_xor(sq, 2); sq += __shfl_xor(sq, 4);
            sk += __shfl_xor(sk, 1); sk += __shfl_xor(sk, 2); sk += __shfl_xor(sk, 4);
            const float rq = 0.125f * rsqrtf(sq + 1e-6f), rk = rsqrtf(sk + 1e-6f), kd = rk * fexp(G63 - Gi);
            float t8[8];
#pragma unroll
            for (int e = 0; e < 8; ++e) t8[e] = y[0][e] * rq;
            *(LAS u32x4*)(Q + i * LT + cseg * 8) = pack8(t8);
#pragma unroll
            for (int e = 0; e < 8; ++e) t8[e] = y[1][e] * rk;
            *(LAS u32x4*)(K + i * LT + cseg * 8) = pack8(t8);
#pragma unroll
            for (int e = 0; e < 8; ++e) t8[e] = y[1][e] * rk * bi;
            *(LAS u32x4*)(KB + i * LT + cseg * 8) = pack8(t8);
            *(LAS u32x4*)(V + i * LT + cseg * 8) = pack8(y[2]);
#pragma unroll
            for (int e = 0; e < 8; ++e) KDT[(cseg * 8 + e) * LT + i] = f2bf(y[1][e] * kd);
        }
    }
    __syncthreads();
    }
    {
        f32x4 aA[4], aP[4];
#pragma unroll
        for (int ct = 0; ct < 4; ++ct) { aA[ct] = mma16(KB, 16 * w4, K, 16 * ct, (f32x4){0.f, 0.f, 0.f, 0.f}, r, q); aP[ct] = mma16(Q, 16 * w4, K, 16 * ct, (f32x4){0.f, 0.f, 0.f, 0.f}, r, q); }
#pragma unroll
        for (int ct = 0; ct < 4; ++ct)
#pragma unroll
            for (int j = 0; j < 4; ++j) { const int ii = 16 * w4 + 4 * q + j, col = 16 * ct + r;
                const float L = fexp(fminf(Gs[ii] - Gs[col], 0.f));
                AB[ii * LT + col] = f2bf(ii > col ? aA[ct][j] * L : 0.f);
                P[ii * LT + col] = f2bf(ii >= col ? aP[ct][j] * L : 0.f); }
    }
    __syncthreads();
    float rc[64];
    if (w4 < 2) {
        const int col = tid_h & 63; const LAS bf16_t* src = w4 == 0 ? V : KB;
#pragma unroll
        for (int i = 0; i < 64; ++i) { const float sc = w4 == 0 ? Bs[i] : fexp(Gs[i]); rc[i] = bf2f(src[i * LT + col]) * sc; }
    }
    __syncthreads();
    {
    for (int idx = tid_h; idx < 1152; idx += 256) { const int tl = idx >= 576; const int rem = idx - tl * 576; *(LAS u32x4*)((tl ? KB : V) + rem * 8) = (u32x4){0u, 0u, 0u, 0u}; }
    __syncthreads();
#pragma unroll
    for (int I = 0; I < 4; ++I) {
        if (I > 0) {
#pragma unroll
            for (int t2 = 0; t2 < 2; ++t2) { const int ct8 = 2 * w4 + t2; const LAS bf16_t* Bt = ct8 < 4 ? UT : WT;
                const f32x4 a = mma16(AB, 16 * I, Bt, 16 * (ct8 & 3), (f32x4){0.f, 0.f, 0.f, 0.f}, r, q);
#pragma unroll
                for (int j = 0; j < 4; ++j) ACCS[(4 * q + j) * 128 + 16 * ct8 + r] = a[j]; }
            __syncthreads();
        }
        if (w4 < 2) {
            const int col = tid_h & 63, c128 = w4 * 64 + col;
            float t[16];
#pragma unroll
            for (int ii = 0; ii < 16; ++ii) t[ii] = rc[16 * I + ii] - (I > 0 ? ACCS[ii * 128 + c128] : 0.f);
#pragma unroll
            for (int ii = 1; ii < 16; ++ii) {
                float a16[16];
                { float lo[8]; unpack8(*(const LAS u32x4*)(AB + (16 * I + ii) * LT + 16 * I), lo);
#pragma unroll
                  for (int e = 0; e < 8; ++e) a16[e] = lo[e]; }
                if (ii > 8) { float hi[8]; unpack8(*(const LAS u32x4*)(AB + (16 * I + ii) * LT + 16 * I + 8), hi);
#pragma unroll
                  for (int e = 0; e < 8; ++e) a16[8 + e] = hi[e]; }
                float s0 = t[ii], s1 = 0.f;
#pragma unroll
                for (int kk = 0; kk < ii; ++kk) { if (kk & 1) s1 -= a16[kk] * t[kk]; else s0 -= a16[kk] * t[kk]; }
                t[ii] = s0 + s1;
            }
            LAS bf16_t* dst = (w4 == 0 ? UT : WT) + col * LT + 16 * I;
            u32x4 w0, w1;
            w0.x = pk2(t[0], t[1]); w0.y = pk2(t[2], t[3]); w0.z = pk2(t[4], t[5]); w0.w = pk2(t[6], t[7]);
            w1.x = pk2(t[8], t[9]); w1.y = pk2(t[10], t[11]); w1.z = pk2(t[12], t[13]); w1.w = pk2(t[14], t[15]);
            *(LAS u32x4*)dst = w0; *(LAS u32x4*)(dst + 8) = w1;
        }
        __syncthreads();
    }
    }
    {
        f32x4 acc[4];
        const float eG63 = fexp(Gs[63]);
#pragma unroll
        for (int ct = 0; ct < 4; ++ct) acc[ct] = mma16(P, 16 * w4, WT, 16 * ct, (f32x4){0.f, 0.f, 0.f, 0.f}, r, q);
        bf16_t* qe = WSP(bf16_t, WS_QEFF) + (size_t)uid * 4096;
#pragma unroll
        for (int ct = 0; ct < 4; ++ct)
#pragma unroll
            for (int j = 0; j < 4; ++j) { const int ii = 16 * w4 + 4 * q + j, col = 16 * ct + r;
                qe[ii * 64 + col] = f2bf(bf2f(Q[ii * LT + col]) * fexp(Gs[ii]) - acc[ct][j]); }
#pragma unroll
        for (int ct = 0; ct < 4; ++ct) acc[ct] = mma16(P, 16 * w4, UT, 16 * ct, (f32x4){0.f, 0.f, 0.f, 0.f}, r, q);
        store_oloc(WSP(bf16_t, WS_OLOC), uid, w4, lane, acc);
#pragma unroll
        for (int ct = 0; ct < 4; ++ct) acc[ct] = mma16(KDT, 16 * w4, WT, 16 * ct, (f32x4){0.f, 0.f, 0.f, 0.f}, r, q);
        bf16_t* mm = WSP(bf16_t, WS_MM) + (size_t)(uid - 2048) * 4096;
#pragma unroll
        for (int ct = 0; ct < 4; ++ct)
#pragma unroll
            for (int j = 0; j < 4; ++j) { const int ii = 16 * w4 + 4 * q + j, col = 16 * ct + r;
                mm[((w4 * 2 + (ct >> 1)) * 64 + (r >> 2) * 16 + 4 * q + j) * 8 + (ct & 1) * 4 + (r & 3)] = f2bf((ii == col ? eG63 : 0.f) - acc[ct][j]); }
#pragma unroll
        for (int ct = 0; ct < 4; ++ct) acc[ct] = mma16(KDT, 16 * w4, UT, 16 * ct, (f32x4){0.f, 0.f, 0.f, 0.f}, r, q);
        store_bc(WSP(bf16_t, WS_BCS), uid, w4, r, q, acc);
    }
    __syncthreads();
}

__device__ __forceinline__ void conf_unit(const Ctx& X, LAS unsigned char* lds, int b, int c, int tid, int wave, int lane, int layer) {
    LAS bf16_t* GL = opq((LAS bf16_t*)lds);
    LAS float* Y = opq((LAS float*)(lds + 49152));
    const bf16_t* proj = WSP(const bf16_t, WS_PROJ);
    bf16_t* mix = WSP(bf16_t, WS_MIX);
    const int t0 = c * 64;
    float w[31]; float bias;
    { const int ch = tid & 255; const float* cw = X.in[4] + (size_t)layer * 31 * 256 + ch;
#pragma unroll
      for (int k = 0; k < 31; ++k) w[k] = cw[k * 256];
      bias = X.in[5][layer * 256 + ch]; }
    {
        u32x4 av[6], gvv[6];
#pragma unroll
        for (int n = 0; n < 6; ++n) { int item = tid + 512 * n; item = item < 94 * 32 ? item : 94 * 32 - 1; const int rr = item >> 5, seg = (item & 31) * 8; int tt = t0 - 30 + rr; tt = tt < 0 ? 0 : tt;
            const bf16_t* pr = proj + ((size_t)b * T + tt) * LDP; av[n] = *(const u32x4*)(pr + C_CA + seg); gvv[n] = *(const u32x4*)(pr + C_CG + seg); }
#pragma unroll
        for (int n = 0; n < 6; ++n) { const int item = tid + 512 * n; if (item < 94 * 32) { const int rr = item >> 5, seg = (item & 31) * 8, tt = t0 - 30 + rr;
            u32x4 w = (u32x4){0u, 0u, 0u, 0u};
            if (tt >= 0) { float a[8], g[8], o[8]; unpack8(av[n], a); unpack8(gvv[n], g);
#pragma unroll
                for (int e = 0; e < 8; ++e) o[e] = a[e] * sigmoid_f(g[e]);
                w = pack8(o); }
            *(LAS u32x4*)(GL + rr * 256 + seg) = w; } }
    }
    __syncthreads();
    {
        const int ch = tid & 255, half = tid >> 8;
        float acc[32];
#pragma unroll
        for (int tk = 0; tk < 32; ++tk) acc[tk] = bias;
#pragma unroll
        for (int rr = 0; rr < 62; ++rr) { const float g = bf2f(GL[(half * 32 + rr) * 256 + ch]);
#pragma unroll
            for (int tk = 0; tk < 32; ++tk) { const int k = rr - tk; if (k >= 0 && k < 31) acc[tk] += w[k] * g; } }
#pragma unroll
        for (int tk = 0; tk < 32; ++tk) Y[(half * 32 + tk) * 256 + ch] = acc[tk];
    }
    __syncthreads();
    {
        const f32x4 lw = *((const f32x4*)(X.in[6] + layer * 256) + lane), lb = *((const f32x4*)(X.in[7] + layer * 256) + lane);
#pragma unroll 2
        for (int tk = wave * 8; tk < wave * 8 + 8; ++tk) {
            const f32x4 v = *((const LAS f32x4*)(Y + tk * 256) + lane);
            const float mu = wave_sum((v.x + v.y) + (v.z + v.w)) * (1.f / 256.f);
            const f32x4 dv = v - mu;
            const float var = wave_sum((dv.x * dv.x + dv.y * dv.y) + (dv.z * dv.z + dv.w * dv.w)) * (1.f / 256.f);
            const float rs = rsqrtf(var + 1e-5f);
            f32x4 o = dv * rs * lw + lb;
            const bool on = (MIX_MASK & 2) != 0;
            u32x2 p; p.x = on ? pk2(silu_acc(o.x), silu_acc(o.y)) : 0u; p.y = on ? pk2(silu_acc(o.z), silu_acc(o.w)) : 0u;
            *(u32x2*)(mix + ((size_t)b * T + t0 + tk) * D + 256 + lane * 4) = p;
        }
    }
    __syncthreads();
}

__device__ __forceinline__ void mixer_local_phase(const Ctx& X, LAS unsigned char* lds, int layer, int tid, int wave, int lane) {
    const int hs = wave >> 2, w4 = wave & 3; int tid_h = tid & 255;
    LAS unsigned char* hl = lds + hs * HEAD_LDS;
    const int nit_ = (3584 + (int)gridDim.x - 1) / (int)gridDim.x;
    for (int it_ = 0; it_ < nit_; ++it_) {
        const int u = (int)blockIdx.x + (int)gridDim.x * ((it_ + (int)(blockIdx.x >> 3)) % nit_);
        if (u >= 3584) continue;
        asm volatile("" : "+v"(tid_h), "+v"(lane), "+v"(tid));
        if (u < 3072) { const int mixer = u >> 10, idx = u & 1023, hp = idx & 1, cb = idx >> 1, b = cb >> 7, c = cb & 127, h = hp * 2 + hs;
            if (mixer == 0) { ret_unit(X, hl, b, c, h, tid_h, w4, lane);
            } else if (mixer == 1) { gdn_unit(X, hl, b, c, h, tid_h, w4, lane, layer);
            } else { hgrn_unit(X, hl, b, c, h, tid_h, w4, lane, layer);
            }
        } else { const int cb = u - 3072; conf_unit(X, lds, cb >> 7, cb & 127, tid, wave, lane, layer);
        }
    }
}

__device__ __forceinline__ void scan_phase(const Ctx& X, int wave, int lane) {
    const int job = blockIdx.x;
    if (job >= 192 || wave != 0) return;
    asm volatile("" : "+v"(lane));
    const int mixer = job >> 6, rem = job & 63, bh = rem >> 2, vg = rem & 3;
    const int uid0 = (mixer * 16 + bh) * NCH;
    const int r = lane & 15, q = lane >> 4;
    bf16_t* bc0 = WSP(bf16_t, WS_BCS) + (size_t)uid0 * 4096 + (vg * 4 * 64 + lane) * 4;
    float S[4][4];
#pragma unroll
    for (int t = 0; t < 4; ++t)
#pragma unroll
        for (int j = 0; j < 4; ++j) S[t][j] = 0.f;
    if (mixer == 1) {
        const bf16_t* mm0 = WSP(const bf16_t, WS_MM) + (size_t)(uid0 - 2048) * 4096;
        u32x2 cb[4][4], ca[4][4][2][2];
#define SCAN_LOAD_G(slot, cc) { const int c_ = (cc) < NCH ? (cc) : NCH - 1; const bf16_t* bcn = bc0 + (size_t)c_ * 4096; const bf16_t* mmn = mm0 + (size_t)c_ * 4096; \
            _Pragma("unroll") for (int t = 0; t < 4; ++t) { cb[slot][t] = *(const u32x2*)(bcn + 256 * t); \
                _Pragma("unroll") for (int s2 = 0; s2 < 2; ++s2) { const u32x4 w_ = *(const u32x4*)(mmn + ((t * 2 + s2) * 64 + lane) * 8); ca[slot][t][s2][0] = (u32x2){w_.x, w_.y}; ca[slot][t][s2][1] = (u32x2){w_.z, w_.w}; } } }
        SCAN_LOAD_G(0, 0) SCAN_LOAD_G(1, 1) SCAN_LOAD_G(2, 2)
#pragma unroll 1
        for (int c0 = 0; c0 < NCH; c0 += 4) {
#pragma unroll
            for (int k = 0; k < 4; ++k) {
                const int c = c0 + k;
                SCAN_LOAD_G((k + 3) & 3, c + 3)
                bf16_t* bcc = bc0 + (size_t)c * 4096;
                u32x2 sp[4];
#pragma unroll
                for (int t = 0; t < 4; ++t) { sp[t].x = pk2(S[t][0], S[t][1]); sp[t].y = pk2(S[t][2], S[t][3]);
                    asm volatile("" : "+v"(sp[t].x) : "v"(cb[k][t].x));
                    *(u32x2*)(bcc + 256 * t) = sp[t]; }
                bf16x8 bfr[2];
#pragma unroll
                for (int s2 = 0; s2 < 2; ++s2) { u32x4 w; w.x = sp[2 * s2].x; w.y = sp[2 * s2].y; w.z = sp[2 * s2 + 1].x; w.w = sp[2 * s2 + 1].y; bfr[s2] = __builtin_bit_cast(bf16x8, w); }
#pragma unroll
                for (int t = 0; t < 4; ++t) {
                    f32x4 acc = (f32x4){bf_lo(cb[k][t].x), bf_hi(cb[k][t].x), bf_lo(cb[k][t].y), bf_hi(cb[k][t].y)};
#pragma unroll
                    for (int s2 = 0; s2 < 2; ++s2) { u32x4 w; w.x = ca[k][t][s2][0].x; w.y = ca[k][t][s2][0].y; w.z = ca[k][t][s2][1].x; w.w = ca[k][t][s2][1].y;
                        acc = __builtin_amdgcn_mfma_f32_16x16x32_bf16(__builtin_bit_cast(bf16x8, w), bfr[s2], acc, 0, 0, 0); }
                    S[t][0] = acc[0]; S[t][1] = acc[1]; S[t][2] = acc[2]; S[t][3] = acc[3];
                }
            }
        }
#undef SCAN_LOAD_G
    } else {
        const int h = bh & 3;
        const float g64 = __expf(64.0f * log1pf(-exp2f(-5.0f - (float)h)));
        const float* mv0 = WSP(const float, WS_MVEC) + (size_t)(mixer == 2 ? uid0 - 2 * 2048 : 0) * 64 + 4 * q;
        u32x2 cb[4][4]; f32x4 cm[4][4];
#define SCAN_LOAD_D(slot, cc) { const int c_ = (cc) < NCH ? (cc) : NCH - 1; const bf16_t* bcn = bc0 + (size_t)c_ * 4096; \
            _Pragma("unroll") for (int t = 0; t < 4; ++t) { cb[slot][t] = *(const u32x2*)(bcn + 256 * t); cm[slot][t] = mixer == 2 ? *(const f32x4*)(mv0 + (size_t)c_ * 64 + 16 * t) : (f32x4){g64, g64, g64, g64}; } }
        SCAN_LOAD_D(0, 0) SCAN_LOAD_D(1, 1) SCAN_LOAD_D(2, 2)
#pragma unroll 1
        for (int c0 = 0; c0 < NCH; c0 += 4) {
#pragma unroll
            for (int k = 0; k < 4; ++k) {
                const int c = c0 + k;
                SCAN_LOAD_D((k + 3) & 3, c + 3)
                bf16_t* bcc = bc0 + (size_t)c * 4096;
#pragma unroll
                for (int t = 0; t < 4; ++t) { u32x2 sp; sp.x = pk2(S[t][0], S[t][1]); sp.y = pk2(S[t][2], S[t][3]);
                    asm volatile("" : "+v"(sp.x) : "v"(cb[k][t].x));
                    *(u32x2*)(bcc + 256 * t) = sp;
                    S[t][0] = cm[k][t].x * S[t][0] + bf_lo(cb[k][t].x); S[t][1] = cm[k][t].y * S[t][1] + bf_hi(cb[k][t].x);
                    S[t][2] = cm[k][t].z * S[t][2] + bf_lo(cb[k][t].y); S[t][3] = cm[k][t].w * S[t][3] + bf_hi(cb[k][t].y); }
            }
        }
#undef SCAN_LOAD_D
    }
}

__device__ __forceinline__ void mixer_out_phase(const Ctx& X, LAS unsigned char* lds, int layer, int tid, int wave, int lane) {
    constexpr int GP = 264;
    const bf16_t* proj = WSP(const bf16_t, WS_PROJ);
    bf16_t* mix = WSP(bf16_t, WS_MIX);
    for (int u = blockIdx.x; u < 1536; u += gridDim.x) {
        asm volatile("" : "+v"(lane), "+v"(tid));
        LAS bf16_t* GT = opq((LAS bf16_t*)lds);
        const int r = lane & 15, q = lane >> 4, h = wave >> 1, half = wave & 1;
        const int mixer = u >> 9, rem = u & 511, b = rem >> 7, c = rem & 127;
        const int uid = unit_id(mixer, b, h, c);
        const int goff = mixer == 0 ? C_RG : (mixer == 1 ? C_GG : C_HG), moff = mixer == 0 ? 0 : (mixer == 1 ? 512 : 768);
        const size_t row0 = (size_t)b * T + c * 64;
        u32x4 gv[4];
#pragma unroll
        for (int n = 0; n < 4; ++n) { const int idx = tid + 512 * n; gv[n] = *(const u32x4*)(proj + (row0 + (idx >> 5)) * LDP + goff + (idx & 31) * 8); }
        const bf16_t* qe = WSP(const bf16_t, WS_QEFF) + (size_t)uid * 4096;
        const bf16_t* st = WSP(const bf16_t, WS_BCS) + (size_t)uid * 4096;
        bf16x8 a[2][2], bb[4][2]; u32x4 ov[2][2];
#pragma unroll
        for (int rt = 0; rt < 2; ++rt) { const int rt4 = 2 * half + rt;
#pragma unroll
            for (int ks = 0; ks < 2; ++ks) a[rt][ks] = *(const bf16x8*)(qe + (16 * rt4 + r) * 64 + ks * 32 + q * 8);
            const u32x4* ol = (const u32x4*)(WSP(const bf16_t, WS_OLOC) + ((size_t)uid * 4 + rt4) * 1024 + lane * 16); ov[rt][0] = ol[0]; ov[rt][1] = ol[1]; }
#pragma unroll
        for (int ct = 0; ct < 4; ++ct)
#pragma unroll
            for (int ks = 0; ks < 2; ++ks) { const bf16_t* tb = st + (size_t)((ct * 4 + 2 * ks + (q >> 1)) * 64) * 4;
                const u32x2 lo = *(const u32x2*)(tb + ((2 * (q & 1)) * 16 + r) * 4), hi = *(const u32x2*)(tb + ((2 * (q & 1) + 1) * 16 + r) * 4);
                bb[ct][ks] = __builtin_bit_cast(bf16x8, (u32x4){lo.x, lo.y, hi.x, hi.y}); }
        const float* nw = mixer == 0 ? X.in[3] + layer * 256 + h * 64 : (mixer == 1 ? X.in[11] + layer * 64 : X.in[13] + layer * 64);
        float wv[4];
#pragma unroll
        for (int ct = 0; ct < 4; ++ct) wv[ct] = nw[16 * ct + r];
#pragma unroll
        for (int n = 0; n < 4; ++n) { const int idx = tid + 512 * n; *(LAS u32x4*)(GT + (idx >> 5) * GP + (idx & 31) * 8) = gv[n]; }
        __syncthreads();
        const bool on = ((MIX_MASK >> (mixer == 0 ? 0 : (mixer == 1 ? 2 : 3))) & 1) != 0;
#pragma unroll
        for (int rt = 0; rt < 2; ++rt) {
            f32x4 acc[4];
            acc[0] = (f32x4){bf_lo(ov[rt][0].x), bf_hi(ov[rt][0].x), bf_lo(ov[rt][0].y), bf_hi(ov[rt][0].y)}; acc[1] = (f32x4){bf_lo(ov[rt][0].z), bf_hi(ov[rt][0].z), bf_lo(ov[rt][0].w), bf_hi(ov[rt][0].w)};
            acc[2] = (f32x4){bf_lo(ov[rt][1].x), bf_hi(ov[rt][1].x), bf_lo(ov[rt][1].y), bf_hi(ov[rt][1].y)}; acc[3] = (f32x4){bf_lo(ov[rt][1].z), bf_hi(ov[rt][1].z), bf_lo(ov[rt][1].w), bf_hi(ov[rt][1].w)};
#pragma unroll
            for (int ct = 0; ct < 4; ++ct)
#pragma unroll
                for (int ks = 0; ks < 2; ++ks) acc[ct] = __builtin_amdgcn_mfma_f32_16x16x32_bf16(a[rt][ks], bb[ct][ks], acc[ct], 0, 0, 0);
#pragma unroll
            for (int j = 0; j < 4; ++j) {
                float sm = (acc[0][j] + acc[1][j]) + (acc[2][j] + acc[3][j]);
                sm += __shfl_xor(sm, 1); sm += __shfl_xor(sm, 2); sm += __shfl_xor(sm, 4); sm += __shfl_xor(sm, 8);
                const float mu = mixer == 0 ? sm * (1.f / 64.f) : 0.f;
                float d[4], s2 = 0.f;
#pragma unroll
                for (int ct = 0; ct < 4; ++ct) { d[ct] = acc[ct][j] - mu; s2 += d[ct] * d[ct]; }
                s2 += __shfl_xor(s2, 1); s2 += __shfl_xor(s2, 2); s2 += __shfl_xor(s2, 4); s2 += __shfl_xor(s2, 8);
                const float rs = rsqrtf(s2 * (1.f / 64.f) + (mixer == 0 ? 1e-5f : 1e-6f));
                const int ii = 16 * (2 * half + rt) + 4 * q + j;
#pragma unroll
                for (int ct = 0; ct < 4; ++ct) { LAS bf16_t* gp = GT + ii * GP + h * 64 + 16 * ct + r;
                    const float y = d[ct] * rs * wv[ct] * silu_acc(bf2f(*gp));
                    *gp = on ? f2bf(y) : (bf16_t)0; }
            }
        }
        __syncthreads();
#pragma unroll
        for (int n = 0; n < 4; ++n) { const int idx = tid + 512 * n; __builtin_nontemporal_store(*(const LAS u32x4*)(GT + (idx >> 5) * GP + (idx & 31) * 8), (u32x4*)(mix + (row0 + (idx >> 5)) * D + moff + (idx & 31) * 8)); }
        __syncthreads();
    }
}

constexpr int PREP_FIRST = (D / 64) * (NINP / 32), PREP_ALL = DEPTH * ((D / 64) * (NINP / 32) + (D / 64) * (D / 32) + 2 * (D / 64) * (DFF / 32) + (DFF / 64) * (D / 32));
__global__ void __launch_bounds__(512, 2) fwd_kernel(Ctx X) {
    extern __shared__ __attribute__((aligned(16))) unsigned char lds_raw[];
    LAS unsigned char* lds = (LAS unsigned char*)lds_raw;
    cg::grid_group grid = cg::this_grid();
    const int tid = threadIdx.x, lane = tid & 63, wave = __builtin_amdgcn_readfirstlane(tid >> 6);
    const int G = gridDim.x, gw = blockIdx.x * 8 + wave, ngw = G * 8;
    bf16_t* XS = (bf16_t*)X.out;
    bf16_t* XN = WSP(bf16_t, WS_XN); bf16_t* PROJ = WSP(bf16_t, WS_PROJ); bf16_t* ACT = WSP(bf16_t, WS_PROJ); bf16_t* MIX = WSP(bf16_t, WS_MIX);

    if (X.ws == nullptr) grid.sync();
    if (tid < 4) ((LAS unsigned*)(lds + LDS_BAR_OFF))[tid] = 0u;
    __syncthreads();
    (void)xcd_barrier_post(WSP(unsigned, WS_CTL), (volatile LAS unsigned*)(lds + LDS_BAR_OFF));
#define GSYNC() do { XcdBarrier b_; b_.bar = WSP(unsigned, WS_CTL); b_.x = xb_xcc_id(); b_.st = (volatile LAS unsigned*)(lds + LDS_BAR_OFF); xcd_barrier(b_); } while (0)
    prep_weights(X, lds, gw, ngw, wave, lane, 0, PREP_FIRST);
    for (int idx = blockIdx.x * 512 + tid; idx < DEPTH * 16 * D; idx += G * 512) { const int ll = idx >> 14, n = (idx >> 10) & 15, k = idx & 1023;
        WSP(bf16_t, WS_WBA)[idx] = n < 8 ? f2bf(X.in[2][((size_t)ll * D + k) * DIN + 2560 + n] * X.in[1][ll * D + k]) : (bf16_t)0; }
    cast_phase(X.in[0], XS, WSP(float, WS_RSA), gw, ngw, lane);
    GSYNC();
#pragma unroll 1
    for (int l = 0; l < DEPTH; ++l) {
        {
            pg8::Gemm g{XS, WSP(const bf16_t, WS_WIN) + (size_t)l * NINP * D, M, NINP, D}; pg8::StaticOrder S; S.init(M, NINP, G, (int)blockIdx.x);
            pg8::EpiProj E{PROJ, LDP, DIN, WSP(const float, WS_RSA)};
            pg8::gemm_phase<pg8::EpiProj, pg8::StaticOrder, true, true>(lds, g, S, E);
            int ln = lane; asm volatile("" : "+v"(ln));
            const int r = ln & 15, q = ln >> 4;
            for (int rb = blockIdx.x; rb < M / 128; rb += G) {
                const bf16_t* Ap = XS + (size_t)(rb * 128 + wave * 16 + r) * D + q * 8;
                const bf16_t* Bp = WSP(const bf16_t, WS_WBA) + (size_t)l * 16 * D + r * D + q * 8;
                f32x4 acc = (f32x4){0.f, 0.f, 0.f, 0.f};
#pragma unroll 8
                for (int ks = 0; ks < 32; ++ks) acc = __builtin_amdgcn_mfma_f32_16x16x32_bf16(*(const bf16x8*)(Ap + ks * 32), *(const bf16x8*)(Bp + ks * 32), acc, 0, 0, 0);
                if (r < 8) {
#pragma unroll
                    for (int j = 0; j < 4; ++j) { const int row = rb * 128 + wave * 16 + 4 * q + j;
                        WSP(float, WS_GBA)[(size_t)row * 8 + r] = acc[j] * rsqrtf(WSP(const float, WS_RSA)[row] * (1.0f / 1024.0f) + 1e-6f); } }
            }
        }
        GSYNC();
        int tz = tid; asm volatile("" : "+v"(tz));
        for (int i = blockIdx.x * 512 + tz; i < M; i += G * 512) { WSP(float, WS_RSA)[i] = 0.f; WSP(float, WS_RSB)[i] = 0.f; }
        mixer_local_phase(X, lds, l, tid, wave, lane);
        GSYNC();
        scan_phase(X, wave, lane);
        if (l == 0 && wave != 0) prep_weights(X, lds, blockIdx.x * 7 + wave - 1, G * 7, wave, lane, PREP_FIRST, PREP_ALL);
        GSYNC();
        mixer_out_phase(X, lds, l, tid, wave, lane);
        GSYNC();
        {
            pg8::Gemm g{MIX, WSP(const bf16_t, WS_WOUT) + (size_t)l * D * D, M, D, D}; pg8::StaticOrder S; S.init(M, D, G, (int)blockIdx.x);
            pg8::EpiResid E{l == 0 ? X.in[0] : nullptr, l == 0 ? nullptr : XS, nullptr, XN, D, WSP(float, WS_RSB)};
            pg8::gemm_phase<pg8::EpiResid, pg8::StaticOrder, true, true>(lds, g, S, E);
        }
        GSYNC();
        {
            pg8::Gemm g{XN, WSP(const bf16_t, WS_WGU) + (size_t)l * NGU * D, M, NGU, D}; pg8::StaticOrder S; S.init(M, NGU, G, (int)blockIdx.x);
            pg8::EpiSwiglu E{ACT, DFF, WSP(const float, WS_RSB)};
            pg8::gemm_phase<pg8::EpiSwiglu, pg8::StaticOrder, true, true>(lds, g, S, E);
        }
        GSYNC();
        {
            pg8::Gemm g{ACT, WSP(const bf16_t, WS_WDN) + (size_t)l * D * DFF, M, D, DFF}; pg8::StaticOrder S; S.init(M, D, G, (int)blockIdx.x);
            pg8::EpiResid E{nullptr, XN, l + 1 < DEPTH ? nullptr : X.out, l + 1 < DEPTH ? XS : nullptr, D, l + 1 < DEPTH ? WSP(float, WS_RSA) : nullptr};
            pg8::gemm_phase<pg8::EpiResid, pg8::StaticOrder, true, true>(lds, g, S, E);
        }
        GSYNC();
        if (l + 1 == DEPTH) norm_phase(X.out, X.in[19], nullptr, X.out, gw, ngw, lane);
    }
}

extern "C" void kernel_launch(void* const* d_in, const int* in_sizes, int n_in, void* d_out, int out_size, void* d_ws, size_t ws_size, hipStream_t stream) {
    static int grid = 0;
    if (grid == 0) {
        if (n_in != 20 || out_size != M * D || ws_size < WS_END) { fprintf(stderr, "kernel_launch: unexpected shapes (n_in %d, out %d, ws %zu)\n", n_in, out_size, ws_size); grid = -1; return; }
        int dev = 0, cus = 0, per_cu = 0;
        hipGetDevice(&dev); hipDeviceGetAttribute(&cus, hipDeviceAttributeMultiprocessorCount, dev);
        if (hipFuncSetAttribute((const void*)fwd_kernel, hipFuncAttributeMaxDynamicSharedMemorySize, LDS_BYTES) != hipSuccess) { fprintf(stderr, "kernel_launch: hipFuncSetAttribute failed\n"); grid = -1; return; }
        if (hipOccupancyMaxActiveBlocksPerMultiprocessor(&per_cu, (const void*)fwd_kernel, 512, LDS_BYTES) != hipSuccess || per_cu < 1) { fprintf(stderr, "kernel_launch: occupancy query says %d\n", per_cu); per_cu = 1; }
        (void)hipGetLastError();
        grid = cus * (per_cu > 1 ? 1 : per_cu);
    }
    if (grid < 0) return;
    Ctx X{};
    for (int i = 0; i < 20; ++i) X.in[i] = (const float*)d_in[i];
    X.out = (float*)d_out; X.ws = (unsigned char*)d_ws;
    void* args[] = {&X};
    if (hipMemsetAsync((char*)d_ws + WS_CTL, 0, 16384, stream) != hipSuccess) { fprintf(stderr, "kernel_launch: hipMemsetAsync of the barrier words failed\n"); return; }
    hipError_t e = hipLaunchCooperativeKernel((const void*)fwd_kernel, dim3(grid), dim3(512), args, LDS_BYTES, stream);
    if (e != hipSuccess) fprintf(stderr, "cooperative launch failed: %s (grid %d)\n", hipGetErrorString(e), grid);
}
```

```cpp
#include <hip/hip_runtime.h>
#include <hip/hip_cooperative_groups.h>
#include <cstdio>
#include <cstdint>
namespace cg = cooperative_groups;

#ifndef MIX_MASK
#define MIX_MASK 15
#endif
namespace pg8 {
#define PG8_LAS __attribute__((address_space(3)))
typedef unsigned short bf16_t;
typedef short bf16x8 __attribute__((ext_vector_type(8)));
typedef float f32x4 __attribute__((ext_vector_type(4)));
typedef unsigned u32x4 __attribute__((ext_vector_type(4)));
constexpr int BM = 256, BK = 64, HALF = 128, HTB = HALF * BK * 2  , STAGE_BYTES = 8 * HTB, NXCD = 8, WGM = 8;

__host__ __device__ __forceinline__ int lds_byte(int r, int c) { const int st = (r >> 4) * 2 + (c >> 5), rr = r & 15, cc = c & 31, ob = rr * 64 + cc * 2; return st * 1024 + (ob ^ (((ob >> 9) & 1) << 5)); }
__host__ __device__ __forceinline__ void stage_rc(int b, int& R, int& C) { const int st = b / 1024, sb = b % 1024, swz = sb ^ (((sb >> 9) & 1) << 5); R = (st >> 1) * 16 + swz / 64; C = (st & 1) * 32 + (swz % 64) / 2; }
__host__ __device__ __forceinline__ int perm32(int rho) { const int n = rho >> 4, i = rho & 15; return 8 * (i >> 2) + 4 * n + (i & 3); }

struct Unit { int pm, pn; };
struct Gemm { const bf16_t* A; const bf16_t* Bt; int M, N, K; };

struct StaticOrder {
    int nM, nN, nwg, G, c;
    __host__ __device__ void init(int M, int N, int G_, int c_) { nM = M / BM; nN = N / BM; nwg = nM * nN; G = G_; c = c_; }
    __host__ __device__ bool next(int i, Unit& u) const {
        const long L = (long)i * G + c; if (L >= nwg) return false;
        int wgid = (int)L; { const int q = nwg / NXCD, r = nwg % NXCD, xcd = wgid % NXCD, off = wgid / NXCD; wgid = (xcd < r ? xcd * (q + 1) : r * (q + 1) + (xcd - r) * q) + off; }
        const int nig = WGM * nN, gid = wgid / nig, fm = gid * WGM, gsz = (nM - fm) < WGM ? (nM - fm) : WGM;
        u.pm = fm + ((wgid % nig) % gsz); u.pn = (wgid % nig) / gsz; return true;
    }
    __device__ __forceinline__ void a_ready(const Unit&) const {}
    __device__ __forceinline__ void done(const Unit&) const {}
};

__device__ __forceinline__ unsigned cvt_pk_bf16(float lo, float hi) { unsigned r; asm volatile("v_cvt_pk_bf16_f32 %0, %1, %2" : "=v"(r) : "v"(lo), "v"(hi)); return r; }
__device__ __forceinline__ float silu_f(float g) { return g * __builtin_amdgcn_rcpf(1.0f + __expf(-g)); }

struct EpiProj {
    static constexpr bool PERM = true, AFTER_DRAIN = false;
    bf16_t* O; int ldc; int ncols; const float* rowsq;
    __device__ __forceinline__ void pre(const Unit& u, int wr, int fr, float (&rsv)[8]) const {
#pragma unroll
        for (int i = 0; i < 8; ++i) rsv[i] = rowsq[u.pm * BM + wr * 64 + fr + (i >> 2) * HALF + (i & 3) * 16]; }
    __device__ __forceinline__ void operator()(const f32x4 (&acc)[2][2][4][2], const Unit& u, int wr, int wc, int fr, int fq, const float (&rsv)[8]) const {
        const int row0 = u.pm * BM + wr * 64 + fr; const int col0 = u.pn * BM + wc * 32 + 8 * fq;
#pragma unroll
        for (int ai = 0; ai < 2; ++ai)
#pragma unroll
            for (int m = 0; m < 4; ++m) { bf16_t* rowp = O + (size_t)(row0 + ai * HALF + m * 16) * ldc;
                const float rs = __builtin_amdgcn_rsqf(rsv[ai * 4 + m] * (1.0f / 1024.0f) + 1e-6f);
#pragma unroll
                for (int bj = 0; bj < 2; ++bj) { const int col = col0 + bj * HALF;
                    if (col < ncols) { const f32x4 v0 = acc[ai][bj][m][0] * rs, v1 = acc[ai][bj][m][1] * rs; u32x4 w;
                        w.x = cvt_pk_bf16(v0[0], v0[1]); w.y = cvt_pk_bf16(v0[2], v0[3]); w.z = cvt_pk_bf16(v1[0], v1[1]); w.w = cvt_pk_bf16(v1[2], v1[3]);
                        __builtin_nontemporal_store(w, (u32x4*)(rowp + col)); } } }
    }
};
struct EpiResid {
    static constexpr bool PERM = true, AFTER_DRAIN = false;
    const float* base_f; const bf16_t* base_b; float* out_f; bf16_t* out_b; int ldc; float* rowsq;
    __device__ __forceinline__ void pre(const Unit&, int, int, float (&)[8]) const {}
    __device__ __forceinline__ void operator()(const f32x4 (&acc)[2][2][4][2], const Unit& u, int wr, int wc, int fr, int fq, const float (&rsv)[8]) const {
        const int row0 = u.pm * BM + wr * 64 + fr; const int col0 = u.pn * BM + wc * 32 + 8 * fq;
#pragma unroll
        for (int ai = 0; ai < 2; ++ai)
#pragma unroll
            for (int m = 0; m < 4; ++m) { const size_t off = (size_t)(row0 + ai * HALF + m * 16) * ldc + col0; float sq = 0.f;
#pragma unroll
                for (int bj = 0; bj < 2; ++bj) { const size_t o_ = off + bj * HALF; f32x4 b0, b1;
                    if (base_b) { const u32x4 w = *(const u32x4*)(base_b + o_);
                        b0 = (f32x4){__uint_as_float(w.x << 16), __uint_as_float(w.x & 0xffff0000u), __uint_as_float(w.y << 16), __uint_as_float(w.y & 0xffff0000u)};
                        b1 = (f32x4){__uint_as_float(w.z << 16), __uint_as_float(w.z & 0xffff0000u), __uint_as_float(w.w << 16), __uint_as_float(w.w & 0xffff0000u)}; }
                    else { b0 = *(const f32x4*)(base_f + o_); b1 = *(const f32x4*)(base_f + o_ + 4); }
                    const f32x4 o0 = b0 + acc[ai][bj][m][0], o1 = b1 + acc[ai][bj][m][1];
                    if (out_f) { *(f32x4*)(out_f + o_) = o0; *(f32x4*)(out_f + o_ + 4) = o1; }
                    if (out_b) { u32x4 w; w.x = cvt_pk_bf16(o0[0], o0[1]); w.y = cvt_pk_bf16(o0[2], o0[3]); w.z = cvt_pk_bf16(o1[0], o1[1]); w.w = cvt_pk_bf16(o1[2], o1[3]); *(u32x4*)(out_b + o_) = w; }
                    sq += ((o0[0] * o0[0] + o0[1] * o0[1]) + (o0[2] * o0[2] + o0[3] * o0[3])) + ((o1[0] * o1[0] + o1[1] * o1[1]) + (o1[2] * o1[2] + o1[3] * o1[3])); }
                if (rowsq) { sq += __shfl_xor(sq, 16); sq += __shfl_xor(sq, 32); if (fq == 0) atomicAdd(rowsq + row0 + ai * HALF + m * 16, sq); } }
    }
};
struct EpiSwiglu {
    static constexpr bool PERM = true, AFTER_DRAIN = false;
    bf16_t* O; int ldc; const float* rowsq;
    __device__ __forceinline__ void pre(const Unit& u, int wr, int fr, float (&rsv)[8]) const {
#pragma unroll
        for (int i = 0; i < 8; ++i) rsv[i] = rowsq[u.pm * BM + wr * 64 + fr + (i >> 2) * HALF + (i & 3) * 16]; }
    __device__ __forceinline__ void operator()(const f32x4 (&acc)[2][2][4][2], const Unit& u, int wr, int wc, int fr, int fq, const float (&rsv)[8]) const {
        const int row0 = u.pm * BM + wr * 64 + fr; const int col0 = u.pn * HALF + wc * 32 + 8 * fq;
#pragma unroll
        for (int ai = 0; ai < 2; ++ai)
#pragma unroll
            for (int m = 0; m < 4; ++m) { bf16_t* rowp = O + (size_t)(row0 + ai * HALF + m * 16) * ldc + col0;
                const float rs = __builtin_amdgcn_rsqf(rsv[ai * 4 + m] * (1.0f / 1024.0f) + 1e-6f);
                const f32x4 g0 = acc[ai][0][m][0] * rs, g1 = acc[ai][0][m][1] * rs, u0 = acc[ai][1][m][0] * rs, u1 = acc[ai][1][m][1] * rs; u32x4 w;
                w.x = cvt_pk_bf16(silu_f(g0[0]) * u0[0], silu_f(g0[1]) * u0[1]); w.y = cvt_pk_bf16(silu_f(g0[2]) * u0[2], silu_f(g0[3]) * u0[3]);
                w.z = cvt_pk_bf16(silu_f(g1[0]) * u1[0], silu_f(g1[1]) * u1[1]); w.w = cvt_pk_bf16(silu_f(g1[2]) * u1[2], silu_f(g1[3]) * u1[3]);
                __builtin_nontemporal_store(w, (u32x4*)rowp); }
    }
};

template <class Epi, class Sched, bool ALIGN_EPI = false, bool SP2 = false>
__device__ __forceinline__ void gemm_phase(PG8_LAS unsigned char* lds, const Gemm g, const Sched& S, const Epi& E) {
    int tid_ = threadIdx.x; asm volatile("" : "+v"(tid_));
    const int tid = tid_, wid = __builtin_amdgcn_readfirstlane(tid >> 6), lane = tid & 63, wr = wid >> 2, wc = wid & 3, fr = lane & 15, fq = lane >> 4;
    const int K = g.K, nt = K / BK;
    unsigned voffA[2], voffB[2];
#pragma unroll
    for (int i = 0; i < 2; ++i) { int R, C; stage_rc(tid * 16 + i * 8192, R, C); const int Rb = Epi::PERM ? ((R & ~31) + perm32(R & 31)) : R;
        voffA[i] = (unsigned)(R * K + C) * 2u; voffB[i] = (unsigned)(Rb * K + C) * 2u; }
    const size_t kstep = (size_t)(BK * 2);
    const size_t hstep = (size_t)HALF * K * 2;
    const size_t tstep = 2 * hstep;
    const unsigned ldsw = (unsigned)wid * 1024u;
    const int aoff = lds_byte(wr * 64 + fr, fq * 8), boff = lds_byte(wc * 32 + fr, fq * 8);
#define PG8_SA(b, h) (((b) * 2 + (h)) * HTB)
#define PG8_SB(b, h) ((4 + (b) * 2 + (h)) * HTB)
#define PG8_STAGE(bufoff, gbase, voff) do { _Pragma("unroll") for (int _i = 0; _i < 2; ++_i) \
        __builtin_amdgcn_global_load_lds((const unsigned*)((const char*)(gbase) + (voff)[_i]), (PG8_LAS unsigned*)(lds + (bufoff) + ldsw + _i * 8192), 16, 0, 0); } while (0)
#define PG8_LDA(dst, b, h) do { _Pragma("unroll") for (int m = 0; m < 4; ++m) _Pragma("unroll") for (int k = 0; k < 2; ++k) dst[m][k] = *(const PG8_LAS bf16x8*)(lds + PG8_SA(b, h) + aoff + m * 2048 + k * 1024); } while (0)
#define PG8_LDB(dst, b, h) do { _Pragma("unroll") for (int n = 0; n < 2; ++n) _Pragma("unroll") for (int k = 0; k < 2; ++k) dst[n][k] = *(const PG8_LAS bf16x8*)(lds + PG8_SB(b, h) + boff + n * 2048 + k * 1024); } while (0)
#define PG8_MMA(ai, bj, At, Bt) do { __builtin_amdgcn_s_setprio(1); _Pragma("unroll") for (int m = 0; m < 4; ++m) _Pragma("unroll") for (int n = 0; n < 2; ++n) _Pragma("unroll") for (int k = 0; k < 2; ++k) \
        acc[ai][bj][m][n] = __builtin_amdgcn_mfma_f32_16x16x32_bf16(Bt[n][k], At[m][k], acc[ai][bj][m][n], 0, 0, 0); __builtin_amdgcn_s_setprio(0); } while (0)
#define PG8_WAIT_V(n) asm volatile("s_waitcnt vmcnt(" #n ")" ::: "memory")
#define PG8_WAIT_L(n) asm volatile("s_waitcnt lgkmcnt(" #n ")" ::: "memory")
#define PG8_BAR __builtin_amdgcn_s_barrier()
#define PG8_SCHED __builtin_amdgcn_sched_barrier(0)
    Unit cur, nxt; int ui = 0;
    float rsv[8];
    if (!S.next(0, cur)) return;
    f32x4 acc[2][2][4][2];
#pragma unroll
    for (int a = 0; a < 2; ++a)
#pragma unroll
        for (int b = 0; b < 2; ++b)
#pragma unroll
            for (int m = 0; m < 4; ++m)
#pragma unroll
                for (int n = 0; n < 2; ++n) acc[a][b][m][n] = (f32x4){0.f, 0.f, 0.f, 0.f};
    bf16x8 At[4][2], B0[2][2], B1[2][2];
    const char* cA = (const char*)g.A + (size_t)cur.pm * tstep; const char* cB = (const char*)g.Bt + (size_t)cur.pn * tstep;
    S.a_ready(cur);
    if constexpr (SP2) {
        PG8_STAGE(PG8_SB(0, 0), cB, voffB); PG8_STAGE(PG8_SB(0, 1), cB + hstep, voffB); PG8_STAGE(PG8_SA(0, 0), cA, voffA); PG8_STAGE(PG8_SA(0, 1), cA + hstep, voffA);
        if (wr == 1) PG8_BAR;
        PG8_WAIT_V(2); PG8_BAR;
        PG8_STAGE(PG8_SB(1, 0), cB + kstep, voffB); PG8_STAGE(PG8_SA(1, 0), cA + kstep, voffA); PG8_STAGE(PG8_SB(1, 1), cB + hstep + kstep, voffB);
        PG8_WAIT_V(6); PG8_BAR;
    } else {
        PG8_STAGE(PG8_SB(0, 0), cB, voffB); PG8_STAGE(PG8_SA(0, 0), cA, voffA); PG8_STAGE(PG8_SB(0, 1), cB + hstep, voffB); PG8_STAGE(PG8_SA(0, 1), cA + hstep, voffA);
        if (wr == 1) PG8_BAR;
        PG8_WAIT_V(4); PG8_BAR;
        PG8_STAGE(PG8_SB(1, 0), cB + kstep, voffB); PG8_STAGE(PG8_SA(1, 0), cA + kstep, voffA); PG8_STAGE(PG8_SB(1, 1), cB + hstep + kstep, voffB);
        PG8_WAIT_V(6); PG8_BAR;
    }
    for (;;) {
        const bool has_next = S.next(ui + 1, nxt);
        const char* nA = has_next ? (const char*)g.A + (size_t)nxt.pm * tstep : cA; const char* nB = has_next ? (const char*)g.Bt + (size_t)nxt.pn * tstep : cB;
        for (int t = 0; t < nt; t += 2) {
            const bool last = (t == nt - 2);
            const char* a1 = cA + (size_t)(t + 1) * kstep;
            const char* a2 = last ? nA : cA + (size_t)(t + 2) * kstep; const char* b2 = last ? nB : cB + (size_t)(t + 2) * kstep;
            const char* a3 = a2 + kstep; const char* b3 = b2 + kstep;
            if (last && has_next) S.a_ready(nxt);
            if (last) E.pre(cur, wr, fr, rsv);
            if constexpr (SP2) {
            PG8_LDB(B0, 0, 0); PG8_LDB(B1, 0, 1); PG8_SCHED; PG8_LDA(At, 0, 0); PG8_STAGE(PG8_SA(1, 1), a1 + hstep, voffA);
            PG8_WAIT_V(8); PG8_WAIT_L(0); PG8_BAR; PG8_MMA(0, 0, At, B0); PG8_MMA(0, 1, At, B1); PG8_BAR; PG8_SCHED;
            PG8_LDA(At, 0, 1); PG8_STAGE(PG8_SB(0, 0), b2, voffB); PG8_STAGE(PG8_SB(0, 1), b2 + hstep, voffB); PG8_STAGE(PG8_SA(0, 0), a2, voffA);
            PG8_WAIT_V(8); PG8_WAIT_L(0); PG8_BAR; PG8_MMA(1, 0, At, B0); PG8_MMA(1, 1, At, B1); PG8_BAR; PG8_SCHED;
            PG8_LDB(B0, 1, 0); PG8_LDB(B1, 1, 1); PG8_SCHED; PG8_LDA(At, 1, 0); PG8_STAGE(PG8_SA(0, 1), a2 + hstep, voffA);
            PG8_WAIT_V(8); PG8_WAIT_L(0); PG8_BAR; PG8_MMA(0, 0, At, B0); PG8_MMA(0, 1, At, B1); PG8_BAR; PG8_SCHED;
            PG8_LDA(At, 1, 1); PG8_STAGE(PG8_SB(1, 0), b3, voffB); PG8_STAGE(PG8_SB(1, 1), b3 + hstep, voffB); PG8_STAGE(PG8_SA(1, 0), a3, voffA);
            PG8_WAIT_V(8); PG8_WAIT_L(0); PG8_BAR; PG8_MMA(1, 0, At, B0); PG8_MMA(1, 1, At, B1); PG8_BAR; PG8_SCHED;
            } else {
            PG8_LDB(B0, 0, 0); PG8_SCHED; PG8_LDA(At, 0, 0); PG8_STAGE(PG8_SA(1, 1), a1 + hstep, voffA);
            PG8_WAIT_L(8); PG8_BAR; PG8_WAIT_L(0); PG8_MMA(0, 0, At, B0); PG8_BAR; PG8_SCHED;
            PG8_LDB(B1, 0, 1); PG8_STAGE(PG8_SB(0, 0), b2, voffB);
            PG8_BAR; PG8_WAIT_L(0); PG8_MMA(0, 1, At, B1); PG8_BAR;
            PG8_LDA(At, 0, 1); PG8_STAGE(PG8_SA(0, 0), a2, voffA);
            PG8_BAR; PG8_WAIT_L(0); PG8_MMA(1, 0, At, B0); PG8_BAR; PG8_SCHED;
            PG8_STAGE(PG8_SB(0, 1), b2 + hstep, voffB);
            PG8_WAIT_V(6); PG8_BAR; PG8_MMA(1, 1, At, B1); PG8_BAR;
            PG8_LDB(B0, 1, 0); PG8_SCHED; PG8_LDA(At, 1, 0); PG8_STAGE(PG8_SA(0, 1), a2 + hstep, voffA);
            PG8_WAIT_L(8); PG8_BAR; PG8_WAIT_L(0); PG8_MMA(0, 0, At, B0); PG8_BAR; PG8_SCHED;
            PG8_LDB(B1, 1, 1); PG8_STAGE(PG8_SB(1, 0), b3, voffB);
            PG8_BAR; PG8_WAIT_L(0); PG8_MMA(0, 1, At, B1); PG8_BAR;
            PG8_LDA(At, 1, 1); PG8_STAGE(PG8_SA(1, 0), a3, voffA);
            PG8_BAR; PG8_WAIT_L(0); PG8_MMA(1, 0, At, B0); PG8_BAR; PG8_SCHED;
            PG8_STAGE(PG8_SB(1, 1), b3 + hstep, voffB);
            PG8_WAIT_V(6); PG8_BAR; PG8_MMA(1, 1, At, B1); PG8_BAR;
            }
        }
        if constexpr (ALIGN_EPI) { if (wr == 0) PG8_BAR; }
        if constexpr (!Epi::AFTER_DRAIN) { E(acc, cur, wr, wc, fr, fq, rsv); S.done(cur); }
        if (!has_next) break;
#pragma unroll
        for (int a = 0; a < 2; ++a)
#pragma unroll
            for (int b = 0; b < 2; ++b)
#pragma unroll
                for (int m = 0; m < 4; ++m)
#pragma unroll
                    for (int n = 0; n < 2; ++n) acc[a][b][m][n] = (f32x4){0.f, 0.f, 0.f, 0.f};
        cur = nxt; cA = nA; cB = nB; ++ui;
        if constexpr (ALIGN_EPI) { if (wr == 1) PG8_BAR; }
    }
    PG8_WAIT_V(0);
    if constexpr (!ALIGN_EPI) { if (wr == 0) PG8_BAR; }
    PG8_BAR;
    if constexpr (Epi::AFTER_DRAIN) { E.fused(acc, cur, wr, wc, fr, fq, lds, wid, lane); S.done(cur); }
#undef PG8_SA
#undef PG8_SB
#undef PG8_STAGE
#undef PG8_LDA
#undef PG8_LDB
#undef PG8_MMA
#undef PG8_WAIT_V
#undef PG8_WAIT_L
#undef PG8_BAR
#undef PG8_SCHED
}
}

constexpr int NB = 4, T = 8192, D = 1024, DIN = 3592, NINP = 3584, DFF = 2816, NGU = 2 * DFF, DEPTH = 2;
constexpr int M = NB * T;
constexpr int NCH = T / 64;
constexpr int LDP = NINP;
constexpr int C_RQ = 0, C_RK = 256, C_RV = 512, C_RG = 768, C_CA = 1024, C_CG = 1280, C_GQ = 1536, C_GK = 1792, C_GV = 2048, C_GG = 2304,
              C_HQ = 2560, C_HF = 2816, C_HI = 3072, C_HG = 3328;
constexpr size_t MiB = 1u << 20;
constexpr size_t WS_CTL = 0;
constexpr size_t WS_WIN = 1 * MiB;
constexpr size_t WS_WOUT = 16 * MiB;
constexpr size_t WS_WGU = 20 * MiB;
constexpr size_t WS_WDN = 42 * MiB;
constexpr size_t WS_XN = 53 * MiB;
constexpr size_t WS_BCS = WS_XN;
constexpr size_t WS_MM = WS_XN + 48 * MiB;
constexpr size_t WS_MIX = 117 * MiB;
constexpr size_t WS_PROJ = 181 * MiB;
constexpr size_t WS_QEFF = 406 * MiB;
constexpr size_t WS_OLOC = 454 * MiB;
constexpr size_t WS_MVEC = 502 * MiB;
constexpr size_t WS_RSA = 503 * MiB;
constexpr size_t WS_RSB = 503 * MiB + 131072;
constexpr size_t WS_GBA = 503 * MiB + 262144;
constexpr size_t WS_WBA = 504 * MiB + 524288;
constexpr size_t WS_END = 505 * MiB;
constexpr int LDS_BYTES = 147456 + 256;
constexpr int LDS_BAR_OFF = 147456;
constexpr int HEAD_LDS = 73728;

#define LAS __attribute__((address_space(3)))
typedef unsigned short bf16_t;
typedef short bf16x8 __attribute__((ext_vector_type(8)));
typedef float f32x4 __attribute__((ext_vector_type(4)));
typedef unsigned u32x4 __attribute__((ext_vector_type(4)));
typedef unsigned u32x2 __attribute__((ext_vector_type(2)));
constexpr int LT = 72;
template <class Tp> __device__ __forceinline__ LAS Tp* opq(LAS Tp* p) { asm volatile("" : "+v"(p)); return p; }

__device__ __forceinline__ float bf_lo(unsigned u) { return __uint_as_float(u << 16); }
__device__ __forceinline__ float bf_hi(unsigned u) { return __uint_as_float(u & 0xffff0000u); }
__device__ __forceinline__ float bf2f(bf16_t b) { return __uint_as_float((unsigned)b << 16); }
__device__ __forceinline__ unsigned pk2(float lo, float hi) { return pg8::cvt_pk_bf16(lo, hi); }
__device__ __forceinline__ bf16_t f2bf(float f) { return (bf16_t)(pk2(f, 0.f) & 0xffffu); }
__device__ __forceinline__ float fexp(float x) { return __expf(x); }
__device__ __forceinline__ float frcp(float x) { return __builtin_amdgcn_rcpf(x); }
__device__ __forceinline__ float sigmoid_f(float x) { return frcp(1.0f + fexp(-x)); }
__device__ __forceinline__ float silu_acc(float x) { return x * frcp(1.0f + fexp(-x)); }
__device__ __forceinline__ float softplus_f(float x) { return fmaxf(x, 0.f) + log1pf(expf(-fabsf(x))); }
__device__ __forceinline__ float wave_sum(float v) {
#pragma unroll
    for (int o = 1; o < 64; o <<= 1) v += __shfl_xor(v, o);
    return v;
}
__device__ __forceinline__ void unpack8(const u32x4 w, float (&f)[8]) {
    f[0] = bf_lo(w.x); f[1] = bf_hi(w.x); f[2] = bf_lo(w.y); f[3] = bf_hi(w.y); f[4] = bf_lo(w.z); f[5] = bf_hi(w.z); f[6] = bf_lo(w.w); f[7] = bf_hi(w.w);
}
__device__ __forceinline__ u32x4 pack8(const float (&f)[8]) { u32x4 w; w.x = pk2(f[0], f[1]); w.y = pk2(f[2], f[3]); w.z = pk2(f[4], f[5]); w.w = pk2(f[6], f[7]); return w; }

struct Ctx {
    const float* in[20]; float* out; unsigned char* ws;
};
#define WSP(T_, off) ((T_*)(X.ws + (off)))

__device__ __forceinline__ f32x4 mma16(const LAS bf16_t* A, int a0, const LAS bf16_t* B, int b0, f32x4 acc, int r, int q) {
#pragma unroll
    for (int ks = 0; ks < 2; ++ks) {
        const bf16x8 a = *(const LAS bf16x8*)(A + (a0 + r) * LT + ks * 32 + q * 8);
        const bf16x8 b = *(const LAS bf16x8*)(B + (b0 + r) * LT + ks * 32 + q * 8);
        acc = __builtin_amdgcn_mfma_f32_16x16x32_bf16(a, b, acc, 0, 0, 0);
    }
    return acc;
}
__device__ __forceinline__ void store_oloc(bf16_t* oloc, int uid, int w4, int lane, const f32x4 (&acc)[4]) {
    u32x4* p = (u32x4*)(oloc + ((size_t)uid * 4 + w4) * 1024 + lane * 16);
    u32x4 a, b;
    a.x = pk2(acc[0][0], acc[0][1]); a.y = pk2(acc[0][2], acc[0][3]); a.z = pk2(acc[1][0], acc[1][1]); a.w = pk2(acc[1][2], acc[1][3]);
    b.x = pk2(acc[2][0], acc[2][1]); b.y = pk2(acc[2][2], acc[2][3]); b.z = pk2(acc[3][0], acc[3][1]); b.w = pk2(acc[3][2], acc[3][3]);
    __builtin_nontemporal_store(a, p); __builtin_nontemporal_store(b, p + 1);
}
__device__ __forceinline__ void store_bc(bf16_t* bcs, int uid, int w4, int r, int q, const f32x4 (&acc)[4]) {
#pragma unroll
    for (int ct = 0; ct < 4; ++ct) { u32x2 w; w.x = pk2(acc[ct][0], acc[ct][1]); w.y = pk2(acc[ct][2], acc[ct][3]);
        *(u32x2*)(bcs + (size_t)uid * 4096 + ((ct * 4 + w4) * 64 + q * 16 + r) * 4) = w; }
}


typedef __attribute__((address_space(1))) unsigned gu32;
#define XB_TMO      128
#define XB_XCNT(j)  (256  + 64 * (j))
#define XB_XSUB(j)  (1280 + 64 * (j))
#define XB_XGEN(j)  (2304 + 64 * (j))
#define XB_TOP      3328
#define XB_TOPGEN   3392
#define XCD_BAR_WORDS 3456
#define XB_SPIN_CAP (1u << 18)

__device__ __forceinline__ unsigned xb_ld(unsigned* p)              { return __hip_atomic_load(p, __ATOMIC_RELAXED, __HIP_MEMORY_SCOPE_AGENT); }
__device__ __forceinline__ unsigned xb_add(unsigned* p, unsigned v) { return __hip_atomic_fetch_add(p, v, __ATOMIC_RELAXED, __HIP_MEMORY_SCOPE_AGENT); }
__device__ __forceinline__ unsigned xb_xcc_id() { return (unsigned)__builtin_amdgcn_s_getreg((3 << 11) | 20) & 0xFu; }
#define XB_SPIN(cond, bar) do { unsigned _sp = 0; while (cond) { __builtin_amdgcn_s_sleep(1); \
    if ((++_sp & 255u) == 0u) { if (xb_ld(&(bar)[XB_TMO])) break; if (_sp > XB_SPIN_CAP) { atomicAdd(&(bar)[XB_TMO], 1u); break; } } } } while (0)

struct XcdBarrier {
    unsigned* bar; unsigned x;
    volatile LAS unsigned* st;
};

__device__ __forceinline__ XcdBarrier xcd_barrier_post(unsigned* bar, volatile LAS unsigned* st) {
    XcdBarrier b; b.bar = bar; b.x = xb_xcc_id(); b.st = st;
    if (threadIdx.x == 0) (void)xb_add(&bar[XB_XCNT(b.x)], 1u);
    return b;
}
__device__ __forceinline__ void xcd_barrier_complete(unsigned* bar, unsigned x, unsigned& nloc, unsigned& nx) {
    const unsigned G = gridDim.x * gridDim.y * gridDim.z;
    unsigned sum, cnt, mine, sp = 0u;
    for (;;) {
        sum = 0u; cnt = 0u; mine = 0u;
#pragma unroll
        for (unsigned j = 0; j < 16; ++j) { const unsigned c = xb_ld(&bar[XB_XCNT(j)]); sum += c; cnt += (c > 0u) ? 1u : 0u; mine = (j == x) ? c : mine; }
        if (sum == G) break;
        __builtin_amdgcn_s_sleep(1);
        if ((++sp & 255u) == 0u) { if (xb_ld(&bar[XB_TMO])) break; if (sp > XB_SPIN_CAP) { atomicAdd(&bar[XB_TMO], 1u); break; } }
    }
    nloc = mine > 0u ? mine : 1u; nx = cnt > 0u ? cnt : 1u;
}

__device__ __forceinline__ void xcd_barrier(const XcdBarrier& b) {
    asm volatile("s_waitcnt vmcnt(0)" ::: "memory");
    __syncthreads();
    if (threadIdx.x == 0) {
        unsigned* bar = b.bar;
        __builtin_amdgcn_s_waitcnt(0);
        unsigned nloc = b.st[0], nx = b.st[1];
        if (nloc == 0u) { xcd_barrier_complete(bar, b.x, nloc, nx); b.st[0] = nloc; b.st[1] = nx; }
        const unsigned old = xb_add(&bar[XB_XSUB(b.x)], 1u);
        const unsigned gen = old / nloc;
        if (old + 1u == (gen + 1u) * nloc) {
            __builtin_amdgcn_fence(__ATOMIC_RELEASE, "agent");
            asm volatile("s_waitcnt vmcnt(0)" ::: "memory");
            const unsigned og = xb_add(&bar[XB_TOP], 1u);
            const unsigned tg = og / nx;
            if (og + 1u == (tg + 1u) * nx) xb_add(&bar[XB_TOPGEN], 1u);
            else XB_SPIN(xb_ld(&bar[XB_TOPGEN]) == tg, bar);
            __builtin_amdgcn_fence(__ATOMIC_ACQUIRE, "agent");
            xb_add(&bar[XB_XGEN(b.x)], 1u);
            asm volatile("s_waitcnt vmcnt(0)" ::: "memory");
        } else {
            XB_SPIN(xb_ld(&bar[XB_XGEN(b.x)]) == gen, bar);
            __builtin_amdgcn_fence(__ATOMIC_ACQUIRE, "agent");
            asm volatile("s_waitcnt vmcnt(0)" ::: "memory");
        }
    }
    __syncthreads();
}

__device__ __forceinline__ void transpose_item(const float* W, int K, int N, bf16_t* WT, int mode, LAS float* scr, int kb, int nb, int lane, const float* kscale, int coff) {
    const int k0 = 64 * kb, n0 = 32 * nb;
    const int nn = n0 + (lane & 31) + coff;
#pragma unroll 8
    for (int i = 0; i < 32; ++i) { const int kk = 2 * i + (lane >> 5); const float ksc = kscale ? kscale[k0 + kk] : 1.0f; scr[kk * 33 + (lane & 31)] = nn < N ? W[(size_t)(k0 + kk) * N + nn] * ksc : 0.f; }
    asm volatile("s_waitcnt lgkmcnt(0)" ::: "memory");
    const int c = lane & 7;
#pragma unroll
    for (int j = 0; j < 4; ++j) { const int n = (lane >> 3) + 8 * j; const LAS float* s = scr + (8 * c) * 33 + n;
        u32x4 o; o.x = pk2(s[0 * 33], s[1 * 33]); o.y = pk2(s[2 * 33], s[3 * 33]); o.z = pk2(s[4 * 33], s[5 * 33]); o.w = pk2(s[6 * 33], s[7 * 33]);
        const int ng = n0 + n; const int row = mode == 0 ? ng : ((ng >> 7) * 256 + (ng & 127) + (mode == 2 ? 128 : 0));
        *(u32x4*)(WT + (size_t)row * K + k0 + 8 * c) = o; }
    asm volatile("s_waitcnt lgkmcnt(0)" ::: "memory");
}
__device__ __forceinline__ void prep_weights(const Ctx& X, LAS unsigned char* lds, int gw, int ngw, int wave, int lane, int it_lo, int it_hi) {
    LAS float* scr = (LAS float*)(lds + wave * 16384);
    constexpr int I_IN = (D / 64) * (NINP / 32), I_OUT = (D / 64) * (D / 32), I_G = (D / 64) * (DFF / 32), I_DN = (DFF / 64) * (D / 32);
    constexpr int PER_L = I_IN + I_OUT + 2 * I_G + I_DN;
    asm volatile("" : "+v"(lane));
    for (int it = it_lo + gw; it < it_hi; it += ngw) {
        const int l = it / PER_L; int r = it % PER_L;
        if (r < I_IN) { transpose_item(X.in[2] + (size_t)l * D * DIN, D, DIN, WSP(bf16_t, WS_WIN) + (size_t)l * NINP * D, 0, scr, r / (NINP / 32), r % (NINP / 32), lane, X.in[1] + l * D, (r % (NINP / 32)) * 32 >= 2560 ? 8 : 0); continue; } r -= I_IN;
        if (r < I_OUT) { transpose_item(X.in[14] + (size_t)l * D * D, D, D, WSP(bf16_t, WS_WOUT) + (size_t)l * D * D, 0, scr, r / (D / 32), r % (D / 32), lane, nullptr, 0); continue; } r -= I_OUT;
        if (r < I_G) { transpose_item(X.in[16] + (size_t)l * D * DFF, D, DFF, WSP(bf16_t, WS_WGU) + (size_t)l * NGU * D, 1, scr, r / (DFF / 32), r % (DFF / 32), lane, X.in[15] + l * D, 0); continue; } r -= I_G;
        if (r < I_G) { transpose_item(X.in[17] + (size_t)l * D * DFF, D, DFF, WSP(bf16_t, WS_WGU) + (size_t)l * NGU * D, 2, scr, r / (DFF / 32), r % (DFF / 32), lane, X.in[15] + l * D, 0); continue; } r -= I_G;
        transpose_item(X.in[18] + (size_t)l * DFF * D, DFF, D, WSP(bf16_t, WS_WDN) + (size_t)l * D * DFF, 0, scr, r / (D / 32), r % (D / 32), lane, nullptr, 0);
    }
}
__device__ __forceinline__ void rms_row(const float* xrow, const float* w, bf16_t* orow, float* of, int lane) {
    const f32x4* xr = (const f32x4*)xrow + lane; const f32x4* wr = (const f32x4*)w + lane;
    f32x4 v[4]; float s = 0.f;
#pragma unroll
    for (int j = 0; j < 4; ++j) { v[j] = xr[64 * j]; s += (v[j].x * v[j].x + v[j].y * v[j].y) + (v[j].z * v[j].z + v[j].w * v[j].w); }
    const float rstd = 1.0f / sqrtf(wave_sum(s) * (1.f / D) + 1e-6f);
#pragma unroll
    for (int j = 0; j < 4; ++j) { const f32x4 ww = wr[64 * j]; const f32x4 o = v[j] * rstd * ww;
        if (of) ((f32x4*)of + lane)[64 * j] = o;
        else { u32x2 p; p.x = pk2(o.x, o.y); p.y = pk2(o.z, o.w); ((u32x2*)orow + lane)[64 * j] = p; } }
}
__device__ __forceinline__ void cast_phase(const float* x, bf16_t* xb, float* rowsq, int gw, int ngw, int lane) {
    asm volatile("" : "+v"(lane));
    for (int m = gw; m < M; m += ngw) {
        const f32x4* xr = (const f32x4*)(x + (size_t)m * D) + lane; float s = 0.f;
#pragma unroll
        for (int j = 0; j < 4; ++j) { const f32x4 v = xr[64 * j]; s += (v.x * v.x + v.y * v.y) + (v.z * v.z + v.w * v.w); u32x2 p; p.x = pk2(v.x, v.y); p.y = pk2(v.z, v.w); ((u32x2*)(xb + (size_t)m * D) + lane)[64 * j] = p; }
        s = wave_sum(s); if (lane == 0) rowsq[m] = s;
    }
}
__device__ __forceinline__ void norm_phase(const float* x, const float* w, bf16_t* xn, float* of, int gw, int ngw, int lane) {
    asm volatile("" : "+v"(lane));
    for (int m = gw; m < M; m += ngw) rms_row(x + (size_t)m * D, w, xn ? xn + (size_t)m * D : nullptr, of ? of + (size_t)m * D : nullptr, lane);
}

#define LBAR() do { asm volatile("s_waitcnt lgkmcnt(0)" ::: "memory"); __builtin_amdgcn_s_barrier(); asm volatile("" ::: "memory"); } while (0)
__device__ __forceinline__ int unit_id(int mixer, int b, int h, int c) { return ((mixer * 4 + b) * 4 + h) * NCH + c; }

__device__ __forceinline__ void ret_unit(const Ctx& X, LAS unsigned char* hl, int b, int c, int h, int tid_h, int w4, int lane) {
    LAS bf16_t* QR = opq((LAS bf16_t*)hl); LAS bf16_t* KR = opq(QR + 64 * LT); LAS bf16_t* KDT = opq(KR + 64 * LT); LAS bf16_t* VT = opq(KDT + 64 * LT); LAS bf16_t* P = opq(VT + 64 * LT);
    const bf16_t* proj = WSP(const bf16_t, WS_PROJ);
    const int uid = unit_id(0, b, h, c);
    const int r = lane & 15, q = lane >> 4;
    const float lg = log1pf(-exp2f(-5.0f - (float)h));
    {
        const int i = tid_h >> 2, sg = tid_h & 3, d0 = sg * 8;
        const bf16_t* pr = proj + ((size_t)b * T + c * 64 + i) * LDP;
        const u32x4 q1 = *(const u32x4*)(pr + C_RQ + h * 64 + d0), q2 = *(const u32x4*)(pr + C_RQ + h * 64 + d0 + 32);
        const u32x4 k1 = *(const u32x4*)(pr + C_RK + h * 64 + d0), k2 = *(const u32x4*)(pr + C_RK + h * 64 + d0 + 32);
        const u32x4 v1 = *(const u32x4*)(pr + C_RV + h * 64 + sg * 16), v2 = *(const u32x4*)(pr + C_RV + h * 64 + sg * 16 + 8);
        float qa[8], qb[8], ka[8], kb[8], va[8], vb[8];
        unpack8(q1, qa); unpack8(q2, qb); unpack8(k1, ka); unpack8(k2, kb); unpack8(v1, va); unpack8(v2, vb);
        const float pos = (float)(c * 64 + i);
        const float qd = fexp(lg * (float)(i + 1)), kd = fexp(lg * (float)(63 - i));
        float qr1[8], qr2[8], kr1[8], kr2[8], qe1[8], qe2[8];
#pragma unroll
        for (int e = 0; e < 8; ++e) {
            const float inv = exp2f(-(float)(d0 + e) * (13.287712379549449f / 32.0f));
            const float rev = __builtin_amdgcn_fractf(pos * inv * 0.15915494309189535f); const float sn = __builtin_amdgcn_sinf(rev), cs = __builtin_amdgcn_cosf(rev);
            qr1[e] = qa[e] * cs - qb[e] * sn; qr2[e] = qa[e] * sn + qb[e] * cs;
            kr1[e] = (ka[e] * cs - kb[e] * sn) * 0.125f; kr2[e] = (ka[e] * sn + kb[e] * cs) * 0.125f;
            qe1[e] = qr1[e] * qd; qe2[e] = qr2[e] * qd;
            KDT[(d0 + e) * LT + i] = f2bf(kr1[e] * kd); KDT[(d0 + 32 + e) * LT + i] = f2bf(kr2[e] * kd);
            VT[(sg * 16 + e) * LT + i] = f2bf(va[e]); VT[(sg * 16 + 8 + e) * LT + i] = f2bf(vb[e]);
        }
        *(LAS u32x4*)(QR + i * LT + d0) = pack8(qr1); *(LAS u32x4*)(QR + i * LT + d0 + 32) = pack8(qr2);
        *(LAS u32x4*)(KR + i * LT + d0) = pack8(kr1); *(LAS u32x4*)(KR + i * LT + d0 + 32) = pack8(kr2);
        bf16_t* qe = WSP(bf16_t, WS_QEFF) + (size_t)uid * 4096 + i * 64;
        *(u32x4*)(qe + d0) = pack8(qe1); *(u32x4*)(qe + d0 + 32) = pack8(qe2);
    }
    LBAR();
    f32x4 acc[4];
#pragma unroll
    for (int ct = 0; ct < 4; ++ct) acc[ct] = mma16(QR, 16 * w4, KR, 16 * ct, (f32x4){0.f, 0.f, 0.f, 0.f}, r, q);
#pragma unroll
    for (int ct = 0; ct < 4; ++ct)
#pragma unroll
        for (int j = 0; j < 4; ++j) { const int ii = 16 * w4 + 4 * q + j, col = 16 * ct + r;
            P[ii * LT + col] = f2bf(ii >= col ? acc[ct][j] * fexp(lg * (float)(ii - col)) : 0.f); }
    LBAR();
#pragma unroll
    for (int ct = 0; ct < 4; ++ct) acc[ct] = mma16(P, 16 * w4, VT, 16 * ct, (f32x4){0.f, 0.f, 0.f, 0.f}, r, q);
    store_oloc(WSP(bf16_t, WS_OLOC), uid, w4, lane, acc);
#pragma unroll
    for (int ct = 0; ct < 4; ++ct) acc[ct] = mma16(KDT, 16 * w4, VT, 16 * ct, (f32x4){0.f, 0.f, 0.f, 0.f}, r, q);
    store_bc(WSP(bf16_t, WS_BCS), uid, w4, r, q, acc);
    LBAR();
}

__device__ __forceinline__ void hgrn_unit(const Ctx& X, LAS unsigned char* hl, int b, int c, int h, int tid_h, int w4, int lane, int layer) {
    LAS bf16_t* QT = opq((LAS bf16_t*)hl);
    LAS float* Gt = opq((LAS float*)(hl + 9216));
    LAS bf16_t* Kt = opq((LAS bf16_t*)(hl + 25600));
    LAS bf16_t* KTI = opq((LAS bf16_t*)(hl + 34816));
    LAS bf16_t* VT = KTI; LAS bf16_t* KDT = opq(KTI + 64 * LT);
    LAS float* tot = opq((LAS float*)(hl + 57856));
    const bf16_t* proj = WSP(const bf16_t, WS_PROJ);
    const int uid = unit_id(2, b, h, c);
    const int r = lane & 15, q = lane >> 4;
    const int i = tid_h >> 2, ds = (tid_h & 3) * 16;
    const bf16_t* pr = proj + ((size_t)b * T + c * 64 + i) * LDP;
    float kk[16], qv[16], vv[16];
    {
        float ff[16];
        { float t0[8], t1[8]; unpack8(*(const u32x4*)(pr + C_HF + h * 64 + ds), t0); unpack8(*(const u32x4*)(pr + C_HF + h * 64 + ds + 8), t1);
#pragma unroll
          for (int e = 0; e < 8; ++e) { ff[e] = t0[e]; ff[8 + e] = t1[e]; } }
        { float t0[8], t1[8]; unpack8(*(const u32x4*)(pr + C_HQ + h * 64 + ds), t0); unpack8(*(const u32x4*)(pr + C_HQ + h * 64 + ds + 8), t1);
#pragma unroll
          for (int e = 0; e < 8; ++e) { qv[e] = t0[e]; qv[8 + e] = t1[e]; } }
        { float t0[8], t1[8]; unpack8(*(const u32x4*)(pr + C_HI + h * 64 + ds), t0); unpack8(*(const u32x4*)(pr + C_HI + h * 64 + ds + 8), t1);
#pragma unroll
          for (int e = 0; e < 8; ++e) { vv[e] = t0[e]; vv[8 + e] = t1[e]; } }
#pragma unroll
        for (int e = 0; e < 16; ++e) {
            const int ch = h * 64 + ds + e;
            const float lb = layer == 0 ? 0.f : sigmoid_f(X.in[12][256 + ch] - X.in[12][ch]);
            const float f = ff[e];
            const float ls = fminf(f, 0.f) - __logf(1.0f + fexp(-fabsf(f)));
            const float lf = layer == 0 ? ls : __logf(lb + (1.f - lb) * fexp(ls));
            kk[e] = (1.f - lb) * frcp(1.f + fexp(f));
            Gt[i * 64 + ds + e] = lf;
        }
    }
    LBAR();
    {
        const int d = tid_h & 63, seg = tid_h >> 6; float cs[16]; float run = 0.f;
#pragma unroll
        for (int jj = 0; jj < 16; ++jj) { run += Gt[(16 * seg + jj) * 64 + d]; cs[jj] = run; }
        tot[seg * 64 + d] = run;
        LBAR();
        float off = 0.f;
#pragma unroll
        for (int s = 0; s < 3; ++s) off += (s < seg) ? tot[s * 64 + d] : 0.f;
#pragma unroll
        for (int jj = 0; jj < 16; ++jj) Gt[(16 * seg + jj) * 64 + d] = cs[jj] + off;
    }
    LBAR();
    float Gi[16], G63[16];
    {
        const int I = i >> 4;
        float qt[16], qe[16];
#pragma unroll
        for (int e = 0; e < 16; ++e) { Gi[e] = Gt[i * 64 + ds + e]; G63[e] = Gt[63 * 64 + ds + e]; const float gr = Gt[(16 * I) * 64 + ds + e];
            qt[e] = qv[e] * fexp(Gi[e] - gr); qe[e] = qv[e] * fexp(Gi[e]); }
        u32x4 w0, w1;
        w0.x = pk2(qt[0], qt[1]); w0.y = pk2(qt[2], qt[3]); w0.z = pk2(qt[4], qt[5]); w0.w = pk2(qt[6], qt[7]);
        w1.x = pk2(qt[8], qt[9]); w1.y = pk2(qt[10], qt[11]); w1.z = pk2(qt[12], qt[13]); w1.w = pk2(qt[14], qt[15]);
        *(LAS u32x4*)(QT + i * LT + ds) = w0; *(LAS u32x4*)(QT + i * LT + ds + 8) = w1;
        w0.x = pk2(qe[0], qe[1]); w0.y = pk2(qe[2], qe[3]); w0.z = pk2(qe[4], qe[5]); w0.w = pk2(qe[6], qe[7]);
        w1.x = pk2(qe[8], qe[9]); w1.y = pk2(qe[10], qe[11]); w1.z = pk2(qe[12], qe[13]); w1.w = pk2(qe[14], qe[15]);
        bf16_t* qg = WSP(bf16_t, WS_QEFF) + (size_t)uid * 4096 + i * 64 + ds;
        *(u32x4*)qg = w0; *(u32x4*)(qg + 8) = w1;
        w0.x = pk2(kk[0], kk[1]); w0.y = pk2(kk[2], kk[3]); w0.z = pk2(kk[4], kk[5]); w0.w = pk2(kk[6], kk[7]);
        w1.x = pk2(kk[8], kk[9]); w1.y = pk2(kk[10], kk[11]); w1.z = pk2(kk[12], kk[13]); w1.w = pk2(kk[14], kk[15]);
        *(LAS u32x4*)(Kt + i * LT + ds) = w0; *(LAS u32x4*)(Kt + i * LT + ds + 8) = w1;
        if (i == 63) { float* mv = WSP(float, WS_MVEC) + (size_t)(uid - 2 * 2048) * 64 + ds;
#pragma unroll
            for (int e = 0; e < 16; ++e) mv[e] = fexp(G63[e]); }
    }
    LBAR();
    const int I = w4;
    LAS bf16_t* KI = opq(KTI + (8 * I * (I + 1)) * LT);
    {
        const int nit = 16 * (I + 1) * 8;
        for (int idx = lane; idx < nit; idx += 64) { const int j = idx >> 3, d8 = (idx & 7) * 8;
            float kf[8]; unpack8(*(const LAS u32x4*)(Kt + j * LT + d8), kf);
            float o[8];
#pragma unroll
            for (int e = 0; e < 8; ++e) o[e] = kf[e] * fexp(fminf(Gt[(16 * I) * 64 + d8 + e] - Gt[j * 64 + d8 + e], 80.f));
            *(LAS u32x4*)(KI + j * LT + d8) = pack8(o); }
    }
    LBAR();
    f32x4 acc[4];
    {
        bf16x8 a[2];
#pragma unroll
        for (int ks = 0; ks < 2; ++ks) a[ks] = *(const LAS bf16x8*)(QT + (16 * I + r) * LT + ks * 32 + q * 8);
#pragma unroll
        for (int ct = 0; ct < 4; ++ct) { acc[ct] = (f32x4){0.f, 0.f, 0.f, 0.f};
            if (ct <= I) {
#pragma unroll
                for (int ks = 0; ks < 2; ++ks) { const bf16x8 bb = *(const LAS bf16x8*)(KI + (16 * ct + r) * LT + ks * 32 + q * 8);
                    acc[ct] = __builtin_amdgcn_mfma_f32_16x16x32_bf16(a[ks], bb, acc[ct], 0, 0, 0); } } }
        asm volatile("s_waitcnt lgkmcnt(0)" ::: "memory");
#pragma unroll
        for (int ct = 0; ct < 4; ++ct)
#pragma unroll
            for (int j = 0; j < 4; ++j) { const int ii = 16 * I + 4 * q + j, col = 16 * ct + r;
                QT[ii * LT + col] = f2bf((ct <= I && ii >= col) ? acc[ct][j] : 0.f); }
    }
    LBAR();
    {
#pragma unroll
        for (int e = 0; e < 16; ++e) { VT[(ds + e) * LT + i] = f2bf(vv[e]); KDT[(ds + e) * LT + i] = f2bf(kk[e] * fexp(G63[e] - Gi[e])); }
    }
    LBAR();
#pragma unroll
    for (int ct = 0; ct < 4; ++ct) acc[ct] = mma16(QT, 16 * w4, VT, 16 * ct, (f32x4){0.f, 0.f, 0.f, 0.f}, r, q);
    store_oloc(WSP(bf16_t, WS_OLOC), uid, w4, lane, acc);
#pragma unroll
    for (int ct = 0; ct < 4; ++ct) acc[ct] = mma16(KDT, 16 * w4, VT, 16 * ct, (f32x4){0.f, 0.f, 0.f, 0.f}, r, q);
    store_bc(WSP(bf16_t, WS_BCS), uid, w4, r, q, acc);
    LBAR();
}

__device__ __forceinline__ void gdn_unit(const Ctx& X, LAS unsigned char* hl, int b, int c, int h, int tid_h, int w4, int lane, int layer) {
    LAS bf16_t* Q = opq((LAS bf16_t*)hl); LAS bf16_t* K = opq(Q + 64 * LT); LAS bf16_t* KB = opq(K + 64 * LT); LAS bf16_t* V = opq(KB + 64 * LT); LAS bf16_t* KDT = opq(V + 64 * LT); LAS bf16_t* P = opq(KDT + 64 * LT);
    LAS bf16_t* WT = KB; LAS bf16_t* UT = V;
    LAS bf16_t* AB = opq((LAS bf16_t*)(hl + 55296));
    LAS float* ACCS = opq((LAS float*)(hl + 64512));
    LAS float* Gs = opq((LAS float*)(hl + 72704));
    LAS float* Bs = opq(Gs + 64);
    const bf16_t* proj = WSP(const bf16_t, WS_PROJ);
    const int uid = unit_id(1, b, h, c);
    const int r = lane & 15, q = lane >> 4;
    {
    LAS bf16_t* RAW = opq((LAS bf16_t*)(hl + 46080));
    const int cseg = tid_h & 7, i0 = tid_h >> 3;
    f32x4 wq[3][4][2];
    {
        const float* cw = X.in[8] + (size_t)layer * 4 * 768 + h * 64 + cseg * 8;
#pragma unroll
        for (int tn = 0; tn < 3; ++tn)
#pragma unroll
            for (int k = 0; k < 4; ++k) { const f32x4* wp = (const f32x4*)(cw + k * 768 + tn * 256); wq[tn][k][0] = wp[0]; wq[tn][k][1] = wp[1]; }
        u32x4 rawv[7];
#pragma unroll
        for (int n = 0; n < 7; ++n) { const int item = tid_h + 256 * n; const int seg = item & 7; int rowid = item >> 3; rowid = rowid < 201 ? rowid : 200;
            const int tn = rowid / 67, rr = rowid - tn * 67; const int tt = c * 64 - 3 + rr; const int ttc = tt < 0 ? 0 : tt;
            const u32x4 v = *(const u32x4*)(proj + ((size_t)b * T + ttc) * LDP + C_GQ + tn * 256 + h * 64 + seg * 8);
            rawv[n] = tt < 0 ? (u32x4){0u, 0u, 0u, 0u} : v; }
        float g = 0.f, bt = 0.f;
        if (tid_h < 64) {
            const bf16_t* pr = proj + ((size_t)b * T + c * 64 + tid_h) * LDP;
            const float* gba = WSP(const float, WS_GBA) + ((size_t)b * T + c * 64 + tid_h) * 8; const float gb = gba[h], ga = gba[4 + h];
            g = -fexp(X.in[9][layer * 4 + h]) * softplus_f(ga + X.in[10][layer * 4 + h]);
#pragma unroll
            for (int o = 1; o < 64; o <<= 1) { const float t = __shfl_up(g, o); if (lane >= o) g += t; }
            bt = sigmoid_f(gb);
            Gs[tid_h] = g; Bs[tid_h] = bt;
        }
#pragma unroll
        for (int n = 0; n < 7; ++n) { const int item = tid_h + 256 * n; if (item < 1608) *(LAS u32x4*)(RAW + (item >> 3) * 64 + (item & 7) * 8) = rawv[n]; }
    }
    LBAR();
    {
        const float G63 = Gs[63];
#pragma unroll
        for (int rs = 0; rs < 2; ++rs) {
            const int i = i0 + 32 * rs;
            const float bi = Bs[i], Gi = Gs[i];
            float y[3][8];
#pragma unroll
            for (int tn = 0; tn < 3; ++tn) {
#pragma unroll
                for (int e = 0; e < 8; ++e) y[tn][e] = 0.f;
#pragma unroll
                for (int k = 0; k < 4; ++k) { float x8[8]; unpack8(*(const LAS u32x4*)(RAW + (tn * 67 + i + k) * 64 + cseg * 8), x8);
                    y[tn][0] += wq[tn][k][0].x * x8[0]; y[tn][1] += wq[tn][k][0].y * x8[1]; y[tn][2] += wq[tn][k][0].z * x8[2]; y[tn][3] += wq[tn][k][0].w * x8[3];
                    y[tn][4] += wq[tn][k][1].x * x8[4]; y[tn][5] += wq[tn][k][1].y * x8[5]; y[tn][6] += wq[tn][k][1].z * x8[6]; y[tn][7] += wq[tn][k][1].w * x8[7]; }
#pragma unroll
                for (int e = 0; e < 8; ++e) y[tn][e] = silu_acc(y[tn][e]);
            }
            float sq = 0.f, sk = 0.f;
#pragma unroll
            for (int e = 0; e < 8; ++e) { sq += y[0][e] * y[0][e]; sk += y[1][e] * y[1][e]; }
            sq += __shfl_xor(sq, 1); sq += __shfl_xor(sq, 2); sq += __shfl_xor(sq, 4);
            sk += __shfl_xor(sk, 1); sk += __shfl_xor(sk, 2); sk += __shfl_xor(sk, 4);
            const float rq = 0.125f * rsqrtf(sq + 1e-6f), rk = rsqrtf(sk + 1e-6f), kd = rk * fexp(G63 - Gi);
            float t8[8];
#pragma unroll
            for (int e = 0; e < 8; ++e) t8[e] = y[0][e] * rq;
            *(LAS u32x4*)(Q + i * LT + cseg * 8) = pack8(t8);
#pragma unroll
            for (int e = 0; e < 8; ++e) t8[e] = y[1][e] * rk;
            *(LAS u32x4*)(K + i * LT + cseg * 8) = pack8(t8);
#pragma unroll
            for (int e = 0; e < 8; ++e) t8[e] = y[1][e] * rk * bi;
            *(LAS u32x4*)(KB + i * LT + cseg * 8) = pack8(t8);
            *(LAS u32x4*)(V + i * LT + cseg * 8) = pack8(y[2]);
#pragma unroll
            for (int e = 0; e < 8; ++e) KDT[(cseg * 8 + e) * LT + i] = f2bf(y[1][e] * kd);
        }
    }
    LBAR();
    }
    {
        f32x4 aA[4], aP[4];
#pragma unroll
        for (int ct = 0; ct < 4; ++ct) { aA[ct] = mma16(KB, 16 * w4, K, 16 * ct, (f32x4){0.f, 0.f, 0.f, 0.f}, r, q); aP[ct] = mma16(Q, 16 * w4, K, 16 * ct, (f32x4){0.f, 0.f, 0.f, 0.f}, r, q); }
#pragma unroll
        for (int ct = 0; ct < 4; ++ct)
#pragma unroll
            for (int j = 0; j < 4; ++j) { const int ii = 16 * w4 + 4 * q + j, col = 16 * ct + r;
                const float L = fexp(fminf(Gs[ii] - Gs[col], 0.f));
                AB[ii * LT + col] = f2bf(ii > col ? aA[ct][j] * L : 0.f);
                P[ii * LT + col] = f2bf(ii >= col ? aP[ct][j] * L : 0.f); }
    }
    LBAR();
    float rc[64];
    if (w4 < 2) {
        const int col = tid_h & 63; const LAS bf16_t* src = w4 == 0 ? V : KB;
#pragma unroll
        for (int i = 0; i < 64; ++i) { const float sc = w4 == 0 ? Bs[i] : fexp(Gs[i]); rc[i] = bf2f(src[i * LT + col]) * sc; }
    }
    LBAR();
    {
    for (int idx = tid_h; idx < 1152; idx += 256) { const int tl = idx >= 576; const int rem = idx - tl * 576; *(LAS u32x4*)((tl ? KB : V) + rem * 8) = (u32x4){0u, 0u, 0u, 0u}; }
    LBAR();
#pragma unroll
    for (int I = 0; I < 4; ++I) {
        if (I > 0) {
#pragma unroll
            for (int t2 = 0; t2 < 2; ++t2) { const int ct8 = 2 * w4 + t2; const LAS bf16_t* Bt = ct8 < 4 ? UT : WT;
                const f32x4 a = mma16(AB, 16 * I, Bt, 16 * (ct8 & 3), (f32x4){0.f, 0.f, 0.f, 0.f}, r, q);
#pragma unroll
                for (int j = 0; j < 4; ++j) ACCS[(4 * q + j) * 128 + 16 * ct8 + r] = a[j]; }
            LBAR();
        }
        if (w4 < 2) {
            const int col = tid_h & 63, c128 = w4 * 64 + col;
            float t[16];
#pragma unroll
            for (int ii = 0; ii < 16; ++ii) t[ii] = rc[16 * I + ii] - (I > 0 ? ACCS[ii * 128 + c128] : 0.f);
#pragma unroll
            for (int ii = 1; ii < 16; ++ii) {
                float a16[16];
                { float lo[8]; unpack8(*(const LAS u32x4*)(AB + (16 * I + ii) * LT + 16 * I), lo);
#pragma unroll
                  for (int e = 0; e < 8; ++e) a16[e] = lo[e]; }
                if (ii > 8) { float hi[8]; unpack8(*(const LAS u32x4*)(AB + (16 * I + ii) * LT + 16 * I + 8), hi);
#pragma unroll
                  for (int e = 0; e < 8; ++e) a16[8 + e] = hi[e]; }
                float s0 = t[ii], s1 = 0.f;
#pragma unroll
                for (int kk = 0; kk < ii; ++kk) { if (kk & 1) s1 -= a16[kk] * t[kk]; else s0 -= a16[kk] * t[kk]; }
                t[ii] = s0 + s1;
            }
            LAS bf16_t* dst = (w4 == 0 ? UT : WT) + col * LT + 16 * I;
            u32x4 w0, w1;
            w0.x = pk2(t[0], t[1]); w0.y = pk2(t[2], t[3]); w0.z = pk2(t[4], t[5]); w0.w = pk2(t[6], t[7]);
            w1.x = pk2(t[8], t[9]); w1.y = pk2(t[10], t[11]); w1.z = pk2(t[12], t[13]); w1.w = pk2(t[14], t[15]);
            *(LAS u32x4*)dst = w0; *(LAS u32x4*)(dst + 8) = w1;
        }
        LBAR();
    }
    }
    {
        f32x4 acc[4];
        const float eG63 = fexp(Gs[63]);
#pragma unroll
        for (int ct = 0; ct < 4; ++ct) acc[ct] = mma16(P, 16 * w4, WT, 16 * ct, (f32x4){0.f, 0.f, 0.f, 0.f}, r, q);
        bf16_t* qe = WSP(bf16_t, WS_QEFF) + (size_t)uid * 4096;
#pragma unroll
        for (int ct = 0; ct < 4; ++ct)
#pragma unroll
            for (int j = 0; j < 4; ++j) { const int ii = 16 * w4 + 4 * q + j, col = 16 * ct + r;
                qe[ii * 64 + col] = f2bf(bf2f(Q[ii * LT + col]) * fexp(Gs[ii]) - acc[ct][j]); }
#pragma unroll
        for (int ct = 0; ct < 4; ++ct) acc[ct] = mma16(P, 16 * w4, UT, 16 * ct, (f32x4){0.f, 0.f, 0.f, 0.f}, r, q);
        store_oloc(WSP(bf16_t, WS_OLOC), uid, w4, lane, acc);
#pragma unroll
        for (int ct = 0; ct < 4; ++ct) acc[ct] = mma16(KDT, 16 * w4, WT, 16 * ct, (f32x4){0.f, 0.f, 0.f, 0.f}, r, q);
        bf16_t* mm = WSP(bf16_t, WS_MM) + (size_t)(uid - 2048) * 4096;
#pragma unroll
        for (int ct = 0; ct < 4; ++ct)
#pragma unroll
            for (int j = 0; j < 4; ++j) { const int ii = 16 * w4 + 4 * q + j, col = 16 * ct + r;
                mm[((w4 * 2 + (ct >> 1)) * 64 + (r >> 2) * 16 + 4 * q + j) * 8 + (ct & 1) * 4 + (r & 3)] = f2bf((ii == col ? eG63 : 0.f) - acc[ct][j]); }
#pragma unroll
        for (int ct = 0; ct < 4; ++ct) acc[ct] = mma16(KDT, 16 * w4, UT, 16 * ct, (f32x4){0.f, 0.f, 0.f, 0.f}, r, q);
        store_bc(WSP(bf16_t, WS_BCS), uid, w4, r, q, acc);
    }
    LBAR();
}

__device__ __forceinline__ void conf_unit(const Ctx& X, LAS unsigned char* lds, int b, int c, int tid, int wave, int lane, int layer) {
    LAS bf16_t* GL = opq((LAS bf16_t*)lds);
    LAS float* Y = opq((LAS float*)(lds + 49152));
    const bf16_t* proj = WSP(const bf16_t, WS_PROJ);
    bf16_t* mix = WSP(bf16_t, WS_MIX);
    const int t0 = c * 64;
    float w[31]; float bias;
    { const int ch = tid & 255; const float* cw = X.in[4] + (size_t)layer * 31 * 256 + ch;
#pragma unroll
      for (int k = 0; k < 31; ++k) w[k] = cw[k * 256];
      bias = X.in[5][layer * 256 + ch]; }
    {
        u32x4 av[6], gvv[6];
#pragma unroll
        for (int n = 0; n < 6; ++n) { int item = tid + 512 * n; item = item < 94 * 32 ? item : 94 * 32 - 1; const int rr = item >> 5, seg = (item & 31) * 8; int tt = t0 - 30 + rr; tt = tt < 0 ? 0 : tt;
            const bf16_t* pr = proj + ((size_t)b * T + tt) * LDP; av[n] = *(const u32x4*)(pr + C_CA + seg); gvv[n] = *(const u32x4*)(pr + C_CG + seg); }
#pragma unroll
        for (int n = 0; n < 6; ++n) { const int item = tid + 512 * n; if (item < 94 * 32) { const int rr = item >> 5, seg = (item & 31) * 8, tt = t0 - 30 + rr;
            u32x4 w = (u32x4){0u, 0u, 0u, 0u};
            if (tt >= 0) { float a[8], g[8], o[8]; unpack8(av[n], a); unpack8(gvv[n], g);
#pragma unroll
                for (int e = 0; e < 8; ++e) o[e] = a[e] * sigmoid_f(g[e]);
                w = pack8(o); }
            *(LAS u32x4*)(GL + rr * 256 + seg) = w; } }
    }
    LBAR();
    {
        const int ch = tid & 255, half = tid >> 8;
        float acc[32];
#pragma unroll
        for (int tk = 0; tk < 32; ++tk) acc[tk] = bias;
#pragma unroll
        for (int rr = 0; rr < 62; ++rr) { const float g = bf2f(GL[(half * 32 + rr) * 256 + ch]);
#pragma unroll
            for (int tk = 0; tk < 32; ++tk) { const int k = rr - tk; if (k >= 0 && k < 31) acc[tk] += w[k] * g; } }
#pragma unroll
        for (int tk = 0; tk < 32; ++tk) Y[(half * 32 + tk) * 256 + ch] = acc[tk];
    }
    LBAR();
    {
        const f32x4 lw = *((const f32x4*)(X.in[6] + layer * 256) + lane), lb = *((const f32x4*)(X.in[7] + layer * 256) + lane);
#pragma unroll 2
        for (int tk = wave * 8; tk < wave * 8 + 8; ++tk) {
            const f32x4 v = *((const LAS f32x4*)(Y + tk * 256) + lane);
            const float mu = wave_sum((v.x + v.y) + (v.z + v.w)) * (1.f / 256.f);
            const f32x4 dv = v - mu;
            const float var = wave_sum((dv.x * dv.x + dv.y * dv.y) + (dv.z * dv.z + dv.w * dv.w)) * (1.f / 256.f);
            const float rs = rsqrtf(var + 1e-5f);
            f32x4 o = dv * rs * lw + lb;
            const bool on = (MIX_MASK & 2) != 0;
            u32x2 p; p.x = on ? pk2(silu_acc(o.x), silu_acc(o.y)) : 0u; p.y = on ? pk2(silu_acc(o.z), silu_acc(o.w)) : 0u;
            *(u32x2*)(mix + ((size_t)b * T + t0 + tk) * D + 256 + lane * 4) = p;
        }
    }
    LBAR();
}

__device__ __forceinline__ void mixer_local_phase(const Ctx& X, LAS unsigned char* lds, int layer, int tid, int wave, int lane) {
    const int hs = wave >> 2, w4 = wave & 3; int tid_h = tid & 255;
    LAS unsigned char* hl = lds + hs * HEAD_LDS;
    const int nit_ = (3584 + (int)gridDim.x - 1) / (int)gridDim.x;
    for (int it_ = 0; it_ < nit_; ++it_) {
        const int u = (int)blockIdx.x + (int)gridDim.x * ((it_ + (int)(blockIdx.x >> 3)) % nit_);
        if (u >= 3584) continue;
        asm volatile("" : "+v"(tid_h), "+v"(lane), "+v"(tid));
        if (u < 3072) { const int mixer = u >> 10, idx = u & 1023, hp = idx & 1, cb = idx >> 1, b = cb >> 7, c = cb & 127, h = hp * 2 + hs;
            if (mixer == 0) { ret_unit(X, hl, b, c, h, tid_h, w4, lane);
            } else if (mixer == 1) { gdn_unit(X, hl, b, c, h, tid_h, w4, lane, layer);
            } else { hgrn_unit(X, hl, b, c, h, tid_h, w4, lane, layer);
            }
        } else { const int cb = u - 3072; conf_unit(X, lds, cb >> 7, cb & 127, tid, wave, lane, layer);
        }
    }
}

__device__ __forceinline__ void scan_phase(const Ctx& X, int wave, int lane) {
    const int job = blockIdx.x;
    if (job >= 192 || wave != 0) return;
    asm volatile("" : "+v"(lane));
    const int mixer = job >> 6, rem = job & 63, bh = rem >> 2, vg = rem & 3;
    const int uid0 = (mixer * 16 + bh) * NCH;
    const int r = lane & 15, q = lane >> 4;
    bf16_t* bc0 = WSP(bf16_t, WS_BCS) + (size_t)uid0 * 4096 + (vg * 4 * 64 + lane) * 4;
    float S[4][4];
#pragma unroll
    for (int t = 0; t < 4; ++t)
#pragma unroll
        for (int j = 0; j < 4; ++j) S[t][j] = 0.f;
    if (mixer == 1) {
        const bf16_t* mm0 = WSP(const bf16_t, WS_MM) + (size_t)(uid0 - 2048) * 4096;
        u32x2 cb[4][4], ca[4][4][2][2];
#define SCAN_LOAD_G(slot, cc) { const int c_ = (cc) < NCH ? (cc) : NCH - 1; const bf16_t* bcn = bc0 + (size_t)c_ * 4096; const bf16_t* mmn = mm0 + (size_t)c_ * 4096; \
            _Pragma("unroll") for (int t = 0; t < 4; ++t) { cb[slot][t] = *(const u32x2*)(bcn + 256 * t); \
                _Pragma("unroll") for (int s2 = 0; s2 < 2; ++s2) { const u32x4 w_ = *(const u32x4*)(mmn + ((t * 2 + s2) * 64 + lane) * 8); ca[slot][t][s2][0] = (u32x2){w_.x, w_.y}; ca[slot][t][s2][1] = (u32x2){w_.z, w_.w}; } } }
        SCAN_LOAD_G(0, 0) SCAN_LOAD_G(1, 1) SCAN_LOAD_G(2, 2)
#pragma unroll 1
        for (int c0 = 0; c0 < NCH; c0 += 4) {
#pragma unroll
            for (int k = 0; k < 4; ++k) {
                const int c = c0 + k;
                SCAN_LOAD_G((k + 3) & 3, c + 3)
                bf16_t* bcc = bc0 + (size_t)c * 4096;
                u32x2 sp[4];
#pragma unroll
                for (int t = 0; t < 4; ++t) { sp[t].x = pk2(S[t][0], S[t][1]); sp[t].y = pk2(S[t][2], S[t][3]);
                    asm volatile("" : "+v"(sp[t].x) : "v"(cb[k][t].x));
                    *(u32x2*)(bcc + 256 * t) = sp[t]; }
                bf16x8 bfr[2];
#pragma unroll
                for (int s2 = 0; s2 < 2; ++s2) { u32x4 w; w.x = sp[2 * s2].x; w.y = sp[2 * s2].y; w.z = sp[2 * s2 + 1].x; w.w = sp[2 * s2 + 1].y; bfr[s2] = __builtin_bit_cast(bf16x8, w); }
#pragma unroll
                for (int t = 0; t < 4; ++t) {
                    f32x4 acc = (f32x4){bf_lo(cb[k][t].x), bf_hi(cb[k][t].x), bf_lo(cb[k][t].y), bf_hi(cb[k][t].y)};
#pragma unroll
                    for (int s2 = 0; s2 < 2; ++s2) { u32x4 w; w.x = ca[k][t][s2][0].x; w.y = ca[k][t][s2][0].y; w.z = ca[k][t][s2][1].x; w.w = ca[k][t][s2][1].y;
                        acc = __builtin_amdgcn_mfma_f32_16x16x32_bf16(__builtin_bit_cast(bf16x8, w), bfr[s2], acc, 0, 0, 0); }
                    S[t][0] = acc[0]; S[t][1] = acc[1]; S[t][2] = acc[2]; S[t][3] = acc[3];
                }
            }
        }
#undef SCAN_LOAD_G
    } else {
        const int h = bh & 3;
        const float g64 = __expf(64.0f * log1pf(-exp2f(-5.0f - (float)h)));
        const float* mv0 = WSP(const float, WS_MVEC) + (size_t)(mixer == 2 ? uid0 - 2 * 2048 : 0) * 64 + 4 * q;
        u32x2 cb[4][4]; f32x4 cm[4][4];
#define SCAN_LOAD_D(slot, cc) { const int c_ = (cc) < NCH ? (cc) : NCH - 1; const bf16_t* bcn = bc0 + (size_t)c_ * 4096; \
            _Pragma("unroll") for (int t = 0; t < 4; ++t) { cb[slot][t] = *(const u32x2*)(bcn + 256 * t); cm[slot][t] = mixer == 2 ? *(const f32x4*)(mv0 + (size_t)c_ * 64 + 16 * t) : (f32x4){g64, g64, g64, g64}; } }
        SCAN_LOAD_D(0, 0) SCAN_LOAD_D(1, 1) SCAN_LOAD_D(2, 2)
#pragma unroll 1
        for (int c0 = 0; c0 < NCH; c0 += 4) {
#pragma unroll
            for (int k = 0; k < 4; ++k) {
                const int c = c0 + k;
                SCAN_LOAD_D((k + 3) & 3, c + 3)
                bf16_t* bcc = bc0 + (size_t)c * 4096;
#pragma unroll
                for (int t = 0; t < 4; ++t) { u32x2 sp; sp.x = pk2(S[t][0], S[t][1]); sp.y = pk2(S[t][2], S[t][3]);
                    asm volatile("" : "+v"(sp.x) : "v"(cb[k][t].x));
                    *(u32x2*)(bcc + 256 * t) = sp;
                    S[t][0] = cm[k][t].x * S[t][0] + bf_lo(cb[k][t].x); S[t][1] = cm[k][t].y * S[t][1] + bf_hi(cb[k][t].x);
                    S[t][2] = cm[k][t].z * S[t][2] + bf_lo(cb[k][t].y); S[t][3] = cm[k][t].w * S[t][3] + bf_hi(cb[k][t].y); }
            }
        }
#undef SCAN_LOAD_D
    }
}

__device__ __forceinline__ void mixer_out_phase(const Ctx& X, LAS unsigned char* lds, int layer, int tid, int wave, int lane) {
    constexpr int GP = 264;
    const bf16_t* proj = WSP(const bf16_t, WS_PROJ);
    bf16_t* mix = WSP(bf16_t, WS_MIX);
    for (int u = blockIdx.x; u < 1536; u += gridDim.x) {
        asm volatile("" : "+v"(lane), "+v"(tid));
        LAS bf16_t* GT = opq((LAS bf16_t*)lds);
        const int r = lane & 15, q = lane >> 4, h = wave >> 1, half = wave & 1;
        const int mixer = u >> 9, rem = u & 511, b = rem >> 7, c = rem & 127;
        const int uid = unit_id(mixer, b, h, c);
        const int goff = mixer == 0 ? C_RG : (mixer == 1 ? C_GG : C_HG), moff = mixer == 0 ? 0 : (mixer == 1 ? 512 : 768);
        const size_t row0 = (size_t)b * T + c * 64;
        u32x4 gv[4];
#pragma unroll
        for (int n = 0; n < 4; ++n) { const int idx = tid + 512 * n; gv[n] = *(const u32x4*)(proj + (row0 + (idx >> 5)) * LDP + goff + (idx & 31) * 8); }
        const bf16_t* qe = WSP(const bf16_t, WS_QEFF) + (size_t)uid * 4096;
        const bf16_t* st = WSP(const bf16_t, WS_BCS) + (size_t)uid * 4096;
        bf16x8 a[2][2], bb[4][2]; u32x4 ov[2][2];
#pragma unroll
        for (int rt = 0; rt < 2; ++rt) { const int rt4 = 2 * half + rt;
#pragma unroll
            for (int ks = 0; ks < 2; ++ks) a[rt][ks] = *(const bf16x8*)(qe + (16 * rt4 + r) * 64 + ks * 32 + q * 8);
            const u32x4* ol = (const u32x4*)(WSP(const bf16_t, WS_OLOC) + ((size_t)uid * 4 + rt4) * 1024 + lane * 16); ov[rt][0] = ol[0]; ov[rt][1] = ol[1]; }
#pragma unroll
        for (int ct = 0; ct < 4; ++ct)
#pragma unroll
            for (int ks = 0; ks < 2; ++ks) { const bf16_t* tb = st + (size_t)((ct * 4 + 2 * ks + (q >> 1)) * 64) * 4;
                const u32x2 lo = *(const u32x2*)(tb + ((2 * (q & 1)) * 16 + r) * 4), hi = *(const u32x2*)(tb + ((2 * (q & 1) + 1) * 16 + r) * 4);
                bb[ct][ks] = __builtin_bit_cast(bf16x8, (u32x4){lo.x, lo.y, hi.x, hi.y}); }
        const float* nw = mixer == 0 ? X.in[3] + layer * 256 + h * 64 : (mixer == 1 ? X.in[11] + layer * 64 : X.in[13] + layer * 64);
        float wv[4];
#pragma unroll
        for (int ct = 0; ct < 4; ++ct) wv[ct] = nw[16 * ct + r];
#pragma unroll
        for (int n = 0; n < 4; ++n) { const int idx = tid + 512 * n; *(LAS u32x4*)(GT + (idx >> 5) * GP + (idx & 31) * 8) = gv[n]; }
        LBAR();
        const bool on = ((MIX_MASK >> (mixer == 0 ? 0 : (mixer == 1 ? 2 : 3))) & 1) != 0;
#pragma unroll
        for (int rt = 0; rt < 2; ++rt) {
            f32x4 acc[4];
            acc[0] = (f32x4){bf_lo(ov[rt][0].x), bf_hi(ov[rt][0].x), bf_lo(ov[rt][0].y), bf_hi(ov[rt][0].y)}; acc[1] = (f32x4){bf_lo(ov[rt][0].z), bf_hi(ov[rt][0].z), bf_lo(ov[rt][0].w), bf_hi(ov[rt][0].w)};
            acc[2] = (f32x4){bf_lo(ov[rt][1].x), bf_hi(ov[rt][1].x), bf_lo(ov[rt][1].y), bf_hi(ov[rt][1].y)}; acc[3] = (f32x4){bf_lo(ov[rt][1].z), bf_hi(ov[rt][1].z), bf_lo(ov[rt][1].w), bf_hi(ov[rt][1].w)};
#pragma unroll
            for (int ct = 0; ct < 4; ++ct)
#pragma unroll
                for (int ks = 0; ks < 2; ++ks) acc[ct] = __builtin_amdgcn_mfma_f32_16x16x32_bf16(a[rt][ks], bb[ct][ks], acc[ct], 0, 0, 0);
#pragma unroll
            for (int j = 0; j < 4; ++j) {
                float sm = (acc[0][j] + acc[1][j]) + (acc[2][j] + acc[3][j]);
                sm += __shfl_xor(sm, 1); sm += __shfl_xor(sm, 2); sm += __shfl_xor(sm, 4); sm += __shfl_xor(sm, 8);
                const float mu = mixer == 0 ? sm * (1.f / 64.f) : 0.f;
                float d[4], s2 = 0.f;
#pragma unroll
                for (int ct = 0; ct < 4; ++ct) { d[ct] = acc[ct][j] - mu; s2 += d[ct] * d[ct]; }
                s2 += __shfl_xor(s2, 1); s2 += __shfl_xor(s2, 2); s2 += __shfl_xor(s2, 4); s2 += __shfl_xor(s2, 8);
                const float rs = rsqrtf(s2 * (1.f / 64.f) + (mixer == 0 ? 1e-5f : 1e-6f));
                const int ii = 16 * (2 * half + rt) + 4 * q + j;
#pragma unroll
                for (int ct = 0; ct < 4; ++ct) { LAS bf16_t* gp = GT + ii * GP + h * 64 + 16 * ct + r;
                    const float y = d[ct] * rs * wv[ct] * silu_acc(bf2f(*gp));
                    *gp = on ? f2bf(y) : (bf16_t)0; }
            }
        }
        LBAR();
#pragma unroll
        for (int n = 0; n < 4; ++n) { const int idx = tid + 512 * n; __builtin_nontemporal_store(*(const LAS u32x4*)(GT + (idx >> 5) * GP + (idx & 31) * 8), (u32x4*)(mix + (row0 + (idx >> 5)) * D + moff + (idx & 31) * 8)); }
        LBAR();
    }
}

constexpr int PREP_FIRST = (D / 64) * (NINP / 32), PREP_ALL = DEPTH * ((D / 64) * (NINP / 32) + (D / 64) * (D / 32) + 2 * (D / 64) * (DFF / 32) + (DFF / 64) * (D / 32));
__global__ void __launch_bounds__(512, 2) fwd_kernel(Ctx X) {
    extern __shared__ __attribute__((aligned(16))) unsigned char lds_raw[];
    LAS unsigned char* lds = (LAS unsigned char*)lds_raw;
    cg::grid_group grid = cg::this_grid();
    const int tid = threadIdx.x, lane = tid & 63, wave = __builtin_amdgcn_readfirstlane(tid >> 6);
    const int G = gridDim.x, gw = blockIdx.x * 8 + wave, ngw = G * 8;
    bf16_t* XS = (bf16_t*)X.out;
    bf16_t* XN = WSP(bf16_t, WS_XN); bf16_t* PROJ = WSP(bf16_t, WS_PROJ); bf16_t* ACT = WSP(bf16_t, WS_PROJ); bf16_t* MIX = WSP(bf16_t, WS_MIX);

    if (X.ws == nullptr) grid.sync();
    if (tid < 4) ((LAS unsigned*)(lds + LDS_BAR_OFF))[tid] = 0u;
    __syncthreads();
    (void)xcd_barrier_post(WSP(unsigned, WS_CTL), (volatile LAS unsigned*)(lds + LDS_BAR_OFF));
#define GSYNC() do { XcdBarrier b_; b_.bar = WSP(unsigned, WS_CTL); b_.x = xb_xcc_id(); b_.st = (volatile LAS unsigned*)(lds + LDS_BAR_OFF); xcd_barrier(b_); } while (0)
    prep_weights(X, lds, gw, ngw, wave, lane, 0, PREP_FIRST);
    for (int idx = blockIdx.x * 512 + tid; idx < DEPTH * 16 * D; idx += G * 512) { const int ll = idx >> 14, n = (idx >> 10) & 15, k = idx & 1023;
        WSP(bf16_t, WS_WBA)[idx] = n < 8 ? f2bf(X.in[2][((size_t)ll * D + k) * DIN + 2560 + n] * X.in[1][ll * D + k]) : (bf16_t)0; }
    cast_phase(X.in[0], XS, WSP(float, WS_RSA), gw, ngw, lane);
    GSYNC();
#pragma unroll 1
    for (int l = 0; l < DEPTH; ++l) {
        {
            pg8::Gemm g{XS, WSP(const bf16_t, WS_WIN) + (size_t)l * NINP * D, M, NINP, D}; pg8::StaticOrder S; S.init(M, NINP, G, (int)blockIdx.x);
            pg8::EpiProj E{PROJ, LDP, DIN, WSP(const float, WS_RSA)};
            pg8::gemm_phase<pg8::EpiProj, pg8::StaticOrder, true, true>(lds, g, S, E);
            int ln = lane; asm volatile("" : "+v"(ln));
            const int r = ln & 15, q = ln >> 4;
            for (int rb = blockIdx.x; rb < M / 128; rb += G) {
                const bf16_t* Ap = XS + (size_t)(rb * 128 + wave * 16 + r) * D + q * 8;
                const bf16_t* Bp = WSP(const bf16_t, WS_WBA) + (size_t)l * 16 * D + r * D + q * 8;
                f32x4 acc = (f32x4){0.f, 0.f, 0.f, 0.f};
#pragma unroll 8
                for (int ks = 0; ks < 32; ++ks) acc = __builtin_amdgcn_mfma_f32_16x16x32_bf16(*(const bf16x8*)(Ap + ks * 32), *(const bf16x8*)(Bp + ks * 32), acc, 0, 0, 0);
                if (r < 8) {
#pragma unroll
                    for (int j = 0; j < 4; ++j) { const int row = rb * 128 + wave * 16 + 4 * q + j;
                        WSP(float, WS_GBA)[(size_t)row * 8 + r] = acc[j] * rsqrtf(WSP(const float, WS_RSA)[row] * (1.0f / 1024.0f) + 1e-6f); } }
            }
        }
        GSYNC();
        int tz = tid; asm volatile("" : "+v"(tz));
        for (int i = blockIdx.x * 512 + tz; i < M; i += G * 512) { WSP(float, WS_RSA)[i] = 0.f; WSP(float, WS_RSB)[i] = 0.f; }
        mixer_local_phase(X, lds, l, tid, wave, lane);
        GSYNC();
        scan_phase(X, wave, lane);
        if (l == 0 && wave != 0) prep_weights(X, lds, blockIdx.x * 7 + wave - 1, G * 7, wave, lane, PREP_FIRST, PREP_ALL);
        GSYNC();
        mixer_out_phase(X, lds, l, tid, wave, lane);
        GSYNC();
        {
            pg8::Gemm g{MIX, WSP(const bf16_t, WS_WOUT) + (size_t)l * D * D, M, D, D}; pg8::StaticOrder S; S.init(M, D, G, (int)blockIdx.x);
            pg8::EpiResid E{l == 0 ? X.in[0] : nullptr, l == 0 ? nullptr : XS, nullptr, XN, D, WSP(float, WS_RSB)};
            pg8::gemm_phase<pg8::EpiResid, pg8::StaticOrder, true, true>(lds, g, S, E);
        }
        GSYNC();
        {
            pg8::Gemm g{XN, WSP(const bf16_t, WS_WGU) + (size_t)l * NGU * D, M, NGU, D}; pg8::StaticOrder S; S.init(M, NGU, G, (int)blockIdx.x);
            pg8::EpiSwiglu E{ACT, DFF, WSP(const float, WS_RSB)};
            pg8::gemm_phase<pg8::EpiSwiglu, pg8::StaticOrder, true, true>(lds, g, S, E);
        }
        GSYNC();
        {
            pg8::Gemm g{ACT, WSP(const bf16_t, WS_WDN) + (size_t)l * D * DFF, M, D, DFF}; pg8::StaticOrder S; S.init(M, D, G, (int)blockIdx.x);
            pg8::EpiResid E{nullptr, XN, l + 1 < DEPTH ? nullptr : X.out, l + 1 < DEPTH ? XS : nullptr, D, l + 1 < DEPTH ? WSP(float, WS_RSA) : nullptr};
            pg8::gemm_phase<pg8::EpiResid, pg8::StaticOrder, true, true>(lds, g, S, E);
        }
        GSYNC();
        if (l + 1 == DEPTH) norm_phase(X.out, X.in[19], nullptr, X.out, gw, ngw, lane);
    }
}

extern "C" void kernel_launch(void* const* d_in, const int* in_sizes, int n_in, void* d_out, int out_size, void* d_ws, size_t ws_size, hipStream_t stream) {
    static int grid = 0;
    if (grid == 0) {
        if (n_in != 20 || out_size != M * D || ws_size < WS_END) { fprintf(stderr, "kernel_launch: unexpected shapes (n_in %d, out %d, ws %zu)\n", n_in, out_size, ws_size); grid = -1; return; }
        int dev = 0, cus = 0, per_cu = 0;
        hipGetDevice(&dev); hipDeviceGetAttribute(&cus, hipDeviceAttributeMultiprocessorCount, dev);
        if (hipFuncSetAttribute((const void*)fwd_kernel, hipFuncAttributeMaxDynamicSharedMemorySize, LDS_BYTES) != hipSuccess) { fprintf(stderr, "kernel_launch: hipFuncSetAttribute failed\n"); grid = -1; return; }
        if (hipOccupancyMaxActiveBlocksPerMultiprocessor(&per_cu, (const void*)fwd_kernel, 512, LDS_BYTES) != hipSuccess || per_cu < 1) { fprintf(stderr, "kernel_launch: occupancy query says %d\n", per_cu); per_cu = 1; }
        (void)hipGetLastError();
        grid = cus * (per_cu > 1 ? 1 : per_cu);
    }
    if (grid < 0) return;
    Ctx X{};
    for (int i = 0; i < 20; ++i) X.in[i] = (const float*)d_in[i];
    X.out = (float*)d_out; X.ws = (unsigned char*)d_ws;
    void* args[] = {&X};
    if (hipMemsetAsync((char*)d_ws + WS_CTL, 0, 16384, stream) != hipSuccess) { fprintf(stderr, "kernel_launch: hipMemsetAsync of the barrier words failed\n"); return; }
    hipError_t e = hipLaunchCooperativeKernel((const void*)fwd_kernel, dim3(grid), dim3(512), args, LDS_BYTES, stream);
    if (e != hipSuccess) fprintf(stderr, "cooperative launch failed: %s (grid %d)\n", hipGetErrorString(e), grid);
}
```

```cpp
#include <hip/hip_runtime.h>
#include <hip/hip_cooperative_groups.h>
#include <cstdio>
#include <cstdint>
namespace cg = cooperative_groups;

#ifndef MIX_MASK
#define MIX_MASK 15
#endif
namespace pg8 {
#define PG8_LAS __attribute__((address_space(3)))
typedef unsigned short bf16_t;
typedef short bf16x8 __attribute__((ext_vector_type(8)));
typedef float f32x4 __attribute__((ext_vector_type(4)));
typedef unsigned u32x4 __attribute__((ext_vector_type(4)));
constexpr int BM = 256, BK = 64, HALF = 128, HTB = HALF * BK * 2  , STAGE_BYTES = 8 * HTB, NXCD = 8, WGM = 8;

__host__ __device__ __forceinline__ int lds_byte(int r, int c) { const int st = (r >> 4) * 2 + (c >> 5), rr = r & 15, cc = c & 31, ob = rr * 64 + cc * 2; return st * 1024 + (ob ^ (((ob >> 9) & 1) << 5)); }
__host__ __device__ __forceinline__ void stage_rc(int b, int& R, int& C) { const int st = b / 1024, sb = b % 1024, swz = sb ^ (((sb >> 9) & 1) << 5); R = (st >> 1) * 16 + swz / 64; C = (st & 1) * 32 + (swz % 64) / 2; }
__host__ __device__ __forceinline__ int perm32(int rho) { const int n = rho >> 4, i = rho & 15; return 8 * (i >> 2) + 4 * n + (i & 3); }

struct Unit { int pm, pn; };
struct Gemm { const bf16_t* A; const bf16_t* Bt; int M, N, K; };

struct StaticOrder {
    int nM, nN, nwg, G, c;
    __host__ __device__ void init(int M, int N, int G_, int c_) { nM = M / BM; nN = N / BM; nwg = nM * nN; G = G_; c = c_; }
    __host__ __device__ bool next(int i, Unit& u) const {
        const long L = (long)i * G + c; if (L >= nwg) return false;
        int wgid = (int)L; { const int q = nwg / NXCD, r = nwg % NXCD, xcd = wgid % NXCD, off = wgid / NXCD; wgid = (xcd < r ? xcd * (q + 1) : r * (q + 1) + (xcd - r) * q) + off; }
        const int nig = WGM * nN, gid = wgid / nig, fm = gid * WGM, gsz = (nM - fm) < WGM ? (nM - fm) : WGM;
        u.pm = fm + ((wgid % nig) % gsz); u.pn = (wgid % nig) / gsz; return true;
    }
    __device__ __forceinline__ void a_ready(const Unit&) const {}
    __device__ __forceinline__ void done(const Unit&) const {}
};

__device__ __forceinline__ unsigned cvt_pk_bf16(float lo, float hi) { unsigned r; asm volatile("v_cvt_pk_bf16_f32 %0, %1, %2" : "=v"(r) : "v"(lo), "v"(hi)); return r; }
__device__ __forceinline__ float silu_f(float g) { return g * __builtin_amdgcn_rcpf(1.0f + __expf(-g)); }

struct EpiProj {
    static constexpr bool PERM = true, AFTER_DRAIN = false;
    bf16_t* O; int ldc; int ncols; const float* rowsq;
    __device__ __forceinline__ void pre(const Unit& u, int wr, int fr, float (&rsv)[8]) const {
#pragma unroll
        for (int i = 0; i < 8; ++i) rsv[i] = rowsq[u.pm * BM + wr * 64 + fr + (i >> 2) * HALF + (i & 3) * 16]; }
    __device__ __forceinline__ void operator()(const f32x4 (&acc)[2][2][4][2], const Unit& u, int wr, int wc, int fr, int fq, const float (&rsv)[8]) const {
        const int row0 = u.pm * BM + wr * 64 + fr; const int col0 = u.pn * BM + wc * 32 + 8 * fq;
#pragma unroll
        for (int ai = 0; ai < 2; ++ai)
#pragma unroll
            for (int m = 0; m < 4; ++m) { bf16_t* rowp = O + (size_t)(row0 + ai * HALF + m * 16) * ldc;
                const float rs = __builtin_amdgcn_rsqf(rsv[ai * 4 + m] * (1.0f / 1024.0f) + 1e-6f);
#pragma unroll
                for (int bj = 0; bj < 2; ++bj) { const int col = col0 + bj * HALF;
                    if (col < ncols) { const f32x4 v0 = acc[ai][bj][m][0] * rs, v1 = acc[ai][bj][m][1] * rs; u32x4 w;
                        w.x = cvt_pk_bf16(v0[0], v0[1]); w.y = cvt_pk_bf16(v0[2], v0[3]); w.z = cvt_pk_bf16(v1[0], v1[1]); w.w = cvt_pk_bf16(v1[2], v1[3]);
                        __builtin_nontemporal_store(w, (u32x4*)(rowp + col)); } } }
    }
};
struct EpiResid {
    static constexpr bool PERM = true, AFTER_DRAIN = false;
    const float* base_f; const bf16_t* base_b; float* out_f; bf16_t* out_b; int ldc; float* rowsq;
    __device__ __forceinline__ void pre(const Unit&, int, int, float (&)[8]) const {}
    __device__ __forceinline__ void operator()(const f32x4 (&acc)[2][2][4][2], const Unit& u, int wr, int wc, int fr, int fq, const float (&rsv)[8]) const {
        const int row0 = u.pm * BM + wr * 64 + fr; const int col0 = u.pn * BM + wc * 32 + 8 * fq;
#pragma unroll
        for (int ai = 0; ai < 2; ++ai)
#pragma unroll
            for (int m = 0; m < 4; ++m) { const size_t off = (size_t)(row0 + ai * HALF + m * 16) * ldc + col0; float sq = 0.f;
#pragma unroll
                for (int bj = 0; bj < 2; ++bj) { const size_t o_ = off + bj * HALF; f32x4 b0, b1;
                    if (base_b) { const u32x4 w = *(const u32x4*)(base_b + o_);
                        b0 = (f32x4){__uint_as_float(w.x << 16), __uint_as_float(w.x & 0xffff0000u), __uint_as_float(w.y << 16), __uint_as_float(w.y & 0xffff0000u)};
                        b1 = (f32x4){__uint_as_float(w.z << 16), __uint_as_float(w.z & 0xffff0000u), __uint_as_float(w.w << 16), __uint_as_float(w.w & 0xffff0000u)}; }
                    else { b0 = *(const f32x4*)(base_f + o_); b1 = *(const f32x4*)(base_f + o_ + 4); }
                    const f32x4 o0 = b0 + acc[ai][bj][m][0], o1 = b1 + acc[ai][bj][m][1];
                    if (out_f) { *(f32x4*)(out_f + o_) = o0; *(f32x4*)(out_f + o_ + 4) = o1; }
                    if (out_b) { u32x4 w; w.x = cvt_pk_bf16(o0[0], o0[1]); w.y = cvt_pk_bf16(o0[2], o0[3]); w.z = cvt_pk_bf16(o1[0], o1[1]); w.w = cvt_pk_bf16(o1[2], o1[3]); *(u32x4*)(out_b + o_) = w; }
                    sq += ((o0[0] * o0[0] + o0[1] * o0[1]) + (o0[2] * o0[2] + o0[3] * o0[3])) + ((o1[0] * o1[0] + o1[1] * o1[1]) + (o1[2] * o1[2] + o1[3] * o1[3])); }
                if (rowsq) { sq += __shfl_xor(sq, 16); sq += __shfl_xor(sq, 32); if (fq == 0) atomicAdd(rowsq + row0 + ai * HALF + m * 16, sq); } }
    }
};
struct EpiSwiglu {
    static constexpr bool PERM = true, AFTER_DRAIN = false;
    bf16_t* O; int ldc; const float* rowsq;
    __device__ __forceinline__ void pre(const Unit& u, int wr, int fr, float (&rsv)[8]) const {
#pragma unroll
        for (int i = 0; i < 8; ++i) rsv[i] = rowsq[u.pm * BM + wr * 64 + fr + (i >> 2) * HALF + (i & 3) * 16]; }
    __device__ __forceinline__ void operator()(const f32x4 (&acc)[2][2][4][2], const Unit& u, int wr, int wc, int fr, int fq, const float (&rsv)[8]) const {
        const int row0 = u.pm * BM + wr * 64 + fr; const int col0 = u.pn * HALF + wc * 32 + 8 * fq;
#pragma unroll
        for (int ai = 0; ai < 2; ++ai)
#pragma unroll
            for (int m = 0; m < 4; ++m) { bf16_t* rowp = O + (size_t)(row0 + ai * HALF + m * 16) * ldc + col0;
                const float rs = __builtin_amdgcn_rsqf(rsv[ai * 4 + m] * (1.0f / 1024.0f) + 1e-6f);
                const f32x4 g0 = acc[ai][0][m][0] * rs, g1 = acc[ai][0][m][1] * rs, u0 = acc[ai][1][m][0] * rs, u1 = acc[ai][1][m][1] * rs; u32x4 w;
                w.x = cvt_pk_bf16(silu_f(g0[0]) * u0[0], silu_f(g0[1]) * u0[1]); w.y = cvt_pk_bf16(silu_f(g0[2]) * u0[2], silu_f(g0[3]) * u0[3]);
                w.z = cvt_pk_bf16(silu_f(g1[0]) * u1[0], silu_f(g1[1]) * u1[1]); w.w = cvt_pk_bf16(silu_f(g1[2]) * u1[2], silu_f(g1[3]) * u1[3]);
                __builtin_nontemporal_store(w, (u32x4*)rowp); }
    }
};

template <class Epi, class Sched, bool ALIGN_EPI = false, bool SP2 = false>
__device__ __forceinline__ void gemm_phase(PG8_LAS unsigned char* lds, const Gemm g, const Sched& S, const Epi& E) {
    int tid_ = threadIdx.x; asm volatile("" : "+v"(tid_));
    const int tid = tid_, wid = __builtin_amdgcn_readfirstlane(tid >> 6), lane = tid & 63, wr = wid >> 2, wc = wid & 3, fr = lane & 15, fq = lane >> 4;
    const int K = g.K, nt = K / BK;
    unsigned voffA[2], voffB[2];
#pragma unroll
    for (int i = 0; i < 2; ++i) { int R, C; stage_rc(tid * 16 + i * 8192, R, C); const int Rb = Epi::PERM ? ((R & ~31) + perm32(R & 31)) : R;
        voffA[i] = (unsigned)(R * K + C) * 2u; voffB[i] = (unsigned)(Rb * K + C) * 2u; }
    const size_t kstep = (size_t)(BK * 2);
    const size_t hstep = (size_t)HALF * K * 2;
    const size_t tstep = 2 * hstep;
    const unsigned ldsw = (unsigned)wid * 1024u;
    const int aoff = lds_byte(wr * 64 + fr, fq * 8), boff = lds_byte(wc * 32 + fr, fq * 8);
#define PG8_SA(b, h) (((b) * 2 + (h)) * HTB)
#define PG8_SB(b, h) ((4 + (b) * 2 + (h)) * HTB)
#define PG8_STAGE(bufoff, gbase, voff) do { _Pragma("unroll") for (int _i = 0; _i < 2; ++_i) \
        __builtin_amdgcn_global_load_lds((const unsigned*)((const char*)(gbase) + (voff)[_i]), (PG8_LAS unsigned*)(lds + (bufoff) + ldsw + _i * 8192), 16, 0, 0); } while (0)
#define PG8_LDA(dst, b, h) do { _Pragma("unroll") for (int m = 0; m < 4; ++m) _Pragma("unroll") for (int k = 0; k < 2; ++k) dst[m][k] = *(const PG8_LAS bf16x8*)(lds + PG8_SA(b, h) + aoff + m * 2048 + k * 1024); } while (0)
#define PG8_LDB(dst, b, h) do { _Pragma("unroll") for (int n = 0; n < 2; ++n) _Pragma("unroll") for (int k = 0; k < 2; ++k) dst[n][k] = *(const PG8_LAS bf16x8*)(lds + PG8_SB(b, h) + boff + n * 2048 + k * 1024); } while (0)
#define PG8_MMA(ai, bj, At, Bt) do { __builtin_amdgcn_s_setprio(1); _Pragma("unroll") for (int m = 0; m < 4; ++m) _Pragma("unroll") for (int n = 0; n < 2; ++n) _Pragma("unroll") for (int k = 0; k < 2; ++k) \
        acc[ai][bj][m][n] = __builtin_amdgcn_mfma_f32_16x16x32_bf16(Bt[n][k], At[m][k], acc[ai][bj][m][n], 0, 0, 0); __builtin_amdgcn_s_setprio(0); } while (0)
#define PG8_WAIT_V(n) asm volatile("s_waitcnt vmcnt(" #n ")" ::: "memory")
#define PG8_WAIT_L(n) asm volatile("s_waitcnt lgkmcnt(" #n ")" ::: "memory")
#define PG8_BAR __builtin_amdgcn_s_barrier()
#define PG8_SCHED __builtin_amdgcn_sched_barrier(0)
    Unit cur, nxt; int ui = 0;
    float rsv[8];
    if (!S.next(0, cur)) return;
    f32x4 acc[2][2][4][2];
#pragma unroll
    for (int a = 0; a < 2; ++a)
#pragma unroll
        for (int b = 0; b < 2; ++b)
#pragma unroll
            for (int m = 0; m < 4; ++m)
#pragma unroll
                for (int n = 0; n < 2; ++n) acc[a][b][m][n] = (f32x4){0.f, 0.f, 0.f, 0.f};
    bf16x8 At[4][2], B0[2][2], B1[2][2];
    const char* cA = (const char*)g.A + (size_t)cur.pm * tstep; const char* cB = (const char*)g.Bt + (size_t)cur.pn * tstep;
    S.a_ready(cur);
    if constexpr (SP2) {
        PG8_STAGE(PG8_SB(0, 0), cB, voffB); PG8_STAGE(PG8_SB(0, 1), cB + hstep, voffB); PG8_STAGE(PG8_SA(0, 0), cA, voffA); PG8_STAGE(PG8_SA(0, 1), cA + hstep, voffA);
        if (wr == 1) PG8_BAR;
        PG8_WAIT_V(2); PG8_BAR;
        PG8_STAGE(PG8_SB(1, 0), cB + kstep, voffB); PG8_STAGE(PG8_SA(1, 0), cA + kstep, voffA); PG8_STAGE(PG8_SB(1, 1), cB + hstep + kstep, voffB);
        PG8_WAIT_V(6); PG8_BAR;
    } else {
        PG8_STAGE(PG8_SB(0, 0), cB, voffB); PG8_STAGE(PG8_SA(0, 0), cA, voffA); PG8_STAGE(PG8_SB(0, 1), cB + hstep, voffB); PG8_STAGE(PG8_SA(0, 1), cA + hstep, voffA);
        if (wr == 1) PG8_BAR;
        PG8_WAIT_V(4); PG8_BAR;
        PG8_STAGE(PG8_SB(1, 0), cB + kstep, voffB); PG8_STAGE(PG8_SA(1, 0), cA + kstep, voffA); PG8_STAGE(PG8_SB(1, 1), cB + hstep + kstep, voffB);
        PG8_WAIT_V(6); PG8_BAR;
    }
    for (;;) {
        const bool has_next = S.next(ui + 1, nxt);
        const char* nA = has_next ? (const char*)g.A + (size_t)nxt.pm * tstep : cA; const char* nB = has_next ? (const char*)g.Bt + (size_t)nxt.pn * tstep : cB;
        for (int t = 0; t < nt; t += 2) {
            const bool last = (t == nt - 2);
            const char* a1 = cA + (size_t)(t + 1) * kstep;
            const char* a2 = last ? nA : cA + (size_t)(t + 2) * kstep; const char* b2 = last ? nB : cB + (size_t)(t + 2) * kstep;
            const char* a3 = a2 + kstep; const char* b3 = b2 + kstep;
            if (last && has_next) S.a_ready(nxt);
            if (last) E.pre(cur, wr, fr, rsv);
            if constexpr (SP2) {
            PG8_LDB(B0, 0, 0); PG8_LDB(B1, 0, 1); PG8_SCHED; PG8_LDA(At, 0, 0); PG8_STAGE(PG8_SA(1, 1), a1 + hstep, voffA);
            PG8_WAIT_V(8); PG8_WAIT_L(0); PG8_BAR; PG8_MMA(0, 0, At, B0); PG8_MMA(0, 1, At, B1); PG8_BAR; PG8_SCHED;
            PG8_LDA(At, 0, 1); PG8_STAGE(PG8_SB(0, 0), b2, voffB); PG8_STAGE(PG8_SB(0, 1), b2 + hstep, voffB); PG8_STAGE(PG8_SA(0, 0), a2, voffA);
            PG8_WAIT_V(8); PG8_WAIT_L(0); PG8_BAR; PG8_MMA(1, 0, At, B0); PG8_MMA(1, 1, At, B1); PG8_BAR; PG8_SCHED;
            PG8_LDB(B0, 1, 0); PG8_LDB(B1, 1, 1); PG8_SCHED; PG8_LDA(At, 1, 0); PG8_STAGE(PG8_SA(0, 1), a2 + hstep, voffA);
            PG8_WAIT_V(8); PG8_WAIT_L(0); PG8_BAR; PG8_MMA(0, 0, At, B0); PG8_MMA(0, 1, At, B1); PG8_BAR; PG8_SCHED;
            PG8_LDA(At, 1, 1); PG8_STAGE(PG8_SB(1, 0), b3, voffB); PG8_STAGE(PG8_SB(1, 1), b3 + hstep, voffB); PG8_STAGE(PG8_SA(1, 0), a3, voffA);
            PG8_WAIT_V(8); PG8_WAIT_L(0); PG8_BAR; PG8_MMA(1, 0, At, B0); PG8_MMA(1, 1, At, B1); PG8_BAR; PG8_SCHED;
            } else {
            PG8_LDB(B0, 0, 0); PG8_SCHED; PG8_LDA(At, 0, 0); PG8_STAGE(PG8_SA(1, 1), a1 + hstep, voffA);
            PG8_WAIT_L(8); PG8_BAR; PG8_WAIT_L(0); PG8_MMA(0, 0, At, B0); PG8_BAR; PG8_SCHED;
            PG8_LDB(B1, 0, 1); PG8_STAGE(PG8_SB(0, 0), b2, voffB);
            PG8_BAR; PG8_WAIT_L(0); PG8_MMA(0, 1, At, B1); PG8_BAR;
            PG8_LDA(At, 0, 1); PG8_STAGE(PG8_SA(0, 0), a2, voffA);
            PG8_BAR; PG8_WAIT_L(0); PG8_MMA(1, 0, At, B0); PG8_BAR; PG8_SCHED;
            PG8_STAGE(PG8_SB(0, 1), b2 + hstep, voffB);
            PG8_WAIT_V(6); PG8_BAR; PG8_MMA(1, 1, At, B1); PG8_BAR;
            PG8_LDB(B0, 1, 0); PG8_SCHED; PG8_LDA(At, 1, 0); PG8_STAGE(PG8_SA(0, 1), a2 + hstep, voffA);
            PG8_WAIT_L(8); PG8_BAR; PG8_WAIT_L(0); PG8_MMA(0, 0, At, B0); PG8_BAR; PG8_SCHED;
            PG8_LDB(B1, 1, 1); PG8_STAGE(PG8_SB(1, 0), b3, voffB);
            PG8_BAR; PG8_WAIT_L(0); PG8_MMA(0, 1, At, B1); PG8_BAR;
            PG8_LDA(At, 1, 1); PG8_STAGE(PG8_SA(1, 0), a3, voffA);
            PG8_BAR; PG8_WAIT_L(0); PG8_MMA(1, 0, At, B0); PG8_BAR; PG8_SCHED;
            PG8_STAGE(PG8_SB(1, 1), b3 + hstep, voffB);
            PG8_WAIT_V(6); PG8_BAR; PG8_MMA(1, 1, At, B1); PG8_BAR;
            }
        }
        if constexpr (ALIGN_EPI) { if (wr == 0) PG8_BAR; }
        if constexpr (!Epi::AFTER_DRAIN) { E(acc, cur, wr, wc, fr, fq, rsv); S.done(cur); }
        if (!has_next) break;
#pragma unroll
        for (int a = 0; a < 2; ++a)
#pragma unroll
            for (int b = 0; b < 2; ++b)
#pragma unroll
                for (int m = 0; m < 4; ++m)
#pragma unroll
                    for (int n = 0; n < 2; ++n) acc[a][b][m][n] = (f32x4){0.f, 0.f, 0.f, 0.f};
        cur = nxt; cA = nA; cB = nB; ++ui;
        if constexpr (ALIGN_EPI) { if (wr == 1) PG8_BAR; }
    }
    PG8_WAIT_V(0);
    if constexpr (!ALIGN_EPI) { if (wr == 0) PG8_BAR; }
    PG8_BAR;
    if constexpr (Epi::AFTER_DRAIN) { E.fused(acc, cur, wr, wc, fr, fq, lds, wid, lane); S.done(cur); }
#undef PG8_SA
#undef PG8_SB
#undef PG8_STAGE
#undef PG8_LDA
#undef PG8_LDB
#undef PG8_MMA
#undef PG8_WAIT_V
#undef PG8_WAIT_L
#undef PG8_BAR
#undef PG8_SCHED
}
}

constexpr int NB = 4, T = 8192, D = 1024, DIN = 3592, NINP = 3584, DFF = 2816, NGU = 2 * DFF, DEPTH = 2;
constexpr int M = NB * T;
constexpr int NCH = T / 64;
constexpr int LDP = NINP;
constexpr int C_RQ = 0, C_RK = 256, C_RV = 512, C_RG = 768, C_CA = 1024, C_CG = 1280, C_GQ = 1536, C_GK = 1792, C_GV = 2048, C_GG = 2304,
              C_HQ = 2560, C_HF = 2816, C_HI = 3072, C_HG = 3328;
constexpr size_t MiB = 1u << 20;
constexpr size_t WS_CTL = 0;
constexpr size_t WS_WIN = 1 * MiB;
constexpr size_t WS_WOUT = 16 * MiB;
constexpr size_t WS_WGU = 20 * MiB;
constexpr size_t WS_WDN = 42 * MiB;
constexpr size_t WS_XN = 53 * MiB;
constexpr size_t WS_BCS = WS_XN;
constexpr size_t WS_MM = WS_XN + 48 * MiB;
constexpr size_t WS_MIX = 117 * MiB;
constexpr size_t WS_PROJ = 181 * MiB;
constexpr size_t WS_QEFF = 406 * MiB;
constexpr size_t WS_OLOC = 454 * MiB;
constexpr size_t WS_MVEC = 502 * MiB;
constexpr size_t WS_RSA = 503 * MiB;
constexpr size_t WS_RSB = 503 * MiB + 131072;
constexpr size_t WS_GBA = 503 * MiB + 262144;
constexpr size_t WS_WBA = 504 * MiB + 524288;
constexpr size_t WS_END = 505 * MiB;
constexpr int LDS_BYTES = 147456 + 256;
constexpr int LDS_BAR_OFF = 147456;
constexpr int HEAD_LDS = 73728;

#define LAS __attribute__((address_space(3)))
typedef unsigned short bf16_t;
typedef short bf16x8 __attribute__((ext_vector_type(8)));
typedef float f32x4 __attribute__((ext_vector_type(4)));
typedef unsigned u32x4 __attribute__((ext_vector_type(4)));
typedef unsigned u32x2 __attribute__((ext_vector_type(2)));
constexpr int LT = 72;
template <class Tp> __device__ __forceinline__ LAS Tp* opq(LAS Tp* p) { asm volatile("" : "+v"(p)); return p; }

__device__ __forceinline__ float bf_lo(unsigned u) { return __uint_as_float(u << 16); }
__device__ __forceinline__ float bf_hi(unsigned u) { return __uint_as_float(u & 0xffff0000u); }
__device__ __forceinline__ float bf2f(bf16_t b) { return __uint_as_float((unsigned)b << 16); }
__device__ __forceinline__ unsigned pk2(float lo, float hi) { return pg8::cvt_pk_bf16(lo, hi); }
__device__ __forceinline__ bf16_t f2bf(float f) { return (bf16_t)(pk2(f, 0.f) & 0xffffu); }
__device__ __forceinline__ float fexp(float x) { return __expf(x); }
__device__ __forceinline__ float frcp(float x) { return __builtin_amdgcn_rcpf(x); }
__device__ __forceinline__ float sigmoid_f(float x) { return frcp(1.0f + fexp(-x)); }
__device__ __forceinline__ float silu_acc(float x) { return x * frcp(1.0f + fexp(-x)); }
__device__ __forceinline__ float softplus_f(float x) { return fmaxf(x, 0.f) + log1pf(expf(-fabsf(x))); }
__device__ __forceinline__ float wave_sum(float v) {
#pragma unroll
    for (int o = 1; o < 64; o <<= 1) v += __shfl_xor(v, o);
    return v;
}
__device__ __forceinline__ void unpack8(const u32x4 w, float (&f)[8]) {
    f[0] = bf_lo(w.x); f[1] = bf_hi(w.x); f[2] = bf_lo(w.y); f[3] = bf_hi(w.y); f[4] = bf_lo(w.z); f[5] = bf_hi(w.z); f[6] = bf_lo(w.w); f[7] = bf_hi(w.w);
}
__device__ __forceinline__ u32x4 pack8(const float (&f)[8]) { u32x4 w; w.x = pk2(f[0], f[1]); w.y = pk2(f[2], f[3]); w.z = pk2(f[4], f[5]); w.w = pk2(f[6], f[7]); return w; }

struct Ctx {
    const float* in[20]; float* out; unsigned char* ws;
};
#define WSP(T_, off) ((T_*)(X.ws + (off)))

__device__ __forceinline__ f32x4 mma16(const LAS bf16_t* A, int a0, const LAS bf16_t* B, int b0, f32x4 acc, int r, int q) {
#pragma unroll
    for (int ks = 0; ks < 2; ++ks) {
        const bf16x8 a = *(const LAS bf16x8*)(A + (a0 + r) * LT + ks * 32 + q * 8);
        const bf16x8 b = *(const LAS bf16x8*)(B + (b0 + r) * LT + ks * 32 + q * 8);
        acc = __builtin_amdgcn_mfma_f32_16x16x32_bf16(a, b, acc, 0, 0, 0);
    }
    return acc;
}
__device__ __forceinline__ void store_oloc(bf16_t* oloc, int uid, int w4, int lane, const f32x4 (&acc)[4]) {
    u32x4* p = (u32x4*)(oloc + ((size_t)uid * 4 + w4) * 1024 + lane * 16);
    u32x4 a, b;
    a.x = pk2(acc[0][0], acc[0][1]); a.y = pk2(acc[0][2], acc[0][3]); a.z = pk2(acc[1][0], acc[1][1]); a.w = pk2(acc[1][2], acc[1][3]);
    b.x = pk2(acc[2][0], acc[2][1]); b.y = pk2(acc[2][2], acc[2][3]); b.z = pk2(acc[3][0], acc[3][1]); b.w = pk2(acc[3][2], acc[3][3]);
    __builtin_nontemporal_store(a, p); __builtin_nontemporal_store(b, p + 1);
}
__device__ __forceinline__ void store_bc(bf16_t* bcs, int uid, int w4, int r, int q, const f32x4 (&acc)[4]) {
#pragma unroll
    for (int ct = 0; ct < 4; ++ct) { u32x2 w; w.x = pk2(acc[ct][0], acc[ct][1]); w.y = pk2(acc[ct][2], acc[ct][3]);
        *(u32x2*)(bcs + (size_t)uid * 4096 + ((ct * 4 + w4) * 64 + q * 16 + r) * 4) = w; }
}


typedef __attribute__((address_space(1))) unsigned gu32;
#define XB_TMO      128
#define XB_XCNT(j)  (256  + 64 * (j))
#define XB_XSUB(j)  (1280 + 64 * (j))
#define XB_XGEN(j)  (2304 + 64 * (j))
#define XB_TOP      3328
#define XB_TOPGEN   3392
#define XCD_BAR_WORDS 3456
#define XB_SPIN_CAP (1u << 18)

__device__ __forceinline__ unsigned xb_ld(unsigned* p)              { return __hip_atomic_load(p, __ATOMIC_RELAXED, __HIP_MEMORY_SCOPE_AGENT); }
__device__ __forceinline__ unsigned xb_add(unsigned* p, unsigned v) { return __hip_atomic_fetch_add(p, v, __ATOMIC_RELAXED, __HIP_MEMORY_SCOPE_AGENT); }
__device__ __forceinline__ unsigned xb_xcc_id() { return (unsigned)__builtin_amdgcn_s_getreg((3 << 11) | 20) & 0xFu; }
#define XB_SPIN(cond, bar) do { unsigned _sp = 0; while (cond) { __builtin_amdgcn_s_sleep(1); \
    if ((++_sp & 255u) == 0u) { if (xb_ld(&(bar)[XB_TMO])) break; if (_sp > XB_SPIN_CAP) { atomicAdd(&(bar)[XB_TMO], 1u); break; } } } } while (0)

struct XcdBarrier {
    unsigned* bar; unsigned x;
    volatile LAS unsigned* st;
};

__device__ __forceinline__ XcdBarrier xcd_barrier_post(unsigned* bar, volatile LAS unsigned* st) {
    XcdBarrier b; b.bar = bar; b.x = xb_xcc_id(); b.st = st;
    if (threadIdx.x == 0) (void)xb_add(&bar[XB_XCNT(b.x)], 1u);
    return b;
}
__device__ __forceinline__ void xcd_barrier_complete(unsigned* bar, unsigned x, unsigned& nloc, unsigned& nx) {
    const unsigned G = gridDim.x * gridDim.y * gridDim.z;
    unsigned sum, cnt, mine, sp = 0u;
    for (;;) {
        sum = 0u; cnt = 0u; mine = 0u;
#pragma unroll
        for (unsigned j = 0; j < 16; ++j) { const unsigned c = xb_ld(&bar[XB_XCNT(j)]); sum += c; cnt += (c > 0u) ? 1u : 0u; mine = (j == x) ? c : mine; }
        if (sum == G) break;
        __builtin_amdgcn_s_sleep(1);
        if ((++sp & 255u) == 0u) { if (xb_ld(&bar[XB_TMO])) break; if (sp > XB_SPIN_CAP) { atomicAdd(&bar[XB_TMO], 1u); break; } }
    }
    nloc = mine > 0u ? mine : 1u; nx = cnt > 0u ? cnt : 1u;
}

__device__ __forceinline__ void xcd_barrier(const XcdBarrier& b) {
    asm volatile("s_waitcnt vmcnt(0)" ::: "memory");
    __syncthreads();
    if (threadIdx.x == 0) {
        unsigned* bar = b.bar;
        __builtin_amdgcn_s_waitcnt(0);
        unsigned nloc = b.st[0], nx = b.st[1];
        if (nloc == 0u) { xcd_barrier_complete(bar, b.x, nloc, nx); b.st[0] = nloc; b.st[1] = nx; }
        const unsigned old = xb_add(&bar[XB_XSUB(b.x)], 1u);
        const unsigned gen = old / nloc;
        if (old + 1u == (gen + 1u) * nloc) {
            __builtin_amdgcn_fence(__ATOMIC_RELEASE, "agent");
            asm volatile("s_waitcnt vmcnt(0)" ::: "memory");
            const unsigned og = xb_add(&bar[XB_TOP], 1u);
            const unsigned tg = og / nx;
            if (og + 1u == (tg + 1u) * nx) xb_add(&bar[XB_TOPGEN], 1u);
            else XB_SPIN(xb_ld(&bar[XB_TOPGEN]) == tg, bar);
            __builtin_amdgcn_fence(__ATOMIC_ACQUIRE, "agent");
            xb_add(&bar[XB_XGEN(b.x)], 1u);
            asm volatile("s_waitcnt vmcnt(0)" ::: "memory");
        } else {
            XB_SPIN(xb_ld(&bar[XB_XGEN(b.x)]) == gen, bar);
            __builtin_amdgcn_fence(__ATOMIC_ACQUIRE, "agent");
            asm volatile("s_waitcnt vmcnt(0)" ::: "memory");
        }
    }
    __syncthreads();
}

__device__ __forceinline__ void transpose_item(const float* W, int K, int N, bf16_t* WT, int mode, LAS float* scr, int kb, int nb, int lane, const float* kscale, int coff) {
    const int k0 = 64 * kb, n0 = 32 * nb;
    const int nn = n0 + (lane & 31) + coff;
#pragma unroll 8
    for (int i = 0; i < 32; ++i) { const int kk = 2 * i + (lane >> 5); const float ksc = kscale ? kscale[k0 + kk] : 1.0f; scr[kk * 33 + (lane & 31)] = nn < N ? W[(size_t)(k0 + kk) * N + nn] * ksc : 0.f; }
    asm volatile("s_waitcnt lgkmcnt(0)" ::: "memory");
    const int c = lane & 7;
#pragma unroll
    for (int j = 0; j < 4; ++j) { const int n = (lane >> 3) + 8 * j; const LAS float* s = scr + (8 * c) * 33 + n;
        u32x4 o; o.x = pk2(s[0 * 33], s[1 * 33]); o.y = pk2(s[2 * 33], s[3 * 33]); o.z = pk2(s[4 * 33], s[5 * 33]); o.w = pk2(s[6 * 33], s[7 * 33]);
        const int ng = n0 + n; const int row = mode == 0 ? ng : ((ng >> 7) * 256 + (ng & 127) + (mode == 2 ? 128 : 0));
        *(u32x4*)(WT + (size_t)row * K + k0 + 8 * c) = o; }
    asm volatile("s_waitcnt lgkmcnt(0)" ::: "memory");
}
__device__ __forceinline__ void prep_weights(const Ctx& X, LAS unsigned char* lds, int gw, int ngw, int wave, int lane, int it_lo, int it_hi) {
    LAS float* scr = (LAS float*)(lds + wave * 16384);
    constexpr int I_IN = (D / 64) * (NINP / 32), I_OUT = (D / 64) * (D / 32), I_G = (D / 64) * (DFF / 32), I_DN = (DFF / 64) * (D / 32);
    constexpr int PER_L = I_IN + I_OUT + 2 * I_G + I_DN;
    asm volatile("" : "+v"(lane));
    for (int it = it_lo + gw; it < it_hi; it += ngw) {
        const int l = it / PER_L; int r = it % PER_L;
        if (r < I_IN) { transpose_item(X.in[2] + (size_t)l * D * DIN, D, DIN, WSP(bf16_t, WS_WIN) + (size_t)l * NINP * D, 0, scr, r / (NINP / 32), r % (NINP / 32), lane, X.in[1] + l * D, (r % (NINP / 32)) * 32 >= 2560 ? 8 : 0); continue; } r -= I_IN;
        if (r < I_OUT) { transpose_item(X.in[14] + (size_t)l * D * D, D, D, WSP(bf16_t, WS_WOUT) + (size_t)l * D * D, 0, scr, r / (D / 32), r % (D / 32), lane, nullptr, 0); continue; } r -= I_OUT;
        if (r < I_G) { transpose_item(X.in[16] + (size_t)l * D * DFF, D, DFF, WSP(bf16_t, WS_WGU) + (size_t)l * NGU * D, 1, scr, r / (DFF / 32), r % (DFF / 32), lane, X.in[15] + l * D, 0); continue; } r -= I_G;
        if (r < I_G) { transpose_item(X.in[17] + (size_t)l * D * DFF, D, DFF, WSP(bf16_t, WS_WGU) + (size_t)l * NGU * D, 2, scr, r / (DFF / 32), r % (DFF / 32), lane, X.in[15] + l * D, 0); continue; } r -= I_G;
        transpose_item(X.in[18] + (size_t)l * DFF * D, DFF, D, WSP(bf16_t, WS_WDN) + (size_t)l * D * DFF, 0, scr, r / (D / 32), r % (D / 32), lane, nullptr, 0);
    }
}
__device__ __forceinline__ void rms_row(const float* xrow, const float* w, bf16_t* orow, float* of, int lane) {
    const f32x4* xr = (const f32x4*)xrow + lane; const f32x4* wr = (const f32x4*)w + lane;
    f32x4 v[4]; float s = 0.f;
#pragma unroll
    for (int j = 0; j < 4; ++j) { v[j] = xr[64 * j]; s += (v[j].x * v[j].x + v[j].y * v[j].y) + (v[j].z * v[j].z + v[j].w * v[j].w); }
    const float rstd = 1.0f / sqrtf(wave_sum(s) * (1.f / D) + 1e-6f);
#pragma unroll
    for (int j = 0; j < 4; ++j) { const f32x4 ww = wr[64 * j]; const f32x4 o = v[j] * rstd * ww;
        if (of) __builtin_nontemporal_store(o, (f32x4*)of + lane + 64 * j);
        else { u32x2 p; p.x = pk2(o.x, o.y); p.y = pk2(o.z, o.w); ((u32x2*)orow + lane)[64 * j] = p; } }
}
__device__ __forceinline__ void cast_phase(const float* x, bf16_t* xb, float* rowsq, int gw, int ngw, int lane) {
    asm volatile("" : "+v"(lane));
    for (int m = gw; m < M; m += ngw) {
        const f32x4* xr = (const f32x4*)(x + (size_t)m * D) + lane; float s = 0.f;
#pragma unroll
        for (int j = 0; j < 4; ++j) { const f32x4 v = xr[64 * j]; s += (v.x * v.x + v.y * v.y) + (v.z * v.z + v.w * v.w); u32x2 p; p.x = pk2(v.x, v.y); p.y = pk2(v.z, v.w); ((u32x2*)(xb + (size_t)m * D) + lane)[64 * j] = p; }
        s = wave_sum(s); if (lane == 0) rowsq[m] = s;
    }
}
__device__ __forceinline__ void norm_phase(const float* x, const float* w, bf16_t* xn, float* of, int gw, int ngw, int lane) {
    asm volatile("" : "+v"(lane));
    for (int m = gw; m < M; m += ngw) rms_row(x + (size_t)m * D, w, xn ? xn + (size_t)m * D : nullptr, of ? of + (size_t)m * D : nullptr, lane);
}

#define LBAR() do { asm volatile("s_waitcnt lgkmcnt(0)" ::: "memory"); __builtin_amdgcn_s_barrier(); asm volatile("" ::: "memory"); } while (0)
__device__ __forceinline__ int unit_id(int mixer, int b, int h, int c) { return ((mixer * 4 + b) * 4 + h) * NCH + c; }

__device__ __forceinline__ void ret_unit(const Ctx& X, LAS unsigned char* hl, int b, int c, int h, int tid_h, int w4, int lane) {
    LAS bf16_t* QR = opq((LAS bf16_t*)hl); LAS bf16_t* KR = opq(QR + 64 * LT); LAS bf16_t* KDT = opq(KR + 64 * LT); LAS bf16_t* VT = opq(KDT + 64 * LT); LAS bf16_t* P = opq(VT + 64 * LT);
    const bf16_t* proj = WSP(const bf16_t, WS_PROJ);
    const int uid = unit_id(0, b, h, c);
    const int r = lane & 15, q = lane >> 4;
    const float lg = log1pf(-exp2f(-5.0f - (float)h));
    {
        const int i = tid_h >> 2, sg = tid_h & 3, d0 = sg * 8;
        const bf16_t* pr = proj + ((size_t)b * T + c * 64 + i) * LDP;
        const u32x4 q1 = *(const u32x4*)(pr + C_RQ + h * 64 + d0), q2 = *(const u32x4*)(pr + C_RQ + h * 64 + d0 + 32);
        const u32x4 k1 = *(const u32x4*)(pr + C_RK + h * 64 + d0), k2 = *(const u32x4*)(pr + C_RK + h * 64 + d0 + 32);
        const u32x4 v1 = *(const u32x4*)(pr + C_RV + h * 64 + sg * 16), v2 = *(const u32x4*)(pr + C_RV + h * 64 + sg * 16 + 8);
        float qa[8], qb[8], ka[8], kb[8], va[8], vb[8];
        unpack8(q1, qa); unpack8(q2, qb); unpack8(k1, ka); unpack8(k2, kb); unpack8(v1, va); unpack8(v2, vb);
        const float pos = (float)(c * 64 + i);
        const float qd = fexp(lg * (float)(i + 1)), kd = fexp(lg * (float)(63 - i));
        float qr1[8], qr2[8], kr1[8], kr2[8], qe1[8], qe2[8];
#pragma unroll
        for (int e = 0; e < 8; ++e) {
            const float inv = exp2f(-(float)(d0 + e) * (13.287712379549449f / 32.0f));
            const float rev = __builtin_amdgcn_fractf(pos * inv * 0.15915494309189535f); const float sn = __builtin_amdgcn_sinf(rev), cs = __builtin_amdgcn_cosf(rev);
            qr1[e] = qa[e] * cs - qb[e] * sn; qr2[e] = qa[e] * sn + qb[e] * cs;
            kr1[e] = (ka[e] * cs - kb[e] * sn) * 0.125f; kr2[e] = (ka[e] * sn + kb[e] * cs) * 0.125f;
            qe1[e] = qr1[e] * qd; qe2[e] = qr2[e] * qd;
            KDT[(d0 + e) * LT + i] = f2bf(kr1[e] * kd); KDT[(d0 + 32 + e) * LT + i] = f2bf(kr2[e] * kd);
            VT[(sg * 16 + e) * LT + i] = f2bf(va[e]); VT[(sg * 16 + 8 + e) * LT + i] = f2bf(vb[e]);
        }
        *(LAS u32x4*)(QR + i * LT + d0) = pack8(qr1); *(LAS u32x4*)(QR + i * LT + d0 + 32) = pack8(qr2);
        *(LAS u32x4*)(KR + i * LT + d0) = pack8(kr1); *(LAS u32x4*)(KR + i * LT + d0 + 32) = pack8(kr2);
        bf16_t* qe = WSP(bf16_t, WS_QEFF) + (size_t)uid * 4096 + i * 64;
        *(u32x4*)(qe + d0) = pack8(qe1); *(u32x4*)(qe + d0 + 32) = pack8(qe2);
    }
    LBAR();
    f32x4 acc[4];
#pragma unroll
    for (int ct = 0; ct < 4; ++ct) acc[ct] = mma16(QR, 16 * w4, KR, 16 * ct, (f32x4){0.f, 0.f, 0.f, 0.f}, r, q);
#pragma unroll
    for (int ct = 0; ct < 4; ++ct)
#pragma unroll
        for (int j = 0; j < 4; ++j) { const int ii = 16 * w4 + 4 * q + j, col = 16 * ct + r;
            P[ii * LT + col] = f2bf(ii >= col ? acc[ct][j] * fexp(lg * (float)(ii - col)) : 0.f); }
    LBAR();
#pragma unroll
    for (int ct = 0; ct < 4; ++ct) acc[ct] = mma16(P, 16 * w4, VT, 16 * ct, (f32x4){0.f, 0.f, 0.f, 0.f}, r, q);
    store_oloc(WSP(bf16_t, WS_OLOC), uid, w4, lane, acc);
#pragma unroll
    for (int ct = 0; ct < 4; ++ct) acc[ct] = mma16(KDT, 16 * w4, VT, 16 * ct, (f32x4){0.f, 0.f, 0.f, 0.f}, r, q);
    store_bc(WSP(bf16_t, WS_BCS), uid, w4, r, q, acc);
    LBAR();
}

__device__ __forceinline__ void hgrn_unit(const Ctx& X, LAS unsigned char* hl, int b, int c, int h, int tid_h, int w4, int lane, int layer) {
    LAS bf16_t* QT = opq((LAS bf16_t*)hl);
    LAS float* Gt = opq((LAS float*)(hl + 9216));
    LAS bf16_t* Kt = opq((LAS bf16_t*)(hl + 25600));
    LAS bf16_t* KTI = opq((LAS bf16_t*)(hl + 34816));
    LAS bf16_t* VT = KTI; LAS bf16_t* KDT = opq(KTI + 64 * LT);
    LAS float* tot = opq((LAS float*)(hl + 57856));
    const bf16_t* proj = WSP(const bf16_t, WS_PROJ);
    const int uid = unit_id(2, b, h, c);
    const int r = lane & 15, q = lane >> 4;
    const int i = tid_h >> 2, ds = (tid_h & 3) * 16;
    const bf16_t* pr = proj + ((size_t)b * T + c * 64 + i) * LDP;
    float kk[16], qv[16], vv[16];
    {
        float ff[16];
        { float t0[8], t1[8]; unpack8(*(const u32x4*)(pr + C_HF + h * 64 + ds), t0); unpack8(*(const u32x4*)(pr + C_HF + h * 64 + ds + 8), t1);
#pragma unroll
          for (int e = 0; e < 8; ++e) { ff[e] = t0[e]; ff[8 + e] = t1[e]; } }
        { float t0[8], t1[8]; unpack8(*(const u32x4*)(pr + C_HQ + h * 64 + ds), t0); unpack8(*(const u32x4*)(pr + C_HQ + h * 64 + ds + 8), t1);
#pragma unroll
          for (int e = 0; e < 8; ++e) { qv[e] = t0[e]; qv[8 + e] = t1[e]; } }
        { float t0[8], t1[8]; unpack8(*(const u32x4*)(pr + C_HI + h * 64 + ds), t0); unpack8(*(const u32x4*)(pr + C_HI + h * 64 + ds + 8), t1);
#pragma unroll
          for (int e = 0; e < 8; ++e) { vv[e] = t0[e]; vv[8 + e] = t1[e]; } }
#pragma unroll
        for (int e = 0; e < 16; ++e) {
            const int ch = h * 64 + ds + e;
            const float lb = layer == 0 ? 0.f : sigmoid_f(X.in[12][256 + ch] - X.in[12][ch]);
            const float f = ff[e];
            const float ls = fminf(f, 0.f) - __logf(1.0f + fexp(-fabsf(f)));
            const float lf = layer == 0 ? ls : __logf(lb + (1.f - lb) * fexp(ls));
            kk[e] = (1.f - lb) * frcp(1.f + fexp(f));
            Gt[i * 64 + ds + e] = lf;
        }
    }
    LBAR();
    {
        const int d = tid_h & 63, seg = tid_h >> 6; float cs[16]; float run = 0.f;
#pragma unroll
        for (int jj = 0; jj < 16; ++jj) { run += Gt[(16 * seg + jj) * 64 + d]; cs[jj] = run; }
        tot[seg * 64 + d] = run;
        LBAR();
        float off = 0.f;
#pragma unroll
        for (int s = 0; s < 3; ++s) off += (s < seg) ? tot[s * 64 + d] : 0.f;
#pragma unroll
        for (int jj = 0; jj < 16; ++jj) Gt[(16 * seg + jj) * 64 + d] = cs[jj] + off;
    }
    LBAR();
    float Gi[16], G63[16];
    {
        const int I = i >> 4;
        float qt[16], qe[16];
#pragma unroll
        for (int e = 0; e < 16; ++e) { Gi[e] = Gt[i * 64 + ds + e]; G63[e] = Gt[63 * 64 + ds + e]; const float gr = Gt[(16 * I) * 64 + ds + e];
            qt[e] = qv[e] * fexp(Gi[e] - gr); qe[e] = qv[e] * fexp(Gi[e]); }
        u32x4 w0, w1;
        w0.x = pk2(qt[0], qt[1]); w0.y = pk2(qt[2], qt[3]); w0.z = pk2(qt[4], qt[5]); w0.w = pk2(qt[6], qt[7]);
        w1.x = pk2(qt[8], qt[9]); w1.y = pk2(qt[10], qt[11]); w1.z = pk2(qt[12], qt[13]); w1.w = pk2(qt[14], qt[15]);
        *(LAS u32x4*)(QT + i * LT + ds) = w0; *(LAS u32x4*)(QT + i * LT + ds + 8) = w1;
        w0.x = pk2(qe[0], qe[1]); w0.y = pk2(qe[2], qe[3]); w0.z = pk2(qe[4], qe[5]); w0.w = pk2(qe[6], qe[7]);
        w1.x = pk2(qe[8], qe[9]); w1.y = pk2(qe[10], qe[11]); w1.z = pk2(qe[12], qe[13]); w1.w = pk2(qe[14], qe[15]);
        bf16_t* qg = WSP(bf16_t, WS_QEFF) + (size_t)uid * 4096 + i * 64 + ds;
        *(u32x4*)qg = w0; *(u32x4*)(qg + 8) = w1;
        w0.x = pk2(kk[0], kk[1]); w0.y = pk2(kk[2], kk[3]); w0.z = pk2(kk[4], kk[5]); w0.w = pk2(kk[6], kk[7]);
        w1.x = pk2(kk[8], kk[9]); w1.y = pk2(kk[10], kk[11]); w1.z = pk2(kk[12], kk[13]); w1.w = pk2(kk[14], kk[15]);
        *(LAS u32x4*)(Kt + i * LT + ds) = w0; *(LAS u32x4*)(Kt + i * LT + ds + 8) = w1;
        if (i == 63) { float* mv = WSP(float, WS_MVEC) + (size_t)(uid - 2 * 2048) * 64 + ds;
#pragma unroll
            for (int e = 0; e < 16; ++e) mv[e] = fexp(G63[e]); }
    }
    LBAR();
    const int I = w4;
    LAS bf16_t* KI = opq(KTI + (8 * I * (I + 1)) * LT);
    {
        const int nit = 16 * (I + 1) * 8;
        for (int idx = lane; idx < nit; idx += 64) { const int j = idx >> 3, d8 = (idx & 7) * 8;
            float kf[8]; unpack8(*(const LAS u32x4*)(Kt + j * LT + d8), kf);
            float o[8];
#pragma unroll
            for (int e = 0; e < 8; ++e) o[e] = kf[e] * fexp(fminf(Gt[(16 * I) * 64 + d8 + e] - Gt[j * 64 + d8 + e], 80.f));
            *(LAS u32x4*)(KI + j * LT + d8) = pack8(o); }
    }
    LBAR();
    f32x4 acc[4];
    {
        bf16x8 a[2];
#pragma unroll
        for (int ks = 0; ks < 2; ++ks) a[ks] = *(const LAS bf16x8*)(QT + (16 * I + r) * LT + ks * 32 + q * 8);
#pragma unroll
        for (int ct = 0; ct < 4; ++ct) { acc[ct] = (f32x4){0.f, 0.f, 0.f, 0.f};
            if (ct <= I) {
#pragma unroll
                for (int ks = 0; ks < 2; ++ks) { const bf16x8 bb = *(const LAS bf16x8*)(KI + (16 * ct + r) * LT + ks * 32 + q * 8);
                    acc[ct] = __builtin_amdgcn_mfma_f32_16x16x32_bf16(a[ks], bb, acc[ct], 0, 0, 0); } } }
        asm volatile("s_waitcnt lgkmcnt(0)" ::: "memory");
#pragma unroll
        for (int ct = 0; ct < 4; ++ct)
#pragma unroll
            for (int j = 0; j < 4; ++j) { const int ii = 16 * I + 4 * q + j, col = 16 * ct + r;
                QT[ii * LT + col] = f2bf((ct <= I && ii >= col) ? acc[ct][j] : 0.f); }
    }
    LBAR();
    {
#pragma unroll
        for (int e = 0; e < 16; ++e) { VT[(ds + e) * LT + i] = f2bf(vv[e]); KDT[(ds + e) * LT + i] = f2bf(kk[e] * fexp(G63[e] - Gi[e])); }
    }
    LBAR();
#pragma unroll
    for (int ct = 0; ct < 4; ++ct) acc[ct] = mma16(QT, 16 * w4, VT, 16 * ct, (f32x4){0.f, 0.f, 0.f, 0.f}, r, q);
    store_oloc(WSP(bf16_t, WS_OLOC), uid, w4, lane, acc);
#pragma unroll
    for (int ct = 0; ct < 4; ++ct) acc[ct] = mma16(KDT, 16 * w4, VT, 16 * ct, (f32x4){0.f, 0.f, 0.f, 0.f}, r, q);
    store_bc(WSP(bf16_t, WS_BCS), uid, w4, r, q, acc);
    LBAR();
}

__device__ __forceinline__ void gdn_unit(const Ctx& X, LAS unsigned char* hl, int b, int c, int h, int tid_h, int w4, int lane, int layer) {
    LAS bf16_t* Q = opq((LAS bf16_t*)hl); LAS bf16_t* K = opq(Q + 64 * LT); LAS bf16_t* KB = opq(K + 64 * LT); LAS bf16_t* V = opq(KB + 64 * LT); LAS bf16_t* KDT = opq(V + 64 * LT); LAS bf16_t* P = opq(KDT + 64 * LT);
    LAS bf16_t* WT = KB; LAS bf16_t* UT = V;
    LAS bf16_t* AB = opq((LAS bf16_t*)(hl + 55296));
    LAS float* ACCS = opq((LAS float*)(hl + 64512));
    LAS float* Gs = opq((LAS float*)(hl + 72704));
    LAS float* Bs = opq(Gs + 64);
    const bf16_t* proj = WSP(const bf16_t, WS_PROJ);
    const int uid = unit_id(1, b, h, c);
    const int r = lane & 15, q = lane >> 4;
    {
    LAS bf16_t* RAW = opq((LAS bf16_t*)(hl + 46080));
    const int cseg = tid_h & 7, i0 = tid_h >> 3;
    f32x4 wq[3][4][2];
    {
        const float* cw = X.in[8] + (size_t)layer * 4 * 768 + h * 64 + cseg * 8;
#pragma unroll
        for (int tn = 0; tn < 3; ++tn)
#pragma unroll
            for (int k = 0; k < 4; ++k) { const f32x4* wp = (const f32x4*)(cw + k * 768 + tn * 256); wq[tn][k][0] = wp[0]; wq[tn][k][1] = wp[1]; }
        u32x4 rawv[7];
#pragma unroll
        for (int n = 0; n < 7; ++n) { const int item = tid_h + 256 * n; const int seg = item & 7; int rowid = item >> 3; rowid = rowid < 201 ? rowid : 200;
            const int tn = rowid / 67, rr = rowid - tn * 67; const int tt = c * 64 - 3 + rr; const int ttc = tt < 0 ? 0 : tt;
            const u32x4 v = *(const u32x4*)(proj + ((size_t)b * T + ttc) * LDP + C_GQ + tn * 256 + h * 64 + seg * 8);
            rawv[n] = tt < 0 ? (u32x4){0u, 0u, 0u, 0u} : v; }
        float g = 0.f, bt = 0.f;
        if (tid_h < 64) {
            const bf16_t* pr = proj + ((size_t)b * T + c * 64 + tid_h) * LDP;
            const float* gba = WSP(const float, WS_GBA) + ((size_t)b * T + c * 64 + tid_h) * 8; const float gb = gba[h], ga = gba[4 + h];
            g = -fexp(X.in[9][layer * 4 + h]) * softplus_f(ga + X.in[10][layer * 4 + h]);
#pragma unroll
            for (int o = 1; o < 64; o <<= 1) { const float t = __shfl_up(g, o); if (lane >= o) g += t; }
            bt = sigmoid_f(gb);
            Gs[tid_h] = g; Bs[tid_h] = bt;
        }
#pragma unroll
        for (int n = 0; n < 7; ++n) { const int item = tid_h + 256 * n; if (item < 1608) *(LAS u32x4*)(RAW + (item >> 3) * 64 + (item & 7) * 8) = rawv[n]; }
    }
    LBAR();
    {
        const float G63 = Gs[63];
#pragma unroll
        for (int rs = 0; rs < 2; ++rs) {
            const int i = i0 + 32 * rs;
            const float bi = Bs[i], Gi = Gs[i];
            float y[3][8];
#pragma unroll
            for (int tn = 0; tn < 3; ++tn) {
#pragma unroll
                for (int e = 0; e < 8; ++e) y[tn][e] = 0.f;
#pragma unroll
                for (int k = 0; k < 4; ++k) { float x8[8]; unpack8(*(const LAS u32x4*)(RAW + (tn * 67 + i + k) * 64 + cseg * 8), x8);
                    y[tn][0] += wq[tn][k][0].x * x8[0]; y[tn][1] += wq[tn][k][0].y * x8[1]; y[tn][2] += wq[tn][k][0].z * x8[2]; y[tn][3] += wq[tn][k][0].w * x8[3];
                    y[tn][4] += wq[tn][k][1].x * x8[4]; y[tn][5] += wq[tn][k][1].y * x8[5]; y[tn][6] += wq[tn][k][1].z * x8[6]; y[tn][7] += wq[tn][k][1].w * x8[7]; }
#pragma unroll
                for (int e = 0; e < 8; ++e) y[tn][e] = silu_acc(y[tn][e]);
            }
            float sq = 0.f, sk = 0.f;
#pragma unroll
            for (int e = 0; e < 8; ++e) { sq += y[0][e] * y[0][e]; sk += y[1][e] * y[1][e]; }
            sq += __shfl_xor(sq, 1); sq += __shfl_xor(sq, 2); sq += __shfl_xor(sq, 4);
            sk += __shfl_xor(sk, 1); sk += __shfl_xor(sk, 2); sk += __shfl_xor(sk, 4);
            const float rq = 0.125f * rsqrtf(sq + 1e-6f), rk = rsqrtf(sk + 1e-6f), kd = rk * fexp(G63 - Gi);
            float t8[8];
#pragma unroll
            for (int e = 0; e < 8; ++e) t8[e] = y[0][e] * rq;
            *(LAS u32x4*)(Q + i * LT + cseg * 8) = pack8(t8);
#pragma unroll
            for (int e = 0; e < 8; ++e) t8[e] = y[1][e] * rk;
            *(LAS u32x4*)(K + i * LT + cseg * 8) = pack8(t8);
#pragma unroll
            for (int e = 0; e < 8; ++e) t8[e] = y[1][e] * rk * bi;
            *(LAS u32x4*)(KB + i * LT + cseg * 8) = pack8(t8);
            *(LAS u32x4*)(V + i * LT + cseg * 8) = pack8(y[2]);
#pragma unroll
            for (int e = 0; e < 8; ++e) KDT[(cseg * 8 + e) * LT + i] = f2bf(y[1][e] * kd);
        }
    }
    LBAR();
    }
    {
        f32x4 aA[4], aP[4];
#pragma unroll
        for (int ct = 0; ct < 4; ++ct) { aA[ct] = mma16(KB, 16 * w4, K, 16 * ct, (f32x4){0.f, 0.f, 0.f, 0.f}, r, q); aP[ct] = mma16(Q, 16 * w4, K, 16 * ct, (f32x4){0.f, 0.f, 0.f, 0.f}, r, q); }
#pragma unroll
        for (int ct = 0; ct < 4; ++ct)
#pragma unroll
            for (int j = 0; j < 4; ++j) { const int ii = 16 * w4 + 4 * q + j, col = 16 * ct + r;
                const float L = fexp(fminf(Gs[ii] - Gs[col], 0.f));
                AB[ii * LT + col] = f2bf(ii > col ? aA[ct][j] * L : 0.f);
                P[ii * LT + col] = f2bf(ii >= col ? aP[ct][j] * L : 0.f); }
    }
    LBAR();
    float rc[64];
    if (w4 < 2) {
        const int col = tid_h & 63; const LAS bf16_t* src = w4 == 0 ? V : KB;
#pragma unroll
        for (int i = 0; i < 64; ++i) { const float sc = w4 == 0 ? Bs[i] : fexp(Gs[i]); rc[i] = bf2f(src[i * LT + col]) * sc; }
    }
    LBAR();
    {
    for (int idx = tid_h; idx < 1152; idx += 256) { const int tl = idx >= 576; const int rem = idx - tl * 576; *(LAS u32x4*)((tl ? KB : V) + rem * 8) = (u32x4){0u, 0u, 0u, 0u}; }
    LBAR();
#pragma unroll
    for (int I = 0; I < 4; ++I) {
        if (I > 0) {
#pragma unroll
            for (int t2 = 0; t2 < 2; ++t2) { const int ct8 = 2 * w4 + t2; const LAS bf16_t* Bt = ct8 < 4 ? UT : WT;
                const f32x4 a = mma16(AB, 16 * I, Bt, 16 * (ct8 & 3), (f32x4){0.f, 0.f, 0.f, 0.f}, r, q);
#pragma unroll
                for (int j = 0; j < 4; ++j) ACCS[(4 * q + j) * 128 + 16 * ct8 + r] = a[j]; }
            LBAR();
        }
        if (w4 < 2) {
            const int col = tid_h & 63, c128 = w4 * 64 + col;
            float t[16];
#pragma unroll
            for (int ii = 0; ii < 16; ++ii) t[ii] = rc[16 * I + ii] - (I > 0 ? ACCS[ii * 128 + c128] : 0.f);
#pragma unroll
            for (int ii = 1; ii < 16; ++ii) {
                float a16[16];
                { float lo[8]; unpack8(*(const LAS u32x4*)(AB + (16 * I + ii) * LT + 16 * I), lo);
#pragma unroll
                  for (int e = 0; e < 8; ++e) a16[e] = lo[e]; }
                if (ii > 8) { float hi[8]; unpack8(*(const LAS u32x4*)(AB + (16 * I + ii) * LT + 16 * I + 8), hi);
#pragma unroll
                  for (int e = 0; e < 8; ++e) a16[8 + e] = hi[e]; }
                float s0 = t[ii], s1 = 0.f;
#pragma unroll
                for (int kk = 0; kk < ii; ++kk) { if (kk & 1) s1 -= a16[kk] * t[kk]; else s0 -= a16[kk] * t[kk]; }
                t[ii] = s0 + s1;
            }
            LAS bf16_t* dst = (w4 == 0 ? UT : WT) + col * LT + 16 * I;
            u32x4 w0, w1;
            w0.x = pk2(t[0], t[1]); w0.y = pk2(t[2], t[3]); w0.z = pk2(t[4], t[5]); w0.w = pk2(t[6], t[7]);
            w1.x = pk2(t[8], t[9]); w1.y = pk2(t[10], t[11]); w1.z = pk2(t[12], t[13]); w1.w = pk2(t[14], t[15]);
            *(LAS u32x4*)dst = w0; *(LAS u32x4*)(dst + 8) = w1;
        }
        LBAR();
    }
    }
    {
        f32x4 acc[4];
        const float eG63 = fexp(Gs[63]);
#pragma unroll
        for (int ct = 0; ct < 4; ++ct) acc[ct] = mma16(P, 16 * w4, WT, 16 * ct, (f32x4){0.f, 0.f, 0.f, 0.f}, r, q);
        bf16_t* qe = WSP(bf16_t, WS_QEFF) + (size_t)uid * 4096;
#pragma unroll
        for (int ct = 0; ct < 4; ++ct)
#pragma unroll
            for (int j = 0; j < 4; ++j) { const int ii = 16 * w4 + 4 * q + j, col = 16 * ct + r;
                qe[ii * 64 + col] = f2bf(bf2f(Q[ii * LT + col]) * fexp(Gs[ii]) - acc[ct][j]); }
#pragma unroll
        for (int ct = 0; ct < 4; ++ct) acc[ct] = mma16(P, 16 * w4, UT, 16 * ct, (f32x4){0.f, 0.f, 0.f, 0.f}, r, q);
        store_oloc(WSP(bf16_t, WS_OLOC), uid, w4, lane, acc);
#pragma unroll
        for (int ct = 0; ct < 4; ++ct) acc[ct] = mma16(KDT, 16 * w4, WT, 16 * ct, (f32x4){0.f, 0.f, 0.f, 0.f}, r, q);
        bf16_t* mm = WSP(bf16_t, WS_MM) + (size_t)(uid - 2048) * 4096;
#pragma unroll
        for (int ct = 0; ct < 4; ++ct)
#pragma unroll
            for (int j = 0; j < 4; ++j) { const int ii = 16 * w4 + 4 * q + j, col = 16 * ct + r;
                mm[((w4 * 2 + (ct >> 1)) * 64 + (r >> 2) * 16 + 4 * q + j) * 8 + (ct & 1) * 4 + (r & 3)] = f2bf((ii == col ? eG63 : 0.f) - acc[ct][j]); }
#pragma unroll
        for (int ct = 0; ct < 4; ++ct) acc[ct] = mma16(KDT, 16 * w4, UT, 16 * ct, (f32x4){0.f, 0.f, 0.f, 0.f}, r, q);
        store_bc(WSP(bf16_t, WS_BCS), uid, w4, r, q, acc);
    }
    LBAR();
}

__device__ __forceinline__ void conf_unit(const Ctx& X, LAS unsigned char* lds, int b, int c, int tid, int wave, int lane, int layer) {
    LAS bf16_t* GL = opq((LAS bf16_t*)lds);
    LAS float* Y = opq((LAS float*)(lds + 49152));
    const bf16_t* proj = WSP(const bf16_t, WS_PROJ);
    bf16_t* mix = WSP(bf16_t, WS_MIX);
    const int t0 = c * 64;
    float w[31]; float bias;
    { const int ch = tid & 255; const float* cw = X.in[4] + (size_t)layer * 31 * 256 + ch;
#pragma unroll
      for (int k = 0; k < 31; ++k) w[k] = cw[k * 256];
      bias = X.in[5][layer * 256 + ch]; }
    {
        u32x4 av[6], gvv[6];
#pragma unroll
        for (int n = 0; n < 6; ++n) { int item = tid + 512 * n; item = item < 94 * 32 ? item : 94 * 32 - 1; const int rr = item >> 5, seg = (item & 31) * 8; int tt = t0 - 30 + rr; tt = tt < 0 ? 0 : tt;
            const bf16_t* pr = proj + ((size_t)b * T + tt) * LDP; av[n] = *(const u32x4*)(pr + C_CA + seg); gvv[n] = *(const u32x4*)(pr + C_CG + seg); }
#pragma unroll
        for (int n = 0; n < 6; ++n) { const int item = tid + 512 * n; if (item < 94 * 32) { const int rr = item >> 5, seg = (item & 31) * 8, tt = t0 - 30 + rr;
            u32x4 w = (u32x4){0u, 0u, 0u, 0u};
            if (tt >= 0) { float a[8], g[8], o[8]; unpack8(av[n], a); unpack8(gvv[n], g);
#pragma unroll
                for (int e = 0; e < 8; ++e) o[e] = a[e] * sigmoid_f(g[e]);
                w = pack8(o); }
            *(LAS u32x4*)(GL + rr * 256 + seg) = w; } }
    }
    LBAR();
    {
        const int ch = tid & 255, half = tid >> 8;
        float acc[32];
#pragma unroll
        for (int tk = 0; tk < 32; ++tk) acc[tk] = bias;
#pragma unroll
        for (int rr = 0; rr < 62; ++rr) { const float g = bf2f(GL[(half * 32 + rr) * 256 + ch]);
#pragma unroll
            for (int tk = 0; tk < 32; ++tk) { const int k = rr - tk; if (k >= 0 && k < 31) acc[tk] += w[k] * g; } }
#pragma unroll
        for (int tk = 0; tk < 32; ++tk) Y[(half * 32 + tk) * 256 + ch] = acc[tk];
    }
    LBAR();
    {
        const f32x4 lw = *((const f32x4*)(X.in[6] + layer * 256) + lane), lb = *((const f32x4*)(X.in[7] + layer * 256) + lane);
#pragma unroll 2
        for (int tk = wave * 8; tk < wave * 8 + 8; ++tk) {
            const f32x4 v = *((const LAS f32x4*)(Y + tk * 256) + lane);
            const float mu = wave_sum((v.x + v.y) + (v.z + v.w)) * (1.f / 256.f);
            const f32x4 dv = v - mu;
            const float var = wave_sum((dv.x * dv.x + dv.y * dv.y) + (dv.z * dv.z + dv.w * dv.w)) * (1.f / 256.f);
            const float rs = rsqrtf(var + 1e-5f);
            f32x4 o = dv * rs * lw + lb;
            const bool on = (MIX_MASK & 2) != 0;
            u32x2 p; p.x = on ? pk2(silu_acc(o.x), silu_acc(o.y)) : 0u; p.y = on ? pk2(silu_acc(o.z), silu_acc(o.w)) : 0u;
            *(u32x2*)(mix + ((size_t)b * T + t0 + tk) * D + 256 + lane * 4) = p;
        }
    }
    LBAR();
}

__device__ __forceinline__ void mixer_local_phase(const Ctx& X, LAS unsigned char* lds, int layer, int tid, int wave, int lane) {
    const int hs = wave >> 2, w4 = wave & 3; int tid_h = tid & 255;
    LAS unsigned char* hl = lds + hs * HEAD_LDS;
    const int nit_ = (3584 + (int)gridDim.x - 1) / (int)gridDim.x;
    for (int it_ = 0; it_ < nit_; ++it_) {
        const int u = (int)blockIdx.x + (int)gridDim.x * ((it_ + (int)(blockIdx.x >> 3)) % nit_);
        if (u >= 3584) continue;
        asm volatile("" : "+v"(tid_h), "+v"(lane), "+v"(tid));
        if (u < 3072) { const int mixer = u >> 10, idx = u & 1023, hp = idx & 1, cb = idx >> 1, b = cb >> 7, c = cb & 127, h = hp * 2 + hs;
            if (mixer == 0) { ret_unit(X, hl, b, c, h, tid_h, w4, lane);
            } else if (mixer == 1) { gdn_unit(X, hl, b, c, h, tid_h, w4, lane, layer);
            } else { hgrn_unit(X, hl, b, c, h, tid_h, w4, lane, layer);
            }
        } else { const int cb = u - 3072; conf_unit(X, lds, cb >> 7, cb & 127, tid, wave, lane, layer);
        }
    }
}

__device__ __forceinline__ void scan_phase(const Ctx& X, int wave, int lane) {
    const int job = blockIdx.x;
    if (job >= 192 || wave != 0) return;
    asm volatile("" : "+v"(lane));
    const int mixer = job >> 6, rem = job & 63, bh = rem >> 2, vg = rem & 3;
    const int uid0 = (mixer * 16 + bh) * NCH;
    const int r = lane & 15, q = lane >> 4;
    bf16_t* bc0 = WSP(bf16_t, WS_BCS) + (size_t)uid0 * 4096 + (vg * 4 * 64 + lane) * 4;
    float S[4][4];
#pragma unroll
    for (int t = 0; t < 4; ++t)
#pragma unroll
        for (int j = 0; j < 4; ++j) S[t][j] = 0.f;
    if (mixer == 1) {
        const bf16_t* mm0 = WSP(const bf16_t, WS_MM) + (size_t)(uid0 - 2048) * 4096;
        u32x2 cb[4][4], ca[4][4][2][2];
#define SCAN_LOAD_G(slot, cc) { const int c_ = (cc) < NCH ? (cc) : NCH - 1; const bf16_t* bcn = bc0 + (size_t)c_ * 4096; const bf16_t* mmn = mm0 + (size_t)c_ * 4096; \
            _Pragma("unroll") for (int t = 0; t < 4; ++t) { cb[slot][t] = *(const u32x2*)(bcn + 256 * t); \
                _Pragma("unroll") for (int s2 = 0; s2 < 2; ++s2) { const u32x4 w_ = *(const u32x4*)(mmn + ((t * 2 + s2) * 64 + lane) * 8); ca[slot][t][s2][0] = (u32x2){w_.x, w_.y}; ca[slot][t][s2][1] = (u32x2){w_.z, w_.w}; } } }
        SCAN_LOAD_G(0, 0) SCAN_LOAD_G(1, 1) SCAN_LOAD_G(2, 2)
#pragma unroll 1
        for (int c0 = 0; c0 < NCH; c0 += 4) {
#pragma unroll
            for (int k = 0; k < 4; ++k) {
                const int c = c0 + k;
                SCAN_LOAD_G((k + 3) & 3, c + 3)
                bf16_t* bcc = bc0 + (size_t)c * 4096;
                u32x2 sp[4];
#pragma unroll
                for (int t = 0; t < 4; ++t) { sp[t].x = pk2(S[t][0], S[t][1]); sp[t].y = pk2(S[t][2], S[t][3]);
                    asm volatile("" : "+v"(sp[t].x) : "v"(cb[k][t].x));
                    *(u32x2*)(bcc + 256 * t) = sp[t]; }
                bf16x8 bfr[2];
#pragma unroll
                for (int s2 = 0; s2 < 2; ++s2) { u32x4 w; w.x = sp[2 * s2].x; w.y = sp[2 * s2].y; w.z = sp[2 * s2 + 1].x; w.w = sp[2 * s2 + 1].y; bfr[s2] = __builtin_bit_cast(bf16x8, w); }
#pragma unroll
                for (int t = 0; t < 4; ++t) {
                    f32x4 acc = (f32x4){bf_lo(cb[k][t].x), bf_hi(cb[k][t].x), bf_lo(cb[k][t].y), bf_hi(cb[k][t].y)};
#pragma unroll
                    for (int s2 = 0; s2 < 2; ++s2) { u32x4 w; w.x = ca[k][t][s2][0].x; w.y = ca[k][t][s2][0].y; w.z = ca[k][t][s2][1].x; w.w = ca[k][t][s2][1].y;
                        acc = __builtin_amdgcn_mfma_f32_16x16x32_bf16(__builtin_bit_cast(bf16x8, w), bfr[s2], acc, 0, 0, 0); }
                    S[t][0] = acc[0]; S[t][1] = acc[1]; S[t][2] = acc[2]; S[t][3] = acc[3];
                }
            }
        }
#undef SCAN_LOAD_G
    } else {
        const int h = bh & 3;
        const float g64 = __expf(64.0f * log1pf(-exp2f(-5.0f - (float)h)));
        const float* mv0 = WSP(const float, WS_MVEC) + (size_t)(mixer == 2 ? uid0 - 2 * 2048 : 0) * 64 + 4 * q;
        u32x2 cb[4][4]; f32x4 cm[4][4];
#define SCAN_LOAD_D(slot, cc) { const int c_ = (cc) < NCH ? (cc) : NCH - 1; const bf16_t* bcn = bc0 + (size_t)c_ * 4096; \
            _Pragma("unroll") for (int t = 0; t < 4; ++t) { cb[slot][t] = *(const u32x2*)(bcn + 256 * t); cm[slot][t] = mixer == 2 ? *(const f32x4*)(mv0 + (size_t)c_ * 64 + 16 * t) : (f32x4){g64, g64, g64, g64}; } }
        SCAN_LOAD_D(0, 0) SCAN_LOAD_D(1, 1) SCAN_LOAD_D(2, 2)
#pragma unroll 1
        for (int c0 = 0; c0 < NCH; c0 += 4) {
#pragma unroll
            for (int k = 0; k < 4; ++k) {
                const int c = c0 + k;
                SCAN_LOAD_D((k + 3) & 3, c + 3)
                bf16_t* bcc = bc0 + (size_t)c * 4096;
#pragma unroll
                for (int t = 0; t < 4; ++t) { u32x2 sp; sp.x = pk2(S[t][0], S[t][1]); sp.y = pk2(S[t][2], S[t][3]);
                    asm volatile("" : "+v"(sp.x) : "v"(cb[k][t].x));
                    *(u32x2*)(bcc + 256 * t) = sp;
                    S[t][0] = cm[k][t].x * S[t][0] + bf_lo(cb[k][t].x); S[t][1] = cm[k][t].y * S[t][1] + bf_hi(cb[k][t].x);
                    S[t][2] = cm[k][t].z * S[t][2] + bf_lo(cb[k][t].y); S[t][3] = cm[k][t].w * S[t][3] + bf_hi(cb[k][t].y); }
            }
        }
#undef SCAN_LOAD_D
    }
}

__device__ __forceinline__ void mixer_out_phase(const Ctx& X, LAS unsigned char* lds, int layer, int tid, int wave, int lane) {
    constexpr int GP = 264;
    const bf16_t* proj = WSP(const bf16_t, WS_PROJ);
    bf16_t* mix = WSP(bf16_t, WS_MIX);
    for (int u = blockIdx.x; u < 1536; u += gridDim.x) {
        asm volatile("" : "+v"(lane), "+v"(tid));
        LAS bf16_t* GT = opq((LAS bf16_t*)lds);
        const int r = lane & 15, q = lane >> 4, h = wave >> 1, half = wave & 1;
        const int mixer = u >> 9, rem = u & 511, b = rem >> 7, c = rem & 127;
        const int uid = unit_id(mixer, b, h, c);
        const int goff = mixer == 0 ? C_RG : (mixer == 1 ? C_GG : C_HG), moff = mixer == 0 ? 0 : (mixer == 1 ? 512 : 768);
        const size_t row0 = (size_t)b * T + c * 64;
        u32x4 gv[4];
#pragma unroll
        for (int n = 0; n < 4; ++n) { const int idx = tid + 512 * n; gv[n] = *(const u32x4*)(proj + (row0 + (idx >> 5)) * LDP + goff + (idx & 31) * 8); }
        const bf16_t* qe = WSP(const bf16_t, WS_QEFF) + (size_t)uid * 4096;
        const bf16_t* st = WSP(const bf16_t, WS_BCS) + (size_t)uid * 4096;
        bf16x8 a[2][2], bb[4][2]; u32x4 ov[2][2];
#pragma unroll
        for (int rt = 0; rt < 2; ++rt) { const int rt4 = 2 * half + rt;
#pragma unroll
            for (int ks = 0; ks < 2; ++ks) a[rt][ks] = *(const bf16x8*)(qe + (16 * rt4 + r) * 64 + ks * 32 + q * 8);
            const u32x4* ol = (const u32x4*)(WSP(const bf16_t, WS_OLOC) + ((size_t)uid * 4 + rt4) * 1024 + lane * 16); ov[rt][0] = ol[0]; ov[rt][1] = ol[1]; }
#pragma unroll
        for (int ct = 0; ct < 4; ++ct)
#pragma unroll
            for (int ks = 0; ks < 2; ++ks) { const bf16_t* tb = st + (size_t)((ct * 4 + 2 * ks + (q >> 1)) * 64) * 4;
                const u32x2 lo = *(const u32x2*)(tb + ((2 * (q & 1)) * 16 + r) * 4), hi = *(const u32x2*)(tb + ((2 * (q & 1) + 1) * 16 + r) * 4);
                bb[ct][ks] = __builtin_bit_cast(bf16x8, (u32x4){lo.x, lo.y, hi.x, hi.y}); }
        const float* nw = mixer == 0 ? X.in[3] + layer * 256 + h * 64 : (mixer == 1 ? X.in[11] + layer * 64 : X.in[13] + layer * 64);
        float wv[4];
#pragma unroll
        for (int ct = 0; ct < 4; ++ct) wv[ct] = nw[16 * ct + r];
#pragma unroll
        for (int n = 0; n < 4; ++n) { const int idx = tid + 512 * n; *(LAS u32x4*)(GT + (idx >> 5) * GP + (idx & 31) * 8) = gv[n]; }
        LBAR();
        const bool on = ((MIX_MASK >> (mixer == 0 ? 0 : (mixer == 1 ? 2 : 3))) & 1) != 0;
#pragma unroll
        for (int rt = 0; rt < 2; ++rt) {
            f32x4 acc[4];
            acc[0] = (f32x4){bf_lo(ov[rt][0].x), bf_hi(ov[rt][0].x), bf_lo(ov[rt][0].y), bf_hi(ov[rt][0].y)}; acc[1] = (f32x4){bf_lo(ov[rt][0].z), bf_hi(ov[rt][0].z), bf_lo(ov[rt][0].w), bf_hi(ov[rt][0].w)};
            acc[2] = (f32x4){bf_lo(ov[rt][1].x), bf_hi(ov[rt][1].x), bf_lo(ov[rt][1].y), bf_hi(ov[rt][1].y)}; acc[3] = (f32x4){bf_lo(ov[rt][1].z), bf_hi(ov[rt][1].z), bf_lo(ov[rt][1].w), bf_hi(ov[rt][1].w)};
#pragma unroll
            for (int ct = 0; ct < 4; ++ct)
#pragma unroll
                for (int ks = 0; ks < 2; ++ks) acc[ct] = __builtin_amdgcn_mfma_f32_16x16x32_bf16(a[rt][ks], bb[ct][ks], acc[ct], 0, 0, 0);
#pragma unroll
            for (int j = 0; j < 4; ++j) {
                float sm = (acc[0][j] + acc[1][j]) + (acc[2][j] + acc[3][j]);
                sm += __shfl_xor(sm, 1); sm += __shfl_xor(sm, 2); sm += __shfl_xor(sm, 4); sm += __shfl_xor(sm, 8);
                const float mu = mixer == 0 ? sm * (1.f / 64.f) : 0.f;
                float d[4], s2 = 0.f;
#pragma unroll
                for (int ct = 0; ct < 4; ++ct) { d[ct] = acc[ct][j] - mu; s2 += d[ct] * d[ct]; }
                s2 += __shfl_xor(s2, 1); s2 += __shfl_xor(s2, 2); s2 += __shfl_xor(s2, 4); s2 += __shfl_xor(s2, 8);
                const float rs = rsqrtf(s2 * (1.f / 64.f) + (mixer == 0 ? 1e-5f : 1e-6f));
                const int ii = 16 * (2 * half + rt) + 4 * q + j;
#pragma unroll
                for (int ct = 0; ct < 4; ++ct) { LAS bf16_t* gp = GT + ii * GP + h * 64 + 16 * ct + r;
                    const float y = d[ct] * rs * wv[ct] * silu_acc(bf2f(*gp));
                    *gp = on ? f2bf(y) : (bf16_t)0; }
            }
        }
        LBAR();
#pragma unroll
        for (int n = 0; n < 4; ++n) { const int idx = tid + 512 * n; __builtin_nontemporal_store(*(const LAS u32x4*)(GT + (idx >> 5) * GP + (idx & 31) * 8), (u32x4*)(mix + (row0 + (idx >> 5)) * D + moff + (idx & 31) * 8)); }
        LBAR();
    }
}

constexpr int PREP_FIRST = (D / 64) * (NINP / 32), PREP_ALL = DEPTH * ((D / 64) * (NINP / 32) + (D / 64) * (D / 32) + 2 * (D / 64) * (DFF / 32) + (DFF / 64) * (D / 32));
__global__ void __launch_bounds__(512, 2) fwd_kernel(Ctx X) {
    extern __shared__ __attribute__((aligned(16))) unsigned char lds_raw[];
    LAS unsigned char* lds = (LAS unsigned char*)lds_raw;
    cg::grid_group grid = cg::this_grid();
    const int tid = threadIdx.x, lane = tid & 63, wave = __builtin_amdgcn_readfirstlane(tid >> 6);
    const int G = gridDim.x, gw = blockIdx.x * 8 + wave, ngw = G * 8;
    bf16_t* XS = (bf16_t*)X.out;
    bf16_t* XN = WSP(bf16_t, WS_XN); bf16_t* PROJ = WSP(bf16_t, WS_PROJ); bf16_t* ACT = WSP(bf16_t, WS_PROJ); bf16_t* MIX = WSP(bf16_t, WS_MIX);

    if (X.ws == nullptr) grid.sync();
    if (tid < 4) ((LAS unsigned*)(lds + LDS_BAR_OFF))[tid] = 0u;
    __syncthreads();
    (void)xcd_barrier_post(WSP(unsigned, WS_CTL), (volatile LAS unsigned*)(lds + LDS_BAR_OFF));
#define GSYNC() do { XcdBarrier b_; b_.bar = WSP(unsigned, WS_CTL); b_.x = xb_xcc_id(); b_.st = (volatile LAS unsigned*)(lds + LDS_BAR_OFF); xcd_barrier(b_); } while (0)
    prep_weights(X, lds, gw, ngw, wave, lane, 0, PREP_FIRST);
    for (int idx = blockIdx.x * 512 + tid; idx < DEPTH * 16 * D; idx += G * 512) { const int ll = idx >> 14, n = (idx >> 10) & 15, k = idx & 1023;
        WSP(bf16_t, WS_WBA)[idx] = n < 8 ? f2bf(X.in[2][((size_t)ll * D + k) * DIN + 2560 + n] * X.in[1][ll * D + k]) : (bf16_t)0; }
    cast_phase(X.in[0], XS, WSP(float, WS_RSA), gw, ngw, lane);
    GSYNC();
#pragma unroll 1
    for (int l = 0; l < DEPTH; ++l) {
        {
            pg8::Gemm g{XS, WSP(const bf16_t, WS_WIN) + (size_t)l * NINP * D, M, NINP, D}; pg8::StaticOrder S; S.init(M, NINP, G, (int)blockIdx.x);
            pg8::EpiProj E{PROJ, LDP, DIN, WSP(const float, WS_RSA)};
            pg8::gemm_phase<pg8::EpiProj, pg8::StaticOrder, true, true>(lds, g, S, E);
            int ln = lane; asm volatile("" : "+v"(ln));
            const int r = ln & 15, q = ln >> 4;
            for (int rb = blockIdx.x; rb < M / 128; rb += G) {
                const bf16_t* Ap = XS + (size_t)(rb * 128 + wave * 16 + r) * D + q * 8;
                const bf16_t* Bp = WSP(const bf16_t, WS_WBA) + (size_t)l * 16 * D + r * D + q * 8;
                f32x4 acc = (f32x4){0.f, 0.f, 0.f, 0.f};
#pragma unroll 8
                for (int ks = 0; ks < 32; ++ks) acc = __builtin_amdgcn_mfma_f32_16x16x32_bf16(*(const bf16x8*)(Ap + ks * 32), *(const bf16x8*)(Bp + ks * 32), acc, 0, 0, 0);
                if (r < 8) {
#pragma unroll
                    for (int j = 0; j < 4; ++j) { const int row = rb * 128 + wave * 16 + 4 * q + j;
                        WSP(float, WS_GBA)[(size_t)row * 8 + r] = acc[j] * rsqrtf(WSP(const float, WS_RSA)[row] * (1.0f / 1024.0f) + 1e-6f); } }
            }
        }
        GSYNC();
        int tz = tid; asm volatile("" : "+v"(tz));
        for (int i = blockIdx.x * 512 + tz; i < M; i += G * 512) { WSP(float, WS_RSA)[i] = 0.f; WSP(float, WS_RSB)[i] = 0.f; }
        mixer_local_phase(X, lds, l, tid, wave, lane);
        GSYNC();
        scan_phase(X, wave, lane);
        if (l == 0 && wave != 0) prep_weights(X, lds, blockIdx.x * 7 + wave - 1, G * 7, wave, lane, PREP_FIRST, PREP_ALL);
        GSYNC();
        mixer_out_phase(X, lds, l, tid, wave, lane);
        GSYNC();
        {
            pg8::Gemm g{MIX, WSP(const bf16_t, WS_WOUT) + (size_t)l * D * D, M, D, D}; pg8::StaticOrder S; S.init(M, D, G, (int)blockIdx.x);
            pg8::EpiResid E{l == 0 ? X.in[0] : nullptr, l == 0 ? nullptr : XS, nullptr, XN, D, WSP(float, WS_RSB)};
            pg8::gemm_phase<pg8::EpiResid, pg8::StaticOrder, true, true>(lds, g, S, E);
        }
        GSYNC();
        {
            pg8::Gemm g{XN, WSP(const bf16_t, WS_WGU) + (size_t)l * NGU * D, M, NGU, D}; pg8::StaticOrder S; S.init(M, NGU, G, (int)blockIdx.x);
            pg8::EpiSwiglu E{ACT, DFF, WSP(const float, WS_RSB)};
            pg8::gemm_phase<pg8::EpiSwiglu, pg8::StaticOrder, true, true>(lds, g, S, E);
        }
        GSYNC();
        {
            pg8::Gemm g{ACT, WSP(const bf16_t, WS_WDN) + (size_t)l * D * DFF, M, D, DFF}; pg8::StaticOrder S; S.init(M, D, G, (int)blockIdx.x);
            pg8::EpiResid E{nullptr, XN, l + 1 < DEPTH ? nullptr : X.out, l + 1 < DEPTH ? XS : nullptr, D, l + 1 < DEPTH ? WSP(float, WS_RSA) : nullptr};
            pg8::gemm_phase<pg8::EpiResid, pg8::StaticOrder, true, true>(lds, g, S, E);
        }
        GSYNC();
        if (l + 1 == DEPTH) norm_phase(X.out, X.in[19], nullptr, X.out, gw, ngw, lane);
    }
}

extern "C" void kernel_launch(void* const* d_in, const int* in_sizes, int n_in, void* d_out, int out_size, void* d_ws, size_t ws_size, hipStream_t stream) {
    static int grid = 0;
    if (grid == 0) {
        if (n_in != 20 || out_size != M * D || ws_size < WS_END) { fprintf(stderr, "kernel_launch: unexpected shapes (n_in %d, out %d, ws %zu)\n", n_in, out_size, ws_size); grid = -1; return; }
        int dev = 0, cus = 0, per_cu = 0;
        hipGetDevice(&dev); hipDeviceGetAttribute(&cus, hipDeviceAttributeMultiprocessorCount, dev);
        if (hipFuncSetAttribute((const void*)fwd_kernel, hipFuncAttributeMaxDynamicSharedMemorySize, LDS_BYTES) != hipSuccess) { fprintf(stderr, "kernel_launch: hipFuncSetAttribute failed\n"); grid = -1; return; }
        if (hipOccupancyMaxActiveBlocksPerMultiprocessor(&per_cu, (const void*)fwd_kernel, 512, LDS_BYTES) != hipSuccess || per_cu < 1) { fprintf(stderr, "kernel_launch: occupancy query says %d\n", per_cu); per_cu = 1; }
        (void)hipGetLastError();
        grid = cus * (per_cu > 1 ? 1 : per_cu);
    }
    if (grid < 0) return;
    Ctx X{};
    for (int i = 0; i < 20; ++i) X.in[i] = (const float*)d_in[i];
    X.out = (float*)d_out; X.ws = (unsigned char*)d_ws;
    void* args[] = {&X};
    if (hipMemsetAsync((char*)d_ws + WS_CTL, 0, 16384, stream) != hipSuccess) { fprintf(stderr, "kernel_launch: hipMemsetAsync of the barrier words failed\n"); return; }
    hipError_t e = hipLaunchCooperativeKernel((const void*)fwd_kernel, dim3(grid), dim3(512), args, LDS_BYTES, stream);
    if (e != hipSuccess) fprintf(stderr, "cooperative launch failed: %s (grid %d)\n", hipGetErrorString(e), grid);
}
```

```cpp
#include <hip/hip_runtime.h>
#include <hip/hip_cooperative_groups.h>
#include <cstdio>
#include <cstdint>
namespace cg = cooperative_groups;

#ifndef MIX_MASK
#define MIX_MASK 15
#endif
namespace pg8 {
#define PG8_LAS __attribute__((address_space(3)))
typedef unsigned short bf16_t;
typedef short bf16x8 __attribute__((ext_vector_type(8)));
typedef float f32x4 __attribute__((ext_vector_type(4)));
typedef unsigned u32x4 __attribute__((ext_vector_type(4)));
constexpr int BM = 256, BK = 64, HALF = 128, HTB = HALF * BK * 2  , STAGE_BYTES = 8 * HTB, NXCD = 8, WGM = 8;

__host__ __device__ __forceinline__ int lds_byte(int r, int c) { const int st = (r >> 4) * 2 + (c >> 5), rr = r & 15, cc = c & 31, ob = rr * 64 + cc * 2; return st * 1024 + (ob ^ (((ob >> 9) & 1) << 5)); }
__host__ __device__ __forceinline__ void stage_rc(int b, int& R, int& C) { const int st = b / 1024, sb = b % 1024, swz = sb ^ (((sb >> 9) & 1) << 5); R = (st >> 1) * 16 + swz / 64; C = (st & 1) * 32 + (swz % 64) / 2; }
__host__ __device__ __forceinline__ int perm32(int rho) { const int n = rho >> 4, i = rho & 15; return 8 * (i >> 2) + 4 * n + (i & 3); }

struct Unit { int pm, pn; };
struct Gemm { const bf16_t* A; const bf16_t* Bt; int M, N, K; };

struct StaticOrder {
    int nM, nN, nwg, G, c;
    __host__ __device__ void init(int M, int N, int G_, int c_) { nM = M / BM; nN = N / BM; nwg = nM * nN; G = G_; c = c_; }
    __host__ __device__ bool next(int i, Unit& u) const {
        const long L = (long)i * G + c; if (L >= nwg) return false;
        int wgid = (int)L; { const int q = nwg / NXCD, r = nwg % NXCD, xcd = wgid % NXCD, off = wgid / NXCD; wgid = (xcd < r ? xcd * (q + 1) : r * (q + 1) + (xcd - r) * q) + off; }
        const int nig = WGM * nN, gid = wgid / nig, fm = gid * WGM, gsz = (nM - fm) < WGM ? (nM - fm) : WGM;
        u.pm = fm + ((wgid % nig) % gsz); u.pn = (wgid % nig) / gsz; return true;
    }
    __device__ __forceinline__ void a_ready(const Unit&) const {}
    __device__ __forceinline__ void done(const Unit&) const {}
};

__device__ __forceinline__ unsigned cvt_pk_bf16(float lo, float hi) { unsigned r; asm volatile("v_cvt_pk_bf16_f32 %0, %1, %2" : "=v"(r) : "v"(lo), "v"(hi)); return r; }
__device__ __forceinline__ float silu_f(float g) { return g * __builtin_amdgcn_rcpf(1.0f + __expf(-g)); }

struct EpiProj {
    static constexpr bool PERM = true, AFTER_DRAIN = false;
    bf16_t* O; int ldc; int ncols; const float* rowsq;
    __device__ __forceinline__ void pre(const Unit& u, int wr, int fr, float (&rsv)[8]) const {
#pragma unroll
        for (int i = 0; i < 8; ++i) rsv[i] = rowsq[u.pm * BM + wr * 64 + fr + (i >> 2) * HALF + (i & 3) * 16]; }
    __device__ __forceinline__ void operator()(const f32x4 (&acc)[2][2][4][2], const Unit& u, int wr, int wc, int fr, int fq, const float (&rsv)[8]) const {
        const int row0 = u.pm * BM + wr * 64 + fr; const int col0 = u.pn * BM + wc * 32 + 8 * fq;
#pragma unroll
        for (int ai = 0; ai < 2; ++ai)
#pragma unroll
            for (int m = 0; m < 4; ++m) { bf16_t* rowp = O + (size_t)(row0 + ai * HALF + m * 16) * ldc;
                const float rs = __builtin_amdgcn_rsqf(rsv[ai * 4 + m] * (1.0f / 1024.0f) + 1e-6f);
#pragma unroll
                for (int bj = 0; bj < 2; ++bj) { const int col = col0 + bj * HALF;
                    if (col < ncols) { const f32x4 v0 = acc[ai][bj][m][0] * rs, v1 = acc[ai][bj][m][1] * rs; u32x4 w;
                        w.x = cvt_pk_bf16(v0[0], v0[1]); w.y = cvt_pk_bf16(v0[2], v0[3]); w.z = cvt_pk_bf16(v1[0], v1[1]); w.w = cvt_pk_bf16(v1[2], v1[3]);
                        __builtin_nontemporal_store(w, (u32x4*)(rowp + col)); } } }
    }
};
struct EpiResid {
    static constexpr bool PERM = true, AFTER_DRAIN = false;
    const float* base_f; const bf16_t* base_b; float* out_f; bf16_t* out_b; int ldc; float* rowsq;
    __device__ __forceinline__ void pre(const Unit&, int, int, float (&)[8]) const {}
    __device__ __forceinline__ void operator()(const f32x4 (&acc)[2][2][4][2], const Unit& u, int wr, int wc, int fr, int fq, const float (&rsv)[8]) const {
        const int row0 = u.pm * BM + wr * 64 + fr; const int col0 = u.pn * BM + wc * 32 + 8 * fq;
#pragma unroll
        for (int ai = 0; ai < 2; ++ai)
#pragma unroll
            for (int m = 0; m < 4; ++m) { const size_t off = (size_t)(row0 + ai * HALF + m * 16) * ldc + col0; float sq = 0.f;
#pragma unroll
                for (int bj = 0; bj < 2; ++bj) { const size_t o_ = off + bj * HALF; f32x4 b0, b1;
                    if (base_b) { const u32x4 w = *(const u32x4*)(base_b + o_);
                        b0 = (f32x4){__uint_as_float(w.x << 16), __uint_as_float(w.x & 0xffff0000u), __uint_as_float(w.y << 16), __uint_as_float(w.y & 0xffff0000u)};
                        b1 = (f32x4){__uint_as_float(w.z << 16), __uint_as_float(w.z & 0xffff0000u), __uint_as_float(w.w << 16), __uint_as_float(w.w & 0xffff0000u)}; }
                    else { b0 = *(const f32x4*)(base_f + o_); b1 = *(const f32x4*)(base_f + o_ + 4); }
                    const f32x4 o0 = b0 + acc[ai][bj][m][0], o1 = b1 + acc[ai][bj][m][1];
                    if (out_f) { *(f32x4*)(out_f + o_) = o0; *(f32x4*)(out_f + o_ + 4) = o1; }
                    if (out_b) { u32x4 w; w.x = cvt_pk_bf16(o0[0], o0[1]); w.y = cvt_pk_bf16(o0[2], o0[3]); w.z = cvt_pk_bf16(o1[0], o1[1]); w.w = cvt_pk_bf16(o1[2], o1[3]); *(u32x4*)(out_b + o_) = w; }
                    sq += ((o0[0] * o0[0] + o0[1] * o0[1]) + (o0[2] * o0[2] + o0[3] * o0[3])) + ((o1[0] * o1[0] + o1[1] * o1[1]) + (o1[2] * o1[2] + o1[3] * o1[3])); }
                if (rowsq) { sq += __shfl_xor(sq, 16); sq += __shfl_xor(sq, 32); if (fq == 0) atomicAdd(rowsq + row0 + ai * HALF + m * 16, sq); } }
    }
};
struct EpiSwiglu {
    static constexpr bool PERM = true, AFTER_DRAIN = false;
    bf16_t* O; int ldc; const float* rowsq;
    __device__ __forceinline__ void pre(const Unit& u, int wr, int fr, float (&rsv)[8]) const {
#pragma unroll
        for (int i = 0; i < 8; ++i) rsv[i] = rowsq[u.pm * BM + wr * 64 + fr + (i >> 2) * HALF + (i & 3) * 16]; }
    __device__ __forceinline__ void operator()(const f32x4 (&acc)[2][2][4][2], const Unit& u, int wr, int wc, int fr, int fq, const float (&rsv)[8]) const {
        const int row0 = u.pm * BM + wr * 64 + fr; const int col0 = u.pn * HALF + wc * 32 + 8 * fq;
#pragma unroll
        for (int ai = 0; ai < 2; ++ai)
#pragma unroll
            for (int m = 0; m < 4; ++m) { bf16_t* rowp = O + (size_t)(row0 + ai * HALF + m * 16) * ldc + col0;
                const float rs = __builtin_amdgcn_rsqf(rsv[ai * 4 + m] * (1.0f / 1024.0f) + 1e-6f);
                const f32x4 g0 = acc[ai][0][m][0] * rs, g1 = acc[ai][0][m][1] * rs, u0 = acc[ai][1][m][0] * rs, u1 = acc[ai][1][m][1] * rs; u32x4 w;
                w.x = cvt_pk_bf16(silu_f(g0[0]) * u0[0], silu_f(g0[1]) * u0[1]); w.y = cvt_pk_bf16(silu_f(g0[2]) * u0[2], silu_f(g0[3]) * u0[3]);
                w.z = cvt_pk_bf16(silu_f(g1[0]) * u1[0], silu_f(g1[1]) * u1[1]); w.w = cvt_pk_bf16(silu_f(g1[2]) * u1[2], silu_f(g1[3]) * u1[3]);
                __builtin_nontemporal_store(w, (u32x4*)rowp); }
    }
};

template <class Epi, class Sched, bool ALIGN_EPI = false, bool SP2 = false>
__device__ __forceinline__ void gemm_phase(PG8_LAS unsigned char* lds, const Gemm g, const Sched& S, const Epi& E) {
    int tid_ = threadIdx.x; asm volatile("" : "+v"(tid_));
    const int tid = tid_, wid = __builtin_amdgcn_readfirstlane(tid >> 6), lane = tid & 63, wr = wid >> 2, wc = wid & 3, fr = lane & 15, fq = lane >> 4;
    const int K = g.K, nt = K / BK;
    unsigned voffA[2], voffB[2];
#pragma unroll
    for (int i = 0; i < 2; ++i) { int R, C; stage_rc(tid * 16 + i * 8192, R, C); const int Rb = Epi::PERM ? ((R & ~31) + perm32(R & 31)) : R;
        voffA[i] = (unsigned)(R * K + C) * 2u; voffB[i] = (unsigned)(Rb * K + C) * 2u; }
    const size_t kstep = (size_t)(BK * 2);
    const size_t hstep = (size_t)HALF * K * 2;
    const size_t tstep = 2 * hstep;
    const unsigned ldsw = (unsigned)wid * 1024u;
    const int aoff = lds_byte(wr * 64 + fr, fq * 8), boff = lds_byte(wc * 32 + fr, fq * 8);
#define PG8_SA(b, h) (((b) * 2 + (h)) * HTB)
#define PG8_SB(b, h) ((4 + (b) * 2 + (h)) * HTB)
#define PG8_STAGE(bufoff, gbase, voff) do { _Pragma("unroll") for (int _i = 0; _i < 2; ++_i) \
        __builtin_amdgcn_global_load_lds((const unsigned*)((const char*)(gbase) + (voff)[_i]), (PG8_LAS unsigned*)(lds + (bufoff) + ldsw + _i * 8192), 16, 0, 0); } while (0)
#define PG8_LDA(dst, b, h) do { _Pragma("unroll") for (int m = 0; m < 4; ++m) _Pragma("unroll") for (int k = 0; k < 2; ++k) dst[m][k] = *(const PG8_LAS bf16x8*)(lds + PG8_SA(b, h) + aoff + m * 2048 + k * 1024); } while (0)
#define PG8_LDB(dst, b, h) do { _Pragma("unroll") for (int n = 0; n < 2; ++n) _Pragma("unroll") for (int k = 0; k < 2; ++k) dst[n][k] = *(const PG8_LAS bf16x8*)(lds + PG8_SB(b, h) + boff + n * 2048 + k * 1024); } while (0)
#define PG8_MMA(ai, bj, At, Bt) do { __builtin_amdgcn_s_setprio(1); _Pragma("unroll") for (int m = 0; m < 4; ++m) _Pragma("unroll") for (int n = 0; n < 2; ++n) _Pragma("unroll") for (int k = 0; k < 2; ++k) \
        acc[ai][bj][m][n] = __builtin_amdgcn_mfma_f32_16x16x32_bf16(Bt[n][k], At[m][k], acc[ai][bj][m][n], 0, 0, 0); __builtin_amdgcn_s_setprio(0); } while (0)
#define PG8_WAIT_V(n) asm volatile("s_waitcnt vmcnt(" #n ")" ::: "memory")
#define PG8_WAIT_L(n) asm volatile("s_waitcnt lgkmcnt(" #n ")" ::: "memory")
#define PG8_BAR __builtin_amdgcn_s_barrier()
#define PG8_SCHED __builtin_amdgcn_sched_barrier(0)
    Unit cur, nxt; int ui = 0;
    float rsv[8];
    if (!S.next(0, cur)) return;
    f32x4 acc[2][2][4][2];
#pragma unroll
    for (int a = 0; a < 2; ++a)
#pragma unroll
        for (int b = 0; b < 2; ++b)
#pragma unroll
            for (int m = 0; m < 4; ++m)
#pragma unroll
                for (int n = 0; n < 2; ++n) acc[a][b][m][n] = (f32x4){0.f, 0.f, 0.f, 0.f};
    bf16x8 At[4][2], B0[2][2], B1[2][2];
    const char* cA = (const char*)g.A + (size_t)cur.pm * tstep; const char* cB = (const char*)g.Bt + (size_t)cur.pn * tstep;
    S.a_ready(cur);
    if constexpr (SP2) {
        PG8_STAGE(PG8_SB(0, 0), cB, voffB); PG8_STAGE(PG8_SB(0, 1), cB + hstep, voffB); PG8_STAGE(PG8_SA(0, 0), cA, voffA); PG8_STAGE(PG8_SA(0, 1), cA + hstep, voffA);
        if (wr == 1) PG8_BAR;
        PG8_WAIT_V(2); PG8_BAR;
        PG8_STAGE(PG8_SB(1, 0), cB + kstep, voffB); PG8_STAGE(PG8_SA(1, 0), cA + kstep, voffA); PG8_STAGE(PG8_SB(1, 1), cB + hstep + kstep, voffB);
        PG8_WAIT_V(6); PG8_BAR;
    } else {
        PG8_STAGE(PG8_SB(0, 0), cB, voffB); PG8_STAGE(PG8_SA(0, 0), cA, voffA); PG8_STAGE(PG8_SB(0, 1), cB + hstep, voffB); PG8_STAGE(PG8_SA(0, 1), cA + hstep, voffA);
        if (wr == 1) PG8_BAR;
        PG8_WAIT_V(4); PG8_BAR;
        PG8_STAGE(PG8_SB(1, 0), cB + kstep, voffB); PG8_STAGE(PG8_SA(1, 0), cA + kstep, voffA); PG8_STAGE(PG8_SB(1, 1), cB + hstep + kstep, voffB);
        PG8_WAIT_V(6); PG8_BAR;
    }
    for (;;) {
        const bool has_next = S.next(ui + 1, nxt);
        const char* nA = has_next ? (const char*)g.A + (size_t)nxt.pm * tstep : cA; const char* nB = has_next ? (const char*)g.Bt + (size_t)nxt.pn * tstep : cB;
        for (int t = 0; t < nt; t += 2) {
            const bool last = (t == nt - 2);
            const char* a1 = cA + (size_t)(t + 1) * kstep;
            const char* a2 = last ? nA : cA + (size_t)(t + 2) * kstep; const char* b2 = last ? nB : cB + (size_t)(t + 2) * kstep;
            const char* a3 = a2 + kstep; const char* b3 = b2 + kstep;
            if (last && has_next) S.a_ready(nxt);
            if (last) E.pre(cur, wr, fr, rsv);
            if constexpr (SP2) {
            PG8_LDB(B0, 0, 0); PG8_LDB(B1, 0, 1); PG8_SCHED; PG8_LDA(At, 0, 0); PG8_STAGE(PG8_SA(1, 1), a1 + hstep, voffA);
            PG8_WAIT_V(8); PG8_WAIT_L(0); PG8_BAR; PG8_MMA(0, 0, At, B0); PG8_MMA(0, 1, At, B1); PG8_BAR; PG8_SCHED;
            PG8_LDA(At, 0, 1); PG8_STAGE(PG8_SB(0, 0), b2, voffB); PG8_STAGE(PG8_SB(0, 1), b2 + hstep, voffB); PG8_STAGE(PG8_SA(0, 0), a2, voffA);
            PG8_WAIT_V(8); PG8_WAIT_L(0); PG8_BAR; PG8_MMA(1, 0, At, B0); PG8_MMA(1, 1, At, B1); PG8_BAR; PG8_SCHED;
            PG8_LDB(B0, 1, 0); PG8_LDB(B1, 1, 1); PG8_SCHED; PG8_LDA(At, 1, 0); PG8_STAGE(PG8_SA(0, 1), a2 + hstep, voffA);
            PG8_WAIT_V(8); PG8_WAIT_L(0); PG8_BAR; PG8_MMA(0, 0, At, B0); PG8_MMA(0, 1, At, B1); PG8_BAR; PG8_SCHED;
            PG8_LDA(At, 1, 1); PG8_STAGE(PG8_SB(1, 0), b3, voffB); PG8_STAGE(PG8_SB(1, 1), b3 + hstep, voffB); PG8_STAGE(PG8_SA(1, 0), a3, voffA);
            PG8_WAIT_V(8); PG8_WAIT_L(0); PG8_BAR; PG8_MMA(1, 0, At, B0); PG8_MMA(1, 1, At, B1); PG8_BAR; PG8_SCHED;
            } else {
            PG8_LDB(B0, 0, 0); PG8_SCHED; PG8_LDA(At, 0, 0); PG8_STAGE(PG8_SA(1, 1), a1 + hstep, voffA);
            PG8_WAIT_L(8); PG8_BAR; PG8_WAIT_L(0); PG8_MMA(0, 0, At, B0); PG8_BAR; PG8_SCHED;
            PG8_LDB(B1, 0, 1); PG8_STAGE(PG8_SB(0, 0), b2, voffB);
            PG8_BAR; PG8_WAIT_L(0); PG8_MMA(0, 1, At, B1); PG8_BAR;
            PG8_LDA(At, 0, 1); PG8_STAGE(PG8_SA(0, 0), a2, voffA);
            PG8_BAR; PG8_WAIT_L(0); PG8_MMA(1, 0, At, B0); PG8_BAR; PG8_SCHED;
            PG8_STAGE(PG8_SB(0, 1), b2 + hstep, voffB);
            PG8_WAIT_V(6); PG8_BAR; PG8_MMA(1, 1, At, B1); PG8_BAR;
            PG8_LDB(B0, 1, 0); PG8_SCHED; PG8_LDA(At, 1, 0); PG8_STAGE(PG8_SA(0, 1), a2 + hstep, voffA);
            PG8_WAIT_L(8); PG8_BAR; PG8_WAIT_L(0); PG8_MMA(0, 0, At, B0); PG8_BAR; PG8_SCHED;
            PG8_LDB(B1, 1, 1); PG8_STAGE(PG8_SB(1, 0), b3, voffB);
            PG8_BAR; PG8_WAIT_L(0); PG8_MMA(0, 1, At, B1); PG8_BAR;
            PG8_LDA(At, 1, 1); PG8_STAGE(PG8_SA(1, 0), a3, voffA);
            PG8_BAR; PG8_WAIT_L(0); PG8_MMA(1, 0, At, B0); PG8_BAR; PG8_SCHED;
            PG8_STAGE(PG8_SB(1, 1), b3 + hstep, voffB);
            PG8_WAIT_V(6); PG8_BAR; PG8_MMA(1, 1, At, B1); PG8_BAR;
            }
        }
        if constexpr (ALIGN_EPI) { if (wr == 0) PG8_BAR; }
        if constexpr (!Epi::AFTER_DRAIN) { E(acc, cur, wr, wc, fr, fq, rsv); S.done(cur); }
        if (!has_next) break;
#pragma unroll
        for (int a = 0; a < 2; ++a)
#pragma unroll
            for (int b = 0; b < 2; ++b)
#pragma unroll
                for (int m = 0; m < 4; ++m)
#pragma unroll
                    for (int n = 0; n < 2; ++n) acc[a][b][m][n] = (f32x4){0.f, 0.f, 0.f, 0.f};
        cur = nxt; cA = nA; cB = nB; ++ui;
        if constexpr (ALIGN_EPI) { if (wr == 1) PG8_BAR; }
    }
    PG8_WAIT_V(0);
    if constexpr (!ALIGN_EPI) { if (wr == 0) PG8_BAR; }
    PG8_BAR;
    if constexpr (Epi::AFTER_DRAIN) { E.fused(acc, cur, wr, wc, fr, fq, lds, wid, lane); S.done(cur); }
#undef PG8_SA
#undef PG8_SB
#undef PG8_STAGE
#undef PG8_LDA
#undef PG8_LDB
#undef PG8_MMA
#undef PG8_WAIT_V
#undef PG8_WAIT_L
#undef PG8_BAR
#undef PG8_SCHED
}
}

constexpr int NB = 4, T = 8192, D = 1024, DIN = 3592, NINP = 3584, DFF = 2816, NGU = 2 * DFF, DEPTH = 2;
constexpr int M = NB * T;
constexpr int NCH = T / 64;
constexpr int LDP = NINP;
constexpr int C_RQ = 0, C_RK = 256, C_RV = 512, C_RG = 768, C_CA = 1024, C_CG = 1280, C_GQ = 1536, C_GK = 1792, C_GV = 2048, C_GG = 2304,
              C_HQ = 2560, C_HF = 2816, C_HI = 3072, C_HG = 3328;
constexpr size_t MiB = 1u << 20;
constexpr size_t WS_CTL = 0;
constexpr size_t WS_WIN = 1 * MiB;
constexpr size_t WS_WOUT = 16 * MiB;
constexpr size_t WS_WGU = 20 * MiB;
constexpr size_t WS_WDN = 42 * MiB;
constexpr size_t WS_XN = 53 * MiB;
constexpr size_t WS_BCS = WS_XN;
constexpr size_t WS_MM = WS_XN + 48 * MiB;
constexpr size_t WS_MIX = 117 * MiB;
constexpr size_t WS_PROJ = 181 * MiB;
constexpr size_t WS_QEFF = 406 * MiB;
constexpr size_t WS_OLOC = 454 * MiB;
constexpr size_t WS_MVEC = 502 * MiB;
constexpr size_t WS_RSA = 503 * MiB;
constexpr size_t WS_RSB = 503 * MiB + 131072;
constexpr size_t WS_GBA = 503 * MiB + 262144;
constexpr size_t WS_WBA = 504 * MiB + 524288;
constexpr size_t WS_END = 505 * MiB;
constexpr int LDS_BYTES = 147456 + 256;
constexpr int LDS_BAR_OFF = 147456;
constexpr int HEAD_LDS = 73728;

#define LAS __attribute__((address_space(3)))
typedef unsigned short bf16_t;
typedef short bf16x8 __attribute__((ext_vector_type(8)));
typedef float f32x4 __attribute__((ext_vector_type(4)));
typedef unsigned u32x4 __attribute__((ext_vector_type(4)));
typedef unsigned u32x2 __attribute__((ext_vector_type(2)));
constexpr int LT = 72;
template <class Tp> __device__ __forceinline__ LAS Tp* opq(LAS Tp* p) { asm volatile("" : "+v"(p)); return p; }

__device__ __forceinline__ float bf_lo(unsigned u) { return __uint_as_float(u << 16); }
__device__ __forceinline__ float bf_hi(unsigned u) { return __uint_as_float(u & 0xffff0000u); }
__device__ __forceinline__ float bf2f(bf16_t b) { return __uint_as_float((unsigned)b << 16); }
__device__ __forceinline__ unsigned pk2(float lo, float hi) { return pg8::cvt_pk_bf16(lo, hi); }
__device__ __forceinline__ bf16_t f2bf(float f) { return (bf16_t)(pk2(f, 0.f) & 0xffffu); }
__device__ __forceinline__ float fexp(float x) { return __expf(x); }
__device__ __forceinline__ float frcp(float x) { return __builtin_amdgcn_rcpf(x); }
__device__ __forceinline__ float sigmoid_f(float x) { return frcp(1.0f + fexp(-x)); }
__device__ __forceinline__ float silu_acc(float x) { return x * frcp(1.0f + fexp(-x)); }
__device__ __forceinline__ float softplus_f(float x) { return fmaxf(x, 0.f) + log1pf(expf(-fabsf(x))); }
__device__ __forceinline__ float wave_sum(float v) {
#pragma unroll
    for (int o = 1; o < 64; o <<= 1) v += __shfl_xor(v, o);
    return v;
}
__device__ __forceinline__ void unpack8(const u32x4 w, float (&f)[8]) {
    f[0] = bf_lo(w.x); f[1] = bf_hi(w.x); f[2] = bf_lo(w.y); f[3] = bf_hi(w.y); f[4] = bf_lo(w.z); f[5] = bf_hi(w.z); f[6] = bf_lo(w.w); f[7] = bf_hi(w.w);
}
__device__ __forceinline__ u32x4 pack8(const float (&f)[8]) { u32x4 w; w.x = pk2(f[0], f[1]); w.y = pk2(f[2], f[3]); w.z = pk2(f[4], f[5]); w.w = pk2(f[6], f[7]); return w; }

struct Ctx {
    const float* in[20]; float* out; unsigned char* ws;
};
#define WSP(T_, off) ((T_*)(X.ws + (off)))

__device__ __forceinline__ f32x4 mma16(const LAS bf16_t* A, int a0, const LAS bf16_t* B, int b0, f32x4 acc, int r, int q) {
#pragma unroll
    for (int ks = 0; ks < 2; ++ks) {
        const bf16x8 a = *(const LAS bf16x8*)(A + (a0 + r) * LT + ks * 32 + q * 8);
        const bf16x8 b = *(const LAS bf16x8*)(B + (b0 + r) * LT + ks * 32 + q * 8);
        acc = __builtin_amdgcn_mfma_f32_16x16x32_bf16(a, b, acc, 0, 0, 0);
    }
    return acc;
}
__device__ __forceinline__ void store_oloc(bf16_t* oloc, int uid, int w4, int lane, const f32x4 (&acc)[4]) {
    u32x4* p = (u32x4*)(oloc + ((size_t)uid * 4 + w4) * 1024 + lane * 16);
    u32x4 a, b;
    a.x = pk2(acc[0][0], acc[0][1]); a.y = pk2(acc[0][2], acc[0][3]); a.z = pk2(acc[1][0], acc[1][1]); a.w = pk2(acc[1][2], acc[1][3]);
    b.x = pk2(acc[2][0], acc[2][1]); b.y = pk2(acc[2][2], acc[2][3]); b.z = pk2(acc[3][0], acc[3][1]); b.w = pk2(acc[3][2], acc[3][3]);
    __builtin_nontemporal_store(a, p); __builtin_nontemporal_store(b, p + 1);
}
__device__ __forceinline__ void store_bc(bf16_t* bcs, int uid, int w4, int r, int q, const f32x4 (&acc)[4]) {
#pragma unroll
    for (int ct = 0; ct < 4; ++ct) { u32x2 w; w.x = pk2(acc[ct][0], acc[ct][1]); w.y = pk2(acc[ct][2], acc[ct][3]);
        *(u32x2*)(bcs + (size_t)uid * 4096 + ((ct * 4 + w4) * 64 + q * 16 + r) * 4) = w; }
}


typedef __attribute__((address_space(1))) unsigned gu32;
#define XB_TMO      128
#define XB_XCNT(j)  (256  + 64 * (j))
#define XB_XSUB(j)  (1280 + 64 * (j))
#define XB_XGEN(j)  (2304 + 64 * (j))
#define XB_TOP      3328
#define XB_TOPGEN   3392
#define XCD_BAR_WORDS 3456
#define XB_SPIN_CAP (1u << 18)

__device__ __forceinline__ unsigned xb_ld(unsigned* p)              { return __hip_atomic_load(p, __ATOMIC_RELAXED, __HIP_MEMORY_SCOPE_AGENT); }
__device__ __forceinline__ unsigned xb_add(unsigned* p, unsigned v) { return __hip_atomic_fetch_add(p, v, __ATOMIC_RELAXED, __HIP_MEMORY_SCOPE_AGENT); }
__device__ __forceinline__ unsigned xb_xcc_id() { return (unsigned)__builtin_amdgcn_s_getreg((3 << 11) | 20) & 0xFu; }
#define XB_SPIN(cond, bar) do { unsigned _sp = 0; while (cond) { __builtin_amdgcn_s_sleep(1); \
    if ((++_sp & 255u) == 0u) { if (xb_ld(&(bar)[XB_TMO])) break; if (_sp > XB_SPIN_CAP) { atomicAdd(&(bar)[XB_TMO], 1u); break; } } } } while (0)

struct XcdBarrier {
    unsigned* bar; unsigned x;
    volatile LAS unsigned* st;
};

__device__ __forceinline__ XcdBarrier xcd_barrier_post(unsigned* bar, volatile LAS unsigned* st) {
    XcdBarrier b; b.bar = bar; b.x = xb_xcc_id(); b.st = st;
    if (threadIdx.x == 0) (void)xb_add(&bar[XB_XCNT(b.x)], 1u);
    return b;
}
__device__ __forceinline__ void xcd_barrier_complete(unsigned* bar, unsigned x, unsigned& nloc, unsigned& nx) {
    const unsigned G = gridDim.x * gridDim.y * gridDim.z;
    unsigned sum, cnt, mine, sp = 0u;
    for (;;) {
        sum = 0u; cnt = 0u; mine = 0u;
#pragma unroll
        for (unsigned j = 0; j < 16; ++j) { const unsigned c = xb_ld(&bar[XB_XCNT(j)]); sum += c; cnt += (c > 0u) ? 1u : 0u; mine = (j == x) ? c : mine; }
        if (sum == G) break;
        __builtin_amdgcn_s_sleep(1);
        if ((++sp & 255u) == 0u) { if (xb_ld(&bar[XB_TMO])) break; if (sp > XB_SPIN_CAP) { atomicAdd(&bar[XB_TMO], 1u); break; } }
    }
    nloc = mine > 0u ? mine : 1u; nx = cnt > 0u ? cnt : 1u;
}

__device__ __forceinline__ void xcd_barrier(const XcdBarrier& b) {
    asm volatile("s_waitcnt vmcnt(0)" ::: "memory");
    __syncthreads();
    if (threadIdx.x == 0) {
        unsigned* bar = b.bar;
        __builtin_amdgcn_s_waitcnt(0);
        unsigned nloc = b.st[0], nx = b.st[1];
        if (nloc == 0u) { xcd_barrier_complete(bar, b.x, nloc, nx); b.st[0] = nloc; b.st[1] = nx; }
        const unsigned old = xb_add(&bar[XB_XSUB(b.x)], 1u);
        const unsigned gen = old / nloc;
        if (old + 1u == (gen + 1u) * nloc) {
            __builtin_amdgcn_fence(__ATOMIC_RELEASE, "agent");
            asm volatile("s_waitcnt vmcnt(0)" ::: "memory");
            const unsigned og = xb_add(&bar[XB_TOP], 1u);
            const unsigned tg = og / nx;
            if (og + 1u == (tg + 1u) * nx) xb_add(&bar[XB_TOPGEN], 1u);
            else XB_SPIN(xb_ld(&bar[XB_TOPGEN]) == tg, bar);
            __builtin_amdgcn_fence(__ATOMIC_ACQUIRE, "agent");
            xb_add(&bar[XB_XGEN(b.x)], 1u);
            asm volatile("s_waitcnt vmcnt(0)" ::: "memory");
        } else {
            XB_SPIN(xb_ld(&bar[XB_XGEN(b.x)]) == gen, bar);
            __builtin_amdgcn_fence(__ATOMIC_ACQUIRE, "agent");
            asm volatile("s_waitcnt vmcnt(0)" ::: "memory");
        }
    }
    __syncthreads();
}

__device__ __forceinline__ void transpose_item(const float* W, int K, int N, bf16_t* WT, int mode, LAS float* scr, int kb, int nb, int lane, const float* kscale, int coff) {
    const int k0 = 64 * kb, n0 = 32 * nb;
    const int nn = n0 + (lane & 31) + coff;
#pragma unroll 8
    for (int i = 0; i < 32; ++i) { const int kk = 2 * i + (lane >> 5); const float ksc = kscale ? kscale[k0 + kk] : 1.0f; scr[kk * 33 + (lane & 31)] = nn < N ? __builtin_nontemporal_load(W + (size_t)(k0 + kk) * N + nn) * ksc : 0.f; }
    asm volatile("s_waitcnt lgkmcnt(0)" ::: "memory");
    const int c = lane & 7;
#pragma unroll
    for (int j = 0; j < 4; ++j) { const int n = (lane >> 3) + 8 * j; const LAS float* s = scr + (8 * c) * 33 + n;
        u32x4 o; o.x = pk2(s[0 * 33], s[1 * 33]); o.y = pk2(s[2 * 33], s[3 * 33]); o.z = pk2(s[4 * 33], s[5 * 33]); o.w = pk2(s[6 * 33], s[7 * 33]);
        const int ng = n0 + n; const int row = mode == 0 ? ng : ((ng >> 7) * 256 + (ng & 127) + (mode == 2 ? 128 : 0));
        *(u32x4*)(WT + (size_t)row * K + k0 + 8 * c) = o; }
    asm volatile("s_waitcnt lgkmcnt(0)" ::: "memory");
}
__device__ __forceinline__ void prep_weights(const Ctx& X, LAS unsigned char* lds, int gw, int ngw, int wave, int lane, int it_lo, int it_hi) {
    LAS float* scr = (LAS float*)(lds + wave * 16384);
    constexpr int I_IN = (D / 64) * (NINP / 32), I_OUT = (D / 64) * (D / 32), I_G = (D / 64) * (DFF / 32), I_DN = (DFF / 64) * (D / 32);
    constexpr int PER_L = I_IN + I_OUT + 2 * I_G + I_DN;
    asm volatile("" : "+v"(lane));
    for (int it = it_lo + gw; it < it_hi; it += ngw) {
        const int l = it / PER_L; int r = it % PER_L;
        if (r < I_IN) { transpose_item(X.in[2] + (size_t)l * D * DIN, D, DIN, WSP(bf16_t, WS_WIN) + (size_t)l * NINP * D, 0, scr, r / (NINP / 32), r % (NINP / 32), lane, X.in[1] + l * D, (r % (NINP / 32)) * 32 >= 2560 ? 8 : 0); continue; } r -= I_IN;
        if (r < I_OUT) { transpose_item(X.in[14] + (size_t)l * D * D, D, D, WSP(bf16_t, WS_WOUT) + (size_t)l * D * D, 0, scr, r / (D / 32), r % (D / 32), lane, nullptr, 0); continue; } r -= I_OUT;
        if (r < I_G) { transpose_item(X.in[16] + (size_t)l * D * DFF, D, DFF, WSP(bf16_t, WS_WGU) + (size_t)l * NGU * D, 1, scr, r / (DFF / 32), r % (DFF / 32), lane, X.in[15] + l * D, 0); continue; } r -= I_G;
        if (r < I_G) { transpose_item(X.in[17] + (size_t)l * D * DFF, D, DFF, WSP(bf16_t, WS_WGU) + (size_t)l * NGU * D, 2, scr, r / (DFF / 32), r % (DFF / 32), lane, X.in[15] + l * D, 0); continue; } r -= I_G;
        transpose_item(X.in[18] + (size_t)l * DFF * D, DFF, D, WSP(bf16_t, WS_WDN) + (size_t)l * D * DFF, 0, scr, r / (D / 32), r % (D / 32), lane, nullptr, 0);
    }
}
__device__ __forceinline__ void rms_row(const float* xrow, const float* w, bf16_t* orow, float* of, int lane) {
    const f32x4* xr = (const f32x4*)xrow + lane; const f32x4* wr = (const f32x4*)w + lane;
    f32x4 v[4]; float s = 0.f;
#pragma unroll
    for (int j = 0; j < 4; ++j) { v[j] = xr[64 * j]; s += (v[j].x * v[j].x + v[j].y * v[j].y) + (v[j].z * v[j].z + v[j].w * v[j].w); }
    const float rstd = 1.0f / sqrtf(wave_sum(s) * (1.f / D) + 1e-6f);
#pragma unroll
    for (int j = 0; j < 4; ++j) { const f32x4 ww = wr[64 * j]; const f32x4 o = v[j] * rstd * ww;
        if (of) __builtin_nontemporal_store(o, (f32x4*)of + lane + 64 * j);
        else { u32x2 p; p.x = pk2(o.x, o.y); p.y = pk2(o.z, o.w); ((u32x2*)orow + lane)[64 * j] = p; } }
}
__device__ __forceinline__ void cast_phase(const float* x, bf16_t* xb, float* rowsq, int gw, int ngw, int lane) {
    asm volatile("" : "+v"(lane));
    for (int m = gw; m < M; m += ngw) {
        const f32x4* xr = (const f32x4*)(x + (size_t)m * D) + lane; float s = 0.f;
#pragma unroll
        for (int j = 0; j < 4; ++j) { const f32x4 v = xr[64 * j]; s += (v.x * v.x + v.y * v.y) + (v.z * v.z + v.w * v.w); u32x2 p; p.x = pk2(v.x, v.y); p.y = pk2(v.z, v.w); ((u32x2*)(xb + (size_t)m * D) + lane)[64 * j] = p; }
        s = wave_sum(s); if (lane == 0) rowsq[m] = s;
    }
}
__device__ __forceinline__ void norm_phase(const float* x, const float* w, bf16_t* xn, float* of, int gw, int ngw, int lane) {
    asm volatile("" : "+v"(lane));
    for (int m = gw; m < M; m += ngw) rms_row(x + (size_t)m * D, w, xn ? xn + (size_t)m * D : nullptr, of ? of + (size_t)m * D : nullptr, lane);
}

#define LBAR() do { asm volatile("s_waitcnt lgkmcnt(0)" ::: "memory"); __builtin_amdgcn_s_barrier(); asm volatile("" ::: "memory"); } while (0)
__device__ __forceinline__ int unit_id(int mixer, int b, int h, int c) { return ((mixer * 4 + b) * 4 + h) * NCH + c; }

__device__ __forceinline__ void ret_unit(const Ctx& X, LAS unsigned char* hl, int b, int c, int h, int tid_h, int w4, int lane) {
    LAS bf16_t* QR = opq((LAS bf16_t*)hl); LAS bf16_t* KR = opq(QR + 64 * LT); LAS bf16_t* KDT = opq(KR + 64 * LT); LAS bf16_t* VT = opq(KDT + 64 * LT); LAS bf16_t* P = opq(VT + 64 * LT);
    const bf16_t* proj = WSP(const bf16_t, WS_PROJ);
    const int uid = unit_id(0, b, h, c);
    const int r = lane & 15, q = lane >> 4;
    const float lg = log1pf(-exp2f(-5.0f - (float)h));
    {
        const int i = tid_h >> 2, sg = tid_h & 3, d0 = sg * 8;
        const bf16_t* pr = proj + ((size_t)b * T + c * 64 + i) * LDP;
        const u32x4 q1 = *(const u32x4*)(pr + C_RQ + h * 64 + d0), q2 = *(const u32x4*)(pr + C_RQ + h * 64 + d0 + 32);
        const u32x4 k1 = *(const u32x4*)(pr + C_RK + h * 64 + d0), k2 = *(const u32x4*)(pr + C_RK + h * 64 + d0 + 32);
        const u32x4 v1 = *(const u32x4*)(pr + C_RV + h * 64 + sg * 16), v2 = *(const u32x4*)(pr + C_RV + h * 64 + sg * 16 + 8);
        float qa[8], qb[8], ka[8], kb[8], va[8], vb[8];
        unpack8(q1, qa); unpack8(q2, qb); unpack8(k1, ka); unpack8(k2, kb); unpack8(v1, va); unpack8(v2, vb);
        const float pos = (float)(c * 64 + i);
        const float qd = fexp(lg * (float)(i + 1)), kd = fexp(lg * (float)(63 - i));
        float qr1[8], qr2[8], kr1[8], kr2[8], qe1[8], qe2[8];
#pragma unroll
        for (int e = 0; e < 8; ++e) {
            const float inv = exp2f(-(float)(d0 + e) * (13.287712379549449f / 32.0f));
            const float rev = __builtin_amdgcn_fractf(pos * inv * 0.15915494309189535f); const float sn = __builtin_amdgcn_sinf(rev), cs = __builtin_amdgcn_cosf(rev);
            qr1[e] = qa[e] * cs - qb[e] * sn; qr2[e] = qa[e] * sn + qb[e] * cs;
            kr1[e] = (ka[e] * cs - kb[e] * sn) * 0.125f; kr2[e] = (ka[e] * sn + kb[e] * cs) * 0.125f;
            qe1[e] = qr1[e] * qd; qe2[e] = qr2[e] * qd;
            KDT[(d0 + e) * LT + i] = f2bf(kr1[e] * kd); KDT[(d0 + 32 + e) * LT + i] = f2bf(kr2[e] * kd);
            VT[(sg * 16 + e) * LT + i] = f2bf(va[e]); VT[(sg * 16 + 8 + e) * LT + i] = f2bf(vb[e]);
        }
        *(LAS u32x4*)(QR + i * LT + d0) = pack8(qr1); *(LAS u32x4*)(QR + i * LT + d0 + 32) = pack8(qr2);
        *(LAS u32x4*)(KR + i * LT + d0) = pack8(kr1); *(LAS u32x4*)(KR + i * LT + d0 + 32) = pack8(kr2);
        bf16_t* qe = WSP(bf16_t, WS_QEFF) + (size_t)uid * 4096 + i * 64;
        *(u32x4*)(qe + d0) = pack8(qe1); *(u32x4*)(qe + d0 + 32) = pack8(qe2);
    }
    LBAR();
    f32x4 acc[4];
#pragma unroll
    for (int ct = 0; ct < 4; ++ct) acc[ct] = mma16(QR, 16 * w4, KR, 16 * ct, (f32x4){0.f, 0.f, 0.f, 0.f}, r, q);
#pragma unroll
    for (int ct = 0; ct < 4; ++ct)
#pragma unroll
        for (int j = 0; j < 4; ++j) { const int ii = 16 * w4 + 4 * q + j, col = 16 * ct + r;
            P[ii * LT + col] = f2bf(ii >= col ? acc[ct][j] * fexp(lg * (float)(ii - col)) : 0.f); }
    LBAR();
#pragma unroll
    for (int ct = 0; ct < 4; ++ct) acc[ct] = mma16(P, 16 * w4, VT, 16 * ct, (f32x4){0.f, 0.f, 0.f, 0.f}, r, q);
    store_oloc(WSP(bf16_t, WS_OLOC), uid, w4, lane, acc);
#pragma unroll
    for (int ct = 0; ct < 4; ++ct) acc[ct] = mma16(KDT, 16 * w4, VT, 16 * ct, (f32x4){0.f, 0.f, 0.f, 0.f}, r, q);
    store_bc(WSP(bf16_t, WS_BCS), uid, w4, r, q, acc);
    LBAR();
}

__device__ __forceinline__ void hgrn_unit(const Ctx& X, LAS unsigned char* hl, int b, int c, int h, int tid_h, int w4, int lane, int layer) {
    LAS bf16_t* QT = opq((LAS bf16_t*)hl);
    LAS float* Gt = opq((LAS float*)(hl + 9216));
    LAS bf16_t* Kt = opq((LAS bf16_t*)(hl + 25600));
    LAS bf16_t* KTI = opq((LAS bf16_t*)(hl + 34816));
    LAS bf16_t* VT = KTI; LAS bf16_t* KDT = opq(KTI + 64 * LT);
    LAS float* tot = opq((LAS float*)(hl + 57856));
    const bf16_t* proj = WSP(const bf16_t, WS_PROJ);
    const int uid = unit_id(2, b, h, c);
    const int r = lane & 15, q = lane >> 4;
    const int i = tid_h >> 2, ds = (tid_h & 3) * 16;
    const bf16_t* pr = proj + ((size_t)b * T + c * 64 + i) * LDP;
    float kk[16], qv[16], vv[16];
    {
        float ff[16];
        { float t0[8], t1[8]; unpack8(*(const u32x4*)(pr + C_HF + h * 64 + ds), t0); unpack8(*(const u32x4*)(pr + C_HF + h * 64 + ds + 8), t1);
#pragma unroll
          for (int e = 0; e < 8; ++e) { ff[e] = t0[e]; ff[8 + e] = t1[e]; } }
        { float t0[8], t1[8]; unpack8(*(const u32x4*)(pr + C_HQ + h * 64 + ds), t0); unpack8(*(const u32x4*)(pr + C_HQ + h * 64 + ds + 8), t1);
#pragma unroll
          for (int e = 0; e < 8; ++e) { qv[e] = t0[e]; qv[8 + e] = t1[e]; } }
        { float t0[8], t1[8]; unpack8(*(const u32x4*)(pr + C_HI + h * 64 + ds), t0); unpack8(*(const u32x4*)(pr + C_HI + h * 64 + ds + 8), t1);
#pragma unroll
          for (int e = 0; e < 8; ++e) { vv[e] = t0[e]; vv[8 + e] = t1[e]; } }
#pragma unroll
        for (int e = 0; e < 16; ++e) {
            const int ch = h * 64 + ds + e;
            const float lb = layer == 0 ? 0.f : sigmoid_f(X.in[12][256 + ch] - X.in[12][ch]);
            const float f = ff[e];
            const float ls = fminf(f, 0.f) - __logf(1.0f + fexp(-fabsf(f)));
            const float lf = layer == 0 ? ls : __logf(lb + (1.f - lb) * fexp(ls));
            kk[e] = (1.f - lb) * frcp(1.f + fexp(f));
            Gt[i * 64 + ds + e] = lf;
        }
    }
    LBAR();
    {
        const int d = tid_h & 63, seg = tid_h >> 6; float cs[16]; float run = 0.f;
#pragma unroll
        for (int jj = 0; jj < 16; ++jj) { run += Gt[(16 * seg + jj) * 64 + d]; cs[jj] = run; }
        tot[seg * 64 + d] = run;
        LBAR();
        float off = 0.f;
#pragma unroll
        for (int s = 0; s < 3; ++s) off += (s < seg) ? tot[s * 64 + d] : 0.f;
#pragma unroll
        for (int jj = 0; jj < 16; ++jj) Gt[(16 * seg + jj) * 64 + d] = cs[jj] + off;
    }
    LBAR();
    float Gi[16], G63[16];
    {
        const int I = i >> 4;
        float qt[16], qe[16];
#pragma unroll
        for (int e = 0; e < 16; ++e) { Gi[e] = Gt[i * 64 + ds + e]; G63[e] = Gt[63 * 64 + ds + e]; const float gr = Gt[(16 * I) * 64 + ds + e];
            qt[e] = qv[e] * fexp(Gi[e] - gr); qe[e] = qv[e] * fexp(Gi[e]); }
        u32x4 w0, w1;
        w0.x = pk2(qt[0], qt[1]); w0.y = pk2(qt[2], qt[3]); w0.z = pk2(qt[4], qt[5]); w0.w = pk2(qt[6], qt[7]);
        w1.x = pk2(qt[8], qt[9]); w1.y = pk2(qt[10], qt[11]); w1.z = pk2(qt[12], qt[13]); w1.w = pk2(qt[14], qt[15]);
        *(LAS u32x4*)(QT + i * LT + ds) = w0; *(LAS u32x4*)(QT + i * LT + ds + 8) = w1;
        w0.x = pk2(qe[0], qe[1]); w0.y = pk2(qe[2], qe[3]); w0.z = pk2(qe[4], qe[5]); w0.w = pk2(qe[6], qe[7]);
        w1.x = pk2(qe[8], qe[9]); w1.y = pk2(qe[10], qe[11]); w1.z = pk2(qe[12], qe[13]); w1.w = pk2(qe[14], qe[15]);
        bf16_t* qg = WSP(bf16_t, WS_QEFF) + (size_t)uid * 4096 + i * 64 + ds;
        *(u32x4*)qg = w0; *(u32x4*)(qg + 8) = w1;
        w0.x = pk2(kk[0], kk[1]); w0.y = pk2(kk[2], kk[3]); w0.z = pk2(kk[4], kk[5]); w0.w = pk2(kk[6], kk[7]);
        w1.x = pk2(kk[8], kk[9]); w1.y = pk2(kk[10], kk[11]); w1.z = pk2(kk[12], kk[13]); w1.w = pk2(kk[14], kk[15]);
        *(LAS u32x4*)(Kt + i * LT + ds) = w0; *(LAS u32x4*)(Kt + i * LT + ds + 8) = w1;
        if (i == 63) { float* mv = WSP(float, WS_MVEC) + (size_t)(uid - 2 * 2048) * 64 + ds;
#pragma unroll
            for (int e = 0; e < 16; ++e) mv[e] = fexp(G63[e]); }
    }
    LBAR();
    const int I = w4;
    LAS bf16_t* KI = opq(KTI + (8 * I * (I + 1)) * LT);
    {
        const int nit = 16 * (I + 1) * 8;
        for (int idx = lane; idx < nit; idx += 64) { const int j = idx >> 3, d8 = (idx & 7) * 8;
            float kf[8]; unpack8(*(const LAS u32x4*)(Kt + j * LT + d8), kf);
            float o[8];
#pragma unroll
            for (int e = 0; e < 8; ++e) o[e] = kf[e] * fexp(fminf(Gt[(16 * I) * 64 + d8 + e] - Gt[j * 64 + d8 + e], 80.f));
            *(LAS u32x4*)(KI + j * LT + d8) = pack8(o); }
    }
    LBAR();
    f32x4 acc[4];
    {
        bf16x8 a[2];
#pragma unroll
        for (int ks = 0; ks < 2; ++ks) a[ks] = *(const LAS bf16x8*)(QT + (16 * I + r) * LT + ks * 32 + q * 8);
#pragma unroll
        for (int ct = 0; ct < 4; ++ct) { acc[ct] = (f32x4){0.f, 0.f, 0.f, 0.f};
            if (ct <= I) {
#pragma unroll
                for (int ks = 0; ks < 2; ++ks) { const bf16x8 bb = *(const LAS bf16x8*)(KI + (16 * ct + r) * LT + ks * 32 + q * 8);
                    acc[ct] = __builtin_amdgcn_mfma_f32_16x16x32_bf16(a[ks], bb, acc[ct], 0, 0, 0); } } }
        asm volatile("s_waitcnt lgkmcnt(0)" ::: "memory");
#pragma unroll
        for (int ct = 0; ct < 4; ++ct)
#pragma unroll
            for (int j = 0; j < 4; ++j) { const int ii = 16 * I + 4 * q + j, col = 16 * ct + r;
                QT[ii * LT + col] = f2bf((ct <= I && ii >= col) ? acc[ct][j] : 0.f); }
    }
    LBAR();
    {
#pragma unroll
        for (int e = 0; e < 16; ++e) { VT[(ds + e) * LT + i] = f2bf(vv[e]); KDT[(ds + e) * LT + i] = f2bf(kk[e] * fexp(G63[e] - Gi[e])); }
    }
    LBAR();
#pragma unroll
    for (int ct = 0; ct < 4; ++ct) acc[ct] = mma16(QT, 16 * w4, VT, 16 * ct, (f32x4){0.f, 0.f, 0.f, 0.f}, r, q);
    store_oloc(WSP(bf16_t, WS_OLOC), uid, w4, lane, acc);
#pragma unroll
    for (int ct = 0; ct < 4; ++ct) acc[ct] = mma16(KDT, 16 * w4, VT, 16 * ct, (f32x4){0.f, 0.f, 0.f, 0.f}, r, q);
    store_bc(WSP(bf16_t, WS_BCS), uid, w4, r, q, acc);
    LBAR();
}

__device__ __forceinline__ void gdn_unit(const Ctx& X, LAS unsigned char* hl, int b, int c, int h, int tid_h, int w4, int lane, int layer) {
    LAS bf16_t* Q = opq((LAS bf16_t*)hl); LAS bf16_t* K = opq(Q + 64 * LT); LAS bf16_t* KB = opq(K + 64 * LT); LAS bf16_t* V = opq(KB + 64 * LT); LAS bf16_t* KDT = opq(V + 64 * LT); LAS bf16_t* P = opq(KDT + 64 * LT);
    LAS bf16_t* WT = KB; LAS bf16_t* UT = V;
    LAS bf16_t* AB = opq((LAS bf16_t*)(hl + 55296));
    LAS float* ACCS = opq((LAS float*)(hl + 64512));
    LAS float* Gs = opq((LAS float*)(hl + 72704));
    LAS float* Bs = opq(Gs + 64);
    const bf16_t* proj = WSP(const bf16_t, WS_PROJ);
    const int uid = unit_id(1, b, h, c);
    const int r = lane & 15, q = lane >> 4;
    {
    LAS bf16_t* RAW = opq((LAS bf16_t*)(hl + 46080));
    const int cseg = tid_h & 7, i0 = tid_h >> 3;
    f32x4 wq[3][4][2];
    {
        const float* cw = X.in[8] + (size_t)layer * 4 * 768 + h * 64 + cseg * 8;
#pragma unroll
        for (int tn = 0; tn < 3; ++tn)
#pragma unroll
            for (int k = 0; k < 4; ++k) { const f32x4* wp = (const f32x4*)(cw + k * 768 + tn * 256); wq[tn][k][0] = wp[0]; wq[tn][k][1] = wp[1]; }
        u32x4 rawv[7];
#pragma unroll
        for (int n = 0; n < 7; ++n) { const int item = tid_h + 256 * n; const int seg = item & 7; int rowid = item >> 3; rowid = rowid < 201 ? rowid : 200;
            const int tn = rowid / 67, rr = rowid - tn * 67; const int tt = c * 64 - 3 + rr; const int ttc = tt < 0 ? 0 : tt;
            const u32x4 v = *(const u32x4*)(proj + ((size_t)b * T + ttc) * LDP + C_GQ + tn * 256 + h * 64 + seg * 8);
            rawv[n] = tt < 0 ? (u32x4){0u, 0u, 0u, 0u} : v; }
        float g = 0.f, bt = 0.f;
        if (tid_h < 64) {
            const bf16_t* pr = proj + ((size_t)b * T + c * 64 + tid_h) * LDP;
            const float* gba = WSP(const float, WS_GBA) + ((size_t)b * T + c * 64 + tid_h) * 8; const float gb = gba[h], ga = gba[4 + h];
            g = -fexp(X.in[9][layer * 4 + h]) * softplus_f(ga + X.in[10][layer * 4 + h]);
#pragma unroll
            for (int o = 1; o < 64; o <<= 1) { const float t = __shfl_up(g, o); if (lane >= o) g += t; }
            bt = sigmoid_f(gb);
            Gs[tid_h] = g; Bs[tid_h] = bt;
        }
#pragma unroll
        for (int n = 0; n < 7; ++n) { const int item = tid_h + 256 * n; if (item < 1608) *(LAS u32x4*)(RAW + (item >> 3) * 64 + (item & 7) * 8) = rawv[n]; }
    }
    LBAR();
    {
        const float G63 = Gs[63];
#pragma unroll
        for (int rs = 0; rs < 2; ++rs) {
            const int i = i0 + 32 * rs;
            const float bi = Bs[i], Gi = Gs[i];
            float y[3][8];
#pragma unroll
            for (int tn = 0; tn < 3; ++tn) {
#pragma unroll
                for (int e = 0; e < 8; ++e) y[tn][e] = 0.f;
#pragma unroll
                for (int k = 0; k < 4; ++k) { float x8[8]; unpack8(*(const LAS u32x4*)(RAW + (tn * 67 + i + k) * 64 + cseg * 8), x8);
                    y[tn][0] += wq[tn][k][0].x * x8[0]; y[tn][1] += wq[tn][k][0].y * x8[1]; y[tn][2] += wq[tn][k][0].z * x8[2]; y[tn][3] += wq[tn][k][0].w * x8[3];
                    y[tn][4] += wq[tn][k][1].x * x8[4]; y[tn][5] += wq[tn][k][1].y * x8[5]; y[tn][6] += wq[tn][k][1].z * x8[6]; y[tn][7] += wq[tn][k][1].w * x8[7]; }
#pragma unroll
                for (int e = 0; e < 8; ++e) y[tn][e] = silu_acc(y[tn][e]);
            }
            float sq = 0.f, sk = 0.f;
#pragma unroll
            for (int e = 0; e < 8; ++e) { sq += y[0][e] * y[0][e]; sk += y[1][e] * y[1][e]; }
            sq += __shfl_xor(sq, 1); sq += __shfl_xor(sq, 2); sq += __shfl_xor(sq, 4);
            sk += __shfl_xor(sk, 1); sk += __shfl_xor(sk, 2); sk += __shfl_xor(sk, 4);
            const float rq = 0.125f * rsqrtf(sq + 1e-6f), rk = rsqrtf(sk + 1e-6f), kd = rk * fexp(G63 - Gi);
            float t8[8];
#pragma unroll
            for (int e = 0; e < 8; ++e) t8[e] = y[0][e] * rq;
            *(LAS u32x4*)(Q + i * LT + cseg * 8) = pack8(t8);
#pragma unroll
            for (int e = 0; e < 8; ++e) t8[e] = y[1][e] * rk;
            *(LAS u32x4*)(K + i * LT + cseg * 8) = pack8(t8);
#pragma unroll
            for (int e = 0; e < 8; ++e) t8[e] = y[1][e] * rk * bi;
            *(LAS u32x4*)(KB + i * LT + cseg * 8) = pack8(t8);
            *(LAS u32x4*)(V + i * LT + cseg * 8) = pack8(y[2]);
#pragma unroll
            for (int e = 0; e < 8; ++e) KDT[(cseg * 8 + e) * LT + i] = f2bf(y[1][e] * kd);
        }
    }
    LBAR();
    }
    {
        f32x4 aA[4], aP[4];
#pragma unroll
        for (int ct = 0; ct < 4; ++ct) { aA[ct] = mma16(KB, 16 * w4, K, 16 * ct, (f32x4){0.f, 0.f, 0.f, 0.f}, r, q); aP[ct] = mma16(Q, 16 * w4, K, 16 * ct, (f32x4){0.f, 0.f, 0.f, 0.f}, r, q); }
#pragma unroll
        for (int ct = 0; ct < 4; ++ct)
#pragma unroll
            for (int j = 0; j < 4; ++j) { const int ii = 16 * w4 + 4 * q + j, col = 16 * ct + r;
                const float L = fexp(fminf(Gs[ii] - Gs[col], 0.f));
                AB[ii * LT + col] = f2bf(ii > col ? aA[ct][j] * L : 0.f);
                P[ii * LT + col] = f2bf(ii >= col ? aP[ct][j] * L : 0.f); }
    }
    LBAR();
    float rc[64];
    if (w4 < 2) {
        const int col = tid_h & 63; const LAS bf16_t* src = w4 == 0 ? V : KB;
#pragma unroll
        for (int i = 0; i < 64; ++i) { const float sc = w4 == 0 ? Bs[i] : fexp(Gs[i]); rc[i] = bf2f(src[i * LT + col]) * sc; }
    }
    LBAR();
    {
    for (int idx = tid_h; idx < 1152; idx += 256) { const int tl = idx >= 576; const int rem = idx - tl * 576; *(LAS u32x4*)((tl ? KB : V) + rem * 8) = (u32x4){0u, 0u, 0u, 0u}; }
    LBAR();
#pragma unroll
    for (int I = 0; I < 4; ++I) {
        if (I > 0) {
#pragma unroll
            for (int t2 = 0; t2 < 2; ++t2) { const int ct8 = 2 * w4 + t2; const LAS bf16_t* Bt = ct8 < 4 ? UT : WT;
                const f32x4 a = mma16(AB, 16 * I, Bt, 16 * (ct8 & 3), (f32x4){0.f, 0.f, 0.f, 0.f}, r, q);
#pragma unroll
                for (int j = 0; j < 4; ++j) ACCS[(4 * q + j) * 128 + 16 * ct8 + r] = a[j]; }
            LBAR();
        }
        if (w4 < 2) {
            const int col = tid_h & 63, c128 = w4 * 64 + col;
            float t[16];
#pragma unroll
            for (int ii = 0; ii < 16; ++ii) t[ii] = rc[16 * I + ii] - (I > 0 ? ACCS[ii * 128 + c128] : 0.f);
#pragma unroll
            for (int ii = 1; ii < 16; ++ii) {
                float a16[16];
                { float lo[8]; unpack8(*(const LAS u32x4*)(AB + (16 * I + ii) * LT + 16 * I), lo);
#pragma unroll
                  for (int e = 0; e < 8; ++e) a16[e] = lo[e]; }
                if (ii > 8) { float hi[8]; unpack8(*(const LAS u32x4*)(AB + (16 * I + ii) * LT + 16 * I + 8), hi);
#pragma unroll
                  for (int e = 0; e < 8; ++e) a16[8 + e] = hi[e]; }
                float s0 = t[ii], s1 = 0.f;
#pragma unroll
                for (int kk = 0; kk < ii; ++kk) { if (kk & 1) s1 -= a16[kk] * t[kk]; else s0 -= a16[kk] * t[kk]; }
                t[ii] = s0 + s1;
            }
            LAS bf16_t* dst = (w4 == 0 ? UT : WT) + col * LT + 16 * I;
            u32x4 w0, w1;
            w0.x = pk2(t[0], t[1]); w0.y = pk2(t[2], t[3]); w0.z = pk2(t[4], t[5]); w0.w = pk2(t[6], t[7]);
            w1.x = pk2(t[8], t[9]); w1.y = pk2(t[10], t[11]); w1.z = pk2(t[12], t[13]); w1.w = pk2(t[14], t[15]);
            *(LAS u32x4*)dst = w0; *(LAS u32x4*)(dst + 8) = w1;
        }
        LBAR();
    }
    }
    {
        f32x4 acc[4];
        const float eG63 = fexp(Gs[63]);
#pragma unroll
        for (int ct = 0; ct < 4; ++ct) acc[ct] = mma16(P, 16 * w4, WT, 16 * ct, (f32x4){0.f, 0.f, 0.f, 0.f}, r, q);
        bf16_t* qe = WSP(bf16_t, WS_QEFF) + (size_t)uid * 4096;
#pragma unroll
        for (int ct = 0; ct < 4; ++ct)
#pragma unroll
            for (int j = 0; j < 4; ++j) { const int ii = 16 * w4 + 4 * q + j, col = 16 * ct + r;
                qe[ii * 64 + col] = f2bf(bf2f(Q[ii * LT + col]) * fexp(Gs[ii]) - acc[ct][j]); }
#pragma unroll
        for (int ct = 0; ct < 4; ++ct) acc[ct] = mma16(P, 16 * w4, UT, 16 * ct, (f32x4){0.f, 0.f, 0.f, 0.f}, r, q);
        store_oloc(WSP(bf16_t, WS_OLOC), uid, w4, lane, acc);
#pragma unroll
        for (int ct = 0; ct < 4; ++ct) acc[ct] = mma16(KDT, 16 * w4, WT, 16 * ct, (f32x4){0.f, 0.f, 0.f, 0.f}, r, q);
        bf16_t* mm = WSP(bf16_t, WS_MM) + (size_t)(uid - 2048) * 4096;
#pragma unroll
        for (int ct = 0; ct < 4; ++ct)
#pragma unroll
            for (int j = 0; j < 4; ++j) { const int ii = 16 * w4 + 4 * q + j, col = 16 * ct + r;
                mm[((w4 * 2 + (ct >> 1)) * 64 + (r >> 2) * 16 + 4 * q + j) * 8 + (ct & 1) * 4 + (r & 3)] = f2bf((ii == col ? eG63 : 0.f) - acc[ct][j]); }
#pragma unroll
        for (int ct = 0; ct < 4; ++ct) acc[ct] = mma16(KDT, 16 * w4, UT, 16 * ct, (f32x4){0.f, 0.f, 0.f, 0.f}, r, q);
        store_bc(WSP(bf16_t, WS_BCS), uid, w4, r, q, acc);
    }
    LBAR();
}

__device__ __forceinline__ void conf_unit(const Ctx& X, LAS unsigned char* lds, int b, int c, int tid, int wave, int lane, int layer) {
    LAS bf16_t* GL = opq((LAS bf16_t*)lds);
    LAS float* Y = opq((LAS float*)(lds + 49152));
    const bf16_t* proj = WSP(const bf16_t, WS_PROJ);
    bf16_t* mix = WSP(bf16_t, WS_MIX);
    const int t0 = c * 64;
    float w[31]; float bias;
    { const int ch = tid & 255; const float* cw = X.in[4] + (size_t)layer * 31 * 256 + ch;
#pragma unroll
      for (int k = 0; k < 31; ++k) w[k] = cw[k * 256];
      bias = X.in[5][layer * 256 + ch]; }
    {
        u32x4 av[6], gvv[6];
#pragma unroll
        for (int n = 0; n < 6; ++n) { int item = tid + 512 * n; item = item < 94 * 32 ? item : 94 * 32 - 1; const int rr = item >> 5, seg = (item & 31) * 8; int tt = t0 - 30 + rr; tt = tt < 0 ? 0 : tt;
            const bf16_t* pr = proj + ((size_t)b * T + tt) * LDP; av[n] = *(const u32x4*)(pr + C_CA + seg); gvv[n] = *(const u32x4*)(pr + C_CG + seg); }
#pragma unroll
        for (int n = 0; n < 6; ++n) { const int item = tid + 512 * n; if (item < 94 * 32) { const int rr = item >> 5, seg = (item & 31) * 8, tt = t0 - 30 + rr;
            u32x4 w = (u32x4){0u, 0u, 0u, 0u};
            if (tt >= 0) { float a[8], g[8], o[8]; unpack8(av[n], a); unpack8(gvv[n], g);
#pragma unroll
                for (int e = 0; e < 8; ++e) o[e] = a[e] * sigmoid_f(g[e]);
                w = pack8(o); }
            *(LAS u32x4*)(GL + rr * 256 + seg) = w; } }
    }
    LBAR();
    {
        const int ch = tid & 255, half = tid >> 8;
        float acc[32];
#pragma unroll
        for (int tk = 0; tk < 32; ++tk) acc[tk] = bias;
#pragma unroll
        for (int rr = 0; rr < 62; ++rr) { const float g = bf2f(GL[(half * 32 + rr) * 256 + ch]);
#pragma unroll
            for (int tk = 0; tk < 32; ++tk) { const int k = rr - tk; if (k >= 0 && k < 31) acc[tk] += w[k] * g; } }
#pragma unroll
        for (int tk = 0; tk < 32; ++tk) Y[(half * 32 + tk) * 256 + ch] = acc[tk];
    }
    LBAR();
    {
        const f32x4 lw = *((const f32x4*)(X.in[6] + layer * 256) + lane), lb = *((const f32x4*)(X.in[7] + layer * 256) + lane);
#pragma unroll 2
        for (int tk = wave * 8; tk < wave * 8 + 8; ++tk) {
            const f32x4 v = *((const LAS f32x4*)(Y + tk * 256) + lane);
            const float mu = wave_sum((v.x + v.y) + (v.z + v.w)) * (1.f / 256.f);
            const f32x4 dv = v - mu;
            const float var = wave_sum((dv.x * dv.x + dv.y * dv.y) + (dv.z * dv.z + dv.w * dv.w)) * (1.f / 256.f);
            const float rs = rsqrtf(var + 1e-5f);
            f32x4 o = dv * rs * lw + lb;
            const bool on = (MIX_MASK & 2) != 0;
            u32x2 p; p.x = on ? pk2(silu_acc(o.x), silu_acc(o.y)) : 0u; p.y = on ? pk2(silu_acc(o.z), silu_acc(o.w)) : 0u;
            *(u32x2*)(mix + ((size_t)b * T + t0 + tk) * D + 256 + lane * 4) = p;
        }
    }
    LBAR();
}

__device__ __forceinline__ void mixer_local_phase(const Ctx& X, LAS unsigned char* lds, int layer, int tid, int wave, int lane) {
    const int hs = wave >> 2, w4 = wave & 3; int tid_h = tid & 255;
    LAS unsigned char* hl = lds + hs * HEAD_LDS;
    const int nit_ = (3584 + (int)gridDim.x - 1) / (int)gridDim.x;
    for (int it_ = 0; it_ < nit_; ++it_) {
        const int u = (int)blockIdx.x + (int)gridDim.x * ((it_ + (int)(blockIdx.x >> 3)) % nit_);
        if (u >= 3584) continue;
        asm volatile("" : "+v"(tid_h), "+v"(lane), "+v"(tid));
        if (u < 3072) { const int mixer = u >> 10, idx = u & 1023, hp = idx & 1, cb = idx >> 1, b = cb >> 7, c = cb & 127, h = hp * 2 + hs;
            if (mixer == 0) { ret_unit(X, hl, b, c, h, tid_h, w4, lane);
            } else if (mixer == 1) { gdn_unit(X, hl, b, c, h, tid_h, w4, lane, layer);
            } else { hgrn_unit(X, hl, b, c, h, tid_h, w4, lane, layer);
            }
        } else { const int cb = u - 3072; conf_unit(X, lds, cb >> 7, cb & 127, tid, wave, lane, layer);
        }
    }
}

__device__ __forceinline__ void scan_phase(const Ctx& X, int wave, int lane) {
    const int job = blockIdx.x;
    if (job >= 192 || wave != 0) return;
    asm volatile("" : "+v"(lane));
    const int mixer = job >> 6, rem = job & 63, bh = rem >> 2, vg = rem & 3;
    const int uid0 = (mixer * 16 + bh) * NCH;
    const int r = lane & 15, q = lane >> 4;
    bf16_t* bc0 = WSP(bf16_t, WS_BCS) + (size_t)uid0 * 4096 + (vg * 4 * 64 + lane) * 4;
    float S[4][4];
#pragma unroll
    for (int t = 0; t < 4; ++t)
#pragma unroll
        for (int j = 0; j < 4; ++j) S[t][j] = 0.f;
    if (mixer == 1) {
        const bf16_t* mm0 = WSP(const bf16_t, WS_MM) + (size_t)(uid0 - 2048) * 4096;
        u32x2 cb[4][4], ca[4][4][2][2];
#define SCAN_LOAD_G(slot, cc) { const int c_ = (cc) < NCH ? (cc) : NCH - 1; const bf16_t* bcn = bc0 + (size_t)c_ * 4096; const bf16_t* mmn = mm0 + (size_t)c_ * 4096; \
            _Pragma("unroll") for (int t = 0; t < 4; ++t) { cb[slot][t] = *(const u32x2*)(bcn + 256 * t); \
                _Pragma("unroll") for (int s2 = 0; s2 < 2; ++s2) { const u32x4 w_ = *(const u32x4*)(mmn + ((t * 2 + s2) * 64 + lane) * 8); ca[slot][t][s2][0] = (u32x2){w_.x, w_.y}; ca[slot][t][s2][1] = (u32x2){w_.z, w_.w}; } } }
        SCAN_LOAD_G(0, 0) SCAN_LOAD_G(1, 1) SCAN_LOAD_G(2, 2)
#pragma unroll 1
        for (int c0 = 0; c0 < NCH; c0 += 4) {
#pragma unroll
            for (int k = 0; k < 4; ++k) {
                const int c = c0 + k;
                SCAN_LOAD_G((k + 3) & 3, c + 3)
                bf16_t* bcc = bc0 + (size_t)c * 4096;
                u32x2 sp[4];
#pragma unroll
                for (int t = 0; t < 4; ++t) { sp[t].x = pk2(S[t][0], S[t][1]); sp[t].y = pk2(S[t][2], S[t][3]);
                    asm volatile("" : "+v"(sp[t].x) : "v"(cb[k][t].x));
                    *(u32x2*)(bcc + 256 * t) = sp[t]; }
                bf16x8 bfr[2];
#pragma unroll
                for (int s2 = 0; s2 < 2; ++s2) { u32x4 w; w.x = sp[2 * s2].x; w.y = sp[2 * s2].y; w.z = sp[2 * s2 + 1].x; w.w = sp[2 * s2 + 1].y; bfr[s2] = __builtin_bit_cast(bf16x8, w); }
#pragma unroll
                for (int t = 0; t < 4; ++t) {
                    f32x4 acc = (f32x4){bf_lo(cb[k][t].x), bf_hi(cb[k][t].x), bf_lo(cb[k][t].y), bf_hi(cb[k][t].y)};
#pragma unroll
                    for (int s2 = 0; s2 < 2; ++s2) { u32x4 w; w.x = ca[k][t][s2][0].x; w.y = ca[k][t][s2][0].y; w.z = ca[k][t][s2][1].x; w.w = ca[k][t][s2][1].y;
                        acc = __builtin_amdgcn_mfma_f32_16x16x32_bf16(__builtin_bit_cast(bf16x8, w), bfr[s2], acc, 0, 0, 0); }
                    S[t][0] = acc[0]; S[t][1] = acc[1]; S[t][2] = acc[2]; S[t][3] = acc[3];
                }
            }
        }
#undef SCAN_LOAD_G
    } else {
        const int h = bh & 3;
        const float g64 = __expf(64.0f * log1pf(-exp2f(-5.0f - (float)h)));
        const float* mv0 = WSP(const float, WS_MVEC) + (size_t)(mixer == 2 ? uid0 - 2 * 2048 : 0) * 64 + 4 * q;
        u32x2 cb[4][4]; f32x4 cm[4][4];
#define SCAN_LOAD_D(slot, cc) { const int c_ = (cc) < NCH ? (cc) : NCH - 1; const bf16_t* bcn = bc0 + (size_t)c_ * 4096; \
            _Pragma("unroll") for (int t = 0; t < 4; ++t) { cb[slot][t] = *(const u32x2*)(bcn + 256 * t); cm[slot][t] = mixer == 2 ? *(const f32x4*)(mv0 + (size_t)c_ * 64 + 16 * t) : (f32x4){g64, g64, g64, g64}; } }
        SCAN_LOAD_D(0, 0) SCAN_LOAD_D(1, 1) SCAN_LOAD_D(2, 2)
#pragma unroll 1
        for (int c0 = 0; c0 < NCH; c0 += 4) {
#pragma unroll
            for (int k = 0; k < 4; ++k) {
                const int c = c0 + k;
                SCAN_LOAD_D((k + 3) & 3, c + 3)
                bf16_t* bcc = bc0 + (size_t)c * 4096;
#pragma unroll
                for (int t = 0; t < 4; ++t) { u32x2 sp; sp.x = pk2(S[t][0], S[t][1]); sp.y = pk2(S[t][2], S[t][3]);
                    asm volatile("" : "+v"(sp.x) : "v"(cb[k][t].x));
                    *(u32x2*)(bcc + 256 * t) = sp;
                    S[t][0] = cm[k][t].x * S[t][0] + bf_lo(cb[k][t].x); S[t][1] = cm[k][t].y * S[t][1] + bf_hi(cb[k][t].x);
                    S[t][2] = cm[k][t].z * S[t][2] + bf_lo(cb[k][t].y); S[t][3] = cm[k][t].w * S[t][3] + bf_hi(cb[k][t].y); }
            }
        }
#undef SCAN_LOAD_D
    }
}

__device__ __forceinline__ void mixer_out_phase(const Ctx& X, LAS unsigned char* lds, int layer, int tid, int wave, int lane) {
    constexpr int GP = 264;
    const bf16_t* proj = WSP(const bf16_t, WS_PROJ);
    bf16_t* mix = WSP(bf16_t, WS_MIX);
    for (int u = blockIdx.x; u < 1536; u += gridDim.x) {
        asm volatile("" : "+v"(lane), "+v"(tid));
        LAS bf16_t* GT = opq((LAS bf16_t*)lds);
        const int r = lane & 15, q = lane >> 4, h = wave >> 1, half = wave & 1;
        const int mixer = u >> 9, rem = u & 511, b = rem >> 7, c = rem & 127;
        const int uid = unit_id(mixer, b, h, c);
        const int goff = mixer == 0 ? C_RG : (mixer == 1 ? C_GG : C_HG), moff = mixer == 0 ? 0 : (mixer == 1 ? 512 : 768);
        const size_t row0 = (size_t)b * T + c * 64;
        u32x4 gv[4];
#pragma unroll
        for (int n = 0; n < 4; ++n) { const int idx = tid + 512 * n; gv[n] = *(const u32x4*)(proj + (row0 + (idx >> 5)) * LDP + goff + (idx & 31) * 8); }
        const bf16_t* qe = WSP(const bf16_t, WS_QEFF) + (size_t)uid * 4096;
        const bf16_t* st = WSP(const bf16_t, WS_BCS) + (size_t)uid * 4096;
        bf16x8 a[2][2], bb[4][2]; u32x4 ov[2][2];
#pragma unroll
        for (int rt = 0; rt < 2; ++rt) { const int rt4 = 2 * half + rt;
#pragma unroll
            for (int ks = 0; ks < 2; ++ks) a[rt][ks] = *(const bf16x8*)(qe + (16 * rt4 + r) * 64 + ks * 32 + q * 8);
            const u32x4* ol = (const u32x4*)(WSP(const bf16_t, WS_OLOC) + ((size_t)uid * 4 + rt4) * 1024 + lane * 16); ov[rt][0] = ol[0]; ov[rt][1] = ol[1]; }
#pragma unroll
        for (int ct = 0; ct < 4; ++ct)
#pragma unroll
            for (int ks = 0; ks < 2; ++ks) { const bf16_t* tb = st + (size_t)((ct * 4 + 2 * ks + (q >> 1)) * 64) * 4;
                const u32x2 lo = *(const u32x2*)(tb + ((2 * (q & 1)) * 16 + r) * 4), hi = *(const u32x2*)(tb + ((2 * (q & 1) + 1) * 16 + r) * 4);
                bb[ct][ks] = __builtin_bit_cast(bf16x8, (u32x4){lo.x, lo.y, hi.x, hi.y}); }
        const float* nw = mixer == 0 ? X.in[3] + layer * 256 + h * 64 : (mixer == 1 ? X.in[11] + layer * 64 : X.in[13] + layer * 64);
        float wv[4];
#pragma unroll
        for (int ct = 0; ct < 4; ++ct) wv[ct] = nw[16 * ct + r];
#pragma unroll
        for (int n = 0; n < 4; ++n) { const int idx = tid + 512 * n; *(LAS u32x4*)(GT + (idx >> 5) * GP + (idx & 31) * 8) = gv[n]; }
        LBAR();
        const bool on = ((MIX_MASK >> (mixer == 0 ? 0 : (mixer == 1 ? 2 : 3))) & 1) != 0;
#pragma unroll
        for (int rt = 0; rt < 2; ++rt) {
            f32x4 acc[4];
            acc[0] = (f32x4){bf_lo(ov[rt][0].x), bf_hi(ov[rt][0].x), bf_lo(ov[rt][0].y), bf_hi(ov[rt][0].y)}; acc[1] = (f32x4){bf_lo(ov[rt][0].z), bf_hi(ov[rt][0].z), bf_lo(ov[rt][0].w), bf_hi(ov[rt][0].w)};
            acc[2] = (f32x4){bf_lo(ov[rt][1].x), bf_hi(ov[rt][1].x), bf_lo(ov[rt][1].y), bf_hi(ov[rt][1].y)}; acc[3] = (f32x4){bf_lo(ov[rt][1].z), bf_hi(ov[rt][1].z), bf_lo(ov[rt][1].w), bf_hi(ov[rt][1].w)};
#pragma unroll
            for (int ct = 0; ct < 4; ++ct)
#pragma unroll
                for (int ks = 0; ks < 2; ++ks) acc[ct] = __builtin_amdgcn_mfma_f32_16x16x32_bf16(a[rt][ks], bb[ct][ks], acc[ct], 0, 0, 0);
#pragma unroll
            for (int j = 0; j < 4; ++j) {
                float sm = (acc[0][j] + acc[1][j]) + (acc[2][j] + acc[3][j]);
                sm += __shfl_xor(sm, 1); sm += __shfl_xor(sm, 2); sm += __shfl_xor(sm, 4); sm += __shfl_xor(sm, 8);
                const float mu = mixer == 0 ? sm * (1.f / 64.f) : 0.f;
                float d[4], s2 = 0.f;
#pragma unroll
                for (int ct = 0; ct < 4; ++ct) { d[ct] = acc[ct][j] - mu; s2 += d[ct] * d[ct]; }
                s2 += __shfl_xor(s2, 1); s2 += __shfl_xor(s2, 2); s2 += __shfl_xor(s2, 4); s2 += __shfl_xor(s2, 8);
                const float rs = rsqrtf(s2 * (1.f / 64.f) + (mixer == 0 ? 1e-5f : 1e-6f));
                const int ii = 16 * (2 * half + rt) + 4 * q + j;
#pragma unroll
                for (int ct = 0; ct < 4; ++ct) { LAS bf16_t* gp = GT + ii * GP + h * 64 + 16 * ct + r;
                    const float y = d[ct] * rs * wv[ct] * silu_acc(bf2f(*gp));
                    *gp = on ? f2bf(y) : (bf16_t)0; }
            }
        }
        LBAR();
#pragma unroll
        for (int n = 0; n < 4; ++n) { const int idx = tid + 512 * n; __builtin_nontemporal_store(*(const LAS u32x4*)(GT + (idx >> 5) * GP + (idx & 31) * 8), (u32x4*)(mix + (row0 + (idx >> 5)) * D + moff + (idx & 31) * 8)); }
        LBAR();
    }
}

constexpr int PREP_FIRST = (D / 64) * (NINP / 32), PREP_ALL = DEPTH * ((D / 64) * (NINP / 32) + (D / 64) * (D / 32) + 2 * (D / 64) * (DFF / 32) + (DFF / 64) * (D / 32));
__global__ void __launch_bounds__(512, 2) fwd_kernel(Ctx X) {
    extern __shared__ __attribute__((aligned(16))) unsigned char lds_raw[];
    LAS unsigned char* lds = (LAS unsigned char*)lds_raw;
    cg::grid_group grid = cg::this_grid();
    const int tid = threadIdx.x, lane = tid & 63, wave = __builtin_amdgcn_readfirstlane(tid >> 6);
    const int G = gridDim.x, gw = blockIdx.x * 8 + wave, ngw = G * 8;
    bf16_t* XS = (bf16_t*)X.out;
    bf16_t* XN = WSP(bf16_t, WS_XN); bf16_t* PROJ = WSP(bf16_t, WS_PROJ); bf16_t* ACT = WSP(bf16_t, WS_PROJ); bf16_t* MIX = WSP(bf16_t, WS_MIX);

    if (X.ws == nullptr) grid.sync();
    if (tid < 4) ((LAS unsigned*)(lds + LDS_BAR_OFF))[tid] = 0u;
    __syncthreads();
    (void)xcd_barrier_post(WSP(unsigned, WS_CTL), (volatile LAS unsigned*)(lds + LDS_BAR_OFF));
#define GSYNC() do { XcdBarrier b_; b_.bar = WSP(unsigned, WS_CTL); b_.x = xb_xcc_id(); b_.st = (volatile LAS unsigned*)(lds + LDS_BAR_OFF); xcd_barrier(b_); } while (0)
    prep_weights(X, lds, gw, ngw, wave, lane, 0, PREP_FIRST);
    for (int idx = blockIdx.x * 512 + tid; idx < DEPTH * 16 * D; idx += G * 512) { const int ll = idx >> 14, n = (idx >> 10) & 15, k = idx & 1023;
        WSP(bf16_t, WS_WBA)[idx] = n < 8 ? f2bf(X.in[2][((size_t)ll * D + k) * DIN + 2560 + n] * X.in[1][ll * D + k]) : (bf16_t)0; }
    cast_phase(X.in[0], XS, WSP(float, WS_RSA), gw, ngw, lane);
    GSYNC();
#pragma unroll 1
    for (int l = 0; l < DEPTH; ++l) {
        {
            pg8::Gemm g{XS, WSP(const bf16_t, WS_WIN) + (size_t)l * NINP * D, M, NINP, D}; pg8::StaticOrder S; S.init(M, NINP, G, (int)blockIdx.x);
            pg8::EpiProj E{PROJ, LDP, DIN, WSP(const float, WS_RSA)};
            pg8::gemm_phase<pg8::EpiProj, pg8::StaticOrder, true, true>(lds, g, S, E);
            int ln = lane; asm volatile("" : "+v"(ln));
            const int r = ln & 15, q = ln >> 4;
            for (int rb = blockIdx.x; rb < M / 128; rb += G) {
                const bf16_t* Ap = XS + (size_t)(rb * 128 + wave * 16 + r) * D + q * 8;
                const bf16_t* Bp = WSP(const bf16_t, WS_WBA) + (size_t)l * 16 * D + r * D + q * 8;
                f32x4 acc = (f32x4){0.f, 0.f, 0.f, 0.f};
#pragma unroll 8
                for (int ks = 0; ks < 32; ++ks) acc = __builtin_amdgcn_mfma_f32_16x16x32_bf16(*(const bf16x8*)(Ap + ks * 32), *(const bf16x8*)(Bp + ks * 32), acc, 0, 0, 0);
                if (r < 8) {
#pragma unroll
                    for (int j = 0; j < 4; ++j) { const int row = rb * 128 + wave * 16 + 4 * q + j;
                        WSP(float, WS_GBA)[(size_t)row * 8 + r] = acc[j] * rsqrtf(WSP(const float, WS_RSA)[row] * (1.0f / 1024.0f) + 1e-6f); } }
            }
        }
        GSYNC();
        int tz = tid; asm volatile("" : "+v"(tz));
        for (int i = blockIdx.x * 512 + tz; i < M; i += G * 512) { WSP(float, WS_RSA)[i] = 0.f; WSP(float, WS_RSB)[i] = 0.f; }
        mixer_local_phase(X, lds, l, tid, wave, lane);
        GSYNC();
        scan_phase(X, wave, lane);
        if (l == 0 && wave != 0) prep_weights(X, lds, blockIdx.x * 7 + wave - 1, G * 7, wave, lane, PREP_FIRST, PREP_ALL);
        GSYNC();
        mixer_out_phase(X, lds, l, tid, wave, lane);
        GSYNC();
        {
            pg8::Gemm g{MIX, WSP(const bf16_t, WS_WOUT) + (size_t)l * D * D, M, D, D}; pg8::StaticOrder S; S.init(M, D, G, (int)blockIdx.x);
            pg8::EpiResid E{l == 0 ? X.in[0] : nullptr, l == 0 ? nullptr : XS, nullptr, XN, D, WSP(float, WS_RSB)};
            pg8::gemm_phase<pg8::EpiResid, pg8::StaticOrder, true, true>(lds, g, S, E);
        }
        GSYNC();
        {
            pg8::Gemm g{XN, WSP(const bf16_t, WS_WGU) + (size_t)l * NGU * D, M, NGU, D}; pg8::StaticOrder S; S.init(M, NGU, G, (int)blockIdx.x);
            pg8::EpiSwiglu E{ACT, DFF, WSP(const float, WS_RSB)};
            pg8::gemm_phase<pg8::EpiSwiglu, pg8::StaticOrder, true, true>(lds, g, S, E);
        }
        GSYNC();
        {
            pg8::Gemm g{ACT, WSP(const bf16_t, WS_WDN) + (size_t)l * D * DFF, M, D, DFF}; pg8::StaticOrder S; S.init(M, D, G, (int)blockIdx.x);
            pg8::EpiResid E{nullptr, XN, l + 1 < DEPTH ? nullptr : X.out, l + 1 < DEPTH ? XS : nullptr, D, l + 1 < DEPTH ? WSP(float, WS_RSA) : nullptr};
            pg8::gemm_phase<pg8::EpiResid, pg8::StaticOrder, true, true>(lds, g, S, E);
        }
        GSYNC();
        if (l + 1 == DEPTH) norm_phase(X.out, X.in[19], nullptr, X.out, gw, ngw, lane);
    }
}

extern "C" void kernel_launch(void* const* d_in, const int* in_sizes, int n_in, void* d_out, int out_size, void* d_ws, size_t ws_size, hipStream_t stream) {
    static int grid = 0;
    if (grid == 0) {
        if (n_in != 20 || out_size != M * D || ws_size < WS_END) { fprintf(stderr, "kernel_launch: unexpected shapes (n_in %d, out %d, ws %zu)\n", n_in, out_size, ws_size); grid = -1; return; }
        int dev = 0, cus = 0, per_cu = 0;
        hipGetDevice(&dev); hipDeviceGetAttribute(&cus, hipDeviceAttributeMultiprocessorCount, dev);
        if (hipFuncSetAttribute((const void*)fwd_kernel, hipFuncAttributeMaxDynamicSharedMemorySize, LDS_BYTES) != hipSuccess) { fprintf(stderr, "kernel_launch: hipFuncSetAttribute failed\n"); grid = -1; return; }
        if (hipOccupancyMaxActiveBlocksPerMultiprocessor(&per_cu, (const void*)fwd_kernel, 512, LDS_BYTES) != hipSuccess || per_cu < 1) { fprintf(stderr, "kernel_launch: occupancy query says %d\n", per_cu); per_cu = 1; }
        (void)hipGetLastError();
        grid = cus * (per_cu > 1 ? 1 : per_cu);
    }
    if (grid < 0) return;
    Ctx X{};
    for (int i = 0; i < 20; ++i) X.in[i] = (const float*)d_in[i];
    X.out = (float*)d_out; X.ws = (unsigned char*)d_ws;
    void* args[] = {&X};
    if (hipMemsetAsync((char*)d_ws + WS_CTL, 0, 16384, stream) != hipSuccess) { fprintf(stderr, "kernel_launch: hipMemsetAsync of the barrier words failed\n"); return; }
    hipError_t e = hipLaunchCooperativeKernel((const void*)fwd_kernel, dim3(grid), dim3(512), args, LDS_BYTES, stream);
    if (e != hipSuccess) fprintf(stderr, "cooperative launch failed: %s (grid %d)\n", hipGetErrorString(e), grid);
}
```

```cpp
#include <hip/hip_runtime.h>
#include <hip/hip_cooperative_groups.h>
#include <cstdio>
#include <cstdint>
namespace cg = cooperative_groups;

#ifndef MIX_MASK
#define MIX_MASK 15
#endif
namespace pg8 {
#define PG8_LAS __attribute__((address_space(3)))
typedef unsigned short bf16_t;
typedef short bf16x8 __attribute__((ext_vector_type(8)));
typedef float f32x4 __attribute__((ext_vector_type(4)));
typedef unsigned u32x4 __attribute__((ext_vector_type(4)));
constexpr int BM = 256, BK = 64, HALF = 128, HTB = HALF * BK * 2  , STAGE_BYTES = 8 * HTB, NXCD = 8, WGM = 8;

__host__ __device__ __forceinline__ int lds_byte(int r, int c) { const int st = (r >> 4) * 2 + (c >> 5), rr = r & 15, cc = c & 31, ob = rr * 64 + cc * 2; return st * 1024 + (ob ^ (((ob >> 9) & 1) << 5)); }
__host__ __device__ __forceinline__ void stage_rc(int b, int& R, int& C) { const int st = b / 1024, sb = b % 1024, swz = sb ^ (((sb >> 9) & 1) << 5); R = (st >> 1) * 16 + swz / 64; C = (st & 1) * 32 + (swz % 64) / 2; }
__host__ __device__ __forceinline__ int perm32(int rho) { const int n = rho >> 4, i = rho & 15; return 8 * (i >> 2) + 4 * n + (i & 3); }

struct Unit { int pm, pn; };
struct Gemm { const bf16_t* A; const bf16_t* Bt; int M, N, K; };

struct StaticOrder {
    int nM, nN, nwg, G, c;
    __host__ __device__ void init(int M, int N, int G_, int c_) { nM = M / BM; nN = N / BM; nwg = nM * nN; G = G_; c = c_; }
    __host__ __device__ bool next(int i, Unit& u) const {
        const long L = (long)i * G + c; if (L >= nwg) return false;
        int wgid = (int)L; { const int q = nwg / NXCD, r = nwg % NXCD, xcd = wgid % NXCD, off = wgid / NXCD; wgid = (xcd < r ? xcd * (q + 1) : r * (q + 1) + (xcd - r) * q) + off; }
        const int nig = WGM * nN, gid = wgid / nig, fm = gid * WGM, gsz = (nM - fm) < WGM ? (nM - fm) : WGM;
        u.pm = fm + ((wgid % nig) % gsz); u.pn = (wgid % nig) / gsz; return true;
    }
    __device__ __forceinline__ void a_ready(const Unit&) const {}
    __device__ __forceinline__ void done(const Unit&) const {}
};

__device__ __forceinline__ unsigned cvt_pk_bf16(float lo, float hi) { unsigned r; asm volatile("v_cvt_pk_bf16_f32 %0, %1, %2" : "=v"(r) : "v"(lo), "v"(hi)); return r; }
__device__ __forceinline__ float silu_f(float g) { return g * __builtin_amdgcn_rcpf(1.0f + __expf(-g)); }

struct EpiProj {
    static constexpr bool PERM = true, AFTER_DRAIN = false;
    bf16_t* O; int ldc; int ncols; const float* rowsq;
    __device__ __forceinline__ void pre(const Unit& u, int wr, int fr, float (&rsv)[8]) const {
#pragma unroll
        for (int i = 0; i < 8; ++i) rsv[i] = rowsq[u.pm * BM + wr * 64 + fr + (i >> 2) * HALF + (i & 3) * 16]; }
    __device__ __forceinline__ void operator()(const f32x4 (&acc)[2][2][4][2], const Unit& u, int wr, int wc, int fr, int fq, const float (&rsv)[8]) const {
        const int row0 = u.pm * BM + wr * 64 + fr; const int col0 = u.pn * BM + wc * 32 + 8 * fq;
#pragma unroll
        for (int ai = 0; ai < 2; ++ai)
#pragma unroll
            for (int m = 0; m < 4; ++m) { bf16_t* rowp = O + (size_t)(row0 + ai * HALF + m * 16) * ldc;
                const float rs = __builtin_amdgcn_rsqf(rsv[ai * 4 + m] * (1.0f / 1024.0f) + 1e-6f);
#pragma unroll
                for (int bj = 0; bj < 2; ++bj) { const int col = col0 + bj * HALF;
                    if (col < ncols) { const f32x4 v0 = acc[ai][bj][m][0] * rs, v1 = acc[ai][bj][m][1] * rs; u32x4 w;
                        w.x = cvt_pk_bf16(v0[0], v0[1]); w.y = cvt_pk_bf16(v0[2], v0[3]); w.z = cvt_pk_bf16(v1[0], v1[1]); w.w = cvt_pk_bf16(v1[2], v1[3]);
                        __builtin_nontemporal_store(w, (u32x4*)(rowp + col)); } } }
    }
};
struct EpiResid {
    static constexpr bool PERM = true, AFTER_DRAIN = false;
    const float* base_f; const bf16_t* base_b; float* out_f; bf16_t* out_b; int ldc; float* rowsq;
    __device__ __forceinline__ void pre(const Unit&, int, int, float (&)[8]) const {}
    __device__ __forceinline__ void operator()(const f32x4 (&acc)[2][2][4][2], const Unit& u, int wr, int wc, int fr, int fq, const float (&rsv)[8]) const {
        const int row0 = u.pm * BM + wr * 64 + fr; const int col0 = u.pn * BM + wc * 32 + 8 * fq;
#pragma unroll
        for (int ai = 0; ai < 2; ++ai)
#pragma unroll
            for (int m = 0; m < 4; ++m) { const size_t off = (size_t)(row0 + ai * HALF + m * 16) * ldc + col0; float sq = 0.f;
#pragma unroll
                for (int bj = 0; bj < 2; ++bj) { const size_t o_ = off + bj * HALF; f32x4 b0, b1;
                    if (base_b) { const u32x4 w = *(const u32x4*)(base_b + o_);
                        b0 = (f32x4){__uint_as_float(w.x << 16), __uint_as_float(w.x & 0xffff0000u), __uint_as_float(w.y << 16), __uint_as_float(w.y & 0xffff0000u)};
                        b1 = (f32x4){__uint_as_float(w.z << 16), __uint_as_float(w.z & 0xffff0000u), __uint_as_float(w.w << 16), __uint_as_float(w.w & 0xffff0000u)}; }
                    else { b0 = __builtin_nontemporal_load((const f32x4*)(base_f + o_)); b1 = __builtin_nontemporal_load((const f32x4*)(base_f + o_ + 4)); }
                    const f32x4 o0 = b0 + acc[ai][bj][m][0], o1 = b1 + acc[ai][bj][m][1];
                    if (out_f) { *(f32x4*)(out_f + o_) = o0; *(f32x4*)(out_f + o_ + 4) = o1; }
                    if (out_b) { u32x4 w; w.x = cvt_pk_bf16(o0[0], o0[1]); w.y = cvt_pk_bf16(o0[2], o0[3]); w.z = cvt_pk_bf16(o1[0], o1[1]); w.w = cvt_pk_bf16(o1[2], o1[3]); *(u32x4*)(out_b + o_) = w; }
                    sq += ((o0[0] * o0[0] + o0[1] * o0[1]) + (o0[2] * o0[2] + o0[3] * o0[3])) + ((o1[0] * o1[0] + o1[1] * o1[1]) + (o1[2] * o1[2] + o1[3] * o1[3])); }
                if (rowsq) { sq += __shfl_xor(sq, 16); sq += __shfl_xor(sq, 32); if (fq == 0) atomicAdd(rowsq + row0 + ai * HALF + m * 16, sq); } }
    }
};
struct EpiSwiglu {
    static constexpr bool PERM = true, AFTER_DRAIN = false;
    bf16_t* O; int ldc; const float* rowsq;
    __device__ __forceinline__ void pre(const Unit& u, int wr, int fr, float (&rsv)[8]) const {
#pragma unroll
        for (int i = 0; i < 8; ++i) rsv[i] = rowsq[u.pm * BM + wr * 64 + fr + (i >> 2) * HALF + (i & 3) * 16]; }
    __device__ __forceinline__ void operator()(const f32x4 (&acc)[2][2][4][2], const Unit& u, int wr, int wc, int fr, int fq, const float (&rsv)[8]) const {
        const int row0 = u.pm * BM + wr * 64 + fr; const int col0 = u.pn * HALF + wc * 32 + 8 * fq;
#pragma unroll
        for (int ai = 0; ai < 2; ++ai)
#pragma unroll
            for (int m = 0; m < 4; ++m) { bf16_t* rowp = O + (size_t)(row0 + ai * HALF + m * 16) * ldc + col0;
                const float rs = __builtin_amdgcn_rsqf(rsv[ai * 4 + m] * (1.0f / 1024.0f) + 1e-6f);
                const f32x4 g0 = acc[ai][0][m][0] * rs, g1 = acc[ai][0][m][1] * rs, u0 = acc[ai][1][m][0] * rs, u1 = acc[ai][1][m][1] * rs; u32x4 w;
                w.x = cvt_pk_bf16(silu_f(g0[0]) * u0[0], silu_f(g0[1]) * u0[1]); w.y = cvt_pk_bf16(silu_f(g0[2]) * u0[2], silu_f(g0[3]) * u0[3]);
                w.z = cvt_pk_bf16(silu_f(g1[0]) * u1[0], silu_f(g1[1]) * u1[1]); w.w = cvt_pk_bf16(silu_f(g1[2]) * u1[2], silu_f(g1[3]) * u1[3]);
                __builtin_nontemporal_store(w, (u32x4*)rowp); }
    }
};

template <class Epi, class Sched, bool ALIGN_EPI = false, bool SP2 = false>
__device__ __forceinline__ void gemm_phase(PG8_LAS unsigned char* lds, const Gemm g, const Sched& S, const Epi& E) {
    int tid_ = threadIdx.x; asm volatile("" : "+v"(tid_));
    const int tid = tid_, wid = __builtin_amdgcn_readfirstlane(tid >> 6), lane = tid & 63, wr = wid >> 2, wc = wid & 3, fr = lane & 15, fq = lane >> 4;
    const int K = g.K, nt = K / BK;
    unsigned voffA[2], voffB[2];
#pragma unroll
    for (int i = 0; i < 2; ++i) { int R, C; stage_rc(tid * 16 + i * 8192, R, C); const int Rb = Epi::PERM ? ((R & ~31) + perm32(R & 31)) : R;
        voffA[i] = (unsigned)(R * K + C) * 2u; voffB[i] = (unsigned)(Rb * K + C) * 2u; }
    const size_t kstep = (size_t)(BK * 2);
    const size_t hstep = (size_t)HALF * K * 2;
    const size_t tstep = 2 * hstep;
    const unsigned ldsw = (unsigned)wid * 1024u;
    const int aoff = lds_byte(wr * 64 + fr, fq * 8), boff = lds_byte(wc * 32 + fr, fq * 8);
#define PG8_SA(b, h) (((b) * 2 + (h)) * HTB)
#define PG8_SB(b, h) ((4 + (b) * 2 + (h)) * HTB)
#define PG8_STAGE(bufoff, gbase, voff) do { _Pragma("unroll") for (int _i = 0; _i < 2; ++_i) \
        __builtin_amdgcn_global_load_lds((const unsigned*)((const char*)(gbase) + (voff)[_i]), (PG8_LAS unsigned*)(lds + (bufoff) + ldsw + _i * 8192), 16, 0, 0); } while (0)
#define PG8_LDA(dst, b, h) do { _Pragma("unroll") for (int m = 0; m < 4; ++m) _Pragma("unroll") for (int k = 0; k < 2; ++k) dst[m][k] = *(const PG8_LAS bf16x8*)(lds + PG8_SA(b, h) + aoff + m * 2048 + k * 1024); } while (0)
#define PG8_LDB(dst, b, h) do { _Pragma("unroll") for (int n = 0; n < 2; ++n) _Pragma("unroll") for (int k = 0; k < 2; ++k) dst[n][k] = *(const PG8_LAS bf16x8*)(lds + PG8_SB(b, h) + boff + n * 2048 + k * 1024); } while (0)
#define PG8_MMA(ai, bj, At, Bt) do { __builtin_amdgcn_s_setprio(1); _Pragma("unroll") for (int m = 0; m < 4; ++m) _Pragma("unroll") for (int n = 0; n < 2; ++n) _Pragma("unroll") for (int k = 0; k < 2; ++k) \
        acc[ai][bj][m][n] = __builtin_amdgcn_mfma_f32_16x16x32_bf16(Bt[n][k], At[m][k], acc[ai][bj][m][n], 0, 0, 0); __builtin_amdgcn_s_setprio(0); } while (0)
#define PG8_WAIT_V(n) asm volatile("s_waitcnt vmcnt(" #n ")" ::: "memory")
#define PG8_WAIT_L(n) asm volatile("s_waitcnt lgkmcnt(" #n ")" ::: "memory")
#define PG8_BAR __builtin_amdgcn_s_barrier()
#define PG8_SCHED __builtin_amdgcn_sched_barrier(0)
    Unit cur, nxt; int ui = 0;
    float rsv[8];
    if (!S.next(0, cur)) return;
    f32x4 acc[2][2][4][2];
#pragma unroll
    for (int a = 0; a < 2; ++a)
#pragma unroll
        for (int b = 0; b < 2; ++b)
#pragma unroll
            for (int m = 0; m < 4; ++m)
#pragma unroll
                for (int n = 0; n < 2; ++n) acc[a][b][m][n] = (f32x4){0.f, 0.f, 0.f, 0.f};
    bf16x8 At[4][2], B0[2][2], B1[2][2];
    const char* cA = (const char*)g.A + (size_t)cur.pm * tstep; const char* cB = (const char*)g.Bt + (size_t)cur.pn * tstep;
    S.a_ready(cur);
    if constexpr (SP2) {
        PG8_STAGE(PG8_SB(0, 0), cB, voffB); PG8_STAGE(PG8_SB(0, 1), cB + hstep, voffB); PG8_STAGE(PG8_SA(0, 0), cA, voffA); PG8_STAGE(PG8_SA(0, 1), cA + hstep, voffA);
        if (wr == 1) PG8_BAR;
        PG8_WAIT_V(2); PG8_BAR;
        PG8_STAGE(PG8_SB(1, 0), cB + kstep, voffB); PG8_STAGE(PG8_SA(1, 0), cA + kstep, voffA); PG8_STAGE(PG8_SB(1, 1), cB + hstep + kstep, voffB);
        PG8_WAIT_V(6); PG8_BAR;
    } else {
        PG8_STAGE(PG8_SB(0, 0), cB, voffB); PG8_STAGE(PG8_SA(0, 0), cA, voffA); PG8_STAGE(PG8_SB(0, 1), cB + hstep, voffB); PG8_STAGE(PG8_SA(0, 1), cA + hstep, voffA);
        if (wr == 1) PG8_BAR;
        PG8_WAIT_V(4); PG8_BAR;
        PG8_STAGE(PG8_SB(1, 0), cB + kstep, voffB); PG8_STAGE(PG8_SA(1, 0), cA + kstep, voffA); PG8_STAGE(PG8_SB(1, 1), cB + hstep + kstep, voffB);
        PG8_WAIT_V(6); PG8_BAR;
    }
    for (;;) {
        const bool has_next = S.next(ui + 1, nxt);
        const char* nA = has_next ? (const char*)g.A + (size_t)nxt.pm * tstep : cA; const char* nB = has_next ? (const char*)g.Bt + (size_t)nxt.pn * tstep : cB;
        for (int t = 0; t < nt; t += 2) {
            const bool last = (t == nt - 2);
            const char* a1 = cA + (size_t)(t + 1) * kstep;
            const char* a2 = last ? nA : cA + (size_t)(t + 2) * kstep; const char* b2 = last ? nB : cB + (size_t)(t + 2) * kstep;
            const char* a3 = a2 + kstep; const char* b3 = b2 + kstep;
            if (last && has_next) S.a_ready(nxt);
            if (last) E.pre(cur, wr, fr, rsv);
            if constexpr (SP2) {
            PG8_LDB(B0, 0, 0); PG8_LDB(B1, 0, 1); PG8_SCHED; PG8_LDA(At, 0, 0); PG8_STAGE(PG8_SA(1, 1), a1 + hstep, voffA);
            PG8_WAIT_V(8); PG8_WAIT_L(0); PG8_BAR; PG8_MMA(0, 0, At, B0); PG8_MMA(0, 1, At, B1); PG8_BAR; PG8_SCHED;
            PG8_LDA(At, 0, 1); PG8_STAGE(PG8_SB(0, 0), b2, voffB); PG8_STAGE(PG8_SB(0, 1), b2 + hstep, voffB); PG8_STAGE(PG8_SA(0, 0), a2, voffA);
            PG8_WAIT_V(8); PG8_WAIT_L(0); PG8_BAR; PG8_MMA(1, 0, At, B0); PG8_MMA(1, 1, At, B1); PG8_BAR; PG8_SCHED;
            PG8_LDB(B0, 1, 0); PG8_LDB(B1, 1, 1); PG8_SCHED; PG8_LDA(At, 1, 0); PG8_STAGE(PG8_SA(0, 1), a2 + hstep, voffA);
            PG8_WAIT_V(8); PG8_WAIT_L(0); PG8_BAR; PG8_MMA(0, 0, At, B0); PG8_MMA(0, 1, At, B1); PG8_BAR; PG8_SCHED;
            PG8_LDA(At, 1, 1); PG8_STAGE(PG8_SB(1, 0), b3, voffB); PG8_STAGE(PG8_SB(1, 1), b3 + hstep, voffB); PG8_STAGE(PG8_SA(1, 0), a3, voffA);
            PG8_WAIT_V(8); PG8_WAIT_L(0); PG8_BAR; PG8_MMA(1, 0, At, B0); PG8_MMA(1, 1, At, B1); PG8_BAR; PG8_SCHED;
            } else {
            PG8_LDB(B0, 0, 0); PG8_SCHED; PG8_LDA(At, 0, 0); PG8_STAGE(PG8_SA(1, 1), a1 + hstep, voffA);
            PG8_WAIT_L(8); PG8_BAR; PG8_WAIT_L(0); PG8_MMA(0, 0, At, B0); PG8_BAR; PG8_SCHED;
            PG8_LDB(B1, 0, 1); PG8_STAGE(PG8_SB(0, 0), b2, voffB);
            PG8_BAR; PG8_WAIT_L(0); PG8_MMA(0, 1, At, B1); PG8_BAR;
            PG8_LDA(At, 0, 1); PG8_STAGE(PG8_SA(0, 0), a2, voffA);
            PG8_BAR; PG8_WAIT_L(0); PG8_MMA(1, 0, At, B0); PG8_BAR; PG8_SCHED;
            PG8_STAGE(PG8_SB(0, 1), b2 + hstep, voffB);
            PG8_WAIT_V(6); PG8_BAR; PG8_MMA(1, 1, At, B1); PG8_BAR;
            PG8_LDB(B0, 1, 0); PG8_SCHED; PG8_LDA(At, 1, 0); PG8_STAGE(PG8_SA(0, 1), a2 + hstep, voffA);
            PG8_WAIT_L(8); PG8_BAR; PG8_WAIT_L(0); PG8_MMA(0, 0, At, B0); PG8_BAR; PG8_SCHED;
            PG8_LDB(B1, 1, 1); PG8_STAGE(PG8_SB(1, 0), b3, voffB);
            PG8_BAR; PG8_WAIT_L(0); PG8_MMA(0, 1, At, B1); PG8_BAR;
            PG8_LDA(At, 1, 1); PG8_STAGE(PG8_SA(1, 0), a3, voffA);
            PG8_BAR; PG8_WAIT_L(0); PG8_MMA(1, 0, At, B0); PG8_BAR; PG8_SCHED;
            PG8_STAGE(PG8_SB(1, 1), b3 + hstep, voffB);
            PG8_WAIT_V(6); PG8_BAR; PG8_MMA(1, 1, At, B1); PG8_BAR;
            }
        }
        if constexpr (ALIGN_EPI) { if (wr == 0) PG8_BAR; }
        if constexpr (!Epi::AFTER_DRAIN) { E(acc, cur, wr, wc, fr, fq, rsv); S.done(cur); }
        if (!has_next) break;
#pragma unroll
        for (int a = 0; a < 2; ++a)
#pragma unroll
            for (int b = 0; b < 2; ++b)
#pragma unroll
                for (int m = 0; m < 4; ++m)
#pragma unroll
                    for (int n = 0; n < 2; ++n) acc[a][b][m][n] = (f32x4){0.f, 0.f, 0.f, 0.f};
        cur = nxt; cA = nA; cB = nB; ++ui;
        if constexpr (ALIGN_EPI) { if (wr == 1) PG8_BAR; }
    }
    PG8_WAIT_V(0);
    if constexpr (!ALIGN_EPI) { if (wr == 0) PG8_BAR; }
    PG8_BAR;
    if constexpr (Epi::AFTER_DRAIN) { E.fused(acc, cur, wr, wc, fr, fq, lds, wid, lane); S.done(cur); }
#undef PG8_SA
#undef PG8_SB
#undef PG8_STAGE
#undef PG8_LDA
#undef PG8_LDB
#undef PG8_MMA
#undef PG8_WAIT_V
#undef PG8_WAIT_L
#undef PG8_BAR
#undef PG8_SCHED
}
}

constexpr int NB = 4, T = 8192, D = 1024, DIN = 3592, NINP = 3584, DFF = 2816, NGU = 2 * DFF, DEPTH = 2;
constexpr int M = NB * T;
constexpr int NCH = T / 64;
constexpr int LDP = NINP;
constexpr int C_RQ = 0, C_RK = 256, C_RV = 512, C_RG = 768, C_CA = 1024, C_CG = 1280, C_GQ = 1536, C_GK = 1792, C_GV = 2048, C_GG = 2304,
              C_HQ = 2560, C_HF = 2816, C_HI = 3072, C_HG = 3328;
constexpr size_t MiB = 1u << 20;
constexpr size_t WS_CTL = 0;
constexpr size_t WS_WIN = 1 * MiB;
constexpr size_t WS_WOUT = 16 * MiB;
constexpr size_t WS_WGU = 20 * MiB;
constexpr size_t WS_WDN = 42 * MiB;
constexpr size_t WS_XN = 53 * MiB;
constexpr size_t WS_BCS = WS_XN;
constexpr size_t WS_MM = WS_XN + 48 * MiB;
constexpr size_t WS_MIX = 117 * MiB;
constexpr size_t WS_PROJ = 181 * MiB;
constexpr size_t WS_QEFF = 406 * MiB;
constexpr size_t WS_OLOC = 454 * MiB;
constexpr size_t WS_MVEC = 502 * MiB;
constexpr size_t WS_RSA = 503 * MiB;
constexpr size_t WS_RSB = 503 * MiB + 131072;
constexpr size_t WS_GBA = 503 * MiB + 262144;
constexpr size_t WS_WBA = 504 * MiB + 524288;
constexpr size_t WS_END = 505 * MiB;
constexpr int LDS_BYTES = 147456 + 256;
constexpr int LDS_BAR_OFF = 147456;
constexpr int HEAD_LDS = 73728;

#define LAS __attribute__((address_space(3)))
typedef unsigned short bf16_t;
typedef short bf16x8 __attribute__((ext_vector_type(8)));
typedef float f32x4 __attribute__((ext_vector_type(4)));
typedef unsigned u32x4 __attribute__((ext_vector_type(4)));
typedef unsigned u32x2 __attribute__((ext_vector_type(2)));
constexpr int LT = 72;
template <class Tp> __device__ __forceinline__ LAS Tp* opq(LAS Tp* p) { asm volatile("" : "+v"(p)); return p; }

__device__ __forceinline__ float bf_lo(unsigned u) { return __uint_as_float(u << 16); }
__device__ __forceinline__ float bf_hi(unsigned u) { return __uint_as_float(u & 0xffff0000u); }
__device__ __forceinline__ float bf2f(bf16_t b) { return __uint_as_float((unsigned)b << 16); }
__device__ __forceinline__ unsigned pk2(float lo, float hi) { return pg8::cvt_pk_bf16(lo, hi); }
__device__ __forceinline__ bf16_t f2bf(float f) { return (bf16_t)(pk2(f, 0.f) & 0xffffu); }
__device__ __forceinline__ float fexp(float x) { return __expf(x); }
__device__ __forceinline__ float frcp(float x) { return __builtin_amdgcn_rcpf(x); }
__device__ __forceinline__ float sigmoid_f(float x) { return frcp(1.0f + fexp(-x)); }
__device__ __forceinline__ float silu_acc(float x) { return x * frcp(1.0f + fexp(-x)); }
__device__ __forceinline__ float softplus_f(float x) { return fmaxf(x, 0.f) + log1pf(expf(-fabsf(x))); }
__device__ __forceinline__ float wave_sum(float v) {
#pragma unroll
    for (int o = 1; o < 64; o <<= 1) v += __shfl_xor(v, o);
    return v;
}
__device__ __forceinline__ void unpack8(const u32x4 w, float (&f)[8]) {
    f[0] = bf_lo(w.x); f[1] = bf_hi(w.x); f[2] = bf_lo(w.y); f[3] = bf_hi(w.y); f[4] = bf_lo(w.z); f[5] = bf_hi(w.z); f[6] = bf_lo(w.w); f[7] = bf_hi(w.w);
}
__device__ __forceinline__ u32x4 pack8(const float (&f)[8]) { u32x4 w; w.x = pk2(f[0], f[1]); w.y = pk2(f[2], f[3]); w.z = pk2(f[4], f[5]); w.w = pk2(f[6], f[7]); return w; }

struct Ctx {
    const float* in[20]; float* out; unsigned char* ws;
};
#define WSP(T_, off) ((T_*)(X.ws + (off)))

__device__ __forceinline__ f32x4 mma16(const LAS bf16_t* A, int a0, const LAS bf16_t* B, int b0, f32x4 acc, int r, int q) {
#pragma unroll
    for (int ks = 0; ks < 2; ++ks) {
        const bf16x8 a = *(const LAS bf16x8*)(A + (a0 + r) * LT + ks * 32 + q * 8);
        const bf16x8 b = *(const LAS bf16x8*)(B + (b0 + r) * LT + ks * 32 + q * 8);
        acc = __builtin_amdgcn_mfma_f32_16x16x32_bf16(a, b, acc, 0, 0, 0);
    }
    return acc;
}
__device__ __forceinline__ void store_oloc(bf16_t* oloc, int uid, int w4, int lane, const f32x4 (&acc)[4]) {
    u32x4* p = (u32x4*)(oloc + ((size_t)uid * 4 + w4) * 1024 + lane * 16);
    u32x4 a, b;
    a.x = pk2(acc[0][0], acc[0][1]); a.y = pk2(acc[0][2], acc[0][3]); a.z = pk2(acc[1][0], acc[1][1]); a.w = pk2(acc[1][2], acc[1][3]);
    b.x = pk2(acc[2][0], acc[2][1]); b.y = pk2(acc[2][2], acc[2][3]); b.z = pk2(acc[3][0], acc[3][1]); b.w = pk2(acc[3][2], acc[3][3]);
    __builtin_nontemporal_store(a, p); __builtin_nontemporal_store(b, p + 1);
}
__device__ __forceinline__ void store_bc(bf16_t* bcs, int uid, int w4, int r, int q, const f32x4 (&acc)[4]) {
#pragma unroll
    for (int ct = 0; ct < 4; ++ct) { u32x2 w; w.x = pk2(acc[ct][0], acc[ct][1]); w.y = pk2(acc[ct][2], acc[ct][3]);
        *(u32x2*)(bcs + (size_t)uid * 4096 + ((ct * 4 + w4) * 64 + q * 16 + r) * 4) = w; }
}


typedef __attribute__((address_space(1))) unsigned gu32;
#define XB_TMO      128
#define XB_XCNT(j)  (256  + 64 * (j))
#define XB_XSUB(j)  (1280 + 64 * (j))
#define XB_XGEN(j)  (2304 + 64 * (j))
#define XB_TOP      3328
#define XB_TOPGEN   3392
#define XCD_BAR_WORDS 3456
#define XB_SPIN_CAP (1u << 18)

__device__ __forceinline__ unsigned xb_ld(unsigned* p)              { return __hip_atomic_load(p, __ATOMIC_RELAXED, __HIP_MEMORY_SCOPE_AGENT); }
__device__ __forceinline__ unsigned xb_add(unsigned* p, unsigned v) { return __hip_atomic_fetch_add(p, v, __ATOMIC_RELAXED, __HIP_MEMORY_SCOPE_AGENT); }
__device__ __forceinline__ unsigned xb_xcc_id() { return (unsigned)__builtin_amdgcn_s_getreg((3 << 11) | 20) & 0xFu; }
#define XB_SPIN(cond, bar) do { unsigned _sp = 0; while (cond) { __builtin_amdgcn_s_sleep(1); \
    if ((++_sp & 255u) == 0u) { if (xb_ld(&(bar)[XB_TMO])) break; if (_sp > XB_SPIN_CAP) { atomicAdd(&(bar)[XB_TMO], 1u); break; } } } } while (0)

struct XcdBarrier {
    unsigned* bar; unsigned x;
    volatile LAS unsigned* st;
};

__device__ __forceinline__ XcdBarrier xcd_barrier_post(unsigned* bar, volatile LAS unsigned* st) {
    XcdBarrier b; b.bar = bar; b.x = xb_xcc_id(); b.st = st;
    if (threadIdx.x == 0) (void)xb_add(&bar[XB_XCNT(b.x)], 1u);
    return b;
}
__device__ __forceinline__ void xcd_barrier_complete(unsigned* bar, unsigned x, unsigned& nloc, unsigned& nx) {
    const unsigned G = gridDim.x * gridDim.y * gridDim.z;
    unsigned sum, cnt, mine, sp = 0u;
    for (;;) {
        sum = 0u; cnt = 0u; mine = 0u;
#pragma unroll
        for (unsigned j = 0; j < 16; ++j) { const unsigned c = xb_ld(&bar[XB_XCNT(j)]); sum += c; cnt += (c > 0u) ? 1u : 0u; mine = (j == x) ? c : mine; }
        if (sum == G) break;
        __builtin_amdgcn_s_sleep(1);
        if ((++sp & 255u) == 0u) { if (xb_ld(&bar[XB_TMO])) break; if (sp > XB_SPIN_CAP) { atomicAdd(&bar[XB_TMO], 1u); break; } }
    }
    nloc = mine > 0u ? mine : 1u; nx = cnt > 0u ? cnt : 1u;
}

__device__ __forceinline__ void xcd_barrier(const XcdBarrier& b) {
    asm volatile("s_waitcnt vmcnt(0)" ::: "memory");
    __syncthreads();
    if (threadIdx.x == 0) {
        unsigned* bar = b.bar;
        __builtin_amdgcn_s_waitcnt(0);
        unsigned nloc = b.st[0], nx = b.st[1];
        if (nloc == 0u) { xcd_barrier_complete(bar, b.x, nloc, nx); b.st[0] = nloc; b.st[1] = nx; }
        const unsigned old = xb_add(&bar[XB_XSUB(b.x)], 1u);
        const unsigned gen = old / nloc;
        if (old + 1u == (gen + 1u) * nloc) {
            __builtin_amdgcn_fence(__ATOMIC_RELEASE, "agent");
            asm volatile("s_waitcnt vmcnt(0)" ::: "memory");
            const unsigned og = xb_add(&bar[XB_TOP], 1u);
            const unsigned tg = og / nx;
            if (og + 1u == (tg + 1u) * nx) xb_add(&bar[XB_TOPGEN], 1u);
            else XB_SPIN(xb_ld(&bar[XB_TOPGEN]) == tg, bar);
            __builtin_amdgcn_fence(__ATOMIC_ACQUIRE, "agent");
            xb_add(&bar[XB_XGEN(b.x)], 1u);
            asm volatile("s_waitcnt vmcnt(0)" ::: "memory");
        } else {
            XB_SPIN(xb_ld(&bar[XB_XGEN(b.x)]) == gen, bar);
            __builtin_amdgcn_fence(__ATOMIC_ACQUIRE, "agent");
            asm volatile("s_waitcnt vmcnt(0)" ::: "memory");
        }
    }
    __syncthreads();
}

__device__ __forceinline__ void transpose_item(const float* W, int K, int N, bf16_t* WT, int mode, LAS float* scr, int kb, int nb, int lane, const float* kscale, int coff) {
    const int k0 = 64 * kb, n0 = 32 * nb;
    const int nn = n0 + (lane & 31) + coff;
#pragma unroll 8
    for (int i = 0; i < 32; ++i) { const int kk = 2 * i + (lane >> 5); const float ksc = kscale ? kscale[k0 + kk] : 1.0f; scr[kk * 33 + (lane & 31)] = nn < N ? __builtin_nontemporal_load(W + (size_t)(k0 + kk) * N + nn) * ksc : 0.f; }
    asm volatile("s_waitcnt lgkmcnt(0)" ::: "memory");
    const int c = lane & 7;
#pragma unroll
    for (int j = 0; j < 4; ++j) { const int n = (lane >> 3) + 8 * j; const LAS float* s = scr + (8 * c) * 33 + n;
        u32x4 o; o.x = pk2(s[0 * 33], s[1 * 33]); o.y = pk2(s[2 * 33], s[3 * 33]); o.z = pk2(s[4 * 33], s[5 * 33]); o.w = pk2(s[6 * 33], s[7 * 33]);
        const int ng = n0 + n; const int row = mode == 0 ? ng : ((ng >> 7) * 256 + (ng & 127) + (mode == 2 ? 128 : 0));
        *(u32x4*)(WT + (size_t)row * K + k0 + 8 * c) = o; }
    asm volatile("s_waitcnt lgkmcnt(0)" ::: "memory");
}
__device__ __forceinline__ void prep_weights(const Ctx& X, LAS unsigned char* lds, int gw, int ngw, int wave, int lane, int it_lo, int it_hi) {
    LAS float* scr = (LAS float*)(lds + wave * 16384);
    constexpr int I_IN = (D / 64) * (NINP / 32), I_OUT = (D / 64) * (D / 32), I_G = (D / 64) * (DFF / 32), I_DN = (DFF / 64) * (D / 32);
    constexpr int PER_L = I_IN + I_OUT + 2 * I_G + I_DN;
    asm volatile("" : "+v"(lane));
    for (int it = it_lo + gw; it < it_hi; it += ngw) {
        const int l = it / PER_L; int r = it % PER_L;
        if (r < I_IN) { transpose_item(X.in[2] + (size_t)l * D * DIN, D, DIN, WSP(bf16_t, WS_WIN) + (size_t)l * NINP * D, 0, scr, r / (NINP / 32), r % (NINP / 32), lane, X.in[1] + l * D, (r % (NINP / 32)) * 32 >= 2560 ? 8 : 0); continue; } r -= I_IN;
        if (r < I_OUT) { transpose_item(X.in[14] + (size_t)l * D * D, D, D, WSP(bf16_t, WS_WOUT) + (size_t)l * D * D, 0, scr, r / (D / 32), r % (D / 32), lane, nullptr, 0); continue; } r -= I_OUT;
        if (r < I_G) { transpose_item(X.in[16] + (size_t)l * D * DFF, D, DFF, WSP(bf16_t, WS_WGU) + (size_t)l * NGU * D, 1, scr, r / (DFF / 32), r % (DFF / 32), lane, X.in[15] + l * D, 0); continue; } r -= I_G;
        if (r < I_G) { transpose_item(X.in[17] + (size_t)l * D * DFF, D, DFF, WSP(bf16_t, WS_WGU) + (size_t)l * NGU * D, 2, scr, r / (DFF / 32), r % (DFF / 32), lane, X.in[15] + l * D, 0); continue; } r -= I_G;
        transpose_item(X.in[18] + (size_t)l * DFF * D, DFF, D, WSP(bf16_t, WS_WDN) + (size_t)l * D * DFF, 0, scr, r / (D / 32), r % (D / 32), lane, nullptr, 0);
    }
}
__device__ __forceinline__ void rms_row(const float* xrow, const float* w, bf16_t* orow, float* of, int lane) {
    const f32x4* xr = (const f32x4*)xrow + lane; const f32x4* wr = (const f32x4*)w + lane;
    f32x4 v[4]; float s = 0.f;
#pragma unroll
    for (int j = 0; j < 4; ++j) { v[j] = xr[64 * j]; s += (v[j].x * v[j].x + v[j].y * v[j].y) + (v[j].z * v[j].z + v[j].w * v[j].w); }
    const float rstd = 1.0f / sqrtf(wave_sum(s) * (1.f / D) + 1e-6f);
#pragma unroll
    for (int j = 0; j < 4; ++j) { const f32x4 ww = wr[64 * j]; const f32x4 o = v[j] * rstd * ww;
        if (of) __builtin_nontemporal_store(o, (f32x4*)of + lane + 64 * j);
        else { u32x2 p; p.x = pk2(o.x, o.y); p.y = pk2(o.z, o.w); ((u32x2*)orow + lane)[64 * j] = p; } }
}
__device__ __forceinline__ void cast_phase(const float* x, bf16_t* xb, float* rowsq, int gw, int ngw, int lane) {
    asm volatile("" : "+v"(lane));
    for (int m = gw; m < M; m += ngw) {
        const f32x4* xr = (const f32x4*)(x + (size_t)m * D) + lane; float s = 0.f;
#pragma unroll
        for (int j = 0; j < 4; ++j) { const f32x4 v = __builtin_nontemporal_load(xr + 64 * j); s += (v.x * v.x + v.y * v.y) + (v.z * v.z + v.w * v.w); u32x2 p; p.x = pk2(v.x, v.y); p.y = pk2(v.z, v.w); ((u32x2*)(xb + (size_t)m * D) + lane)[64 * j] = p; }
        s = wave_sum(s); if (lane == 0) rowsq[m] = s;
    }
}
__device__ __forceinline__ void norm_phase(const float* x, const float* w, bf16_t* xn, float* of, int gw, int ngw, int lane) {
    asm volatile("" : "+v"(lane));
    for (int m = gw; m < M; m += ngw) rms_row(x + (size_t)m * D, w, xn ? xn + (size_t)m * D : nullptr, of ? of + (size_t)m * D : nullptr, lane);
}

#define LBAR() do { asm volatile("s_waitcnt lgkmcnt(0)" ::: "memory"); __builtin_amdgcn_s_barrier(); asm volatile("" ::: "memory"); } while (0)
__device__ __forceinline__ int unit_id(int mixer, int b, int h, int c) { return ((mixer * 4 + b) * 4 + h) * NCH + c; }

__device__ __forceinline__ void ret_unit(const Ctx& X, LAS unsigned char* hl, int b, int c, int h, int tid_h, int w4, int lane) {
    LAS bf16_t* QR = opq((LAS bf16_t*)hl); LAS bf16_t* KR = opq(QR + 64 * LT); LAS bf16_t* KDT = opq(KR + 64 * LT); LAS bf16_t* VT = opq(KDT + 64 * LT); LAS bf16_t* P = opq(VT + 64 * LT);
    const bf16_t* proj = WSP(const bf16_t, WS_PROJ);
    const int uid = unit_id(0, b, h, c);
    const int r = lane & 15, q = lane >> 4;
    const float lg = log1pf(-exp2f(-5.0f - (float)h));
    {
        const int i = tid_h >> 2, sg = tid_h & 3, d0 = sg * 8;
        const bf16_t* pr = proj + ((size_t)b * T + c * 64 + i) * LDP;
        const u32x4 q1 = *(const u32x4*)(pr + C_RQ + h * 64 + d0), q2 = *(const u32x4*)(pr + C_RQ + h * 64 + d0 + 32);
        const u32x4 k1 = *(const u32x4*)(pr + C_RK + h * 64 + d0), k2 = *(const u32x4*)(pr + C_RK + h * 64 + d0 + 32);
        const u32x4 v1 = *(const u32x4*)(pr + C_RV + h * 64 + sg * 16), v2 = *(const u32x4*)(pr + C_RV + h * 64 + sg * 16 + 8);
        float qa[8], qb[8], ka[8], kb[8], va[8], vb[8];
        unpack8(q1, qa); unpack8(q2, qb); unpack8(k1, ka); unpack8(k2, kb); unpack8(v1, va); unpack8(v2, vb);
        const float pos = (float)(c * 64 + i);
        const float qd = fexp(lg * (float)(i + 1)), kd = fexp(lg * (float)(63 - i));
        float qr1[8], qr2[8], kr1[8], kr2[8], qe1[8], qe2[8];
#pragma unroll
        for (int e = 0; e < 8; ++e) {
            const float inv = exp2f(-(float)(d0 + e) * (13.287712379549449f / 32.0f));
            const float rev = __builtin_amdgcn_fractf(pos * inv * 0.15915494309189535f); const float sn = __builtin_amdgcn_sinf(rev), cs = __builtin_amdgcn_cosf(rev);
            qr1[e] = qa[e] * cs - qb[e] * sn; qr2[e] = qa[e] * sn + qb[e] * cs;
            kr1[e] = (ka[e] * cs - kb[e] * sn) * 0.125f; kr2[e] = (ka[e] * sn + kb[e] * cs) * 0.125f;
            qe1[e] = qr1[e] * qd; qe2[e] = qr2[e] * qd;
            KDT[(d0 + e) * LT + i] = f2bf(kr1[e] * kd); KDT[(d0 + 32 + e) * LT + i] = f2bf(kr2[e] * kd);
            VT[(sg * 16 + e) * LT + i] = f2bf(va[e]); VT[(sg * 16 + 8 + e) * LT + i] = f2bf(vb[e]);
        }
        *(LAS u32x4*)(QR + i * LT + d0) = pack8(qr1); *(LAS u32x4*)(QR + i * LT + d0 + 32) = pack8(qr2);
        *(LAS u32x4*)(KR + i * LT + d0) = pack8(kr1); *(LAS u32x4*)(KR + i * LT + d0 + 32) = pack8(kr2);
        bf16_t* qe = WSP(bf16_t, WS_QEFF) + (size_t)uid * 4096 + i * 64;
        *(u32x4*)(qe + d0) = pack8(qe1); *(u32x4*)(qe + d0 + 32) = pack8(qe2);
    }
    LBAR();
    f32x4 acc[4];
#pragma unroll
    for (int ct = 0; ct < 4; ++ct) acc[ct] = mma16(QR, 16 * w4, KR, 16 * ct, (f32x4){0.f, 0.f, 0.f, 0.f}, r, q);
#pragma unroll
    for (int ct = 0; ct < 4; ++ct)
#pragma unroll
        for (int j = 0; j < 4; ++j) { const int ii = 16 * w4 + 4 * q + j, col = 16 * ct + r;
            P[ii * LT + col] = f2bf(ii >= col ? acc[ct][j] * fexp(lg * (float)(ii - col)) : 0.f); }
    LBAR();
#pragma unroll
    for (int ct = 0; ct < 4; ++ct) acc[ct] = mma16(P, 16 * w4, VT, 16 * ct, (f32x4){0.f, 0.f, 0.f, 0.f}, r, q);
    store_oloc(WSP(bf16_t, WS_OLOC), uid, w4, lane, acc);
#pragma unroll
    for (int ct = 0; ct < 4; ++ct) acc[ct] = mma16(KDT, 16 * w4, VT, 16 * ct, (f32x4){0.f, 0.f, 0.f, 0.f}, r, q);
    store_bc(WSP(bf16_t, WS_BCS), uid, w4, r, q, acc);
    LBAR();
}

__device__ __forceinline__ void hgrn_unit(const Ctx& X, LAS unsigned char* hl, int b, int c, int h, int tid_h, int w4, int lane, int layer) {
    LAS bf16_t* QT = opq((LAS bf16_t*)hl);
    LAS float* Gt = opq((LAS float*)(hl + 9216));
    LAS bf16_t* Kt = opq((LAS bf16_t*)(hl + 25600));
    LAS bf16_t* KTI = opq((LAS bf16_t*)(hl + 34816));
    LAS bf16_t* VT = KTI; LAS bf16_t* KDT = opq(KTI + 64 * LT);
    LAS float* tot = opq((LAS float*)(hl + 57856));
    const bf16_t* proj = WSP(const bf16_t, WS_PROJ);
    const int uid = unit_id(2, b, h, c);
    const int r = lane & 15, q = lane >> 4;
    const int i = tid_h >> 2, ds = (tid_h & 3) * 16;
    const bf16_t* pr = proj + ((size_t)b * T + c * 64 + i) * LDP;
    float kk[16], qv[16], vv[16];
    {
        float ff[16];
        { float t0[8], t1[8]; unpack8(*(const u32x4*)(pr + C_HF + h * 64 + ds), t0); unpack8(*(const u32x4*)(pr + C_HF + h * 64 + ds + 8), t1);
#pragma unroll
          for (int e = 0; e < 8; ++e) { ff[e] = t0[e]; ff[8 + e] = t1[e]; } }
        { float t0[8], t1[8]; unpack8(*(const u32x4*)(pr + C_HQ + h * 64 + ds), t0); unpack8(*(const u32x4*)(pr + C_HQ + h * 64 + ds + 8), t1);
#pragma unroll
          for (int e = 0; e < 8; ++e) { qv[e] = t0[e]; qv[8 + e] = t1[e]; } }
        { float t0[8], t1[8]; unpack8(*(const u32x4*)(pr + C_HI + h * 64 + ds), t0); unpack8(*(const u32x4*)(pr + C_HI + h * 64 + ds + 8), t1);
#pragma unroll
          for (int e = 0; e < 8; ++e) { vv[e] = t0[e]; vv[8 + e] = t1[e]; } }
#pragma unroll
        for (int e = 0; e < 16; ++e) {
            const int ch = h * 64 + ds + e;
            const float lb = layer == 0 ? 0.f : sigmoid_f(X.in[12][256 + ch] - X.in[12][ch]);
            const float f = ff[e];
            const float ls = fminf(f, 0.f) - __logf(1.0f + fexp(-fabsf(f)));
            const float lf = layer == 0 ? ls : __logf(lb + (1.f - lb) * fexp(ls));
            kk[e] = (1.f - lb) * frcp(1.f + fexp(f));
            Gt[i * 64 + ds + e] = lf;
        }
    }
    LBAR();
    {
        const int d = tid_h & 63, seg = tid_h >> 6; float cs[16]; float run = 0.f;
#pragma unroll
        for (int jj = 0; jj < 16; ++jj) { run += Gt[(16 * seg + jj) * 64 + d]; cs[jj] = run; }
        tot[seg * 64 + d] = run;
        LBAR();
        float off = 0.f;
#pragma unroll
        for (int s = 0; s < 3; ++s) off += (s < seg) ? tot[s * 64 + d] : 0.f;
#pragma unroll
        for (int jj = 0; jj < 16; ++jj) Gt[(16 * seg + jj) * 64 + d] = cs[jj] + off;
    }
    LBAR();
    float Gi[16], G63[16];
    {
        const int I = i >> 4;
        float qt[16], qe[16];
#pragma unroll
        for (int e = 0; e < 16; ++e) { Gi[e] = Gt[i * 64 + ds + e]; G63[e] = Gt[63 * 64 + ds + e]; const float gr = Gt[(16 * I) * 64 + ds + e];
            qt[e] = qv[e] * fexp(Gi[e] - gr); qe[e] = qv[e] * fexp(Gi[e]); }
        u32x4 w0, w1;
        w0.x = pk2(qt[0], qt[1]); w0.y = pk2(qt[2], qt[3]); w0.z = pk2(qt[4], qt[5]); w0.w = pk2(qt[6], qt[7]);
        w1.x = pk2(qt[8], qt[9]); w1.y = pk2(qt[10], qt[11]); w1.z = pk2(qt[12], qt[13]); w1.w = pk2(qt[14], qt[15]);
        *(LAS u32x4*)(QT + i * LT + ds) = w0; *(LAS u32x4*)(QT + i * LT + ds + 8) = w1;
        w0.x = pk2(qe[0], qe[1]); w0.y = pk2(qe[2], qe[3]); w0.z = pk2(qe[4], qe[5]); w0.w = pk2(qe[6], qe[7]);
        w1.x = pk2(qe[8], qe[9]); w1.y = pk2(qe[10], qe[11]); w1.z = pk2(qe[12], qe[13]); w1.w = pk2(qe[14], qe[15]);
        bf16_t* qg = WSP(bf16_t, WS_QEFF) + (size_t)uid * 4096 + i * 64 + ds;
        *(u32x4*)qg = w0; *(u32x4*)(qg + 8) = w1;
        w0.x = pk2(kk[0], kk[1]); w0.y = pk2(kk[2], kk[3]); w0.z = pk2(kk[4], kk[5]); w0.w = pk2(kk[6], kk[7]);
        w1.x = pk2(kk[8], kk[9]); w1.y = pk2(kk[10], kk[11]); w1.z = pk2(kk[12], kk[13]); w1.w = pk2(kk[14], kk[15]);
        *(LAS u32x4*)(Kt + i * LT + ds) = w0; *(LAS u32x4*)(Kt + i * LT + ds + 8) = w1;
        if (i == 63) { float* mv = WSP(float, WS_MVEC) + (size_t)(uid - 2 * 2048) * 64 + ds;
#pragma unroll
            for (int e = 0; e < 16; ++e) mv[e] = fexp(G63[e]); }
    }
    LBAR();
    const int I = w4;
    LAS bf16_t* KI = opq(KTI + (8 * I * (I + 1)) * LT);
    {
        const int nit = 16 * (I + 1) * 8;
        for (int idx = lane; idx < nit; idx += 64) { const int j = idx >> 3, d8 = (idx & 7) * 8;
            float kf[8]; unpack8(*(const LAS u32x4*)(Kt + j * LT + d8), kf);
            float o[8];
#pragma unroll
            for (int e = 0; e < 8; ++e) o[e] = kf[e] * fexp(fminf(Gt[(16 * I) * 64 + d8 + e] - Gt[j * 64 + d8 + e], 80.f));
            *(LAS u32x4*)(KI + j * LT + d8) = pack8(o); }
    }
    LBAR();
    f32x4 acc[4];
    {
        bf16x8 a[2];
#pragma unroll
        for (int ks = 0; ks < 2; ++ks) a[ks] = *(const LAS bf16x8*)(QT + (16 * I + r) * LT + ks * 32 + q * 8);
#pragma unroll
        for (int ct = 0; ct < 4; ++ct) { acc[ct] = (f32x4){0.f, 0.f, 0.f, 0.f};
            if (ct <= I) {
#pragma unroll
                for (int ks = 0; ks < 2; ++ks) { const bf16x8 bb = *(const LAS bf16x8*)(KI + (16 * ct + r) * LT + ks * 32 + q * 8);
                    acc[ct] = __builtin_amdgcn_mfma_f32_16x16x32_bf16(a[ks], bb, acc[ct], 0, 0, 0); } } }
        asm volatile("s_waitcnt lgkmcnt(0)" ::: "memory");
#pragma unroll
        for (int ct = 0; ct < 4; ++ct)
#pragma unroll
            for (int j = 0; j < 4; ++j) { const int ii = 16 * I + 4 * q + j, col = 16 * ct + r;
                QT[ii * LT + col] = f2bf((ct <= I && ii >= col) ? acc[ct][j] : 0.f); }
    }
    LBAR();
    {
#pragma unroll
        for (int e = 0; e < 16; ++e) { VT[(ds + e) * LT + i] = f2bf(vv[e]); KDT[(ds + e) * LT + i] = f2bf(kk[e] * fexp(G63[e] - Gi[e])); }
    }
    LBAR();
#pragma unroll
    for (int ct = 0; ct < 4; ++ct) acc[ct] = mma16(QT, 16 * w4, VT, 16 * ct, (f32x4){0.f, 0.f, 0.f, 0.f}, r, q);
    store_oloc(WSP(bf16_t, WS_OLOC), uid, w4, lane, acc);
#pragma unroll
    for (int ct = 0; ct < 4; ++ct) acc[ct] = mma16(KDT, 16 * w4, VT, 16 * ct, (f32x4){0.f, 0.f, 0.f, 0.f}, r, q);
    store_bc(WSP(bf16_t, WS_BCS), uid, w4, r, q, acc);
    LBAR();
}

__device__ __forceinline__ void gdn_unit(const Ctx& X, LAS unsigned char* hl, int b, int c, int h, int tid_h, int w4, int lane, int layer) {
    LAS bf16_t* Q = opq((LAS bf16_t*)hl); LAS bf16_t* K = opq(Q + 64 * LT); LAS bf16_t* KB = opq(K + 64 * LT); LAS bf16_t* V = opq(KB + 64 * LT); LAS bf16_t* KDT = opq(V + 64 * LT); LAS bf16_t* P = opq(KDT + 64 * LT);
    LAS bf16_t* WT = KB; LAS bf16_t* UT = V;
    LAS bf16_t* AB = opq((LAS bf16_t*)(hl + 55296));
    LAS float* ACCS = opq((LAS float*)(hl + 64512));
    LAS float* Gs = opq((LAS float*)(hl + 72704));
    LAS float* Bs = opq(Gs + 64);
    const bf16_t* proj = WSP(const bf16_t, WS_PROJ);
    const int uid = unit_id(1, b, h, c);
    const int r = lane & 15, q = lane >> 4;
    {
    LAS bf16_t* RAW = opq((LAS bf16_t*)(hl + 46080));
    const int cseg = tid_h & 7, i0 = tid_h >> 3;
    f32x4 wq[3][4][2];
    {
        const float* cw = X.in[8] + (size_t)layer * 4 * 768 + h * 64 + cseg * 8;
#pragma unroll
        for (int tn = 0; tn < 3; ++tn)
#pragma unroll
            for (int k = 0; k < 4; ++k) { const f32x4* wp = (const f32x4*)(cw + k * 768 + tn * 256); wq[tn][k][0] = wp[0]; wq[tn][k][1] = wp[1]; }
        u32x4 rawv[7];
#pragma unroll
        for (int n = 0; n < 7; ++n) { const int item = tid_h + 256 * n; const int seg = item & 7; int rowid = item >> 3; rowid = rowid < 201 ? rowid : 200;
            const int tn = rowid / 67, rr = rowid - tn * 67; const int tt = c * 64 - 3 + rr; const int ttc = tt < 0 ? 0 : tt;
            const u32x4 v = *(const u32x4*)(proj + ((size_t)b * T + ttc) * LDP + C_GQ + tn * 256 + h * 64 + seg * 8);
            rawv[n] = tt < 0 ? (u32x4){0u, 0u, 0u, 0u} : v; }
        float g = 0.f, bt = 0.f;
        if (tid_h < 64) {
            const bf16_t* pr = proj + ((size_t)b * T + c * 64 + tid_h) * LDP;
            const float* gba = WSP(const float, WS_GBA) + ((size_t)b * T + c * 64 + tid_h) * 8; const float gb = gba[h], ga = gba[4 + h];
            g = -fexp(X.in[9][layer * 4 + h]) * softplus_f(ga + X.in[10][layer * 4 + h]);
#pragma unroll
            for (int o = 1; o < 64; o <<= 1) { const float t = __shfl_up(g, o); if (lane >= o) g += t; }
            bt = sigmoid_f(gb);
            Gs[tid_h] = g; Bs[tid_h] = bt;
        }
#pragma unroll
        for (int n = 0; n < 7; ++n) { const int item = tid_h + 256 * n; if (item < 1608) *(LAS u32x4*)(RAW + (item >> 3) * 64 + (item & 7) * 8) = rawv[n]; }
    }
    LBAR();
    {
        const float G63 = Gs[63];
#pragma unroll
        for (int rs = 0; rs < 2; ++rs) {
            const int i = i0 + 32 * rs;
            const float bi = Bs[i], Gi = Gs[i];
            float y[3][8];
#pragma unroll
            for (int tn = 0; tn < 3; ++tn) {
#pragma unroll
                for (int e = 0; e < 8; ++e) y[tn][e] = 0.f;
#pragma unroll
                for (int k = 0; k < 4; ++k) { float x8[8]; unpack8(*(const LAS u32x4*)(RAW + (tn * 67 + i + k) * 64 + cseg * 8), x8);
                    y[tn][0] += wq[tn][k][0].x * x8[0]; y[tn][1] += wq[tn][k][0].y * x8[1]; y[tn][2] += wq[tn][k][0].z * x8[2]; y[tn][3] += wq[tn][k][0].w * x8[3];
                    y[tn][4] += wq[tn][k][1].x * x8[4]; y[tn][5] += wq[tn][k][1].y * x8[5]; y[tn][6] += wq[tn][k][1].z * x8[6]; y[tn][7] += wq[tn][k][1].w * x8[7]; }
#pragma unroll
                for (int e = 0; e < 8; ++e) y[tn][e] = silu_acc(y[tn][e]);
            }
            float sq = 0.f, sk = 0.f;
#pragma unroll
            for (int e = 0; e < 8; ++e) { sq += y[0][e] * y[0][e]; sk += y[1][e] * y[1][e]; }
            sq += __shfl_xor(sq, 1); sq += __shfl_xor(sq, 2); sq += __shfl_xor(sq, 4);
            sk += __shfl_xor(sk, 1); sk += __shfl_xor(sk, 2); sk += __shfl_xor(sk, 4);
            const float rq = 0.125f * rsqrtf(sq + 1e-6f), rk = rsqrtf(sk + 1e-6f), kd = rk * fexp(G63 - Gi);
            float t8[8];
#pragma unroll
            for (int e = 0; e < 8; ++e) t8[e] = y[0][e] * rq;
            *(LAS u32x4*)(Q + i * LT + cseg * 8) = pack8(t8);
#pragma unroll
            for (int e = 0; e < 8; ++e) t8[e] = y[1][e] * rk;
            *(LAS u32x4*)(K + i * LT + cseg * 8) = pack8(t8);
#pragma unroll
            for (int e = 0; e < 8; ++e) t8[e] = y[1][e] * rk * bi;
            *(LAS u32x4*)(KB + i * LT + cseg * 8) = pack8(t8);
            *(LAS u32x4*)(V + i * LT + cseg * 8) = pack8(y[2]);
#pragma unroll
            for (int e = 0; e < 8; ++e) KDT[(cseg * 8 + e) * LT + i] = f2bf(y[1][e] * kd);
        }
    }
    LBAR();
    }
    {
        f32x4 aA[4], aP[4];
#pragma unroll
        for (int ct = 0; ct < 4; ++ct) { aA[ct] = mma16(KB, 16 * w4, K, 16 * ct, (f32x4){0.f, 0.f, 0.f, 0.f}, r, q); aP[ct] = mma16(Q, 16 * w4, K, 16 * ct, (f32x4){0.f, 0.f, 0.f, 0.f}, r, q); }
#pragma unroll
        for (int ct = 0; ct < 4; ++ct)
#pragma unroll
            for (int j = 0; j < 4; ++j) { const int ii = 16 * w4 + 4 * q + j, col = 16 * ct + r;
                const float L = fexp(fminf(Gs[ii] - Gs[col], 0.f));
                AB[ii * LT + col] = f2bf(ii > col ? aA[ct][j] * L : 0.f);
                P[ii * LT + col] = f2bf(ii >= col ? aP[ct][j] * L : 0.f); }
    }
    LBAR();
    float rc[64];
    if (w4 < 2) {
        const int col = tid_h & 63; const LAS bf16_t* src = w4 == 0 ? V : KB;
#pragma unroll
        for (int i = 0; i < 64; ++i) { const float sc = w4 == 0 ? Bs[i] : fexp(Gs[i]); rc[i] = bf2f(src[i * LT + col]) * sc; }
    }
    LBAR();
    {
    for (int idx = tid_h; idx < 1152; idx += 256) { const int tl = idx >= 576; const int rem = idx - tl * 576; *(LAS u32x4*)((tl ? KB : V) + rem * 8) = (u32x4){0u, 0u, 0u, 0u}; }
    LBAR();
#pragma unroll
    for (int I = 0; I < 4; ++I) {
        if (I > 0) {
#pragma unroll
            for (int t2 = 0; t2 < 2; ++t2) { const int ct8 = 2 * w4 + t2; const LAS bf16_t* Bt = ct8 < 4 ? UT : WT;
                const f32x4 a = mma16(AB, 16 * I, Bt, 16 * (ct8 & 3), (f32x4){0.f, 0.f, 0.f, 0.f}, r, q);
#pragma unroll
                for (int j = 0; j < 4; ++j) ACCS[(4 * q + j) * 128 + 16 * ct8 + r] = a[j]; }
            LBAR();
        }
        if (w4 < 2) {
            const int col = tid_h & 63, c128 = w4 * 64 + col;
            float t[16];
#pragma unroll
            for (int ii = 0; ii < 16; ++ii) t[ii] = rc[16 * I + ii] - (I > 0 ? ACCS[ii * 128 + c128] : 0.f);
#pragma unroll
            for (int ii = 1; ii < 16; ++ii) {
                float a16[16];
                { float lo[8]; unpack8(*(const LAS u32x4*)(AB + (16 * I + ii) * LT + 16 * I), lo);
#pragma unroll
                  for (int e = 0; e < 8; ++e) a16[e] = lo[e]; }
                if (ii > 8) { float hi[8]; unpack8(*(const LAS u32x4*)(AB + (16 * I + ii) * LT + 16 * I + 8), hi);
#pragma unroll
                  for (int e = 0; e < 8; ++e) a16[8 + e] = hi[e]; }
                float s0 = t[ii], s1 = 0.f;
#pragma unroll
                for (int kk = 0; kk < ii; ++kk) { if (kk & 1) s1 -= a16[kk] * t[kk]; else s0 -= a16[kk] * t[kk]; }
                t[ii] = s0 + s1;
            }
            LAS bf16_t* dst = (w4 == 0 ? UT : WT) + col * LT + 16 * I;
            u32x4 w0, w1;
            w0.x = pk2(t[0], t[1]); w0.y = pk2(t[2], t[3]); w0.z = pk2(t[4], t[5]); w0.w = pk2(t[6], t[7]);
            w1.x = pk2(t[8], t[9]); w1.y = pk2(t[10], t[11]); w1.z = pk2(t[12], t[13]); w1.w = pk2(t[14], t[15]);
            *(LAS u32x4*)dst = w0; *(LAS u32x4*)(dst + 8) = w1;
        }
        LBAR();
    }
    }
    {
        f32x4 acc[4];
        const float eG63 = fexp(Gs[63]);
#pragma unroll
        for (int ct = 0; ct < 4; ++ct) acc[ct] = mma16(P, 16 * w4, WT, 16 * ct, (f32x4){0.f, 0.f, 0.f, 0.f}, r, q);
        bf16_t* qe = WSP(bf16_t, WS_QEFF) + (size_t)uid * 4096;
#pragma unroll
        for (int ct = 0; ct < 4; ++ct)
#pragma unroll
            for (int j = 0; j < 4; ++j) { const int ii = 16 * w4 + 4 * q + j, col = 16 * ct + r;
                qe[ii * 64 + col] = f2bf(bf2f(Q[ii * LT + col]) * fexp(Gs[ii]) - acc[ct][j]); }
#pragma unroll
        for (int ct = 0; ct < 4; ++ct) acc[ct] = mma16(P, 16 * w4, UT, 16 * ct, (f32x4){0.f, 0.f, 0.f, 0.f}, r, q);
        store_oloc(WSP(bf16_t, WS_OLOC), uid, w4, lane, acc);
#pragma unroll
        for (int ct = 0; ct < 4; ++ct) acc[ct] = mma16(KDT, 16 * w4, WT, 16 * ct, (f32x4){0.f, 0.f, 0.f, 0.f}, r, q);
        bf16_t* mm = WSP(bf16_t, WS_MM) + (size_t)(uid - 2048) * 4096;
#pragma unroll
        for (int ct = 0; ct < 4; ++ct)
#pragma unroll
            for (int j = 0; j < 4; ++j) { const int ii = 16 * w4 + 4 * q + j, col = 16 * ct + r;
                mm[((w4 * 2 + (ct >> 1)) * 64 + (r >> 2) * 16 + 4 * q + j) * 8 + (ct & 1) * 4 + (r & 3)] = f2bf((ii == col ? eG63 : 0.f) - acc[ct][j]); }
#pragma unroll
        for (int ct = 0; ct < 4; ++ct) acc[ct] = mma16(KDT, 16 * w4, UT, 16 * ct, (f32x4){0.f, 0.f, 0.f, 0.f}, r, q);
        store_bc(WSP(bf16_t, WS_BCS), uid, w4, r, q, acc);
    }
    LBAR();
}

__device__ __forceinline__ void conf_unit(const Ctx& X, LAS unsigned char* lds, int b, int c, int tid, int wave, int lane, int layer) {
    LAS bf16_t* GL = opq((LAS bf16_t*)lds);
    LAS float* Y = opq((LAS float*)(lds + 49152));
    const bf16_t* proj = WSP(const bf16_t, WS_PROJ);
    bf16_t* mix = WSP(bf16_t, WS_MIX);
    const int t0 = c * 64;
    float w[31]; float bias;
    { const int ch = tid & 255; const float* cw = X.in[4] + (size_t)layer * 31 * 256 + ch;
#pragma unroll
      for (int k = 0; k < 31; ++k) w[k] = cw[k * 256];
      bias = X.in[5][layer * 256 + ch]; }
    {
        u32x4 av[6], gvv[6];
#pragma unroll
        for (int n = 0; n < 6; ++n) { int item = tid + 512 * n; item = item < 94 * 32 ? item : 94 * 32 - 1; const int rr = item >> 5, seg = (item & 31) * 8; int tt = t0 - 30 + rr; tt = tt < 0 ? 0 : tt;
            const bf16_t* pr = proj + ((size_t)b * T + tt) * LDP; av[n] = *(const u32x4*)(pr + C_CA + seg); gvv[n] = *(const u32x4*)(pr + C_CG + seg); }
#pragma unroll
        for (int n = 0; n < 6; ++n) { const int item = tid + 512 * n; if (item < 94 * 32) { const int rr = item >> 5, seg = (item & 31) * 8, tt = t0 - 30 + rr;
            u32x4 w = (u32x4){0u, 0u, 0u, 0u};
            if (tt >= 0) { float a[8], g[8], o[8]; unpack8(av[n], a); unpack8(gvv[n], g);
#pragma unroll
                for (int e = 0; e < 8; ++e) o[e] = a[e] * sigmoid_f(g[e]);
                w = pack8(o); }
            *(LAS u32x4*)(GL + rr * 256 + seg) = w; } }
    }
    LBAR();
    {
        const int ch = tid & 255, half = tid >> 8;
        float acc[32];
#pragma unroll
        for (int tk = 0; tk < 32; ++tk) acc[tk] = bias;
#pragma unroll
        for (int rr = 0; rr < 62; ++rr) { const float g = bf2f(GL[(half * 32 + rr) * 256 + ch]);
#pragma unroll
            for (int tk = 0; tk < 32; ++tk) { const int k = rr - tk; if (k >= 0 && k < 31) acc[tk] += w[k] * g; } }
#pragma unroll
        for (int tk = 0; tk < 32; ++tk) Y[(half * 32 + tk) * 256 + ch] = acc[tk];
    }
    LBAR();
    {
        const f32x4 lw = *((const f32x4*)(X.in[6] + layer * 256) + lane), lb = *((const f32x4*)(X.in[7] + layer * 256) + lane);
#pragma unroll 2
        for (int tk = wave * 8; tk < wave * 8 + 8; ++tk) {
            const f32x4 v = *((const LAS f32x4*)(Y + tk * 256) + lane);
            const float mu = wave_sum((v.x + v.y) + (v.z + v.w)) * (1.f / 256.f);
            const f32x4 dv = v - mu;
            const float var = wave_sum((dv.x * dv.x + dv.y * dv.y) + (dv.z * dv.z + dv.w * dv.w)) * (1.f / 256.f);
            const float rs = rsqrtf(var + 1e-5f);
            f32x4 o = dv * rs * lw + lb;
            const bool on = (MIX_MASK & 2) != 0;
            u32x2 p; p.x = on ? pk2(silu_acc(o.x), silu_acc(o.y)) : 0u; p.y = on ? pk2(silu_acc(o.z), silu_acc(o.w)) : 0u;
            *(u32x2*)(mix + ((size_t)b * T + t0 + tk) * D + 256 + lane * 4) = p;
        }
    }
    LBAR();
}

__device__ __forceinline__ void mixer_local_phase(const Ctx& X, LAS unsigned char* lds, int layer, int tid, int wave, int lane) {
    const int hs = wave >> 2, w4 = wave & 3; int tid_h = tid & 255;
    LAS unsigned char* hl = lds + hs * HEAD_LDS;
    const int nit_ = (3584 + (int)gridDim.x - 1) / (int)gridDim.x;
    for (int it_ = 0; it_ < nit_; ++it_) {
        const int u = (int)blockIdx.x + (int)gridDim.x * ((it_ + (int)(blockIdx.x >> 3)) % nit_);
        if (u >= 3584) continue;
        asm volatile("" : "+v"(tid_h), "+v"(lane), "+v"(tid));
        if (u < 3072) { const int mixer = u >> 10, idx = u & 1023, hp = idx & 1, cb = idx >> 1, b = cb >> 7, c = cb & 127, h = hp * 2 + hs;
            if (mixer == 0) { ret_unit(X, hl, b, c, h, tid_h, w4, lane);
            } else if (mixer == 1) { gdn_unit(X, hl, b, c, h, tid_h, w4, lane, layer);
            } else { hgrn_unit(X, hl, b, c, h, tid_h, w4, lane, layer);
            }
        } else { const int cb = u - 3072; conf_unit(X, lds, cb >> 7, cb & 127, tid, wave, lane, layer);
        }
    }
}

__device__ __forceinline__ void scan_phase(const Ctx& X, int wave, int lane) {
    const int job = blockIdx.x;
    if (job >= 192 || wave != 0) return;
    asm volatile("" : "+v"(lane));
    const int mixer = job >> 6, rem = job & 63, bh = rem >> 2, vg = rem & 3;
    const int uid0 = (mixer * 16 + bh) * NCH;
    const int r = lane & 15, q = lane >> 4;
    bf16_t* bc0 = WSP(bf16_t, WS_BCS) + (size_t)uid0 * 4096 + (vg * 4 * 64 + lane) * 4;
    float S[4][4];
#pragma unroll
    for (int t = 0; t < 4; ++t)
#pragma unroll
        for (int j = 0; j < 4; ++j) S[t][j] = 0.f;
    if (mixer == 1) {
        const bf16_t* mm0 = WSP(const bf16_t, WS_MM) + (size_t)(uid0 - 2048) * 4096;
        u32x2 cb[4][4], ca[4][4][2][2];
#define SCAN_LOAD_G(slot, cc) { const int c_ = (cc) < NCH ? (cc) : NCH - 1; const bf16_t* bcn = bc0 + (size_t)c_ * 4096; const bf16_t* mmn = mm0 + (size_t)c_ * 4096; \
            _Pragma("unroll") for (int t = 0; t < 4; ++t) { cb[slot][t] = *(const u32x2*)(bcn + 256 * t); \
                _Pragma("unroll") for (int s2 = 0; s2 < 2; ++s2) { const u32x4 w_ = *(const u32x4*)(mmn + ((t * 2 + s2) * 64 + lane) * 8); ca[slot][t][s2][0] = (u32x2){w_.x, w_.y}; ca[slot][t][s2][1] = (u32x2){w_.z, w_.w}; } } }
        SCAN_LOAD_G(0, 0) SCAN_LOAD_G(1, 1) SCAN_LOAD_G(2, 2)
#pragma unroll 1
        for (int c0 = 0; c0 < NCH; c0 += 4) {
#pragma unroll
            for (int k = 0; k < 4; ++k) {
                const int c = c0 + k;
                SCAN_LOAD_G((k + 3) & 3, c + 3)
                bf16_t* bcc = bc0 + (size_t)c * 4096;
                u32x2 sp[4];
#pragma unroll
                for (int t = 0; t < 4; ++t) { sp[t].x = pk2(S[t][0], S[t][1]); sp[t].y = pk2(S[t][2], S[t][3]);
                    asm volatile("" : "+v"(sp[t].x) : "v"(cb[k][t].x));
                    *(u32x2*)(bcc + 256 * t) = sp[t]; }
                bf16x8 bfr[2];
#pragma unroll
                for (int s2 = 0; s2 < 2; ++s2) { u32x4 w; w.x = sp[2 * s2].x; w.y = sp[2 * s2].y; w.z = sp[2 * s2 + 1].x; w.w = sp[2 * s2 + 1].y; bfr[s2] = __builtin_bit_cast(bf16x8, w); }
#pragma unroll
                for (int t = 0; t < 4; ++t) {
                    f32x4 acc = (f32x4){bf_lo(cb[k][t].x), bf_hi(cb[k][t].x), bf_lo(cb[k][t].y), bf_hi(cb[k][t].y)};
#pragma unroll
                    for (int s2 = 0; s2 < 2; ++s2) { u32x4 w; w.x = ca[k][t][s2][0].x; w.y = ca[k][t][s2][0].y; w.z = ca[k][t][s2][1].x; w.w = ca[k][t][s2][1].y;
                        acc = __builtin_amdgcn_mfma_f32_16x16x32_bf16(__builtin_bit_cast(bf16x8, w), bfr[s2], acc, 0, 0, 0); }
                    S[t][0] = acc[0]; S[t][1] = acc[1]; S[t][2] = acc[2]; S[t][3] = acc[3];
                }
            }
        }
#undef SCAN_LOAD_G
    } else {
        const int h = bh & 3;
        const float g64 = __expf(64.0f * log1pf(-exp2f(-5.0f - (float)h)));
        const float* mv0 = WSP(const float, WS_MVEC) + (size_t)(mixer == 2 ? uid0 - 2 * 2048 : 0) * 64 + 4 * q;
        u32x2 cb[4][4]; f32x4 cm[4][4];
#define SCAN_LOAD_D(slot, cc) { const int c_ = (cc) < NCH ? (cc) : NCH - 1; const bf16_t* bcn = bc0 + (size_t)c_ * 4096; \
            _Pragma("unroll") for (int t = 0; t < 4; ++t) { cb[slot][t] = *(const u32x2*)(bcn + 256 * t); cm[slot][t] = mixer == 2 ? *(const f32x4*)(mv0 + (size_t)c_ * 64 + 16 * t) : (f32x4){g64, g64, g64, g64}; } }
        SCAN_LOAD_D(0, 0) SCAN_LOAD_D(1, 1) SCAN_LOAD_D(2, 2)
#pragma unroll 1
        for (int c0 = 0; c0 < NCH; c0 += 4) {
#pragma unroll
            for (int k = 0; k < 4; ++k) {
                const int c = c0 + k;
                SCAN_LOAD_D((k + 3) & 3, c + 3)
                bf16_t* bcc = bc0 + (size_t)c * 4096;
#pragma unroll
                for (int t = 0; t < 4; ++t) { u32x2 sp; sp.x = pk2(S[t][0], S[t][1]); sp.y = pk2(S[t][2], S[t][3]);
                    asm volatile("" : "+v"(sp.x) : "v"(cb[k][t].x));
                    *(u32x2*)(bcc + 256 * t) = sp;
                    S[t][0] = cm[k][t].x * S[t][0] + bf_lo(cb[k][t].x); S[t][1] = cm[k][t].y * S[t][1] + bf_hi(cb[k][t].x);
                    S[t][2] = cm[k][t].z * S[t][2] + bf_lo(cb[k][t].y); S[t][3] = cm[k][t].w * S[t][3] + bf_hi(cb[k][t].y); }
            }
        }
#undef SCAN_LOAD_D
    }
}

__device__ __forceinline__ void mixer_out_phase(const Ctx& X, LAS unsigned char* lds, int layer, int tid, int wave, int lane) {
    constexpr int GP = 264;
    const bf16_t* proj = WSP(const bf16_t, WS_PROJ);
    bf16_t* mix = WSP(bf16_t, WS_MIX);
    for (int u = blockIdx.x; u < 1536; u += gridDim.x) {
        asm volatile("" : "+v"(lane), "+v"(tid));
        LAS bf16_t* GT = opq((LAS bf16_t*)lds);
        const int r = lane & 15, q = lane >> 4, h = wave >> 1, half = wave & 1;
        const int mixer = u >> 9, rem = u & 511, b = rem >> 7, c = rem & 127;
        const int uid = unit_id(mixer, b, h, c);
        const int goff = mixer == 0 ? C_RG : (mixer == 1 ? C_GG : C_HG), moff = mixer == 0 ? 0 : (mixer == 1 ? 512 : 768);
        const size_t row0 = (size_t)b * T + c * 64;
        u32x4 gv[4];
#pragma unroll
        for (int n = 0; n < 4; ++n) { const int idx = tid + 512 * n; gv[n] = *(const u32x4*)(proj + (row0 + (idx >> 5)) * LDP + goff + (idx & 31) * 8); }
        const bf16_t* qe = WSP(const bf16_t, WS_QEFF) + (size_t)uid * 4096;
        const bf16_t* st = WSP(const bf16_t, WS_BCS) + (size_t)uid * 4096;
        bf16x8 a[2][2], bb[4][2]; u32x4 ov[2][2];
#pragma unroll
        for (int rt = 0; rt < 2; ++rt) { const int rt4 = 2 * half + rt;
#pragma unroll
            for (int ks = 0; ks < 2; ++ks) a[rt][ks] = *(const bf16x8*)(qe + (16 * rt4 + r) * 64 + ks * 32 + q * 8);
            const u32x4* ol = (const u32x4*)(WSP(const bf16_t, WS_OLOC) + ((size_t)uid * 4 + rt4) * 1024 + lane * 16); ov[rt][0] = ol[0]; ov[rt][1] = ol[1]; }
#pragma unroll
        for (int ct = 0; ct < 4; ++ct)
#pragma unroll
            for (int ks = 0; ks < 2; ++ks) { const bf16_t* tb = st + (size_t)((ct * 4 + 2 * ks + (q >> 1)) * 64) * 4;
                const u32x2 lo = *(const u32x2*)(tb + ((2 * (q & 1)) * 16 + r) * 4), hi = *(const u32x2*)(tb + ((2 * (q & 1) + 1) * 16 + r) * 4);
                bb[ct][ks] = __builtin_bit_cast(bf16x8, (u32x4){lo.x, lo.y, hi.x, hi.y}); }
        const float* nw = mixer == 0 ? X.in[3] + layer * 256 + h * 64 : (mixer == 1 ? X.in[11] + layer * 64 : X.in[13] + layer * 64);
        float wv[4];
#pragma unroll
        for (int ct = 0; ct < 4; ++ct) wv[ct] = nw[16 * ct + r];
#pragma unroll
        for (int n = 0; n < 4; ++n) { const int idx = tid + 512 * n; *(LAS u32x4*)(GT + (idx >> 5) * GP + (idx & 31) * 8) = gv[n]; }
        LBAR();
        const bool on = ((MIX_MASK >> (mixer == 0 ? 0 : (mixer == 1 ? 2 : 3))) & 1) != 0;
#pragma unroll
        for (int rt = 0; rt < 2; ++rt) {
            f32x4 acc[4];
            acc[0] = (f32x4){bf_lo(ov[rt][0].x), bf_hi(ov[rt][0].x), bf_lo(ov[rt][0].y), bf_hi(ov[rt][0].y)}; acc[1] = (f32x4){bf_lo(ov[rt][0].z), bf_hi(ov[rt][0].z), bf_lo(ov[rt][0].w), bf_hi(ov[rt][0].w)};
            acc[2] = (f32x4){bf_lo(ov[rt][1].x), bf_hi(ov[rt][1].x), bf_lo(ov[rt][1].y), bf_hi(ov[rt][1].y)}; acc[3] = (f32x4){bf_lo(ov[rt][1].z), bf_hi(ov[rt][1].z), bf_lo(ov[rt][1].w), bf_hi(ov[rt][1].w)};
#pragma unroll
            for (int ct = 0; ct < 4; ++ct)
#pragma unroll
                for (int ks = 0; ks < 2; ++ks) acc[ct] = __builtin_amdgcn_mfma_f32_16x16x32_bf16(a[rt][ks], bb[ct][ks], acc[ct], 0, 0, 0);
#pragma unroll
            for (int j = 0; j < 4; ++j) {
                float sm = (acc[0][j] + acc[1][j]) + (acc[2][j] + acc[3][j]);
                sm += __shfl_xor(sm, 1); sm += __shfl_xor(sm, 2); sm += __shfl_xor(sm, 4); sm += __shfl_xor(sm, 8);
                const float mu = mixer == 0 ? sm * (1.f / 64.f) : 0.f;
                float d[4], s2 = 0.f;
#pragma unroll
                for (int ct = 0; ct < 4; ++ct) { d[ct] = acc[ct][j] - mu; s2 += d[ct] * d[ct]; }
                s2 += __shfl_xor(s2, 1); s2 += __shfl_xor(s2, 2); s2 += __shfl_xor(s2, 4); s2 += __shfl_xor(s2, 8);
                const float rs = rsqrtf(s2 * (1.f / 64.f) + (mixer == 0 ? 1e-5f : 1e-6f));
                const int ii = 16 * (2 * half + rt) + 4 * q + j;
#pragma unroll
                for (int ct = 0; ct < 4; ++ct) { LAS bf16_t* gp = GT + ii * GP + h * 64 + 16 * ct + r;
                    const float y = d[ct] * rs * wv[ct] * silu_acc(bf2f(*gp));
                    *gp = on ? f2bf(y) : (bf16_t)0; }
            }
        }
        LBAR();
#pragma unroll
        for (int n = 0; n < 4; ++n) { const int idx = tid + 512 * n; __builtin_nontemporal_store(*(const LAS u32x4*)(GT + (idx >> 5) * GP + (idx & 31) * 8), (u32x4*)(mix + (row0 + (idx >> 5)) * D + moff + (idx & 31) * 8)); }
        LBAR();
    }
}

constexpr int PREP_FIRST = (D / 64) * (NINP / 32), PREP_ALL = DEPTH * ((D / 64) * (NINP / 32) + (D / 64) * (D / 32) + 2 * (D / 64) * (DFF / 32) + (DFF / 64) * (D / 32));
__global__ void __launch_bounds__(512, 2) fwd_kernel(Ctx X) {
    extern __shared__ __attribute__((aligned(16))) unsigned char lds_raw[];
    LAS unsigned char* lds = (LAS unsigned char*)lds_raw;
    cg::grid_group grid = cg::this_grid();
    const int tid = threadIdx.x, lane = tid & 63, wave = __builtin_amdgcn_readfirstlane(tid >> 6);
    const int G = gridDim.x, gw = blockIdx.x * 8 + wave, ngw = G * 8;
    bf16_t* XS = (bf16_t*)X.out;
    bf16_t* XN = WSP(bf16_t, WS_XN); bf16_t* PROJ = WSP(bf16_t, WS_PROJ); bf16_t* ACT = WSP(bf16_t, WS_PROJ); bf16_t* MIX = WSP(bf16_t, WS_MIX);

    if (X.ws == nullptr) grid.sync();
    if (tid < 4) ((LAS unsigned*)(lds + LDS_BAR_OFF))[tid] = 0u;
    __syncthreads();
    (void)xcd_barrier_post(WSP(unsigned, WS_CTL), (volatile LAS unsigned*)(lds + LDS_BAR_OFF));
#define GSYNC() do { XcdBarrier b_; b_.bar = WSP(unsigned, WS_CTL); b_.x = xb_xcc_id(); b_.st = (volatile LAS unsigned*)(lds + LDS_BAR_OFF); xcd_barrier(b_); } while (0)
    prep_weights(X, lds, gw, ngw, wave, lane, 0, PREP_FIRST);
    for (int idx = blockIdx.x * 512 + tid; idx < DEPTH * 16 * D; idx += G * 512) { const int ll = idx >> 14, n = (idx >> 10) & 15, k = idx & 1023;
        WSP(bf16_t, WS_WBA)[idx] = n < 8 ? f2bf(X.in[2][((size_t)ll * D + k) * DIN + 2560 + n] * X.in[1][ll * D + k]) : (bf16_t)0; }
    cast_phase(X.in[0], XS, WSP(float, WS_RSA), gw, ngw, lane);
    GSYNC();
#pragma unroll 1
    for (int l = 0; l < DEPTH; ++l) {
        {
            pg8::Gemm g{XS, WSP(const bf16_t, WS_WIN) + (size_t)l * NINP * D, M, NINP, D}; pg8::StaticOrder S; S.init(M, NINP, G, (int)blockIdx.x);
            pg8::EpiProj E{PROJ, LDP, DIN, WSP(const float, WS_RSA)};
            pg8::gemm_phase<pg8::EpiProj, pg8::StaticOrder, true, true>(lds, g, S, E);
            int ln = lane; asm volatile("" : "+v"(ln));
            const int r = ln & 15, q = ln >> 4;
            for (int rb = blockIdx.x; rb < M / 128; rb += G) {
                const bf16_t* Ap = XS + (size_t)(rb * 128 + wave * 16 + r) * D + q * 8;
                const bf16_t* Bp = WSP(const bf16_t, WS_WBA) + (size_t)l * 16 * D + r * D + q * 8;
                f32x4 acc = (f32x4){0.f, 0.f, 0.f, 0.f};
#pragma unroll 8
                for (int ks = 0; ks < 32; ++ks) acc = __builtin_amdgcn_mfma_f32_16x16x32_bf16(*(const bf16x8*)(Ap + ks * 32), *(const bf16x8*)(Bp + ks * 32), acc, 0, 0, 0);
                if (r < 8) {
#pragma unroll
                    for (int j = 0; j < 4; ++j) { const int row = rb * 128 + wave * 16 + 4 * q + j;
                        WSP(float, WS_GBA)[(size_t)row * 8 + r] = acc[j] * rsqrtf(WSP(const float, WS_RSA)[row] * (1.0f / 1024.0f) + 1e-6f); } }
            }
        }
        GSYNC();
        int tz = tid; asm volatile("" : "+v"(tz));
        for (int i = blockIdx.x * 512 + tz; i < M; i += G * 512) { WSP(float, WS_RSA)[i] = 0.f; WSP(float, WS_RSB)[i] = 0.f; }
        mixer_local_phase(X, lds, l, tid, wave, lane);
        GSYNC();
        scan_phase(X, wave, lane);
        if (l == 0 && wave != 0) prep_weights(X, lds, blockIdx.x * 7 + wave - 1, G * 7, wave, lane, PREP_FIRST, PREP_ALL);
        GSYNC();
        mixer_out_phase(X, lds, l, tid, wave, lane);
        GSYNC();
        {
            pg8::Gemm g{MIX, WSP(const bf16_t, WS_WOUT) + (size_t)l * D * D, M, D, D}; pg8::StaticOrder S; S.init(M, D, G, (int)blockIdx.x);
            pg8::EpiResid E{l == 0 ? X.in[0] : nullptr, l == 0 ? nullptr : XS, nullptr, XN, D, WSP(float, WS_RSB)};
            pg8::gemm_phase<pg8::EpiResid, pg8::StaticOrder, true, true>(lds, g, S, E);
        }
        GSYNC();
        {
            pg8::Gemm g{XN, WSP(const bf16_t, WS_WGU) + (size_t)l * NGU * D, M, NGU, D}; pg8::StaticOrder S; S.init(M, NGU, G, (int)blockIdx.x);
            pg8::EpiSwiglu E{ACT, DFF, WSP(const float, WS_RSB)};
            pg8::gemm_phase<pg8::EpiSwiglu, pg8::StaticOrder, true, true>(lds, g, S, E);
        }
        GSYNC();
        {
            pg8::Gemm g{ACT, WSP(const bf16_t, WS_WDN) + (size_t)l * D * DFF, M, D, DFF}; pg8::StaticOrder S; S.init(M, D, G, (int)blockIdx.x);
            pg8::EpiResid E{nullptr, XN, l + 1 < DEPTH ? nullptr : X.out, l + 1 < DEPTH ? XS : nullptr, D, l + 1 < DEPTH ? WSP(float, WS_RSA) : nullptr};
            pg8::gemm_phase<pg8::EpiResid, pg8::StaticOrder, true, true>(lds, g, S, E);
        }
        GSYNC();
        if (l + 1 == DEPTH) norm_phase(X.out, X.in[19], nullptr, X.out, gw, ngw, lane);
    }
}

extern "C" void kernel_launch(void* const* d_in, const int* in_sizes, int n_in, void* d_out, int out_size, void* d_ws, size_t ws_size, hipStream_t stream) {
    static int grid = 0;
    if (grid == 0) {
        if (n_in != 20 || out_size != M * D || ws_size < WS_END) { fprintf(stderr, "kernel_launch: unexpected shapes (n_in %d, out %d, ws %zu)\n", n_in, out_size, ws_size); grid = -1; return; }
        int dev = 0, cus = 0, per_cu = 0;
        hipGetDevice(&dev); hipDeviceGetAttribute(&cus, hipDeviceAttributeMultiprocessorCount, dev);
        if (hipFuncSetAttribute((const void*)fwd_kernel, hipFuncAttributeMaxDynamicSharedMemorySize, LDS_BYTES) != hipSuccess) { fprintf(stderr, "kernel_launch: hipFuncSetAttribute failed\n"); grid = -1; return; }
        if (hipOccupancyMaxActiveBlocksPerMultiprocessor(&per_cu, (const void*)fwd_kernel, 512, LDS_BYTES) != hipSuccess || per_cu < 1) { fprintf(stderr, "kernel_launch: occupancy query says %d\n", per_cu); per_cu = 1; }
        (void)hipGetLastError();
        grid = cus * (per_cu > 1 ? 1 : per_cu);
    }
    if (grid < 0) return;
    Ctx X{};
    for (int i = 0; i < 20; ++i) X.in[i] = (const float*)d_in[i];
    X.out = (float*)d_out; X.ws = (unsigned char*)d_ws;
    void* args[] = {&X};
    if (hipMemsetAsync((char*)d_ws + WS_CTL, 0, 16384, stream) != hipSuccess) { fprintf(stderr, "kernel_launch: hipMemsetAsync of the barrier words failed\n"); return; }
    hipError_t e = hipLaunchCooperativeKernel((const void*)fwd_kernel, dim3(grid), dim3(512), args, LDS_BYTES, stream);
    if (e != hipSuccess) fprintf(stderr, "cooperative launch failed: %s (grid %d)\n", hipGetErrorString(e), grid);
}
```
